# Optimizing an MI355X kernel written in HIP

```python
import jax, jax.numpy as jnp
from jax import lax
import numpy as np

D_MODEL = 1024
BATCH = 4
SEQ = 8192
DEPTH = 1

CHUNK = 64
HEAD_DIM = 64
SB_HEADS = 8
FOX_HEADS = 8
SB_WIDTH = SB_HEADS * HEAD_DIM
FOX_WIDTH = FOX_HEADS * HEAD_DIM
MIX_WIDTH = SB_WIDTH + FOX_WIDTH
QUERY_BLOCK = 128
OFF_Q_SB = 0
OFF_K_SB = OFF_Q_SB + SB_WIDTH
OFF_V_SB = OFF_K_SB + SB_WIDTH
OFF_Q_FX = OFF_V_SB + SB_WIDTH
OFF_K_FX = OFF_Q_FX + FOX_WIDTH
OFF_V_FX = OFF_K_FX + FOX_WIDTH
OFF_F = OFF_V_FX + FOX_WIDTH
IN_COLS = OFF_F + FOX_HEADS
N_GROUPS = 4
EXPERTS_PER_GROUP = 8
N_EXPERTS = N_GROUPS * EXPERTS_PER_GROUP
TOP_K = 2
D_EXPERT = 512
DISPATCH_BLOCK = 128
PLE_DIM = 256
ALPHA = (2 * DEPTH) ** 0.25
BETA_INIT = (8 * DEPTH) ** -0.25
LN_EPS = 1e-5

kernel_name = 'sb_fox_hier_moe_deepnorm_ple_layer'


def layer_norm(x, g, b):
    xf = x.astype(jnp.float32)
    mu = jnp.mean(xf, axis=-1, keepdims=True)
    var = jnp.mean(jnp.square(xf - mu), axis=-1, keepdims=True)
    return ((xf - mu) * lax.rsqrt(var + LN_EPS) * g + b).astype(x.dtype)


def stick_breaking_block(q, k, v, t0):
    n_q, n_k = q.shape[2], k.shape[2]
    z = jnp.einsum('bhqd,bhkd->bhqk', q, k).astype(jnp.float32) * (HEAD_DIM ** -0.5)
    t_pos = t0 + jnp.arange(n_q)[:, None]
    s_pos = jnp.arange(n_k)[None, :]
    earlier = s_pos < t_pos
    log_keep = jnp.where(earlier, jax.nn.log_sigmoid(-z), 0.0)
    after_s = lax.cumsum(log_keep, axis=3, reverse=True) - log_keep
    w = jnp.where(earlier, jnp.exp(jax.nn.log_sigmoid(z) + after_s), 0.0)
    return jnp.einsum('bhqk,bhkd->bhqd', w.astype(v.dtype), v)


def forgetting_block(q, k, v, cf_q, cf_k, t0):
    n_q, n_k = q.shape[2], k.shape[2]
    z = jnp.einsum('bhqd,bhkd->bhqk', q, k).astype(jnp.float32) * (HEAD_DIM ** -0.5)
    z = z + cf_q[..., :, None] - cf_k[..., None, :]
    visible = jnp.arange(n_k)[None, :] <= (t0 + jnp.arange(n_q)[:, None])
    probs = jax.nn.softmax(jnp.where(visible, z, -jnp.inf), axis=-1)
    return jnp.einsum('bhqk,bhkd->bhqd', probs.astype(v.dtype), v)


def hybrid_token_mixer(x, w_in, b_forget, w_out):
    bsz, seq, _ = x.shape
    proj = jnp.einsum('bsd,de->bse', x, w_in)

    def heads(lo, n_heads):
        t = proj[..., lo:lo + n_heads * HEAD_DIM]
        return t.reshape(bsz, seq, n_heads, HEAD_DIM).transpose(0, 2, 1, 3)

    q_sb, k_sb, v_sb = heads(OFF_Q_SB, SB_HEADS), heads(OFF_K_SB, SB_HEADS), heads(OFF_V_SB, SB_HEADS)
    q_fx, k_fx, v_fx = heads(OFF_Q_FX, FOX_HEADS), heads(OFF_K_FX, FOX_HEADS), heads(OFF_V_FX, FOX_HEADS)
    f_logit = proj[..., OFF_F:OFF_F + FOX_HEADS].astype(jnp.float32) + b_forget.astype(jnp.float32)
    cum_log_f = jnp.cumsum(jax.nn.log_sigmoid(f_logit), axis=1).transpose(0, 2, 1)

    sb_out, fx_out = [], []
    for t0 in range(0, seq, QUERY_BLOCK):
        t1 = t0 + QUERY_BLOCK
        sb_out.append(stick_breaking_block(q_sb[:, :, t0:t1], k_sb[:, :, :t1], v_sb[:, :, :t1], t0))
        fx_out.append(forgetting_block(q_fx[:, :, t0:t1], k_fx[:, :, :t1], v_fx[:, :, :t1],
                                       cum_log_f[:, :, t0:t1], cum_log_f[:, :, :t1], t0))

    def merge(blocks):
        o = jnp.concatenate(blocks, axis=2)
        return o.transpose(0, 2, 1, 3).reshape(bsz, seq, -1)

    mixed = jnp.concatenate([merge(sb_out), merge(fx_out)], axis=-1)
    return jnp.einsum('bse,ed->bsd', mixed, w_out)


def hierarchical_moe(x_tok, w_group, b_group, w_router, b_router, w_gate, w_up, w_down):
    n, d = x_tok.shape
    xf = x_tok.astype(jnp.float32)
    g_logits = xf @ w_group.astype(jnp.float32) + b_group.astype(jnp.float32)
    g_prob = jax.nn.softmax(g_logits, axis=-1)
    g_sel = jnp.argmax(g_logits, axis=-1).astype(jnp.int32)
    e_logits = (xf @ w_router.astype(jnp.float32) + b_router.astype(jnp.float32))
    e_logits = e_logits.reshape(n, N_GROUPS, EXPERTS_PER_GROUP)
    e_in_group = jnp.take_along_axis(e_logits, g_sel[:, None, None], axis=1)[:, 0]
    top_val, top_loc = lax.top_k(e_in_group, TOP_K)
    gate = jax.nn.softmax(top_val, axis=-1) * jnp.take_along_axis(g_prob, g_sel[:, None], axis=1)
    expert_id = (g_sel[:, None] * EXPERTS_PER_GROUP + top_loc).astype(jnp.int32)

    m = n * TOP_K
    flat_e = expert_id.reshape(m)
    flat_tok = jnp.arange(m, dtype=jnp.int32) // TOP_K
    flat_w = gate.reshape(m)
    order = jnp.argsort(flat_e)
    e_sorted = flat_e[order]
    counts = jnp.bincount(flat_e, length=N_EXPERTS)
    starts = jnp.cumsum(counts) - counts
    padded = ((counts + DISPATCH_BLOCK - 1) // DISPATCH_BLOCK) * DISPATCH_BLOCK
    pad_end = jnp.cumsum(padded)
    pad_start = pad_end - padded
    dest = pad_start[e_sorted] + (jnp.arange(m, dtype=jnp.int32) - starts[e_sorted])
    cap = m + N_EXPERTS * DISPATCH_BLOCK
    n_blk = cap // DISPATCH_BLOCK
    tok_buf = jnp.zeros((cap,), jnp.int32).at[dest].set(flat_tok[order])
    w_buf = jnp.zeros((cap,), jnp.float32).at[dest].set(flat_w[order])
    blk_expert = jnp.minimum(
        jnp.searchsorted(pad_end, jnp.arange(n_blk) * DISPATCH_BLOCK, side='right'),
        N_EXPERTS - 1).astype(jnp.int32)

    def run_block(args):
        tok, e = args
        xb = x_tok[tok]
        hdn = jax.nn.silu(xb @ w_gate[e]) * (xb @ w_up[e])
        return hdn @ w_down[e]

    y = lax.map(run_block, (tok_buf.reshape(n_blk, DISPATCH_BLOCK), blk_expert))
    y = y.reshape(cap, d) * w_buf[:, None].astype(y.dtype)
    return jnp.zeros_like(x_tok).at[tok_buf].add(y)


def setup_inputs(seed: int = 0) -> dict:
    key = jax.random.key(seed)
    ks = jax.random.split(key, 20)
    nrm = jax.random.normal
    col_scale = np.ones((IN_COLS,), np.float32)
    col_scale[OFF_V_SB:OFF_V_SB + SB_WIDTH] = BETA_INIT
    col_scale[OFF_V_FX:OFF_V_FX + FOX_WIDTH] = BETA_INIT
    return {
        'x': nrm(ks[0], (BATCH, SEQ, D_MODEL), jnp.float32),
        'p': nrm(ks[1], (DEPTH, BATCH, SEQ, PLE_DIM), jnp.float32),
        'w_in': nrm(ks[2], (DEPTH, D_MODEL, IN_COLS), jnp.float32) * (D_MODEL ** -0.5) * jnp.asarray(col_scale),
        'b_forget': 3.0 + 0.1 * nrm(ks[3], (DEPTH, FOX_HEADS), jnp.float32),
        'w_out': nrm(ks[4], (DEPTH, MIX_WIDTH, D_MODEL), jnp.float32) * (MIX_WIDTH ** -0.5) * BETA_INIT,
        'ln_mix_g': 1.0 + 0.02 * nrm(ks[5], (DEPTH, D_MODEL), jnp.float32),
        'ln_mix_b': 0.02 * nrm(ks[6], (DEPTH, D_MODEL), jnp.float32),
        'w_group': nrm(ks[7], (DEPTH, D_MODEL, N_GROUPS), jnp.float32) * (D_MODEL ** -0.5),
        'b_group': 0.01 * nrm(ks[8], (DEPTH, N_GROUPS), jnp.float32),
        'w_router': nrm(ks[9], (DEPTH, D_MODEL, N_EXPERTS), jnp.float32) * (D_MODEL ** -0.5),
        'b_router': 0.01 * nrm(ks[10], (DEPTH, N_EXPERTS), jnp.float32),
        'w_gate': nrm(ks[11], (DEPTH, N_EXPERTS, D_MODEL, D_EXPERT), jnp.float32) * (D_MODEL ** -0.5),
        'w_up': nrm(ks[12], (DEPTH, N_EXPERTS, D_MODEL, D_EXPERT), jnp.float32) * (D_MODEL ** -0.5) * BETA_INIT,
        'w_down': nrm(ks[13], (DEPTH, N_EXPERTS, D_EXPERT, D_MODEL), jnp.float32) * (D_EXPERT ** -0.5) * BETA_INIT,
        'w_ple': nrm(ks[14], (DEPTH, PLE_DIM, D_MODEL), jnp.float32) * (PLE_DIM ** -0.5),
        'w_ple_gate': nrm(ks[15], (DEPTH, D_MODEL, D_MODEL), jnp.float32) * (D_MODEL ** -0.5),
        'ln_ffn_g': 1.0 + 0.02 * nrm(ks[16], (DEPTH, D_MODEL), jnp.float32),
        'ln_ffn_b': 0.02 * nrm(ks[17], (DEPTH, D_MODEL), jnp.float32),
    }


def reference(x, p, w_in, b_forget, w_out, ln_mix_g, ln_mix_b, w_group, b_group, w_router, b_router,
              w_gate, w_up, w_down, w_ple, w_ple_gate, ln_ffn_g, ln_ffn_b):
    bsz, seq, d = x.shape
    h = x
    for i in range(DEPTH):
        mix = hybrid_token_mixer(h, w_in[i], b_forget[i], w_out[i])
        h = layer_norm(ALPHA * h + mix, ln_mix_g[i], ln_mix_b[i])
        ffn = hierarchical_moe(h.reshape(bsz * seq, d), w_group[i], b_group[i], w_router[i], b_router[i],
                               w_gate[i], w_up[i], w_down[i]).reshape(bsz, seq, d)
        ple = jnp.einsum('bse,ed->bsd', p[i], w_ple[i]) * jax.nn.sigmoid(jnp.einsum('bsd,de->bse', h, w_ple_gate[i]))
        h = layer_norm(ALPHA * h + ffn + ple, ln_ffn_g[i], ln_ffn_b[i])
    return h
```

```cpp
#include <hip/hip_runtime.h>
#include <hip/hip_bf16.h>
#include <cstdio>
#include <cstdint>
#include <cmath>
namespace pg8 {
#define PG8_LAS __attribute__((address_space(3)))
typedef unsigned short bf16_t;
typedef short bf16x8 __attribute__((ext_vector_type(8)));
typedef float f32x4 __attribute__((ext_vector_type(4)));
typedef unsigned u32x4 __attribute__((ext_vector_type(4)));
constexpr int BM = 256, BK = 64, HALF = 128, HTB = HALF * BK * 2  , STAGE_BYTES = 8 * HTB, NXCD = 8, WGM = 8;

__host__ __device__ __forceinline__ int lds_byte(int r, int c) { const int st = (r >> 4) * 2 + (c >> 5), rr = r & 15, cc = c & 31, ob = rr * 64 + cc * 2; return st * 1024 + (ob ^ (((ob >> 9) & 1) << 5)); }
__host__ __device__ __forceinline__ void stage_rc(int b, int& R, int& C) { const int st = b / 1024, sb = b % 1024, swz = sb ^ (((sb >> 9) & 1) << 5); R = (st >> 1) * 16 + swz / 64; C = (st & 1) * 32 + (swz % 64) / 2; }
__host__ __device__ __forceinline__ int perm32(int rho) { const int n = rho >> 4, i = rho & 15; return 8 * (i >> 2) + 4 * n + (i & 3); }

struct Unit { int pm, pn; };
struct Gemm { const bf16_t* A; const bf16_t* Bt; int M, N, K; };

struct StaticOrder {
    int nM, nN, nwg, G, c;
    __host__ __device__ void init(int M, int N, int G_, int c_) { nM = M / BM; nN = N / BM; nwg = nM * nN; G = G_; c = c_; }
    __host__ __device__ bool next(int i, Unit& u) const {
        const long L = (long)i * G + c; if (L >= nwg) return false;
        int wgid = (int)L; { const int q = nwg / NXCD, r = nwg % NXCD, xcd = wgid % NXCD, off = wgid / NXCD; wgid = (xcd < r ? xcd * (q + 1) : r * (q + 1) + (xcd - r) * q) + off; }
        const int nig = WGM * nN, gid = wgid / nig, fm = gid * WGM, gsz = (nM - fm) < WGM ? (nM - fm) : WGM;
        u.pm = fm + ((wgid % nig) % gsz); u.pn = (wgid % nig) / gsz; return true;
    }
    __device__ __forceinline__ void a_ready(const Unit&) const {}
    __device__ __forceinline__ void done(const Unit&) const {}
};

__device__ __forceinline__ unsigned cvt_pk_bf16(float lo, float hi) { unsigned r; asm volatile("v_cvt_pk_bf16_f32 %0, %1, %2" : "=v"(r) : "v"(lo), "v"(hi)); return r; }
typedef float f32x2 __attribute__((ext_vector_type(2)));
__device__ __forceinline__ f32x2 gelu_pk(f32x2 v) {
    const f32x2 av = __builtin_elementwise_abs(v), d = av * 0.2316418882f + 1.0f;
    f32x2 t; t.x = __builtin_amdgcn_rcpf(d.x); t.y = __builtin_amdgcn_rcpf(d.y);
    f32x2 q = t * 0.5307027145f + (-0.7265760135f); q = q * t + 0.7107068705f; q = q * t + (-0.142248368f); q = q * t + 0.127414796f; q = q * t;
    const f32x2 s = (v * v) * (-0.72134752044f);
    f32x2 e; e.x = __builtin_amdgcn_exp2f(s.x); e.y = __builtin_amdgcn_exp2f(s.y);
    const f32x2 m = v * (q * e), r = v - m;
    f32x2 o; o.x = v.x < 0.f ? m.x : r.x; o.y = v.y < 0.f ? m.y : r.y; return o;
}

template <int ACT  > struct EpiBf16 {
    static constexpr bool PERM = true, AFTER_DRAIN = false; static_assert(ACT == 0 || ACT == 1, "EpiBf16: ACT is 0 (none) or 1 (gelu_pk)");
    bf16_t* O; int ldc; const float* bias; int split_cols; size_t split_stride; float scale0;
    __device__ __forceinline__ void operator()(const f32x4 (&acc)[2][2][4][2], const Unit& u, int wr, int wc, int fr, int fq) const {
        const int row0 = u.pm * BM + wr * 64 + fr; int colt = u.pn * BM; bf16_t* base = O;
        float sc = 1.f; if (split_cols) { const int t = colt / split_cols; base += (size_t)t * split_stride; colt -= t * split_cols; if (t == 0) sc = scale0; }
        const int col0 = colt + wc * 32 + 8 * fq, bcol0 = u.pn * BM + wc * 32 + 8 * fq;
        f32x4 bv[2][2];
#pragma unroll
        for (int bj = 0; bj < 2; ++bj)
#pragma unroll
            for (int n = 0; n < 2; ++n) bv[bj][n] = bias ? *(const f32x4*)(bias + bcol0 + bj * HALF + 4 * n) : (f32x4){0.f, 0.f, 0.f, 0.f};
#pragma unroll
        for (int ai = 0; ai < 2; ++ai)
#pragma unroll
            for (int m = 0; m < 4; ++m) { bf16_t* rowp = base + (size_t)(row0 + ai * HALF + m * 16) * ldc + col0;
#pragma unroll
                for (int bj = 0; bj < 2; ++bj) { f32x4 v0 = acc[ai][bj][m][0] + bv[bj][0], v1 = acc[ai][bj][m][1] + bv[bj][1];
                    if (ACT == 1) { f32x2 a = gelu_pk((f32x2){v0[0], v0[1]}), b = gelu_pk((f32x2){v0[2], v0[3]}), c = gelu_pk((f32x2){v1[0], v1[1]}), d = gelu_pk((f32x2){v1[2], v1[3]});
                        v0 = (f32x4){a.x, a.y, b.x, b.y}; v1 = (f32x4){c.x, c.y, d.x, d.y}; }
                    v0 = v0 * sc; v1 = v1 * sc; u32x4 w; w.x = cvt_pk_bf16(v0[0], v0[1]); w.y = cvt_pk_bf16(v0[2], v0[3]); w.z = cvt_pk_bf16(v1[0], v1[1]); w.w = cvt_pk_bf16(v1[2], v1[3]);
                    *(u32x4*)(rowp + bj * HALF) = w; } }
    }
};

struct PanelStats {
    unsigned* xbuf;
    unsigned* cnt;
    unsigned* tmo;
    int ntn; float eps;
    unsigned code;
    __device__ __forceinline__ bool run(const f32x4 (&v)[2][2][4][2], const Unit& u, int wr, int wc, int fr, int fq, PG8_LAS unsigned char* lds, int wid, int lane) const {
        typedef float f32x2v __attribute__((ext_vector_type(2)));
        PG8_LAS f32x2v* P = (PG8_LAS f32x2v*)lds;
        PG8_LAS f32x2v* S = (PG8_LAS f32x2v*)(lds + 8192);
        PG8_LAS unsigned* flag = (PG8_LAS unsigned*)(lds + 8192 + 2048);
#pragma unroll
        for (int ai = 0; ai < 2; ++ai)
#pragma unroll
            for (int m = 0; m < 4; ++m) {
                float s = 0.f;
#pragma unroll
                for (int bj = 0; bj < 2; ++bj)
#pragma unroll
                    for (int n = 0; n < 2; ++n) { const f32x4 x = v[ai][bj][m][n]; s += (x[0] + x[1]) + (x[2] + x[3]); }
                s += __shfl_xor(s, 16); s += __shfl_xor(s, 32);
                const float mw = s * (1.0f / 64.0f); float q = 0.f;
#pragma unroll
                for (int bj = 0; bj < 2; ++bj)
#pragma unroll
                    for (int n = 0; n < 2; ++n) { const f32x4 d = v[ai][bj][m][n] - mw; q += (d[0] * d[0] + d[1] * d[1]) + (d[2] * d[2] + d[3] * d[3]); }
                q += __shfl_xor(q, 16); q += __shfl_xor(q, 32);
                if (fq == 0) P[(ai * HALF + wr * 64 + m * 16 + fr) * 4 + wc] = (f32x2v){mw, q};
            }
        asm volatile("s_waitcnt lgkmcnt(0)" ::: "memory"); __builtin_amdgcn_s_barrier(); asm volatile("" ::: "memory");
#if defined(BROKEN_EXCHANGE_NO_WAIT)
#warning BROKEN CONTROL BUILD: the row-statistics exchange does not wait; results are wrong by design
        if (blockIdx.x >= 64) { const long long t0_ = clock64(); while (clock64() - t0_ < 60000) __builtin_amdgcn_s_sleep(8); }
#endif
        const int row = wid * 32 + (lane & 31);
        if (lane < 32) {
            const f32x2v a = P[row * 4 + 0], b = P[row * 4 + 1], c = P[row * 4 + 2], d = P[row * 4 + 3];
            const float mt = (a.x + b.x + c.x + d.x) * 0.25f;
            const float da = a.x - mt, db = b.x - mt, dc = c.x - mt, dd = d.x - mt;
            const float m2 = (a.y + b.y) + (c.y + d.y) + 64.0f * ((da * da + db * db) + (dc * dc + dd * dd));
            unsigned long long* slot = (unsigned long long*)xbuf + ((size_t)(u.pm * BM + row) * 4 + u.pn);
            __hip_atomic_store(slot, ((unsigned long long)__float_as_uint(m2) << 32) | __float_as_uint(mt), __ATOMIC_RELAXED, __HIP_MEMORY_SCOPE_AGENT);
        }
        asm volatile("s_waitcnt vmcnt(0)" ::: "memory");
        if (lane == 0) __hip_atomic_fetch_add(cnt + 64 * u.pm, 1u, __ATOMIC_RELAXED, __HIP_MEMORY_SCOPE_AGENT);
        if (wid == 0) {
            bool dead = false; const unsigned long long t0 = __builtin_amdgcn_s_memrealtime(); const unsigned want = 8u * (unsigned)ntn;
            for (;;) {
#if defined(BROKEN_EXCHANGE_NO_WAIT)
                break;
#endif
                if ((unsigned)__builtin_amdgcn_readfirstlane(__hip_atomic_load(cnt + 64 * u.pm, __ATOMIC_RELAXED, __HIP_MEMORY_SCOPE_AGENT)) >= want) break;
                if (__builtin_amdgcn_s_memrealtime() - t0 > 2000000ull) {
                    if (lane == 0) { unsigned expect = 0u; __hip_atomic_compare_exchange_strong(tmo + 1, &expect, code | (unsigned)(u.pm & 0xff), __ATOMIC_RELAXED, __ATOMIC_RELAXED, __HIP_MEMORY_SCOPE_AGENT);
                                     __hip_atomic_store(tmo, 1u, __ATOMIC_RELAXED, __HIP_MEMORY_SCOPE_AGENT); }
                    dead = true; break; }
                __builtin_amdgcn_s_sleep(2);
            }
            __builtin_amdgcn_fence(__ATOMIC_ACQUIRE, "agent");
            if (lane == 0) flag[0] = dead ? 1u : 0u;
        }
        asm volatile("s_waitcnt vmcnt(0) lgkmcnt(0)" ::: "memory"); __builtin_amdgcn_s_barrier(); asm volatile("" ::: "memory");
        const bool bad = flag[0] != 0u;
        if (lane < 32) {
            const unsigned long long* slot = (const unsigned long long*)xbuf + (size_t)(u.pm * BM + row) * 4; float mt[4], m2[4]; float ms = 0.f;
#pragma unroll
            for (int t = 0; t < 4; ++t) { if (t < ntn) { const unsigned long long w = __hip_atomic_load(slot + t, __ATOMIC_RELAXED, __HIP_MEMORY_SCOPE_AGENT); mt[t] = __uint_as_float((unsigned)w); m2[t] = __uint_as_float((unsigned)(w >> 32)); } else { mt[t] = 0.f; m2[t] = 0.f; } ms += mt[t]; }
            const float mean = ms / (float)ntn; float q = 0.f;
#pragma unroll
            for (int t = 0; t < 4; ++t) if (t < ntn) { const float dm = mt[t] - mean; q += m2[t] + 256.0f * dm * dm; }
            S[row] = (f32x2v){mean, 1.0f / sqrtf(q / (256.0f * (float)ntn) + eps)};
        }
        asm volatile("s_waitcnt lgkmcnt(0)" ::: "memory"); __builtin_amdgcn_s_barrier(); asm volatile("" ::: "memory");
        return bad;
    }
};
struct EpiLnRes {
    static constexpr bool PERM = false, AFTER_DRAIN = true;
    const float* base; float* out; int ldc; const float* bias; PanelStats st; unsigned poison;
    __device__ __forceinline__ void fused(f32x4 (&acc)[2][2][4][2], const Unit& u, int wr, int wc, int fr, int fq, PG8_LAS unsigned char* lds, int wid, int lane) const {
        typedef float f32x2v __attribute__((ext_vector_type(2)));
        const PG8_LAS f32x2v* S = (const PG8_LAS f32x2v*)(lds + 8192);
        const int col0 = u.pn * BM + wc * 32 + 4 * fq;
#pragma unroll
        for (int bj = 0; bj < 2; ++bj)
#pragma unroll
            for (int n = 0; n < 2; ++n) { const f32x4 bv = bias ? *(const f32x4*)(bias + col0 + bj * HALF + n * 16) : (f32x4){0.f, 0.f, 0.f, 0.f};
#pragma unroll
                for (int ai = 0; ai < 2; ++ai)
#pragma unroll
                    for (int m = 0; m < 4; ++m) acc[ai][bj][m][n] += bv; }
        f32x4 pre[4][2][2];
#pragma unroll
        for (int m = 0; m < 4; ++m) { const size_t off = (size_t)(u.pm * BM + wr * 64 + m * 16 + fr) * ldc + col0;
#pragma unroll
            for (int bj = 0; bj < 2; ++bj)
#pragma unroll
                for (int n = 0; n < 2; ++n) pre[m][bj][n] = *(const f32x4*)(base + off + bj * HALF + n * 16); }
        const bool bad = st.run(acc, u, wr, wc, fr, fq, lds, wid, lane) || poison != 0u;
        const float qnan = __builtin_nanf("");
#pragma unroll
        for (int ai = 0; ai < 2; ++ai)
#pragma unroll
            for (int m = 0; m < 4; ++m) { const int r = ai * HALF + wr * 64 + m * 16 + fr; const f32x2v sr = S[r]; const size_t off = (size_t)(u.pm * BM + r) * ldc + col0;
#pragma unroll
                for (int bj = 0; bj < 2; ++bj)
#pragma unroll
                    for (int n = 0; n < 2; ++n) { const f32x4 bs = ai == 0 ? pre[m][bj][n] : *(const f32x4*)(base + off + bj * HALF + n * 16); f32x4 o = bs + (acc[ai][bj][m][n] - sr.x) * sr.y;
                        if (bad) o = (f32x4){qnan, qnan, qnan, qnan}; *(f32x4*)(out + off + bj * HALF + n * 16) = o; }
                if (m & 1) asm volatile("" ::: "memory"); }
    }
};
struct EpiLnResLn {
    static constexpr bool PERM = false, AFTER_DRAIN = true;
    const float* base; float* out; bf16_t* xn; int ldc; const float* bias; PanelStats st1, st2; unsigned poison;
    __device__ __forceinline__ void fused(f32x4 (&acc)[2][2][4][2], const Unit& u, int wr, int wc, int fr, int fq, PG8_LAS unsigned char* lds, int wid, int lane) const {
        typedef float f32x2v __attribute__((ext_vector_type(2))); typedef unsigned u32x2v __attribute__((ext_vector_type(2)));
        const PG8_LAS f32x2v* S = (const PG8_LAS f32x2v*)(lds + 8192);
        const int col0 = u.pn * BM + wc * 32 + 4 * fq;
#pragma unroll
        for (int bj = 0; bj < 2; ++bj)
#pragma unroll
            for (int n = 0; n < 2; ++n) { const f32x4 bv = bias ? *(const f32x4*)(bias + col0 + bj * HALF + n * 16) : (f32x4){0.f, 0.f, 0.f, 0.f};
#pragma unroll
                for (int ai = 0; ai < 2; ++ai)
#pragma unroll
                    for (int m = 0; m < 4; ++m) acc[ai][bj][m][n] += bv; }
        bool bad = st1.run(acc, u, wr, wc, fr, fq, lds, wid, lane) || poison != 0u;
        const float qnan = __builtin_nanf("");
#pragma unroll
        for (int ai = 0; ai < 2; ++ai)
#pragma unroll
            for (int m = 0; m < 4; ++m) { const int r = ai * HALF + wr * 64 + m * 16 + fr; const f32x2v sr = S[r]; const size_t off = (size_t)(u.pm * BM + r) * ldc + col0;
#pragma unroll
                for (int bj = 0; bj < 2; ++bj)
#pragma unroll
                    for (int n = 0; n < 2; ++n) { const f32x4 bs = *(const f32x4*)(base + off + bj * HALF + n * 16); acc[ai][bj][m][n] = bs + (acc[ai][bj][m][n] - sr.x) * sr.y; }
                asm volatile("" : "+v"(acc[ai][0][m][0]), "+v"(acc[ai][0][m][1]), "+v"(acc[ai][1][m][0]), "+v"(acc[ai][1][m][1]));
                if (m & 1) asm volatile("" ::: "memory"); }
        const bool bad1 = bad;
        bad = st2.run(acc, u, wr, wc, fr, fq, lds, wid, lane) || bad;
#pragma unroll
        for (int ai = 0; ai < 2; ++ai)
#pragma unroll
            for (int m = 0; m < 4; ++m) { const int r = ai * HALF + wr * 64 + m * 16 + fr; const f32x2v sr = S[r]; const size_t off = (size_t)(u.pm * BM + r) * ldc + col0;
#pragma unroll
                for (int bj = 0; bj < 2; ++bj)
#pragma unroll
                    for (int n = 0; n < 2; ++n) { const f32x4 x1 = acc[ai][bj][m][n]; *(f32x4*)(out + off + bj * HALF + n * 16) = bad1 ? (f32x4){qnan, qnan, qnan, qnan} : x1;
                        const f32x4 o = (x1 - sr.x) * sr.y; u32x2v w; w.x = cvt_pk_bf16(o[0], o[1]); w.y = cvt_pk_bf16(o[2], o[3]);
                        if (bad) { w.x = 0x7fc07fc0u; w.y = 0x7fc07fc0u; } *(u32x2v*)(xn + off + bj * HALF + n * 16) = w; }
                asm volatile("" ::: "memory"); }
    }
};

template <class Epi, class Sched, bool ALIGN_EPI = false, bool SP2 = false>
__device__ __forceinline__ void gemm_phase(PG8_LAS unsigned char* lds, const Gemm g, const Sched& S, const Epi& E) {
    const int tid = threadIdx.x, wid = __builtin_amdgcn_readfirstlane(tid >> 6), lane = tid & 63, wr = wid >> 2, wc = wid & 3, fr = lane & 15, fq = lane >> 4;
    const int K = g.K, nt = K / BK;
    unsigned voffA[2], voffB[2];
#pragma unroll
    for (int i = 0; i < 2; ++i) { int R, C; stage_rc(tid * 16 + i * 8192, R, C); const int Rb = Epi::PERM ? ((R & ~31) + perm32(R & 31)) : R;
        voffA[i] = (unsigned)(R * K + C) * 2u; voffB[i] = (unsigned)(Rb * K + C) * 2u; }
    const size_t kstep = (size_t)(BK * 2);
    const size_t hstep = (size_t)HALF * K * 2;
    const size_t tstep = 2 * hstep;
    const unsigned ldsw = (unsigned)wid * 1024u;
    const int aoff = lds_byte(wr * 64 + fr, fq * 8), boff = lds_byte(wc * 32 + fr, fq * 8);
#define PG8_SA(b, h) (((b) * 2 + (h)) * HTB)
#define PG8_SB(b, h) ((4 + (b) * 2 + (h)) * HTB)
#define PG8_STAGE(bufoff, gbase, voff) do { _Pragma("unroll") for (int _i = 0; _i < 2; ++_i) \
        __builtin_amdgcn_global_load_lds((const unsigned*)((const char*)(gbase) + (voff)[_i]), (PG8_LAS unsigned*)(lds + (bufoff) + ldsw + _i * 8192), 16, 0, 0); } while (0)
#define PG8_LDA(dst, b, h) do { _Pragma("unroll") for (int m = 0; m < 4; ++m) _Pragma("unroll") for (int k = 0; k < 2; ++k) dst[m][k] = *(const PG8_LAS bf16x8*)(lds + PG8_SA(b, h) + aoff + m * 2048 + k * 1024); } while (0)
#define PG8_LDB(dst, b, h) do { _Pragma("unroll") for (int n = 0; n < 2; ++n) _Pragma("unroll") for (int k = 0; k < 2; ++k) dst[n][k] = *(const PG8_LAS bf16x8*)(lds + PG8_SB(b, h) + boff + n * 2048 + k * 1024); } while (0)
#define PG8_MMA(ai, bj, At, Bt) do { __builtin_amdgcn_s_setprio(1); _Pragma("unroll") for (int m = 0; m < 4; ++m) _Pragma("unroll") for (int n = 0; n < 2; ++n) _Pragma("unroll") for (int k = 0; k < 2; ++k) \
        acc[ai][bj][m][n] = __builtin_amdgcn_mfma_f32_16x16x32_bf16(Bt[n][k], At[m][k], acc[ai][bj][m][n], 0, 0, 0); __builtin_amdgcn_s_setprio(0); } while (0)
#define PG8_WAIT_V(n) asm volatile("s_waitcnt vmcnt(" #n ")" ::: "memory")
#define PG8_WAIT_L(n) asm volatile("s_waitcnt lgkmcnt(" #n ")" ::: "memory")
#define PG8_BAR __builtin_amdgcn_s_barrier()
#define PG8_SCHED __builtin_amdgcn_sched_barrier(0)
    Unit cur, nxt; int ui = 0;
    if (!S.next(0, cur)) return;
    f32x4 acc[2][2][4][2];
#pragma unroll
    for (int a = 0; a < 2; ++a)
#pragma unroll
        for (int b = 0; b < 2; ++b)
#pragma unroll
            for (int m = 0; m < 4; ++m)
#pragma unroll
                for (int n = 0; n < 2; ++n) acc[a][b][m][n] = (f32x4){0.f, 0.f, 0.f, 0.f};
    bf16x8 At[4][2], B0[2][2], B1[2][2];
    const char* cA = (const char*)g.A + (size_t)cur.pm * tstep; const char* cB = (const char*)g.Bt + (size_t)cur.pn * tstep;
    S.a_ready(cur);
    if constexpr (SP2) {
        PG8_STAGE(PG8_SB(0, 0), cB, voffB); PG8_STAGE(PG8_SB(0, 1), cB + hstep, voffB); PG8_STAGE(PG8_SA(0, 0), cA, voffA); PG8_STAGE(PG8_SA(0, 1), cA + hstep, voffA);
        if (wr == 1) PG8_BAR;
        PG8_WAIT_V(2); PG8_BAR;
        PG8_STAGE(PG8_SB(1, 0), cB + kstep, voffB); PG8_STAGE(PG8_SA(1, 0), cA + kstep, voffA); PG8_STAGE(PG8_SB(1, 1), cB + hstep + kstep, voffB);
        PG8_WAIT_V(6); PG8_BAR;
    } else {
        PG8_STAGE(PG8_SB(0, 0), cB, voffB); PG8_STAGE(PG8_SA(0, 0), cA, voffA); PG8_STAGE(PG8_SB(0, 1), cB + hstep, voffB); PG8_STAGE(PG8_SA(0, 1), cA + hstep, voffA);
        if (wr == 1) PG8_BAR;
        PG8_WAIT_V(4); PG8_BAR;
        PG8_STAGE(PG8_SB(1, 0), cB + kstep, voffB); PG8_STAGE(PG8_SA(1, 0), cA + kstep, voffA); PG8_STAGE(PG8_SB(1, 1), cB + hstep + kstep, voffB);
        PG8_WAIT_V(6); PG8_BAR;
    }
    for (;;) {
        const bool has_next = S.next(ui + 1, nxt);
        const char* nA = has_next ? (const char*)g.A + (size_t)nxt.pm * tstep : cA; const char* nB = has_next ? (const char*)g.Bt + (size_t)nxt.pn * tstep : cB;
        for (int t = 0; t < nt; t += 2) {
            const bool last = (t == nt - 2);
            const char* a1 = cA + (size_t)(t + 1) * kstep;
            const char* a2 = last ? nA : cA + (size_t)(t + 2) * kstep; const char* b2 = last ? nB : cB + (size_t)(t + 2) * kstep;
            const char* a3 = a2 + kstep; const char* b3 = b2 + kstep;
            if (last && has_next) S.a_ready(nxt);
            if constexpr (SP2) {
            PG8_LDB(B0, 0, 0); PG8_LDB(B1, 0, 1); PG8_SCHED; PG8_LDA(At, 0, 0); PG8_STAGE(PG8_SA(1, 1), a1 + hstep, voffA);
            PG8_WAIT_V(8); PG8_WAIT_L(0); PG8_BAR; PG8_MMA(0, 0, At, B0); PG8_MMA(0, 1, At, B1); PG8_BAR; PG8_SCHED;
            PG8_LDA(At, 0, 1); PG8_STAGE(PG8_SB(0, 0), b2, voffB); PG8_STAGE(PG8_SB(0, 1), b2 + hstep, voffB); PG8_STAGE(PG8_SA(0, 0), a2, voffA);
            PG8_WAIT_V(8); PG8_WAIT_L(0); PG8_BAR; PG8_MMA(1, 0, At, B0); PG8_MMA(1, 1, At, B1); PG8_BAR; PG8_SCHED;
            PG8_LDB(B0, 1, 0); PG8_LDB(B1, 1, 1); PG8_SCHED; PG8_LDA(At, 1, 0); PG8_STAGE(PG8_SA(0, 1), a2 + hstep, voffA);
            PG8_WAIT_V(8); PG8_WAIT_L(0); PG8_BAR; PG8_MMA(0, 0, At, B0); PG8_MMA(0, 1, At, B1); PG8_BAR; PG8_SCHED;
            PG8_LDA(At, 1, 1); PG8_STAGE(PG8_SB(1, 0), b3, voffB); PG8_STAGE(PG8_SB(1, 1), b3 + hstep, voffB); PG8_STAGE(PG8_SA(1, 0), a3, voffA);
            PG8_WAIT_V(8); PG8_WAIT_L(0); PG8_BAR; PG8_MMA(1, 0, At, B0); PG8_MMA(1, 1, At, B1); PG8_BAR; PG8_SCHED;
            } else {
            PG8_LDB(B0, 0, 0); PG8_SCHED; PG8_LDA(At, 0, 0); PG8_STAGE(PG8_SA(1, 1), a1 + hstep, voffA);
            PG8_WAIT_L(8); PG8_BAR; PG8_WAIT_L(0); PG8_MMA(0, 0, At, B0); PG8_BAR; PG8_SCHED;
            PG8_LDB(B1, 0, 1); PG8_STAGE(PG8_SB(0, 0), b2, voffB);
            PG8_BAR; PG8_WAIT_L(0); PG8_MMA(0, 1, At, B1); PG8_BAR;
            PG8_LDA(At, 0, 1); PG8_STAGE(PG8_SA(0, 0), a2, voffA);
            PG8_BAR; PG8_WAIT_L(0); PG8_MMA(1, 0, At, B0); PG8_BAR; PG8_SCHED;
            PG8_STAGE(PG8_SB(0, 1), b2 + hstep, voffB);
            PG8_WAIT_V(6); PG8_BAR; PG8_MMA(1, 1, At, B1); PG8_BAR;
            PG8_LDB(B0, 1, 0); PG8_SCHED; PG8_LDA(At, 1, 0); PG8_STAGE(PG8_SA(0, 1), a2 + hstep, voffA);
            PG8_WAIT_L(8); PG8_BAR; PG8_WAIT_L(0); PG8_MMA(0, 0, At, B0); PG8_BAR; PG8_SCHED;
            PG8_LDB(B1, 1, 1); PG8_STAGE(PG8_SB(1, 0), b3, voffB);
            PG8_BAR; PG8_WAIT_L(0); PG8_MMA(0, 1, At, B1); PG8_BAR;
            PG8_LDA(At, 1, 1); PG8_STAGE(PG8_SA(1, 0), a3, voffA);
            PG8_BAR; PG8_WAIT_L(0); PG8_MMA(1, 0, At, B0); PG8_BAR; PG8_SCHED;
            PG8_STAGE(PG8_SB(1, 1), b3 + hstep, voffB);
            PG8_WAIT_V(6); PG8_BAR; PG8_MMA(1, 1, At, B1); PG8_BAR;
            }
        }
        if constexpr (ALIGN_EPI) { if (wr == 0) PG8_BAR; }
        if constexpr (!Epi::AFTER_DRAIN) { E(acc, cur, wr, wc, fr, fq); S.done(cur); }
        if (!has_next) break;
#pragma unroll
        for (int a = 0; a < 2; ++a)
#pragma unroll
            for (int b = 0; b < 2; ++b)
#pragma unroll
                for (int m = 0; m < 4; ++m)
#pragma unroll
                    for (int n = 0; n < 2; ++n) acc[a][b][m][n] = (f32x4){0.f, 0.f, 0.f, 0.f};
        cur = nxt; cA = nA; cB = nB; ++ui;
        if constexpr (ALIGN_EPI) { if (wr == 1) PG8_BAR; }
    }
    PG8_WAIT_V(0);
    if constexpr (!ALIGN_EPI) { if (wr == 0) PG8_BAR; }
    PG8_BAR;
    if constexpr (Epi::AFTER_DRAIN) { E.fused(acc, cur, wr, wc, fr, fq, lds, wid, lane); S.done(cur); }
#undef PG8_SA
#undef PG8_SB
#undef PG8_STAGE
#undef PG8_LDA
#undef PG8_LDB
#undef PG8_MMA
#undef PG8_WAIT_V
#undef PG8_WAIT_L
#undef PG8_BAR
#undef PG8_SCHED
}
}
namespace pg8 {
template <class F> struct EpiScalar {
    static constexpr bool PERM = true, AFTER_DRAIN = false; F f;
    __device__ __forceinline__ void operator()(const f32x4 (&acc)[2][2][4][2], const Unit& u, int wr, int wc, int fr, int fq) const {
        const int row0 = u.pm * BM + wr * 64 + fr, col0 = u.pn * BM + wc * 32 + 8 * fq;
#pragma unroll
        for (int ai = 0; ai < 2; ++ai)
#pragma unroll
            for (int m = 0; m < 4; ++m) {
#pragma unroll
                for (int bj = 0; bj < 2; ++bj)
#pragma unroll
                    for (int n = 0; n < 2; ++n)
#pragma unroll
                        for (int e = 0; e < 4; ++e) f(row0 + ai * HALF + m * 16, col0 + bj * HALF + 4 * n + e, acc[ai][bj][m][n][e]);
                asm volatile("" ::: "memory"); }
    }
};
template <class F> struct EpiScalarPair {
    static constexpr bool PERM = true, AFTER_DRAIN = false; F f;
    __device__ __forceinline__ void operator()(const f32x4 (&acc)[2][2][4][2], const Unit& u, int wr, int wc, int fr, int fq) const {
        const int row0 = u.pm * BM + wr * 64 + fr, cl0 = wc * 32 + 8 * fq;
#pragma unroll
        for (int ai = 0; ai < 2; ++ai)
#pragma unroll
            for (int m = 0; m < 4; ++m) {
#pragma unroll
                for (int n = 0; n < 2; ++n)
#pragma unroll
                    for (int e = 0; e < 4; ++e) f(row0 + ai * HALF + m * 16, u.pn, cl0 + 4 * n + e, acc[ai][0][m][n][e], acc[ai][1][m][n][e]);
                asm volatile("" ::: "memory"); }
    }
};
}
#define GAS __attribute__((address_space(1)))
#define LAS __attribute__((address_space(3)))
typedef unsigned short bf16;
typedef unsigned v4u __attribute__((ext_vector_type(4)));
typedef float f32x4 __attribute__((ext_vector_type(4)));
typedef short bf16x8 __attribute__((ext_vector_type(8)));
typedef GAS unsigned gu32;
typedef GAS unsigned long long gu64;
#define RLX_AGENT __ATOMIC_RELAXED, __HIP_MEMORY_SCOPE_AGENT
#define LDS_WAIT() asm volatile("s_waitcnt lgkmcnt(0)" ::: "memory")
#define VM_WAIT() asm volatile("s_waitcnt vmcnt(0)" ::: "memory")
__device__ __forceinline__ unsigned long long rt() { return __builtin_amdgcn_s_memrealtime(); }
__device__ __forceinline__ unsigned f2bf(float f) { unsigned u = __builtin_bit_cast(unsigned, f); return (u + 0x7fffu + ((u >> 16) & 1u)) >> 16; }
__device__ __forceinline__ unsigned pk2(float lo, float hi) { return f2bf(lo) | (f2bf(hi) << 16); }

#define XB_TMO      128
#define XB_XCNT(j)  (256  + 64 * (j))
#define XB_XSUB(j)  (1280 + 64 * (j))
#define XB_XGEN(j)  (2304 + 64 * (j))
#define XB_TOP      3328
#define XB_TOPGEN   3392
#define XCD_BAR_WORDS 3456
#define XB_SPIN_CAP (1u << 18)

__device__ __forceinline__ unsigned xb_ld(unsigned* p)              { return __hip_atomic_load(p, __ATOMIC_RELAXED, __HIP_MEMORY_SCOPE_AGENT); }
__device__ __forceinline__ unsigned xb_add(unsigned* p, unsigned v) { return __hip_atomic_fetch_add(p, v, __ATOMIC_RELAXED, __HIP_MEMORY_SCOPE_AGENT); }
__device__ __forceinline__ unsigned xb_xcc_id() { return (unsigned)__builtin_amdgcn_s_getreg((3 << 11) | 20) & 0xFu; }
#define XB_SPIN(cond, bar) do { unsigned _sp = 0; while (cond) { __builtin_amdgcn_s_sleep(1); \
    if ((++_sp & 255u) == 0u) { if (xb_ld(&(bar)[XB_TMO])) break; if (_sp > XB_SPIN_CAP) { atomicAdd(&(bar)[XB_TMO], 1u); break; } } } } while (0)

struct XcdBarrier {
    unsigned* bar; unsigned x;
    volatile LAS unsigned* st;
};

__device__ __forceinline__ XcdBarrier xcd_barrier_post(unsigned* bar, volatile LAS unsigned* st) {
    XcdBarrier b; b.bar = bar; b.x = xb_xcc_id(); b.st = st;
    if (threadIdx.x == 0) (void)xb_add(&bar[XB_XCNT(b.x)], 1u);
    return b;
}
__device__ __forceinline__ void xcd_barrier_complete(unsigned* bar, unsigned x, unsigned& nloc, unsigned& nx) {
    const unsigned G = gridDim.x * gridDim.y * gridDim.z;
    unsigned sum, cnt, mine, sp = 0u;
    for (;;) {
        sum = 0u; cnt = 0u; mine = 0u;
#pragma unroll
        for (unsigned j = 0; j < 16; ++j) { const unsigned c = xb_ld(&bar[XB_XCNT(j)]); sum += c; cnt += (c > 0u) ? 1u : 0u; mine = (j == x) ? c : mine; }
        if (sum == G) break;
        __builtin_amdgcn_s_sleep(1);
        if ((++sp & 255u) == 0u) { if (xb_ld(&bar[XB_TMO])) break; if (sp > XB_SPIN_CAP) { atomicAdd(&bar[XB_TMO], 1u); break; } }
    }
    nloc = mine > 0u ? mine : 1u; nx = cnt > 0u ? cnt : 1u;
}

__device__ __forceinline__ void xcd_barrier(const XcdBarrier& b) {
    asm volatile("s_waitcnt vmcnt(0)" ::: "memory");
    __syncthreads();
    if (threadIdx.x == 0) {
        unsigned* bar = b.bar;
        __builtin_amdgcn_s_waitcnt(0);
        unsigned nloc = b.st[0], nx = b.st[1];
        if (nloc == 0u) { xcd_barrier_complete(bar, b.x, nloc, nx); b.st[0] = nloc; b.st[1] = nx; }
        const unsigned old = xb_add(&bar[XB_XSUB(b.x)], 1u);
        const unsigned gen = old / nloc;
        if (old + 1u == (gen + 1u) * nloc) {
            __builtin_amdgcn_fence(__ATOMIC_RELEASE, "agent");
            asm volatile("s_waitcnt vmcnt(0)" ::: "memory");
            const unsigned og = xb_add(&bar[XB_TOP], 1u);
            const unsigned tg = og / nx;
            if (og + 1u == (tg + 1u) * nx) xb_add(&bar[XB_TOPGEN], 1u);
            else XB_SPIN(xb_ld(&bar[XB_TOPGEN]) == tg, bar);
            __builtin_amdgcn_fence(__ATOMIC_ACQUIRE, "agent");
            xb_add(&bar[XB_XGEN(b.x)], 1u);
            asm volatile("s_waitcnt vmcnt(0)" ::: "memory");
        } else {
            XB_SPIN(xb_ld(&bar[XB_XGEN(b.x)]) == gen, bar);
            __builtin_amdgcn_fence(__ATOMIC_ACQUIRE, "agent");
            asm volatile("s_waitcnt vmcnt(0)" ::: "memory");
        }
    }
    __syncthreads();
}

constexpr int NWAVES = 8, NTHR = NWAVES * 64;
constexpr int BATCH = 4, SEQ = 8192, D = 1024, M = BATCH * SEQ;
constexpr int NHG = 8, HD = 64, HW = NHG * HD;
constexpr int INCOLS = 3080, NPROJ = 3072;
constexpr int NE = 32, NGRP = 4, EPG = 8, DF = 512, PLED = 256;
constexpr int SPAD = 2 * M + NE * 256;
constexpr float ALPHA = 1.189207115002721f, LN_EPS = 1e-5f, LOG2E = 1.4426950408889634f;
constexpr int NPH = 11;

constexpr size_t MiB = 1u << 20;
constexpr size_t WS_CTL = 0, CTL_ZERO_BYTES = 256 * 1024;
constexpr size_t WS_LS = 1 * MiB, WS_CFL = 2 * MiB, WS_CTOT = 3 * MiB, WS_KNT = 3 * MiB + 4096, WS_EID = 3 * MiB + 256 * 1024, WS_GATE = 3 * MiB + 512 * 1024, WS_RANK = 3 * MiB + 768 * 1024,
                 WS_SLOT = 4 * MiB, WS_GSLOT = 4 * MiB + 256 * 1024;
constexpr size_t WS_WIN = 5 * MiB, WS_WOUT = 11 * MiB, WS_WPLE = 13 * MiB, WS_WPG = 14 * MiB, WS_WGU = 16 * MiB, WS_WD = 80 * MiB, WS_PPLE = 112 * MiB;
constexpr size_t WS_R1 = 176 * MiB;
constexpr size_t WS_R2 = 368 * MiB;
constexpr size_t WS_R3 = 432 * MiB;
constexpr size_t WS_END = 504 * MiB;
static_assert(WS_GSLOT + (size_t)SPAD * 4 <= WS_WIN && WS_R1 + (size_t)SPAD * 2048 <= WS_R2 && WS_R3 + (size_t)SPAD * 1024 <= WS_END, "ws map");
constexpr int CW_TMO = 0, CW_BAR = 4096, CW_CNT = 8192;

constexpr int RING_OFF = 0, RING_BYTES = 131072;
constexpr int LDSCTL_OFF = RING_BYTES, MISC_OFF = LDSCTL_OFF + 320, PST_OFF = LDSCTL_OFF + 1024, HIST_OFF = LDSCTL_OFF + 1280, BASE_OFF = LDSCTL_OFF + 1408, ROWL_OFF = LDSCTL_OFF + 2048;
constexpr int LDS_BYTES = 147456;

__device__ __forceinline__ float bf2f(unsigned short v) { return __builtin_bit_cast(float, (unsigned)v << 16); }
__device__ __forceinline__ float wave_sum(float v) {
#pragma unroll
    for (int o = 1; o < 64; o <<= 1) v += __shfl_xor(v, o);
    return v;
}
__device__ __forceinline__ float wave_max(float v) {
#pragma unroll
    for (int o = 1; o < 64; o <<= 1) v = fmaxf(v, __shfl_xor(v, o));
    return v;
}

struct Frame {
    LAS unsigned char* lds; volatile LAS unsigned* MISC; gu32* ctl;
    int tid, lane, wave, vcu, G;
    const float *x, *p, *w_in, *b_forget, *w_out, *ln1g, *ln1b, *w_group, *b_group, *w_router, *b_router, *w_gate, *w_up, *w_down, *w_ple, *w_pg, *ln2g, *ln2b;
    float* out;
    bf16 *Win_t, *Wout_t, *Wple_t, *Wpg_t, *Wgu_t, *Wd_t, *pple, *qkv, *xs, *y, *xb, *mixed, *hb, *pb, *hdn;
    float *ls, *cfl, *ctot, *knt, *gatev, *gslot; int *eid, *rank, *slot;
};

__device__ __forceinline__ void transpose_tile(const float* Wt, int ldw, bf16* WTt, int ldt, LAS float* scr, int lane, float sc = 1.f) {
#pragma unroll 8
    for (int i = 0; i < 32; ++i) { const int kk = 2 * i + (lane >> 5); scr[kk * 33 + (lane & 31)] = Wt[(size_t)kk * ldw + (lane & 31)] * sc; }
    LDS_WAIT(); asm volatile("" ::: "memory");
    const int c = lane & 7;
#pragma unroll
    for (int j = 0; j < 4; ++j) { const int n = (lane >> 3) + 8 * j; const LAS float* s = scr + (8 * c) * 33 + n;
        v4u o; o.x = pk2(s[0 * 33], s[1 * 33]); o.y = pk2(s[2 * 33], s[3 * 33]); o.z = pk2(s[4 * 33], s[5 * 33]); o.w = pk2(s[6 * 33], s[7 * 33]);
        *(GAS v4u*)(WTt + (size_t)n * ldt + 8 * c) = o; }
    LDS_WAIT(); asm volatile("" ::: "memory");
}
__device__ __forceinline__ float log_sigmoid_f(float v) { return fminf(v, 0.f) - log1pf(expf(-fabsf(v))); }

__device__ __forceinline__ void p0_prologue(Frame& F) {
    LAS float* scr = (LAS float*)(F.lds + RING_OFF + F.wave * 16384);
    const int gw = F.vcu * NWAVES + F.wave, NGW = F.G * NWAVES;
    constexpr int I_IN = 16 * 96, I_OUT = 16 * 32, I_PLE = 4 * 32, I_PG = 16 * 32, I_GU = NE * 2 * 16 * 16, I_DN = NE * 8 * 32;
    constexpr int NITEMS = I_IN + I_OUT + I_PLE + I_PG + I_GU + I_DN;
    for (int it = gw; it < NITEMS; it += NGW) {
        int r = it;
        if (r < I_IN) { const int kb = r / 96, nb = r % 96; const int t = nb >> 4;
            transpose_tile(F.w_in + (size_t)kb * 64 * INCOLS + nb * 32, INCOLS, F.Win_t + (size_t)nb * 32 * D + kb * 64, D, scr, F.lane, (t == 0 || t == 3) ? 0.125f : 1.f); continue; } r -= I_IN;
        if (r < I_OUT) { const int kb = r / 32, nb = r % 32; transpose_tile(F.w_out + (size_t)kb * 64 * D + nb * 32, D, F.Wout_t + (size_t)nb * 32 * D + kb * 64, D, scr, F.lane); continue; } r -= I_OUT;
        if (r < I_PLE) { const int kb = r / 32, nb = r % 32; transpose_tile(F.w_ple + (size_t)kb * 64 * D + nb * 32, D, F.Wple_t + (size_t)nb * 32 * PLED + kb * 64, PLED, scr, F.lane); continue; } r -= I_PLE;
        if (r < I_PG) { const int kb = r / 32, nb = r % 32; transpose_tile(F.w_pg + (size_t)kb * 64 * D + nb * 32, D, F.Wpg_t + (size_t)nb * 32 * D + kb * 64, D, scr, F.lane); continue; } r -= I_PG;
        if (r < I_GU) { const int e = r / 512, gu = (r >> 8) & 1, kb = (r >> 4) & 15, nb = r & 15;
            const float* src = (gu ? F.w_up : F.w_gate) + (size_t)e * D * DF + (size_t)kb * 64 * DF + nb * 32;
            const int row = e * 1024 + (nb >> 2) * 256 + gu * 128 + (nb & 3) * 32;
            transpose_tile(src, DF, F.Wgu_t + (size_t)row * D + kb * 64, D, scr, F.lane); continue; } r -= I_GU;
        { const int e = r / 256, kb = (r >> 5) & 7, nb = r & 31;
            transpose_tile(F.w_down + (size_t)e * DF * D + (size_t)kb * 64 * D + nb * 32, D, F.Wd_t + (size_t)(e * 1024 + nb * 32) * DF + kb * 64, DF, scr, F.lane); }
    }
    __syncthreads();
    LAS float* wf = (LAS float*)(F.lds + RING_OFF);
    for (int i = F.tid; i < 2048; i += NTHR) { const int c = i >> 1, j0 = (i & 1) * 4; const f32x4 w = *(const GAS f32x4*)(F.w_in + (size_t)c * INCOLS + NPROJ + j0);
        wf[(j0 + 0) * 1024 + c] = w.x; wf[(j0 + 1) * 1024 + c] = w.y; wf[(j0 + 2) * 1024 + c] = w.z; wf[(j0 + 3) * 1024 + c] = w.w; }
    __syncthreads();
    for (int m = gw; m < M; m += NGW) {
        const GAS f32x4* xr = (const GAS f32x4*)(F.x + (size_t)m * D) + F.lane;
        f32x4 v[4];
#pragma unroll
        for (int j = 0; j < 4; ++j) v[j] = xr[64 * j];
        GAS unsigned long long* o8 = (GAS unsigned long long*)(F.xb + (size_t)m * D) + F.lane;
#pragma unroll
        for (int j = 0; j < 4; ++j) o8[64 * j] = (unsigned long long)pk2(v[j].x, v[j].y) | ((unsigned long long)pk2(v[j].z, v[j].w) << 32);
        float acc[8];
#pragma unroll
        for (int g = 0; g < 8; ++g) { float a = 0.f;
#pragma unroll
            for (int j = 0; j < 4; ++j) { const f32x4 w = *(const LAS f32x4*)(wf + g * 1024 + 4 * F.lane + 256 * j); a += (v[j].x * w.x + v[j].y * w.y) + (v[j].z * w.z + v[j].w * w.w); }
            acc[g] = wave_sum(a); }
        float mine = 0.f;
#pragma unroll
        for (int g = 0; g < 8; ++g) if (F.lane == g) mine = acc[g];
        if (F.lane < 8) F.ls[(size_t)m * 8 + F.lane] = log_sigmoid_f(mine + F.b_forget[F.lane]);
    }
    { const int gtid = blockIdx.x * NTHR + F.tid, NT = F.G * NTHR;
      for (int i = gtid; i < M * PLED / 8; i += NT) { const GAS f32x4* s = (const GAS f32x4*)(F.p) + 2 * (size_t)i; const f32x4 a = s[0], b = s[1];
          v4u o; o.x = pk2(a.x, a.y); o.y = pk2(a.z, a.w); o.z = pk2(b.x, b.y); o.w = pk2(b.z, b.w); ((GAS v4u*)F.pb)[i] = o; } }
}

__device__ __forceinline__ void p2_scan(Frame& F) {
    LAS float* wt = (LAS float*)(F.lds + RING_OFF);
    for (int it = blockIdx.x; it < 256; it += F.G) {
        const int bh = it >> 3, chunk = it & 7, b = bh >> 3, h = bh & 7, t = chunk * 1024 + 2 * F.tid;
        const float a0 = F.ls[(size_t)(b * SEQ + t) * 8 + h] * LOG2E, a1 = F.ls[(size_t)(b * SEQ + t + 1) * 8 + h] * LOG2E;
        float s = a0 + a1;
#pragma unroll
        for (int o = 1; o < 64; o <<= 1) { const float u = __shfl_up(s, o); if (F.lane >= o) s += u; }
        __syncthreads();
        if (F.lane == 63) wt[F.wave] = s;
        __syncthreads();
        float off = 0.f, tot = 0.f;
#pragma unroll
        for (int w = 0; w < 8; ++w) { const float u = wt[w]; if (w < F.wave) off += u; tot += u; }
        const float i1 = off + s, i0 = i1 - a1;
        F.cfl[(size_t)bh * SEQ + t] = i0; F.cfl[(size_t)bh * SEQ + t + 1] = i1;
        if (F.tid == 0) F.ctot[bh * 8 + chunk] = tot;
        const bf16* kf = F.qkv + (size_t)4 * M * HW;
        float nmax = 0.f;
#pragma unroll
        for (int rr = 0; rr < 2; ++rr) { const GAS v4u* kp = (const GAS v4u*)(kf + (size_t)(b * SEQ + t + rr) * HW + h * HD); float n2 = 0.f;
#pragma unroll
            for (int c = 0; c < 8; ++c) { const v4u w = kp[c];
#pragma unroll
                for (int e = 0; e < 4; ++e) { const float lo = __builtin_bit_cast(float, w[e] << 16), hi = __builtin_bit_cast(float, w[e] & 0xffff0000u); n2 += lo * lo + hi * hi; } }
            nmax = fmaxf(nmax, n2); }
#pragma unroll
        for (int o = 1; o < 32; o <<= 1) nmax = fmaxf(nmax, __shfl_xor(nmax, o));
        if ((F.lane & 31) == 0) F.knt[bh * 128 + chunk * 16 + F.wave * 2 + (F.lane >> 5)] = sqrtf(nmax);
    }
}

#define BFLO(w) __builtin_bit_cast(float, (w) << 16)
#define BFHI(w) __builtin_bit_cast(float, (w) & 0xffff0000u)
__device__ __forceinline__ void ld64(float (&d)[64], const bf16* p) {
    const GAS v4u* s = (const GAS v4u*)p;
#pragma unroll
    for (int c = 0; c < 8; ++c) { const v4u w = s[c];
#pragma unroll
        for (int e = 0; e < 4; ++e) { d[c * 8 + 2 * e] = BFLO(w[e]); d[c * 8 + 2 * e + 1] = BFHI(w[e]); } }
}
__device__ __forceinline__ float dot64(const float (&q)[64], const bf16* p) {
    const GAS v4u* s = (const GAS v4u*)p; float z = 0.f;
#pragma unroll
    for (int c = 0; c < 8; ++c) { const v4u w = s[c];
#pragma unroll
        for (int e = 0; e < 4; ++e) { z += q[c * 8 + 2 * e] * BFLO(w[e]); z += q[c * 8 + 2 * e + 1] * BFHI(w[e]); } }
    return z;
}
__device__ __forceinline__ void axpy64(float (&o)[64], float a, const bf16* p) {
    const GAS v4u* s = (const GAS v4u*)p;
#pragma unroll
    for (int c = 0; c < 8; ++c) { const v4u w = s[c];
#pragma unroll
        for (int e = 0; e < 4; ++e) { o[c * 8 + 2 * e] += a * BFLO(w[e]); o[c * 8 + 2 * e + 1] += a * BFHI(w[e]); } }
}
__device__ __forceinline__ void st64(bf16* p, const float (&d)[64], float sc) {
    GAS v4u* s = (GAS v4u*)p;
#pragma unroll
    for (int c = 0; c < 8; ++c) { v4u w;
#pragma unroll
        for (int e = 0; e < 4; ++e) w[e] = pk2(d[c * 8 + 2 * e] * sc, d[c * 8 + 2 * e + 1] * sc);
        s[c] = w; }
}
__device__ __forceinline__ void p3_attn_simple(Frame& F) {
    const int gtid = blockIdx.x * NTHR + F.tid, NT = F.G * NTHR;
    const bf16 *Qs = F.qkv, *Ks = F.qkv + (size_t)1 * M * HW, *Vs = F.qkv + (size_t)2 * M * HW, *Qf = F.qkv + (size_t)3 * M * HW, *Kf = F.qkv + (size_t)4 * M * HW, *Vf = F.qkv + (size_t)5 * M * HW;
    for (int idx = gtid; idx < M * NHG; idx += NT) {
        const int h = idx >> 15, m = idx & (M - 1), b = m >> 13, t = m & (SEQ - 1);
        float q[64], o[64];
        ld64(q, Qs + (size_t)m * HW + h * HD);
#pragma unroll
        for (int d = 0; d < 64; ++d) o[d] = 0.f;
        float C2 = 0.f;
        for (int s = t - 1; s >= 0; --s) {
            const float z = dot64(q, Ks + (size_t)(b * SEQ + s) * HW + h * HD);
            const float L2 = -(fmaxf(z, 0.f) * LOG2E + log2f(1.f + exp2f(-fabsf(z) * LOG2E)));
            const float w = exp2f(z * LOG2E + L2 + C2);
            axpy64(o, w, Vs + (size_t)(b * SEQ + s) * HW + h * HD);
            C2 += L2;
            if (C2 < -160.f) break;
        }
        st64(F.mixed + (size_t)m * D + h * HD, o, 1.f);
    }
    for (int idx = gtid; idx < M * NHG; idx += NT) {
        const int h = idx >> 15, m = idx & (M - 1), b = m >> 13, t = m & (SEQ - 1), bh = b * 8 + h;
        float q[64], o[64];
        ld64(q, Qf + (size_t)m * HW + h * HD);
#pragma unroll
        for (int d = 0; d < 64; ++d) o[d] = 0.f;
        float cq = F.cfl[(size_t)bh * SEQ + t];
        for (int c = 0; c < (t >> 10); ++c) cq += F.ctot[bh * 8 + c];
        float carry = 0.f, mr = -1e30f, l = 0.f;
        for (int s = 0; s <= t; ++s) {
            if ((s & 1023) == 0 && s > 0) carry += F.ctot[bh * 8 + (s >> 10) - 1];
            const float z = dot64(q, Kf + (size_t)(b * SEQ + s) * HW + h * HD);
            const float s2 = z * LOG2E + (cq - (F.cfl[(size_t)bh * SEQ + s] + carry));
            if (s2 > mr) { const float f = exp2f(mr - s2); l *= f;
#pragma unroll
                for (int d = 0; d < 64; ++d) o[d] *= f;
                mr = s2; }
            const float pw = exp2f(s2 - mr); l += pw;
            axpy64(o, pw, Vf + (size_t)(b * SEQ + s) * HW + h * HD);
        }
        st64(F.mixed + (size_t)m * D + HW + h * HD, o, 1.f / l);
    }
}

struct FProj { bf16* qkv; __device__ __forceinline__ void operator()(int row, int col, float v) const { const int t = col >> 9, cc = col & 511; const float sc = (t == 0 || t == 3) ? 0.125f : 1.f;
    qkv[(size_t)t * M * HW + (size_t)row * HW + cc] = (bf16)f2bf(v * sc); } };
struct FBf16 { bf16* O; int ldc; int cmask; __device__ __forceinline__ void operator()(int row, int col, float v) const { O[(size_t)row * ldc + (col & cmask)] = (bf16)f2bf(v); } };
struct FPre { const float* x; float* out; __device__ __forceinline__ void operator()(int row, int col, float v) const { const size_t i = (size_t)row * D + col; out[i] = ALPHA * x[i] + v; } };
struct FSwiglu { bf16* hdn; const float* gslot; __device__ __forceinline__ void operator()(int row, int pn, int cl, float g, float u) const {
    const int f = (pn & 3) * 128 + cl; const float s = g / (1.f + __expf(-g)); hdn[(size_t)row * DF + f] = (bf16)f2bf(s * u * gslot[row]); } };
struct FComb { float* out; const bf16* pple; const bf16* y; const int* slot; __device__ __forceinline__ void operator()(int row, int col, float v) const {
    const size_t i = (size_t)row * D + col; const int s0 = slot[row * 2], s1 = slot[row * 2 + 1]; const float sig = 1.f / (1.f + __expf(-v));
    out[i] = ALPHA * out[i] + bf2f(pple[i]) * sig + bf2f(y[(size_t)s0 * D + col]) + bf2f(y[(size_t)s1 * D + col]); } };

struct MoeOrder {
    const LAS int* pst; int nunits, G, c;
    __device__ __forceinline__ bool next(int i, pg8::Unit& u) const {
        const int L = i * G + c; if (L >= nunits) return false;
        const int pm = L >> 2, r0 = pm * 256; int e = 0;
        for (int k = 0; k < NE - 1; ++k) if (r0 >= pst[k + 1]) e = k + 1;
        u.pm = pm; u.pn = e * 4 + (L & 3); return true;
    }
    __device__ __forceinline__ void a_ready(const pg8::Unit&) const {}
    __device__ __forceinline__ void done(const pg8::Unit&) const {}
};
__device__ __forceinline__ void build_pstart(Frame& F) {
    LAS int* pst = (LAS int*)(F.lds + PST_OFF);
    if (F.tid == 0) { int acc = 0; for (int e = 0; e < NE; ++e) { const int c = (int)__hip_atomic_load(F.ctl + CW_CNT + 64 * e, RLX_AGENT); pst[e] = acc; acc += (c + 255) & ~255; } pst[NE] = acc; }
    __syncthreads();
}

__device__ __forceinline__ void p5_ln_route(Frame& F) {
    LAS unsigned* hist = (LAS unsigned*)(F.lds + HIST_OFF); LAS unsigned* base = (LAS unsigned*)(F.lds + BASE_OFF);
    LAS int* eidL = (LAS int*)(F.lds + ROWL_OFF); LAS int* rankL = eidL + 256;
    if (F.tid < NE) hist[F.tid] = 0u;
    __syncthreads();
    f32x4 gv[4], bv[4];
#pragma unroll
    for (int j = 0; j < 4; ++j) { gv[j] = *(const GAS f32x4*)(F.ln1g + 4 * F.lane + 256 * j); bv[j] = *(const GAS f32x4*)(F.ln1b + 4 * F.lane + 256 * j); }
    for (int r = F.wave; r < 128; r += NWAVES) {
        const int m = blockIdx.x * 128 + r;
        GAS f32x4* pr = (GAS f32x4*)(F.out + (size_t)m * D) + F.lane;
        f32x4 v[4]; float s = 0.f;
#pragma unroll
        for (int j = 0; j < 4; ++j) { v[j] = pr[64 * j]; s += (v[j].x + v[j].y) + (v[j].z + v[j].w); }
        const float mean = wave_sum(s) * (1.f / D); float s2 = 0.f;
#pragma unroll
        for (int j = 0; j < 4; ++j) { v[j] = v[j] - mean; s2 += (v[j].x * v[j].x + v[j].y * v[j].y) + (v[j].z * v[j].z + v[j].w * v[j].w); }
        const float rstd = 1.f / sqrtf(wave_sum(s2) * (1.f / D) + LN_EPS);
        GAS unsigned long long* o8 = (GAS unsigned long long*)(F.hb + (size_t)m * D) + F.lane;
#pragma unroll
        for (int j = 0; j < 4; ++j) { v[j] = v[j] * rstd * gv[j] + bv[j]; pr[64 * j] = v[j]; o8[64 * j] = (unsigned long long)pk2(v[j].x, v[j].y) | ((unsigned long long)pk2(v[j].z, v[j].w) << 32); }
        float gl[4] = {0.f, 0.f, 0.f, 0.f};
#pragma unroll
        for (int j = 0; j < 4; ++j)
#pragma unroll
            for (int e = 0; e < 4; ++e) { const int c = 4 * F.lane + 256 * j + e; const f32x4 w = *(const GAS f32x4*)(F.w_group + (size_t)c * 4); const float hv = v[j][e];
                gl[0] += hv * w.x; gl[1] += hv * w.y; gl[2] += hv * w.z; gl[3] += hv * w.w; }
#pragma unroll
        for (int i = 0; i < 4; ++i) gl[i] = wave_sum(gl[i]) + F.b_group[i];
        int gs = 0; float gm = gl[0];
#pragma unroll
        for (int i = 1; i < 4; ++i) if (gl[i] > gm) { gm = gl[i]; gs = i; }
        gs = __builtin_amdgcn_readfirstlane(gs);
        float gden = 0.f;
#pragma unroll
        for (int i = 0; i < 4; ++i) gden += expf(gl[i] - gm);
        const float gprob = 1.f / gden;
        float el[8] = {0.f, 0.f, 0.f, 0.f, 0.f, 0.f, 0.f, 0.f};
#pragma unroll
        for (int j = 0; j < 4; ++j)
#pragma unroll
            for (int e = 0; e < 4; ++e) { const int c = 4 * F.lane + 256 * j + e; const GAS f32x4* wp = (const GAS f32x4*)(F.w_router + (size_t)c * NE + gs * EPG); const f32x4 w0 = wp[0], w1 = wp[1]; const float hv = v[j][e];
                el[0] += hv * w0.x; el[1] += hv * w0.y; el[2] += hv * w0.z; el[3] += hv * w0.w; el[4] += hv * w1.x; el[5] += hv * w1.y; el[6] += hv * w1.z; el[7] += hv * w1.w; }
#pragma unroll
        for (int i = 0; i < 8; ++i) el[i] = wave_sum(el[i]) + F.b_router[gs * EPG + i];
        int i1 = 0; float v1 = el[0];
#pragma unroll
        for (int i = 1; i < 8; ++i) if (el[i] > v1) { v1 = el[i]; i1 = i; }
        int i2 = (i1 == 0) ? 1 : 0; float v2 = (i1 == 0) ? el[1] : el[0];
#pragma unroll
        for (int i = 1; i < 8; ++i) if (i != i1 && el[i] > v2) { v2 = el[i]; i2 = i; }
        const float e2 = expf(v2 - v1), g1 = 1.f / (1.f + e2), g2 = e2 * g1;
        if (F.lane == 0) {
            const int ea = gs * EPG + i1, eb = gs * EPG + i2;
            const unsigned ra = __hip_atomic_fetch_add(hist + ea, 1u, __ATOMIC_RELAXED, __HIP_MEMORY_SCOPE_WORKGROUP);
            const unsigned rb = __hip_atomic_fetch_add(hist + eb, 1u, __ATOMIC_RELAXED, __HIP_MEMORY_SCOPE_WORKGROUP);
            eidL[r * 2] = ea; eidL[r * 2 + 1] = eb; rankL[r * 2] = (int)ra; rankL[r * 2 + 1] = (int)rb;
            F.eid[m * 2] = ea; F.eid[m * 2 + 1] = eb; F.gatev[m * 2] = g1 * gprob; F.gatev[m * 2 + 1] = g2 * gprob;
        }
    }
    __syncthreads();
    if (F.tid < NE) base[F.tid] = __hip_atomic_fetch_add(F.ctl + CW_CNT + 64 * F.tid, hist[F.tid], RLX_AGENT);
    __syncthreads();
    if (F.tid < 256) F.rank[blockIdx.x * 256 + F.tid] = rankL[F.tid] + (int)base[eidL[F.tid]];
}
__device__ __forceinline__ void p6_slots_gather(Frame& F) {
    build_pstart(F);
    const LAS int* pst = (const LAS int*)(F.lds + PST_OFF);
    for (int r = F.wave; r < 128; r += NWAVES) {
        const int m = blockIdx.x * 128 + r; int s = 0;
        if (F.lane < 2) { const int e = F.eid[m * 2 + F.lane]; s = pst[e] + F.rank[m * 2 + F.lane]; F.slot[m * 2 + F.lane] = s; F.gslot[s] = F.gatev[m * 2 + F.lane]; }
        const int s0 = __shfl(s, 0), s1 = __shfl(s, 1);
        const GAS v4u* src = (const GAS v4u*)(F.hb + (size_t)m * D); const v4u a = src[F.lane], b = src[F.lane + 64];
        GAS v4u* d0 = (GAS v4u*)(F.xs + (size_t)s0 * D); GAS v4u* d1 = (GAS v4u*)(F.xs + (size_t)s1 * D);
        d0[F.lane] = a; d0[F.lane + 64] = b; d1[F.lane] = a; d1[F.lane + 64] = b;
    }
}
__device__ __forceinline__ void p10_final_ln(Frame& F, bool poison) {
    f32x4 gv[4], bv[4];
#pragma unroll
    for (int j = 0; j < 4; ++j) { gv[j] = *(const GAS f32x4*)(F.ln2g + 4 * F.lane + 256 * j); bv[j] = *(const GAS f32x4*)(F.ln2b + 4 * F.lane + 256 * j); }
    const int gw = blockIdx.x * NWAVES + F.wave, NGW = F.G * NWAVES; const float qn = __builtin_nanf("");
    for (int m = gw; m < M; m += NGW) {
        GAS f32x4* pr = (GAS f32x4*)(F.out + (size_t)m * D) + F.lane;
        f32x4 v[4]; float s = 0.f;
#pragma unroll
        for (int j = 0; j < 4; ++j) { v[j] = pr[64 * j]; s += (v[j].x + v[j].y) + (v[j].z + v[j].w); }
        const float mean = wave_sum(s) * (1.f / D); float s2 = 0.f;
#pragma unroll
        for (int j = 0; j < 4; ++j) { v[j] = v[j] - mean; s2 += (v[j].x * v[j].x + v[j].y * v[j].y) + (v[j].z * v[j].z + v[j].w * v[j].w); }
        const float rstd = 1.f / sqrtf(wave_sum(s2) * (1.f / D) + LN_EPS);
#pragma unroll
        for (int j = 0; j < 4; ++j) { f32x4 o = v[j] * rstd * gv[j] + bv[j]; if (poison) o = (f32x4){qn, qn, qn, qn}; pr[64 * j] = o; }
    }
}

struct Args { const float* in[18]; float* out; unsigned char* ws; int ph_lo, ph_hi; };
__global__ void __launch_bounds__(NTHR, 2) mk_fwd(Args args) {
    extern __shared__ __attribute__((aligned(16))) unsigned char lds[];
    Frame F;
    F.lds = (LAS unsigned char*)lds; F.MISC = (volatile LAS unsigned*)(F.lds + MISC_OFF);
    F.tid = threadIdx.x; F.lane = F.tid & 63; F.wave = __builtin_amdgcn_readfirstlane(F.tid >> 6);
    F.G = gridDim.x; { const int bx = blockIdx.x; F.vcu = (F.G % 8 == 0) ? (bx % 8) * (F.G / 8) + bx / 8 : bx; }
    unsigned char* ws = args.ws;
    F.ctl = (gu32*)(ws + WS_CTL);
    F.x = args.in[0]; F.p = args.in[1]; F.w_in = args.in[2]; F.b_forget = args.in[3]; F.w_out = args.in[4]; F.ln1g = args.in[5]; F.ln1b = args.in[6]; F.w_group = args.in[7]; F.b_group = args.in[8];
    F.w_router = args.in[9]; F.b_router = args.in[10]; F.w_gate = args.in[11]; F.w_up = args.in[12]; F.w_down = args.in[13]; F.w_ple = args.in[14]; F.w_pg = args.in[15]; F.ln2g = args.in[16]; F.ln2b = args.in[17];
    F.out = args.out;
    F.Win_t = (bf16*)(ws + WS_WIN); F.Wout_t = (bf16*)(ws + WS_WOUT); F.Wple_t = (bf16*)(ws + WS_WPLE); F.Wpg_t = (bf16*)(ws + WS_WPG); F.Wgu_t = (bf16*)(ws + WS_WGU); F.Wd_t = (bf16*)(ws + WS_WD);
    F.pple = (bf16*)(ws + WS_PPLE); F.qkv = (bf16*)(ws + WS_R1); F.xs = (bf16*)(ws + WS_R1); F.y = (bf16*)(ws + WS_R1);
    F.xb = (bf16*)(ws + WS_R2); F.mixed = (bf16*)(ws + WS_R2); F.hb = (bf16*)(ws + WS_R2); F.pb = (bf16*)(ws + WS_R3); F.hdn = (bf16*)(ws + WS_R3);
    F.ls = (float*)(ws + WS_LS); F.cfl = (float*)(ws + WS_CFL); F.ctot = (float*)(ws + WS_CTOT); F.knt = (float*)(ws + WS_KNT); F.gatev = (float*)(ws + WS_GATE); F.gslot = (float*)(ws + WS_GSLOT);
    F.eid = (int*)(ws + WS_EID); F.rank = (int*)(ws + WS_RANK); F.slot = (int*)(ws + WS_SLOT);
    for (int u = F.tid; u < (LDS_BYTES - LDSCTL_OFF) / 4; u += NTHR) ((LAS unsigned*)(F.lds + LDSCTL_OFF))[u] = 0u;
    __syncthreads();
    XcdBarrier bar = xcd_barrier_post((unsigned*)(F.ctl + CW_BAR), F.MISC + 8);
    const int lo = args.ph_lo, hi = args.ph_hi;
#ifndef PH_MASK
#define PH_MASK 0x7ff
#endif
#define IN(k) (((PH_MASK >> (k)) & 1) && lo <= (k) && (k) < hi)
#define SEAM(k) do { if (IN(k) && IN((k) + 1)) xcd_barrier(bar); } while (0)

    if (IN(0)) { p0_prologue(F); } SEAM(0);

    if (IN(1)) {
        { pg8::Gemm g{F.xb, F.Win_t, M, NPROJ, D}; pg8::StaticOrder S; S.init(M, NPROJ, F.G, (int)blockIdx.x);
          pg8::EpiBf16<0> E{F.qkv, HW, nullptr, HW, (size_t)M * HW, 1.f};
          pg8::gemm_phase<pg8::EpiBf16<0>, pg8::StaticOrder, true, true>(F.lds + RING_OFF, g, S, E); }
        { pg8::Gemm g{F.pb, F.Wple_t, M, D, PLED}; pg8::StaticOrder S; S.init(M, D, F.G, (int)blockIdx.x);
          pg8::EpiBf16<0> E{F.pple, D, nullptr, 0, 0, 1.f};
          pg8::gemm_phase<pg8::EpiBf16<0>, pg8::StaticOrder, true, true>(F.lds + RING_OFF, g, S, E); }
    } SEAM(1);

    if (IN(2)) { p2_scan(F); } SEAM(2);

    if (IN(3)) { p3_attn_simple(F); } SEAM(3);

    if (IN(4)) {
        pg8::Gemm g{F.mixed, F.Wout_t, M, D, D}; pg8::StaticOrder S; S.init(M, D, F.G, (int)blockIdx.x);
        pg8::EpiScalar<FPre> E{FPre{F.x, F.out}};
        pg8::gemm_phase<pg8::EpiScalar<FPre>, pg8::StaticOrder, true, true>(F.lds + RING_OFF, g, S, E);
    } SEAM(4);

    if (IN(5)) { p5_ln_route(F); } SEAM(5);

    if (IN(6)) { p6_slots_gather(F); } SEAM(6);

    if (IN(7)) {
        build_pstart(F);
        const LAS int* pst = (const LAS int*)(F.lds + PST_OFF);
        pg8::Gemm g{F.xs, F.Wgu_t, SPAD, NE * 1024, D}; MoeOrder S{pst, (pst[NE] >> 8) * 4, F.G, (int)blockIdx.x};
        pg8::EpiScalarPair<FSwiglu> E{FSwiglu{F.hdn, F.gslot}};
        pg8::gemm_phase<pg8::EpiScalarPair<FSwiglu>, MoeOrder, true, true>(F.lds + RING_OFF, g, S, E);
    } SEAM(7);

    if (IN(8)) {
        build_pstart(F);
        const LAS int* pst = (const LAS int*)(F.lds + PST_OFF);
        pg8::Gemm g{F.hdn, F.Wd_t, SPAD, NE * 1024, DF}; MoeOrder S{pst, (pst[NE] >> 8) * 4, F.G, (int)blockIdx.x};
        pg8::EpiScalar<FBf16> E{FBf16{F.y, D, 1023}};
        pg8::gemm_phase<pg8::EpiScalar<FBf16>, MoeOrder, true, true>(F.lds + RING_OFF, g, S, E);
    } SEAM(8);

    if (IN(9)) {
        pg8::Gemm g{F.hb, F.Wpg_t, M, D, D}; pg8::StaticOrder S; S.init(M, D, F.G, (int)blockIdx.x);
        pg8::EpiScalar<FComb> E{FComb{F.out, F.pple, F.y, F.slot}};
        pg8::gemm_phase<pg8::EpiScalar<FComb>, pg8::StaticOrder, true, true>(F.lds + RING_OFF, g, S, E);
    } SEAM(9);

    if (IN(10)) {
        const bool poison = __hip_atomic_load((gu32*)((unsigned*)(F.ctl + CW_BAR) + XB_TMO), RLX_AGENT) != 0u || F.G != 256;
        p10_final_ln(F, poison);
    }
#undef IN
#undef SEAM
}

#ifndef MK_CUTS
#define MK_CUTS 0
#endif
extern "C" void kernel_launch(void* const* d_in, const int* in_sizes, int n_in, void* d_out, int out_size, void* d_ws, size_t ws_size, hipStream_t stream) {
    static int grid = 0;
    if (grid == 0) {
        if (n_in != 18 || in_sizes[0] != M * D || out_size != M * D || ws_size < WS_END) { fprintf(stderr, "kernel_launch: shape/workspace mismatch (n_in %d, in0 %d, out %d, ws %zu)\n", n_in, n_in > 0 ? in_sizes[0] : -1, out_size, ws_size); grid = -1; return; }
        int dev = 0, cus = 0, per_cu = 0;
        if (hipGetDevice(&dev) != hipSuccess || hipDeviceGetAttribute(&cus, hipDeviceAttributeMultiprocessorCount, dev) != hipSuccess) { grid = -1; return; }
        if (hipFuncSetAttribute((const void*)mk_fwd, hipFuncAttributeMaxDynamicSharedMemorySize, LDS_BYTES) != hipSuccess) { fprintf(stderr, "kernel_launch: hipFuncSetAttribute failed\n"); grid = -1; return; }
        if (hipOccupancyMaxActiveBlocksPerMultiprocessor(&per_cu, (const void*)mk_fwd, NTHR, LDS_BYTES) != hipSuccess || per_cu < 1) fprintf(stderr, "kernel_launch: occupancy query reports %d\n", per_cu);
        (void)hipGetLastError();
        grid = cus;
        if (grid != 256) fprintf(stderr, "kernel_launch: %d CUs; this kernel is built for 256\n", grid);
    }
    if (grid < 0) return;
    if (hipMemsetAsync((char*)d_ws + WS_CTL, 0, CTL_ZERO_BYTES, stream) != hipSuccess) return;
    Args a{};
    for (int i = 0; i < 18; ++i) a.in[i] = (const float*)d_in[i];
    a.out = (float*)d_out; a.ws = (unsigned char*)d_ws;
#if MK_CUTS
    for (int ph = 0; ph < NPH; ++ph) { a.ph_lo = ph; a.ph_hi = ph + 1; hipLaunchKernelGGL(mk_fwd, dim3(grid), dim3(NTHR), LDS_BYTES, stream, a); }
#else
    a.ph_lo = 0; a.ph_hi = NPH;
    hipLaunchKernelGGL(mk_fwd, dim3(grid), dim3(NTHR), LDS_BYTES, stream, a);
#endif
}
```

```cpp
#include <hip/hip_runtime.h>
#include <hip/hip_bf16.h>
#include <cstdio>
#include <cstdint>
#include <cmath>
namespace pg8 {
#define PG8_LAS __attribute__((address_space(3)))
typedef unsigned short bf16_t;
typedef short bf16x8 __attribute__((ext_vector_type(8)));
typedef float f32x4 __attribute__((ext_vector_type(4)));
typedef unsigned u32x4 __attribute__((ext_vector_type(4)));
constexpr int BM = 256, BK = 64, HALF = 128, HTB = HALF * BK * 2  , STAGE_BYTES = 8 * HTB, NXCD = 8, WGM = 8;

__host__ __device__ __forceinline__ int lds_byte(int r, int c) { const int st = (r >> 4) * 2 + (c >> 5), rr = r & 15, cc = c & 31, ob = rr * 64 + cc * 2; return st * 1024 + (ob ^ (((ob >> 9) & 1) << 5)); }
__host__ __device__ __forceinline__ void stage_rc(int b, int& R, int& C) { const int st = b / 1024, sb = b % 1024, swz = sb ^ (((sb >> 9) & 1) << 5); R = (st >> 1) * 16 + swz / 64; C = (st & 1) * 32 + (swz % 64) / 2; }
__host__ __device__ __forceinline__ int perm32(int rho) { const int n = rho >> 4, i = rho & 15; return 8 * (i >> 2) + 4 * n + (i & 3); }

struct Unit { int pm, pn; };
struct Gemm { const bf16_t* A; const bf16_t* Bt; int M, N, K; };

struct StaticOrder {
    int nM, nN, nwg, G, c;
    __host__ __device__ void init(int M, int N, int G_, int c_) { nM = M / BM; nN = N / BM; nwg = nM * nN; G = G_; c = c_; }
    __host__ __device__ bool next(int i, Unit& u) const {
        const long L = (long)i * G + c; if (L >= nwg) return false;
        int wgid = (int)L; { const int q = nwg / NXCD, r = nwg % NXCD, xcd = wgid % NXCD, off = wgid / NXCD; wgid = (xcd < r ? xcd * (q + 1) : r * (q + 1) + (xcd - r) * q) + off; }
        const int nig = WGM * nN, gid = wgid / nig, fm = gid * WGM, gsz = (nM - fm) < WGM ? (nM - fm) : WGM;
        u.pm = fm + ((wgid % nig) % gsz); u.pn = (wgid % nig) / gsz; return true;
    }
    __device__ __forceinline__ void a_ready(const Unit&) const {}
    __device__ __forceinline__ void done(const Unit&) const {}
};

__device__ __forceinline__ unsigned cvt_pk_bf16(float lo, float hi) { unsigned r; asm volatile("v_cvt_pk_bf16_f32 %0, %1, %2" : "=v"(r) : "v"(lo), "v"(hi)); return r; }
typedef float f32x2 __attribute__((ext_vector_type(2)));
__device__ __forceinline__ f32x2 gelu_pk(f32x2 v) {
    const f32x2 av = __builtin_elementwise_abs(v), d = av * 0.2316418882f + 1.0f;
    f32x2 t; t.x = __builtin_amdgcn_rcpf(d.x); t.y = __builtin_amdgcn_rcpf(d.y);
    f32x2 q = t * 0.5307027145f + (-0.7265760135f); q = q * t + 0.7107068705f; q = q * t + (-0.142248368f); q = q * t + 0.127414796f; q = q * t;
    const f32x2 s = (v * v) * (-0.72134752044f);
    f32x2 e; e.x = __builtin_amdgcn_exp2f(s.x); e.y = __builtin_amdgcn_exp2f(s.y);
    const f32x2 m = v * (q * e), r = v - m;
    f32x2 o; o.x = v.x < 0.f ? m.x : r.x; o.y = v.y < 0.f ? m.y : r.y; return o;
}

template <int ACT  > struct EpiBf16 {
    static constexpr bool PERM = true, AFTER_DRAIN = false; static_assert(ACT == 0 || ACT == 1, "EpiBf16: ACT is 0 (none) or 1 (gelu_pk)");
    bf16_t* O; int ldc; const float* bias; int split_cols; size_t split_stride; float scale0;
    __device__ __forceinline__ void operator()(const f32x4 (&acc)[2][2][4][2], const Unit& u, int wr, int wc, int fr, int fq) const {
        const int row0 = u.pm * BM + wr * 64 + fr; int colt = u.pn * BM; bf16_t* base = O;
        float sc = 1.f; if (split_cols) { const int t = colt / split_cols; base += (size_t)t * split_stride; colt -= t * split_cols; if (t == 0) sc = scale0; }
        const int col0 = colt + wc * 32 + 8 * fq, bcol0 = u.pn * BM + wc * 32 + 8 * fq;
        f32x4 bv[2][2];
#pragma unroll
        for (int bj = 0; bj < 2; ++bj)
#pragma unroll
            for (int n = 0; n < 2; ++n) bv[bj][n] = bias ? *(const f32x4*)(bias + bcol0 + bj * HALF + 4 * n) : (f32x4){0.f, 0.f, 0.f, 0.f};
#pragma unroll
        for (int ai = 0; ai < 2; ++ai)
#pragma unroll
            for (int m = 0; m < 4; ++m) { bf16_t* rowp = base + (size_t)(row0 + ai * HALF + m * 16) * ldc + col0;
#pragma unroll
                for (int bj = 0; bj < 2; ++bj) { f32x4 v0 = acc[ai][bj][m][0] + bv[bj][0], v1 = acc[ai][bj][m][1] + bv[bj][1];
                    if (ACT == 1) { f32x2 a = gelu_pk((f32x2){v0[0], v0[1]}), b = gelu_pk((f32x2){v0[2], v0[3]}), c = gelu_pk((f32x2){v1[0], v1[1]}), d = gelu_pk((f32x2){v1[2], v1[3]});
                        v0 = (f32x4){a.x, a.y, b.x, b.y}; v1 = (f32x4){c.x, c.y, d.x, d.y}; }
                    v0 = v0 * sc; v1 = v1 * sc; u32x4 w; w.x = cvt_pk_bf16(v0[0], v0[1]); w.y = cvt_pk_bf16(v0[2], v0[3]); w.z = cvt_pk_bf16(v1[0], v1[1]); w.w = cvt_pk_bf16(v1[2], v1[3]);
                    *(u32x4*)(rowp + bj * HALF) = w; } }
    }
};

struct PanelStats {
    unsigned* xbuf;
    unsigned* cnt;
    unsigned* tmo;
    int ntn; float eps;
    unsigned code;
    __device__ __forceinline__ bool run(const f32x4 (&v)[2][2][4][2], const Unit& u, int wr, int wc, int fr, int fq, PG8_LAS unsigned char* lds, int wid, int lane) const {
        typedef float f32x2v __attribute__((ext_vector_type(2)));
        PG8_LAS f32x2v* P = (PG8_LAS f32x2v*)lds;
        PG8_LAS f32x2v* S = (PG8_LAS f32x2v*)(lds + 8192);
        PG8_LAS unsigned* flag = (PG8_LAS unsigned*)(lds + 8192 + 2048);
#pragma unroll
        for (int ai = 0; ai < 2; ++ai)
#pragma unroll
            for (int m = 0; m < 4; ++m) {
                float s = 0.f;
#pragma unroll
                for (int bj = 0; bj < 2; ++bj)
#pragma unroll
                    for (int n = 0; n < 2; ++n) { const f32x4 x = v[ai][bj][m][n]; s += (x[0] + x[1]) + (x[2] + x[3]); }
                s += __shfl_xor(s, 16); s += __shfl_xor(s, 32);
                const float mw = s * (1.0f / 64.0f); float q = 0.f;
#pragma unroll
                for (int bj = 0; bj < 2; ++bj)
#pragma unroll
                    for (int n = 0; n < 2; ++n) { const f32x4 d = v[ai][bj][m][n] - mw; q += (d[0] * d[0] + d[1] * d[1]) + (d[2] * d[2] + d[3] * d[3]); }
                q += __shfl_xor(q, 16); q += __shfl_xor(q, 32);
                if (fq == 0) P[(ai * HALF + wr * 64 + m * 16 + fr) * 4 + wc] = (f32x2v){mw, q};
            }
        asm volatile("s_waitcnt lgkmcnt(0)" ::: "memory"); __builtin_amdgcn_s_barrier(); asm volatile("" ::: "memory");
#if defined(BROKEN_EXCHANGE_NO_WAIT)
#warning BROKEN CONTROL BUILD: the row-statistics exchange does not wait; results are wrong by design
        if (blockIdx.x >= 64) { const long long t0_ = clock64(); while (clock64() - t0_ < 60000) __builtin_amdgcn_s_sleep(8); }
#endif
        const int row = wid * 32 + (lane & 31);
        if (lane < 32) {
            const f32x2v a = P[row * 4 + 0], b = P[row * 4 + 1], c = P[row * 4 + 2], d = P[row * 4 + 3];
            const float mt = (a.x + b.x + c.x + d.x) * 0.25f;
            const float da = a.x - mt, db = b.x - mt, dc = c.x - mt, dd = d.x - mt;
            const float m2 = (a.y + b.y) + (c.y + d.y) + 64.0f * ((da * da + db * db) + (dc * dc + dd * dd));
            unsigned long long* slot = (unsigned long long*)xbuf + ((size_t)(u.pm * BM + row) * 4 + u.pn);
            __hip_atomic_store(slot, ((unsigned long long)__float_as_uint(m2) << 32) | __float_as_uint(mt), __ATOMIC_RELAXED, __HIP_MEMORY_SCOPE_AGENT);
        }
        asm volatile("s_waitcnt vmcnt(0)" ::: "memory");
        if (lane == 0) __hip_atomic_fetch_add(cnt + 64 * u.pm, 1u, __ATOMIC_RELAXED, __HIP_MEMORY_SCOPE_AGENT);
        if (wid == 0) {
            bool dead = false; const unsigned long long t0 = __builtin_amdgcn_s_memrealtime(); const unsigned want = 8u * (unsigned)ntn;
            for (;;) {
#if defined(BROKEN_EXCHANGE_NO_WAIT)
                break;
#endif
                if ((unsigned)__builtin_amdgcn_readfirstlane(__hip_atomic_load(cnt + 64 * u.pm, __ATOMIC_RELAXED, __HIP_MEMORY_SCOPE_AGENT)) >= want) break;
                if (__builtin_amdgcn_s_memrealtime() - t0 > 2000000ull) {
                    if (lane == 0) { unsigned expect = 0u; __hip_atomic_compare_exchange_strong(tmo + 1, &expect, code | (unsigned)(u.pm & 0xff), __ATOMIC_RELAXED, __ATOMIC_RELAXED, __HIP_MEMORY_SCOPE_AGENT);
                                     __hip_atomic_store(tmo, 1u, __ATOMIC_RELAXED, __HIP_MEMORY_SCOPE_AGENT); }
                    dead = true; break; }
                __builtin_amdgcn_s_sleep(2);
            }
            __builtin_amdgcn_fence(__ATOMIC_ACQUIRE, "agent");
            if (lane == 0) flag[0] = dead ? 1u : 0u;
        }
        asm volatile("s_waitcnt vmcnt(0) lgkmcnt(0)" ::: "memory"); __builtin_amdgcn_s_barrier(); asm volatile("" ::: "memory");
        const bool bad = flag[0] != 0u;
        if (lane < 32) {
            const unsigned long long* slot = (const unsigned long long*)xbuf + (size_t)(u.pm * BM + row) * 4; float mt[4], m2[4]; float ms = 0.f;
#pragma unroll
            for (int t = 0; t < 4; ++t) { if (t < ntn) { const unsigned long long w = __hip_atomic_load(slot + t, __ATOMIC_RELAXED, __HIP_MEMORY_SCOPE_AGENT); mt[t] = __uint_as_float((unsigned)w); m2[t] = __uint_as_float((unsigned)(w >> 32)); } else { mt[t] = 0.f; m2[t] = 0.f; } ms += mt[t]; }
            const float mean = ms / (float)ntn; float q = 0.f;
#pragma unroll
            for (int t = 0; t < 4; ++t) if (t < ntn) { const float dm = mt[t] - mean; q += m2[t] + 256.0f * dm * dm; }
            S[row] = (f32x2v){mean, 1.0f / sqrtf(q / (256.0f * (float)ntn) + eps)};
        }
        asm volatile("s_waitcnt lgkmcnt(0)" ::: "memory"); __builtin_amdgcn_s_barrier(); asm volatile("" ::: "memory");
        return bad;
    }
};
struct EpiLnRes {
    static constexpr bool PERM = false, AFTER_DRAIN = true;
    const float* base; float* out; int ldc; const float* bias; PanelStats st; unsigned poison;
    __device__ __forceinline__ void fused(f32x4 (&acc)[2][2][4][2], const Unit& u, int wr, int wc, int fr, int fq, PG8_LAS unsigned char* lds, int wid, int lane) const {
        typedef float f32x2v __attribute__((ext_vector_type(2)));
        const PG8_LAS f32x2v* S = (const PG8_LAS f32x2v*)(lds + 8192);
        const int col0 = u.pn * BM + wc * 32 + 4 * fq;
#pragma unroll
        for (int bj = 0; bj < 2; ++bj)
#pragma unroll
            for (int n = 0; n < 2; ++n) { const f32x4 bv = bias ? *(const f32x4*)(bias + col0 + bj * HALF + n * 16) : (f32x4){0.f, 0.f, 0.f, 0.f};
#pragma unroll
                for (int ai = 0; ai < 2; ++ai)
#pragma unroll
                    for (int m = 0; m < 4; ++m) acc[ai][bj][m][n] += bv; }
        f32x4 pre[4][2][2];
#pragma unroll
        for (int m = 0; m < 4; ++m) { const size_t off = (size_t)(u.pm * BM + wr * 64 + m * 16 + fr) * ldc + col0;
#pragma unroll
            for (int bj = 0; bj < 2; ++bj)
#pragma unroll
                for (int n = 0; n < 2; ++n) pre[m][bj][n] = *(const f32x4*)(base + off + bj * HALF + n * 16); }
        const bool bad = st.run(acc, u, wr, wc, fr, fq, lds, wid, lane) || poison != 0u;
        const float qnan = __builtin_nanf("");
#pragma unroll
        for (int ai = 0; ai < 2; ++ai)
#pragma unroll
            for (int m = 0; m < 4; ++m) { const int r = ai * HALF + wr * 64 + m * 16 + fr; const f32x2v sr = S[r]; const size_t off = (size_t)(u.pm * BM + r) * ldc + col0;
#pragma unroll
                for (int bj = 0; bj < 2; ++bj)
#pragma unroll
                    for (int n = 0; n < 2; ++n) { const f32x4 bs = ai == 0 ? pre[m][bj][n] : *(const f32x4*)(base + off + bj * HALF + n * 16); f32x4 o = bs + (acc[ai][bj][m][n] - sr.x) * sr.y;
                        if (bad) o = (f32x4){qnan, qnan, qnan, qnan}; *(f32x4*)(out + off + bj * HALF + n * 16) = o; }
                if (m & 1) asm volatile("" ::: "memory"); }
    }
};
struct EpiLnResLn {
    static constexpr bool PERM = false, AFTER_DRAIN = true;
    const float* base; float* out; bf16_t* xn; int ldc; const float* bias; PanelStats st1, st2; unsigned poison;
    __device__ __forceinline__ void fused(f32x4 (&acc)[2][2][4][2], const Unit& u, int wr, int wc, int fr, int fq, PG8_LAS unsigned char* lds, int wid, int lane) const {
        typedef float f32x2v __attribute__((ext_vector_type(2))); typedef unsigned u32x2v __attribute__((ext_vector_type(2)));
        const PG8_LAS f32x2v* S = (const PG8_LAS f32x2v*)(lds + 8192);
        const int col0 = u.pn * BM + wc * 32 + 4 * fq;
#pragma unroll
        for (int bj = 0; bj < 2; ++bj)
#pragma unroll
            for (int n = 0; n < 2; ++n) { const f32x4 bv = bias ? *(const f32x4*)(bias + col0 + bj * HALF + n * 16) : (f32x4){0.f, 0.f, 0.f, 0.f};
#pragma unroll
                for (int ai = 0; ai < 2; ++ai)
#pragma unroll
                    for (int m = 0; m < 4; ++m) acc[ai][bj][m][n] += bv; }
        bool bad = st1.run(acc, u, wr, wc, fr, fq, lds, wid, lane) || poison != 0u;
        const float qnan = __builtin_nanf("");
#pragma unroll
        for (int ai = 0; ai < 2; ++ai)
#pragma unroll
            for (int m = 0; m < 4; ++m) { const int r = ai * HALF + wr * 64 + m * 16 + fr; const f32x2v sr = S[r]; const size_t off = (size_t)(u.pm * BM + r) * ldc + col0;
#pragma unroll
                for (int bj = 0; bj < 2; ++bj)
#pragma unroll
                    for (int n = 0; n < 2; ++n) { const f32x4 bs = *(const f32x4*)(base + off + bj * HALF + n * 16); acc[ai][bj][m][n] = bs + (acc[ai][bj][m][n] - sr.x) * sr.y; }
                asm volatile("" : "+v"(acc[ai][0][m][0]), "+v"(acc[ai][0][m][1]), "+v"(acc[ai][1][m][0]), "+v"(acc[ai][1][m][1]));
                if (m & 1) asm volatile("" ::: "memory"); }
        const bool bad1 = bad;
        bad = st2.run(acc, u, wr, wc, fr, fq, lds, wid, lane) || bad;
#pragma unroll
        for (int ai = 0; ai < 2; ++ai)
#pragma unroll
            for (int m = 0; m < 4; ++m) { const int r = ai * HALF + wr * 64 + m * 16 + fr; const f32x2v sr = S[r]; const size_t off = (size_t)(u.pm * BM + r) * ldc + col0;
#pragma unroll
                for (int bj = 0; bj < 2; ++bj)
#pragma unroll
                    for (int n = 0; n < 2; ++n) { const f32x4 x1 = acc[ai][bj][m][n]; *(f32x4*)(out + off + bj * HALF + n * 16) = bad1 ? (f32x4){qnan, qnan, qnan, qnan} : x1;
                        const f32x4 o = (x1 - sr.x) * sr.y; u32x2v w; w.x = cvt_pk_bf16(o[0], o[1]); w.y = cvt_pk_bf16(o[2], o[3]);
                        if (bad) { w.x = 0x7fc07fc0u; w.y = 0x7fc07fc0u; } *(u32x2v*)(xn + off + bj * HALF + n * 16) = w; }
                asm volatile("" ::: "memory"); }
    }
};

template <class Epi, class Sched, bool ALIGN_EPI = false, bool SP2 = false>
__device__ __forceinline__ void gemm_phase(PG8_LAS unsigned char* lds, const Gemm g, const Sched& S, const Epi& E) {
    const int tid = threadIdx.x, wid = __builtin_amdgcn_readfirstlane(tid >> 6), lane = tid & 63, wr = wid >> 2, wc = wid & 3, fr = lane & 15, fq = lane >> 4;
    const int K = g.K, nt = K / BK;
    unsigned voffA[2], voffB[2];
#pragma unroll
    for (int i = 0; i < 2; ++i) { int R, C; stage_rc(tid * 16 + i * 8192, R, C); const int Rb = Epi::PERM ? ((R & ~31) + perm32(R & 31)) : R;
        voffA[i] = (unsigned)(R * K + C) * 2u; voffB[i] = (unsigned)(Rb * K + C) * 2u; }
    const size_t kstep = (size_t)(BK * 2);
    const size_t hstep = (size_t)HALF * K * 2;
    const size_t tstep = 2 * hstep;
    const unsigned ldsw = (unsigned)wid * 1024u;
    const int aoff = lds_byte(wr * 64 + fr, fq * 8), boff = lds_byte(wc * 32 + fr, fq * 8);
#define PG8_SA(b, h) (((b) * 2 + (h)) * HTB)
#define PG8_SB(b, h) ((4 + (b) * 2 + (h)) * HTB)
#define PG8_STAGE(bufoff, gbase, voff) do { _Pragma("unroll") for (int _i = 0; _i < 2; ++_i) \
        __builtin_amdgcn_global_load_lds((const unsigned*)((const char*)(gbase) + (voff)[_i]), (PG8_LAS unsigned*)(lds + (bufoff) + ldsw + _i * 8192), 16, 0, 0); } while (0)
#define PG8_LDA(dst, b, h) do { _Pragma("unroll") for (int m = 0; m < 4; ++m) _Pragma("unroll") for (int k = 0; k < 2; ++k) dst[m][k] = *(const PG8_LAS bf16x8*)(lds + PG8_SA(b, h) + aoff + m * 2048 + k * 1024); } while (0)
#define PG8_LDB(dst, b, h) do { _Pragma("unroll") for (int n = 0; n < 2; ++n) _Pragma("unroll") for (int k = 0; k < 2; ++k) dst[n][k] = *(const PG8_LAS bf16x8*)(lds + PG8_SB(b, h) + boff + n * 2048 + k * 1024); } while (0)
#define PG8_MMA(ai, bj, At, Bt) do { __builtin_amdgcn_s_setprio(1); _Pragma("unroll") for (int m = 0; m < 4; ++m) _Pragma("unroll") for (int n = 0; n < 2; ++n) _Pragma("unroll") for (int k = 0; k < 2; ++k) \
        acc[ai][bj][m][n] = __builtin_amdgcn_mfma_f32_16x16x32_bf16(Bt[n][k], At[m][k], acc[ai][bj][m][n], 0, 0, 0); __builtin_amdgcn_s_setprio(0); } while (0)
#define PG8_WAIT_V(n) asm volatile("s_waitcnt vmcnt(" #n ")" ::: "memory")
#define PG8_WAIT_L(n) asm volatile("s_waitcnt lgkmcnt(" #n ")" ::: "memory")
#define PG8_BAR __builtin_amdgcn_s_barrier()
#define PG8_SCHED __builtin_amdgcn_sched_barrier(0)
    Unit cur, nxt; int ui = 0;
    if (!S.next(0, cur)) return;
    f32x4 acc[2][2][4][2];
#pragma unroll
    for (int a = 0; a < 2; ++a)
#pragma unroll
        for (int b = 0; b < 2; ++b)
#pragma unroll
            for (int m = 0; m < 4; ++m)
#pragma unroll
                for (int n = 0; n < 2; ++n) acc[a][b][m][n] = (f32x4){0.f, 0.f, 0.f, 0.f};
    bf16x8 At[4][2], B0[2][2], B1[2][2];
    const char* cA = (const char*)g.A + (size_t)cur.pm * tstep; const char* cB = (const char*)g.Bt + (size_t)cur.pn * tstep;
    S.a_ready(cur);
    if constexpr (SP2) {
        PG8_STAGE(PG8_SB(0, 0), cB, voffB); PG8_STAGE(PG8_SB(0, 1), cB + hstep, voffB); PG8_STAGE(PG8_SA(0, 0), cA, voffA); PG8_STAGE(PG8_SA(0, 1), cA + hstep, voffA);
        if (wr == 1) PG8_BAR;
        PG8_WAIT_V(2); PG8_BAR;
        PG8_STAGE(PG8_SB(1, 0), cB + kstep, voffB); PG8_STAGE(PG8_SA(1, 0), cA + kstep, voffA); PG8_STAGE(PG8_SB(1, 1), cB + hstep + kstep, voffB);
        PG8_WAIT_V(6); PG8_BAR;
    } else {
        PG8_STAGE(PG8_SB(0, 0), cB, voffB); PG8_STAGE(PG8_SA(0, 0), cA, voffA); PG8_STAGE(PG8_SB(0, 1), cB + hstep, voffB); PG8_STAGE(PG8_SA(0, 1), cA + hstep, voffA);
        if (wr == 1) PG8_BAR;
        PG8_WAIT_V(4); PG8_BAR;
        PG8_STAGE(PG8_SB(1, 0), cB + kstep, voffB); PG8_STAGE(PG8_SA(1, 0), cA + kstep, voffA); PG8_STAGE(PG8_SB(1, 1), cB + hstep + kstep, voffB);
        PG8_WAIT_V(6); PG8_BAR;
    }
    for (;;) {
        const bool has_next = S.next(ui + 1, nxt);
        const char* nA = has_next ? (const char*)g.A + (size_t)nxt.pm * tstep : cA; const char* nB = has_next ? (const char*)g.Bt + (size_t)nxt.pn * tstep : cB;
        for (int t = 0; t < nt; t += 2) {
            const bool last = (t == nt - 2);
            const char* a1 = cA + (size_t)(t + 1) * kstep;
            const char* a2 = last ? nA : cA + (size_t)(t + 2) * kstep; const char* b2 = last ? nB : cB + (size_t)(t + 2) * kstep;
            const char* a3 = a2 + kstep; const char* b3 = b2 + kstep;
            if (last && has_next) S.a_ready(nxt);
            if constexpr (SP2) {
            PG8_LDB(B0, 0, 0); PG8_LDB(B1, 0, 1); PG8_SCHED; PG8_LDA(At, 0, 0); PG8_STAGE(PG8_SA(1, 1), a1 + hstep, voffA);
            PG8_WAIT_V(8); PG8_WAIT_L(0); PG8_BAR; PG8_MMA(0, 0, At, B0); PG8_MMA(0, 1, At, B1); PG8_BAR; PG8_SCHED;
            PG8_LDA(At, 0, 1); PG8_STAGE(PG8_SB(0, 0), b2, voffB); PG8_STAGE(PG8_SB(0, 1), b2 + hstep, voffB); PG8_STAGE(PG8_SA(0, 0), a2, voffA);
            PG8_WAIT_V(8); PG8_WAIT_L(0); PG8_BAR; PG8_MMA(1, 0, At, B0); PG8_MMA(1, 1, At, B1); PG8_BAR; PG8_SCHED;
            PG8_LDB(B0, 1, 0); PG8_LDB(B1, 1, 1); PG8_SCHED; PG8_LDA(At, 1, 0); PG8_STAGE(PG8_SA(0, 1), a2 + hstep, voffA);
            PG8_WAIT_V(8); PG8_WAIT_L(0); PG8_BAR; PG8_MMA(0, 0, At, B0); PG8_MMA(0, 1, At, B1); PG8_BAR; PG8_SCHED;
            PG8_LDA(At, 1, 1); PG8_STAGE(PG8_SB(1, 0), b3, voffB); PG8_STAGE(PG8_SB(1, 1), b3 + hstep, voffB); PG8_STAGE(PG8_SA(1, 0), a3, voffA);
            PG8_WAIT_V(8); PG8_WAIT_L(0); PG8_BAR; PG8_MMA(1, 0, At, B0); PG8_MMA(1, 1, At, B1); PG8_BAR; PG8_SCHED;
            } else {
            PG8_LDB(B0, 0, 0); PG8_SCHED; PG8_LDA(At, 0, 0); PG8_STAGE(PG8_SA(1, 1), a1 + hstep, voffA);
            PG8_WAIT_L(8); PG8_BAR; PG8_WAIT_L(0); PG8_MMA(0, 0, At, B0); PG8_BAR; PG8_SCHED;
            PG8_LDB(B1, 0, 1); PG8_STAGE(PG8_SB(0, 0), b2, voffB);
            PG8_BAR; PG8_WAIT_L(0); PG8_MMA(0, 1, At, B1); PG8_BAR;
            PG8_LDA(At, 0, 1); PG8_STAGE(PG8_SA(0, 0), a2, voffA);
            PG8_BAR; PG8_WAIT_L(0); PG8_MMA(1, 0, At, B0); PG8_BAR; PG8_SCHED;
            PG8_STAGE(PG8_SB(0, 1), b2 + hstep, voffB);
            PG8_WAIT_V(6); PG8_BAR; PG8_MMA(1, 1, At, B1); PG8_BAR;
            PG8_LDB(B0, 1, 0); PG8_SCHED; PG8_LDA(At, 1, 0); PG8_STAGE(PG8_SA(0, 1), a2 + hstep, voffA);
            PG8_WAIT_L(8); PG8_BAR; PG8_WAIT_L(0); PG8_MMA(0, 0, At, B0); PG8_BAR; PG8_SCHED;
            PG8_LDB(B1, 1, 1); PG8_STAGE(PG8_SB(1, 0), b3, voffB);
            PG8_BAR; PG8_WAIT_L(0); PG8_MMA(0, 1, At, B1); PG8_BAR;
            PG8_LDA(At, 1, 1); PG8_STAGE(PG8_SA(1, 0), a3, voffA);
            PG8_BAR; PG8_WAIT_L(0); PG8_MMA(1, 0, At, B0); PG8_BAR; PG8_SCHED;
            PG8_STAGE(PG8_SB(1, 1), b3 + hstep, voffB);
            PG8_WAIT_V(6); PG8_BAR; PG8_MMA(1, 1, At, B1); PG8_BAR;
            }
        }
        if constexpr (ALIGN_EPI) { if (wr == 0) PG8_BAR; }
        if constexpr (!Epi::AFTER_DRAIN) { E(acc, cur, wr, wc, fr, fq); S.done(cur); }
        if (!has_next) break;
#pragma unroll
        for (int a = 0; a < 2; ++a)
#pragma unroll
            for (int b = 0; b < 2; ++b)
#pragma unroll
                for (int m = 0; m < 4; ++m)
#pragma unroll
                    for (int n = 0; n < 2; ++n) acc[a][b][m][n] = (f32x4){0.f, 0.f, 0.f, 0.f};
        cur = nxt; cA = nA; cB = nB; ++ui;
        if constexpr (ALIGN_EPI) { if (wr == 1) PG8_BAR; }
    }
    PG8_WAIT_V(0);
    if constexpr (!ALIGN_EPI) { if (wr == 0) PG8_BAR; }
    PG8_BAR;
    if constexpr (Epi::AFTER_DRAIN) { E.fused(acc, cur, wr, wc, fr, fq, lds, wid, lane); S.done(cur); }
#undef PG8_SA
#undef PG8_SB
#undef PG8_STAGE
#undef PG8_LDA
#undef PG8_LDB
#undef PG8_MMA
#undef PG8_WAIT_V
#undef PG8_WAIT_L
#undef PG8_BAR
#undef PG8_SCHED
}
}
namespace pg8 {
template <class F> struct EpiScalar {
    static constexpr bool PERM = true, AFTER_DRAIN = false; F f;
    __device__ __forceinline__ void operator()(const f32x4 (&acc)[2][2][4][2], const Unit& u, int wr, int wc, int fr, int fq) const {
        const int row0 = u.pm * BM + wr * 64 + fr, col0 = u.pn * BM + wc * 32 + 8 * fq;
#pragma unroll
        for (int ai = 0; ai < 2; ++ai)
#pragma unroll
            for (int m = 0; m < 4; ++m) {
#pragma unroll
                for (int bj = 0; bj < 2; ++bj)
#pragma unroll
                    for (int n = 0; n < 2; ++n)
#pragma unroll
                        for (int e = 0; e < 4; ++e) f(row0 + ai * HALF + m * 16, col0 + bj * HALF + 4 * n + e, acc[ai][bj][m][n][e]);
                asm volatile("" ::: "memory"); }
    }
};
template <class F> struct EpiScalarPair {
    static constexpr bool PERM = true, AFTER_DRAIN = false; F f;
    __device__ __forceinline__ void operator()(const f32x4 (&acc)[2][2][4][2], const Unit& u, int wr, int wc, int fr, int fq) const {
        const int row0 = u.pm * BM + wr * 64 + fr, cl0 = wc * 32 + 8 * fq;
#pragma unroll
        for (int ai = 0; ai < 2; ++ai)
#pragma unroll
            for (int m = 0; m < 4; ++m) {
#pragma unroll
                for (int n = 0; n < 2; ++n)
#pragma unroll
                    for (int e = 0; e < 4; ++e) f(row0 + ai * HALF + m * 16, u.pn, cl0 + 4 * n + e, acc[ai][0][m][n][e], acc[ai][1][m][n][e]);
                asm volatile("" ::: "memory"); }
    }
};
}
#define GAS __attribute__((address_space(1)))
#define LAS __attribute__((address_space(3)))
typedef unsigned short bf16;
typedef unsigned v4u __attribute__((ext_vector_type(4)));
typedef float f32x4 __attribute__((ext_vector_type(4)));
typedef short bf16x8 __attribute__((ext_vector_type(8)));
typedef GAS unsigned gu32;
typedef GAS unsigned long long gu64;
#define RLX_AGENT __ATOMIC_RELAXED, __HIP_MEMORY_SCOPE_AGENT
#define LDS_WAIT() asm volatile("s_waitcnt lgkmcnt(0)" ::: "memory")
#define VM_WAIT() asm volatile("s_waitcnt vmcnt(0)" ::: "memory")
__device__ __forceinline__ unsigned long long rt() { return __builtin_amdgcn_s_memrealtime(); }
__device__ __forceinline__ unsigned f2bf(float f) { unsigned u = __builtin_bit_cast(unsigned, f); return (u + 0x7fffu + ((u >> 16) & 1u)) >> 16; }
__device__ __forceinline__ unsigned pk2(float lo, float hi) { return f2bf(lo) | (f2bf(hi) << 16); }

#define XB_TMO      128
#define XB_XCNT(j)  (256  + 64 * (j))
#define XB_XSUB(j)  (1280 + 64 * (j))
#define XB_XGEN(j)  (2304 + 64 * (j))
#define XB_TOP      3328
#define XB_TOPGEN   3392
#define XCD_BAR_WORDS 3456
#define XB_SPIN_CAP (1u << 18)

__device__ __forceinline__ unsigned xb_ld(unsigned* p)              { return __hip_atomic_load(p, __ATOMIC_RELAXED, __HIP_MEMORY_SCOPE_AGENT); }
__device__ __forceinline__ unsigned xb_add(unsigned* p, unsigned v) { return __hip_atomic_fetch_add(p, v, __ATOMIC_RELAXED, __HIP_MEMORY_SCOPE_AGENT); }
__device__ __forceinline__ unsigned xb_xcc_id() { return (unsigned)__builtin_amdgcn_s_getreg((3 << 11) | 20) & 0xFu; }
#define XB_SPIN(cond, bar) do { unsigned _sp = 0; while (cond) { __builtin_amdgcn_s_sleep(1); \
    if ((++_sp & 255u) == 0u) { if (xb_ld(&(bar)[XB_TMO])) break; if (_sp > XB_SPIN_CAP) { atomicAdd(&(bar)[XB_TMO], 1u); break; } } } } while (0)

struct XcdBarrier {
    unsigned* bar; unsigned x;
    volatile LAS unsigned* st;
};

__device__ __forceinline__ XcdBarrier xcd_barrier_post(unsigned* bar, volatile LAS unsigned* st) {
    XcdBarrier b; b.bar = bar; b.x = xb_xcc_id(); b.st = st;
    if (threadIdx.x == 0) (void)xb_add(&bar[XB_XCNT(b.x)], 1u);
    return b;
}
__device__ __forceinline__ void xcd_barrier_complete(unsigned* bar, unsigned x, unsigned& nloc, unsigned& nx) {
    const unsigned G = gridDim.x * gridDim.y * gridDim.z;
    unsigned sum, cnt, mine, sp = 0u;
    for (;;) {
        sum = 0u; cnt = 0u; mine = 0u;
#pragma unroll
        for (unsigned j = 0; j < 16; ++j) { const unsigned c = xb_ld(&bar[XB_XCNT(j)]); sum += c; cnt += (c > 0u) ? 1u : 0u; mine = (j == x) ? c : mine; }
        if (sum == G) break;
        __builtin_amdgcn_s_sleep(1);
        if ((++sp & 255u) == 0u) { if (xb_ld(&bar[XB_TMO])) break; if (sp > XB_SPIN_CAP) { atomicAdd(&bar[XB_TMO], 1u); break; } }
    }
    nloc = mine > 0u ? mine : 1u; nx = cnt > 0u ? cnt : 1u;
}

__device__ __forceinline__ void xcd_barrier(const XcdBarrier& b) {
    asm volatile("s_waitcnt vmcnt(0)" ::: "memory");
    __syncthreads();
    if (threadIdx.x == 0) {
        unsigned* bar = b.bar;
        __builtin_amdgcn_s_waitcnt(0);
        unsigned nloc = b.st[0], nx = b.st[1];
        if (nloc == 0u) { xcd_barrier_complete(bar, b.x, nloc, nx); b.st[0] = nloc; b.st[1] = nx; }
        const unsigned old = xb_add(&bar[XB_XSUB(b.x)], 1u);
        const unsigned gen = old / nloc;
        if (old + 1u == (gen + 1u) * nloc) {
            __builtin_amdgcn_fence(__ATOMIC_RELEASE, "agent");
            asm volatile("s_waitcnt vmcnt(0)" ::: "memory");
            const unsigned og = xb_add(&bar[XB_TOP], 1u);
            const unsigned tg = og / nx;
            if (og + 1u == (tg + 1u) * nx) xb_add(&bar[XB_TOPGEN], 1u);
            else XB_SPIN(xb_ld(&bar[XB_TOPGEN]) == tg, bar);
            __builtin_amdgcn_fence(__ATOMIC_ACQUIRE, "agent");
            xb_add(&bar[XB_XGEN(b.x)], 1u);
            asm volatile("s_waitcnt vmcnt(0)" ::: "memory");
        } else {
            XB_SPIN(xb_ld(&bar[XB_XGEN(b.x)]) == gen, bar);
            __builtin_amdgcn_fence(__ATOMIC_ACQUIRE, "agent");
            asm volatile("s_waitcnt vmcnt(0)" ::: "memory");
        }
    }
    __syncthreads();
}
#ifndef ATT_FAST
#define ATT_FAST 1
#endif

constexpr int NWAVES = 8, NTHR = NWAVES * 64;
constexpr int BATCH = 4, SEQ = 8192, D = 1024, M = BATCH * SEQ;
constexpr int NHG = 8, HD = 64, HW = NHG * HD;
constexpr int INCOLS = 3080, NPROJ = 3072;
constexpr int NE = 32, NGRP = 4, EPG = 8, DF = 512, PLED = 256;
constexpr int SPAD = 2 * M + NE * 256;
constexpr float ALPHA = 1.189207115002721f, LN_EPS = 1e-5f, LOG2E = 1.4426950408889634f;
constexpr int NPH = 11;

constexpr size_t MiB = 1u << 20;
constexpr size_t WS_CTL = 0, CTL_ZERO_BYTES = 256 * 1024;
constexpr size_t WS_LS = 1 * MiB, WS_CFL = 2 * MiB, WS_CTOT = 3 * MiB, WS_KNT = 3 * MiB + 4096, WS_EID = 3 * MiB + 256 * 1024, WS_GATE = 3 * MiB + 512 * 1024, WS_RANK = 3 * MiB + 768 * 1024,
                 WS_SLOT = 4 * MiB, WS_GSLOT = 4 * MiB + 256 * 1024;
constexpr size_t WS_WIN = 5 * MiB, WS_WOUT = 11 * MiB, WS_WPLE = 13 * MiB, WS_WPG = 14 * MiB, WS_WGU = 16 * MiB, WS_WD = 80 * MiB, WS_PPLE = 112 * MiB;
constexpr size_t WS_R1 = 176 * MiB;
constexpr size_t WS_R2 = 368 * MiB;
constexpr size_t WS_R3 = 432 * MiB;
constexpr size_t WS_END = 504 * MiB;
static_assert(WS_GSLOT + (size_t)SPAD * 4 <= WS_WIN && WS_R1 + (size_t)SPAD * 2048 <= WS_R2 && WS_R3 + (size_t)SPAD * 1024 <= WS_END, "ws map");
constexpr int CW_TMO = 0, CW_BAR = 4096, CW_CNT = 8192;

constexpr int RING_OFF = 0, RING_BYTES = 131072;
constexpr int LDSCTL_OFF = RING_BYTES, MISC_OFF = LDSCTL_OFF + 320, PST_OFF = LDSCTL_OFF + 1024, HIST_OFF = LDSCTL_OFF + 1280, BASE_OFF = LDSCTL_OFF + 1408, ROWL_OFF = LDSCTL_OFF + 2048;
constexpr int LDS_BYTES = 147456;

__device__ __forceinline__ float bf2f(unsigned short v) { return __builtin_bit_cast(float, (unsigned)v << 16); }
__device__ __forceinline__ float wave_sum(float v) {
#pragma unroll
    for (int o = 1; o < 64; o <<= 1) v += __shfl_xor(v, o);
    return v;
}
__device__ __forceinline__ float wave_max(float v) {
#pragma unroll
    for (int o = 1; o < 64; o <<= 1) v = fmaxf(v, __shfl_xor(v, o));
    return v;
}

struct Frame {
    LAS unsigned char* lds; volatile LAS unsigned* MISC; gu32* ctl;
    int tid, lane, wave, vcu, G;
    const float *x, *p, *w_in, *b_forget, *w_out, *ln1g, *ln1b, *w_group, *b_group, *w_router, *b_router, *w_gate, *w_up, *w_down, *w_ple, *w_pg, *ln2g, *ln2b;
    float* out;
    bf16 *Win_t, *Wout_t, *Wple_t, *Wpg_t, *Wgu_t, *Wd_t, *pple, *qkv, *xs, *y, *xb, *mixed, *hb, *pb, *hdn;
    float *ls, *cfl, *ctot, *knt, *gatev, *gslot; int *eid, *rank, *slot;
};

__device__ __forceinline__ void transpose_tile(const float* Wt, int ldw, bf16* WTt, int ldt, LAS float* scr, int lane, float sc = 1.f) {
#pragma unroll 8
    for (int i = 0; i < 32; ++i) { const int kk = 2 * i + (lane >> 5); scr[kk * 33 + (lane & 31)] = Wt[(size_t)kk * ldw + (lane & 31)] * sc; }
    LDS_WAIT(); asm volatile("" ::: "memory");
    const int c = lane & 7;
#pragma unroll
    for (int j = 0; j < 4; ++j) { const int n = (lane >> 3) + 8 * j; const LAS float* s = scr + (8 * c) * 33 + n;
        v4u o; o.x = pk2(s[0 * 33], s[1 * 33]); o.y = pk2(s[2 * 33], s[3 * 33]); o.z = pk2(s[4 * 33], s[5 * 33]); o.w = pk2(s[6 * 33], s[7 * 33]);
        *(GAS v4u*)(WTt + (size_t)n * ldt + 8 * c) = o; }
    LDS_WAIT(); asm volatile("" ::: "memory");
}
__device__ __forceinline__ float log_sigmoid_f(float v) { return fminf(v, 0.f) - log1pf(expf(-fabsf(v))); }

__device__ __forceinline__ void p0_prologue(Frame& F) {
    LAS float* scr = (LAS float*)(F.lds + RING_OFF + F.wave * 16384);
    const int gw = F.vcu * NWAVES + F.wave, NGW = F.G * NWAVES;
    constexpr int I_IN = 16 * 96, I_OUT = 16 * 32, I_PLE = 4 * 32, I_PG = 16 * 32, I_GU = NE * 2 * 16 * 16, I_DN = NE * 8 * 32;
    constexpr int NITEMS = I_IN + I_OUT + I_PLE + I_PG + I_GU + I_DN;
    for (int it = gw; it < NITEMS; it += NGW) {
        int r = it;
        if (r < I_IN) { const int kb = r / 96, nb = r % 96; const int t = nb >> 4;
            transpose_tile(F.w_in + (size_t)kb * 64 * INCOLS + nb * 32, INCOLS, F.Win_t + (size_t)nb * 32 * D + kb * 64, D, scr, F.lane, (t == 0 || t == 3) ? 0.125f : 1.f); continue; } r -= I_IN;
        if (r < I_OUT) { const int kb = r / 32, nb = r % 32; transpose_tile(F.w_out + (size_t)kb * 64 * D + nb * 32, D, F.Wout_t + (size_t)nb * 32 * D + kb * 64, D, scr, F.lane); continue; } r -= I_OUT;
        if (r < I_PLE) { const int kb = r / 32, nb = r % 32; transpose_tile(F.w_ple + (size_t)kb * 64 * D + nb * 32, D, F.Wple_t + (size_t)nb * 32 * PLED + kb * 64, PLED, scr, F.lane); continue; } r -= I_PLE;
        if (r < I_PG) { const int kb = r / 32, nb = r % 32; transpose_tile(F.w_pg + (size_t)kb * 64 * D + nb * 32, D, F.Wpg_t + (size_t)nb * 32 * D + kb * 64, D, scr, F.lane); continue; } r -= I_PG;
        if (r < I_GU) { const int e = r / 512, gu = (r >> 8) & 1, kb = (r >> 4) & 15, nb = r & 15;
            const float* src = (gu ? F.w_up : F.w_gate) + (size_t)e * D * DF + (size_t)kb * 64 * DF + nb * 32;
            const int row = e * 1024 + (nb >> 2) * 256 + gu * 128 + (nb & 3) * 32;
            transpose_tile(src, DF, F.Wgu_t + (size_t)row * D + kb * 64, D, scr, F.lane); continue; } r -= I_GU;
        { const int e = r / 256, kb = (r >> 5) & 7, nb = r & 31;
            transpose_tile(F.w_down + (size_t)e * DF * D + (size_t)kb * 64 * D + nb * 32, D, F.Wd_t + (size_t)(e * 1024 + nb * 32) * DF + kb * 64, DF, scr, F.lane); }
    }
    __syncthreads();
    LAS float* wf = (LAS float*)(F.lds + RING_OFF);
    for (int i = F.tid; i < 2048; i += NTHR) { const int c = i >> 1, j0 = (i & 1) * 4; const f32x4 w = *(const GAS f32x4*)(F.w_in + (size_t)c * INCOLS + NPROJ + j0);
        wf[(j0 + 0) * 1024 + c] = w.x; wf[(j0 + 1) * 1024 + c] = w.y; wf[(j0 + 2) * 1024 + c] = w.z; wf[(j0 + 3) * 1024 + c] = w.w; }
    __syncthreads();
    for (int m = gw; m < M; m += NGW) {
        const GAS f32x4* xr = (const GAS f32x4*)(F.x + (size_t)m * D) + F.lane;
        f32x4 v[4];
#pragma unroll
        for (int j = 0; j < 4; ++j) v[j] = xr[64 * j];
        GAS unsigned long long* o8 = (GAS unsigned long long*)(F.xb + (size_t)m * D) + F.lane;
#pragma unroll
        for (int j = 0; j < 4; ++j) o8[64 * j] = (unsigned long long)pk2(v[j].x, v[j].y) | ((unsigned long long)pk2(v[j].z, v[j].w) << 32);
        float acc[8];
#pragma unroll
        for (int g = 0; g < 8; ++g) { float a = 0.f;
#pragma unroll
            for (int j = 0; j < 4; ++j) { const f32x4 w = *(const LAS f32x4*)(wf + g * 1024 + 4 * F.lane + 256 * j); a += (v[j].x * w.x + v[j].y * w.y) + (v[j].z * w.z + v[j].w * w.w); }
            acc[g] = wave_sum(a); }
        float mine = 0.f;
#pragma unroll
        for (int g = 0; g < 8; ++g) if (F.lane == g) mine = acc[g];
        if (F.lane < 8) F.ls[(size_t)m * 8 + F.lane] = log_sigmoid_f(mine + F.b_forget[F.lane]);
    }
    { const int gtid = blockIdx.x * NTHR + F.tid, NT = F.G * NTHR;
      for (int i = gtid; i < M * PLED / 8; i += NT) { const GAS f32x4* s = (const GAS f32x4*)(F.p) + 2 * (size_t)i; const f32x4 a = s[0], b = s[1];
          v4u o; o.x = pk2(a.x, a.y); o.y = pk2(a.z, a.w); o.z = pk2(b.x, b.y); o.w = pk2(b.z, b.w); ((GAS v4u*)F.pb)[i] = o; } }
}

__device__ __forceinline__ void p2_scan(Frame& F) {
    LAS float* wt = (LAS float*)(F.lds + RING_OFF);
    for (int it = blockIdx.x; it < 256; it += F.G) {
        const int bh = it >> 3, chunk = it & 7, b = bh >> 3, h = bh & 7, t = chunk * 1024 + 2 * F.tid;
        const float a0 = F.ls[(size_t)(b * SEQ + t) * 8 + h] * LOG2E, a1 = F.ls[(size_t)(b * SEQ + t + 1) * 8 + h] * LOG2E;
        float s = a0 + a1;
#pragma unroll
        for (int o = 1; o < 64; o <<= 1) { const float u = __shfl_up(s, o); if (F.lane >= o) s += u; }
        __syncthreads();
        if (F.lane == 63) wt[F.wave] = s;
        __syncthreads();
        float off = 0.f, tot = 0.f;
#pragma unroll
        for (int w = 0; w < 8; ++w) { const float u = wt[w]; if (w < F.wave) off += u; tot += u; }
        const float i1 = off + s, i0 = i1 - a1;
        F.cfl[(size_t)bh * SEQ + t] = i0; F.cfl[(size_t)bh * SEQ + t + 1] = i1;
        if (F.tid == 0) F.ctot[bh * 8 + chunk] = tot;
        const bf16* kf = F.qkv + (size_t)4 * M * HW;
        float nmax = 0.f;
#pragma unroll
        for (int rr = 0; rr < 2; ++rr) { const GAS v4u* kp = (const GAS v4u*)(kf + (size_t)(b * SEQ + t + rr) * HW + h * HD); float n2 = 0.f;
#pragma unroll
            for (int c = 0; c < 8; ++c) { const v4u w = kp[c];
#pragma unroll
                for (int e = 0; e < 4; ++e) { const float lo = __builtin_bit_cast(float, w[e] << 16), hi = __builtin_bit_cast(float, w[e] & 0xffff0000u); n2 += lo * lo + hi * hi; } }
            nmax = fmaxf(nmax, n2); }
#pragma unroll
        for (int o = 1; o < 32; o <<= 1) nmax = fmaxf(nmax, __shfl_xor(nmax, o));
        if ((F.lane & 31) == 0) F.knt[bh * 128 + chunk * 16 + F.wave * 2 + (F.lane >> 5)] = sqrtf(nmax);
    }
}

#if !defined(ATT_FAST) || !ATT_FAST
#define BFLO(w) __builtin_bit_cast(float, (w) << 16)
#define BFHI(w) __builtin_bit_cast(float, (w) & 0xffff0000u)
__device__ __forceinline__ void ld64(float (&d)[64], const bf16* p) {
    const GAS v4u* s = (const GAS v4u*)p;
#pragma unroll
    for (int c = 0; c < 8; ++c) { const v4u w = s[c];
#pragma unroll
        for (int e = 0; e < 4; ++e) { d[c * 8 + 2 * e] = BFLO(w[e]); d[c * 8 + 2 * e + 1] = BFHI(w[e]); } }
}
__device__ __forceinline__ float dot64(const float (&q)[64], const bf16* p) {
    const GAS v4u* s = (const GAS v4u*)p; float z = 0.f;
#pragma unroll
    for (int c = 0; c < 8; ++c) { const v4u w = s[c];
#pragma unroll
        for (int e = 0; e < 4; ++e) { z += q[c * 8 + 2 * e] * BFLO(w[e]); z += q[c * 8 + 2 * e + 1] * BFHI(w[e]); } }
    return z;
}
__device__ __forceinline__ void axpy64(float (&o)[64], float a, const bf16* p) {
    const GAS v4u* s = (const GAS v4u*)p;
#pragma unroll
    for (int c = 0; c < 8; ++c) { const v4u w = s[c];
#pragma unroll
        for (int e = 0; e < 4; ++e) { o[c * 8 + 2 * e] += a * BFLO(w[e]); o[c * 8 + 2 * e + 1] += a * BFHI(w[e]); } }
}
__device__ __forceinline__ void st64(bf16* p, const float (&d)[64], float sc) {
    GAS v4u* s = (GAS v4u*)p;
#pragma unroll
    for (int c = 0; c < 8; ++c) { v4u w;
#pragma unroll
        for (int e = 0; e < 4; ++e) w[e] = pk2(d[c * 8 + 2 * e] * sc, d[c * 8 + 2 * e + 1] * sc);
        s[c] = w; }
}
__device__ __forceinline__ void p3_attn_simple(Frame& F) {
    const int gtid = blockIdx.x * NTHR + F.tid, NT = F.G * NTHR;
    const bf16 *Qs = F.qkv, *Ks = F.qkv + (size_t)1 * M * HW, *Vs = F.qkv + (size_t)2 * M * HW, *Qf = F.qkv + (size_t)3 * M * HW, *Kf = F.qkv + (size_t)4 * M * HW, *Vf = F.qkv + (size_t)5 * M * HW;
    for (int idx = gtid; idx < M * NHG; idx += NT) {
        const int h = idx >> 15, m = idx & (M - 1), b = m >> 13, t = m & (SEQ - 1);
        float q[64], o[64];
        ld64(q, Qs + (size_t)m * HW + h * HD);
#pragma unroll
        for (int d = 0; d < 64; ++d) o[d] = 0.f;
        float C2 = 0.f;
        for (int s = t - 1; s >= 0; --s) {
            const float z = dot64(q, Ks + (size_t)(b * SEQ + s) * HW + h * HD);
            const float L2 = -(fmaxf(z, 0.f) * LOG2E + log2f(1.f + exp2f(-fabsf(z) * LOG2E)));
            const float w = exp2f(z * LOG2E + L2 + C2);
            axpy64(o, w, Vs + (size_t)(b * SEQ + s) * HW + h * HD);
            C2 += L2;
            if (C2 < -160.f) break;
        }
        st64(F.mixed + (size_t)m * D + h * HD, o, 1.f);
    }
    for (int idx = gtid; idx < M * NHG; idx += NT) {
        const int h = idx >> 15, m = idx & (M - 1), b = m >> 13, t = m & (SEQ - 1), bh = b * 8 + h;
        float q[64], o[64];
        ld64(q, Qf + (size_t)m * HW + h * HD);
#pragma unroll
        for (int d = 0; d < 64; ++d) o[d] = 0.f;
        float cq = F.cfl[(size_t)bh * SEQ + t];
        for (int c = 0; c < (t >> 10); ++c) cq += F.ctot[bh * 8 + c];
        float carry = 0.f, mr = -1e30f, l = 0.f;
        for (int s = 0; s <= t; ++s) {
            if ((s & 1023) == 0 && s > 0) carry += F.ctot[bh * 8 + (s >> 10) - 1];
            const float z = dot64(q, Kf + (size_t)(b * SEQ + s) * HW + h * HD);
            const float s2 = z * LOG2E + (cq - (F.cfl[(size_t)bh * SEQ + s] + carry));
            if (s2 > mr) { const float f = exp2f(mr - s2); l *= f;
#pragma unroll
                for (int d = 0; d < 64; ++d) o[d] *= f;
                mr = s2; }
            const float pw = exp2f(s2 - mr); l += pw;
            axpy64(o, pw, Vf + (size_t)(b * SEQ + s) * HW + h * HD);
        }
        st64(F.mixed + (size_t)m * D + HW + h * HD, o, 1.f / l);
    }
}

#endif
struct FProj { bf16* qkv; __device__ __forceinline__ void operator()(int row, int col, float v) const { const int t = col >> 9, cc = col & 511; const float sc = (t == 0 || t == 3) ? 0.125f : 1.f;
    qkv[(size_t)t * M * HW + (size_t)row * HW + cc] = (bf16)f2bf(v * sc); } };
struct FBf16 { bf16* O; int ldc; int cmask; __device__ __forceinline__ void operator()(int row, int col, float v) const { O[(size_t)row * ldc + (col & cmask)] = (bf16)f2bf(v); } };
struct FPre { const float* x; float* out; __device__ __forceinline__ void operator()(int row, int col, float v) const { const size_t i = (size_t)row * D + col; out[i] = ALPHA * x[i] + v; } };
struct FSwiglu { bf16* hdn; const float* gslot; __device__ __forceinline__ void operator()(int row, int pn, int cl, float g, float u) const {
    const int f = (pn & 3) * 128 + cl; const float s = g / (1.f + __expf(-g)); hdn[(size_t)row * DF + f] = (bf16)f2bf(s * u * gslot[row]); } };
struct FComb { float* out; const bf16* pple; const bf16* y; const int* slot; __device__ __forceinline__ void operator()(int row, int col, float v) const {
    const size_t i = (size_t)row * D + col; const int s0 = slot[row * 2], s1 = slot[row * 2 + 1]; const float sig = 1.f / (1.f + __expf(-v));
    out[i] = ALPHA * out[i] + bf2f(pple[i]) * sig + bf2f(y[(size_t)s0 * D + col]) + bf2f(y[(size_t)s1 * D + col]); } };

struct MoeOrder {
    const LAS int* pst; int nunits, G, c;
    __device__ __forceinline__ bool next(int i, pg8::Unit& u) const {
        const int L = i * G + c; if (L >= nunits) return false;
        const int pm = L >> 2, r0 = pm * 256; int e = 0;
        for (int k = 0; k < NE - 1; ++k) if (r0 >= pst[k + 1]) e = k + 1;
        u.pm = pm; u.pn = e * 4 + (L & 3); return true;
    }
    __device__ __forceinline__ void a_ready(const pg8::Unit&) const {}
    __device__ __forceinline__ void done(const pg8::Unit&) const {}
};
__device__ __forceinline__ void build_pstart(Frame& F) {
    LAS int* pst = (LAS int*)(F.lds + PST_OFF);
    if (F.tid == 0) { int acc = 0; for (int e = 0; e < NE; ++e) { const int c = (int)__hip_atomic_load(F.ctl + CW_CNT + 64 * e, RLX_AGENT); pst[e] = acc; acc += (c + 255) & ~255; } pst[NE] = acc; }
    __syncthreads();
}

__device__ __forceinline__ void p5_ln_route(Frame& F) {
    LAS unsigned* hist = (LAS unsigned*)(F.lds + HIST_OFF); LAS unsigned* base = (LAS unsigned*)(F.lds + BASE_OFF);
    LAS int* eidL = (LAS int*)(F.lds + ROWL_OFF); LAS int* rankL = eidL + 256;
    if (F.tid < NE) hist[F.tid] = 0u;
    __syncthreads();
    f32x4 gv[4], bv[4];
#pragma unroll
    for (int j = 0; j < 4; ++j) { gv[j] = *(const GAS f32x4*)(F.ln1g + 4 * F.lane + 256 * j); bv[j] = *(const GAS f32x4*)(F.ln1b + 4 * F.lane + 256 * j); }
    for (int r = F.wave; r < 128; r += NWAVES) {
        const int m = blockIdx.x * 128 + r;
        GAS f32x4* pr = (GAS f32x4*)(F.out + (size_t)m * D) + F.lane;
        f32x4 v[4]; float s = 0.f;
#pragma unroll
        for (int j = 0; j < 4; ++j) { v[j] = pr[64 * j]; s += (v[j].x + v[j].y) + (v[j].z + v[j].w); }
        const float mean = wave_sum(s) * (1.f / D); float s2 = 0.f;
#pragma unroll
        for (int j = 0; j < 4; ++j) { v[j] = v[j] - mean; s2 += (v[j].x * v[j].x + v[j].y * v[j].y) + (v[j].z * v[j].z + v[j].w * v[j].w); }
        const float rstd = 1.f / sqrtf(wave_sum(s2) * (1.f / D) + LN_EPS);
        GAS unsigned long long* o8 = (GAS unsigned long long*)(F.hb + (size_t)m * D) + F.lane;
#pragma unroll
        for (int j = 0; j < 4; ++j) { v[j] = v[j] * rstd * gv[j] + bv[j]; pr[64 * j] = v[j]; o8[64 * j] = (unsigned long long)pk2(v[j].x, v[j].y) | ((unsigned long long)pk2(v[j].z, v[j].w) << 32); }
        float gl[4] = {0.f, 0.f, 0.f, 0.f};
#pragma unroll
        for (int j = 0; j < 4; ++j)
#pragma unroll
            for (int e = 0; e < 4; ++e) { const int c = 4 * F.lane + 256 * j + e; const f32x4 w = *(const GAS f32x4*)(F.w_group + (size_t)c * 4); const float hv = v[j][e];
                gl[0] += hv * w.x; gl[1] += hv * w.y; gl[2] += hv * w.z; gl[3] += hv * w.w; }
#pragma unroll
        for (int i = 0; i < 4; ++i) gl[i] = wave_sum(gl[i]) + F.b_group[i];
        int gs = 0; float gm = gl[0];
#pragma unroll
        for (int i = 1; i < 4; ++i) if (gl[i] > gm) { gm = gl[i]; gs = i; }
        gs = __builtin_amdgcn_readfirstlane(gs);
        float gden = 0.f;
#pragma unroll
        for (int i = 0; i < 4; ++i) gden += expf(gl[i] - gm);
        const float gprob = 1.f / gden;
        float el[8] = {0.f, 0.f, 0.f, 0.f, 0.f, 0.f, 0.f, 0.f};
#pragma unroll
        for (int j = 0; j < 4; ++j)
#pragma unroll
            for (int e = 0; e < 4; ++e) { const int c = 4 * F.lane + 256 * j + e; const GAS f32x4* wp = (const GAS f32x4*)(F.w_router + (size_t)c * NE + gs * EPG); const f32x4 w0 = wp[0], w1 = wp[1]; const float hv = v[j][e];
                el[0] += hv * w0.x; el[1] += hv * w0.y; el[2] += hv * w0.z; el[3] += hv * w0.w; el[4] += hv * w1.x; el[5] += hv * w1.y; el[6] += hv * w1.z; el[7] += hv * w1.w; }
#pragma unroll
        for (int i = 0; i < 8; ++i) el[i] = wave_sum(el[i]) + F.b_router[gs * EPG + i];
        int i1 = 0; float v1 = el[0];
#pragma unroll
        for (int i = 1; i < 8; ++i) if (el[i] > v1) { v1 = el[i]; i1 = i; }
        int i2 = (i1 == 0) ? 1 : 0; float v2 = (i1 == 0) ? el[1] : el[0];
#pragma unroll
        for (int i = 1; i < 8; ++i) if (i != i1 && el[i] > v2) { v2 = el[i]; i2 = i; }
        const float e2 = expf(v2 - v1), g1 = 1.f / (1.f + e2), g2 = e2 * g1;
        if (F.lane == 0) {
            const int ea = gs * EPG + i1, eb = gs * EPG + i2;
            const unsigned ra = __hip_atomic_fetch_add(hist + ea, 1u, __ATOMIC_RELAXED, __HIP_MEMORY_SCOPE_WORKGROUP);
            const unsigned rb = __hip_atomic_fetch_add(hist + eb, 1u, __ATOMIC_RELAXED, __HIP_MEMORY_SCOPE_WORKGROUP);
            eidL[r * 2] = ea; eidL[r * 2 + 1] = eb; rankL[r * 2] = (int)ra; rankL[r * 2 + 1] = (int)rb;
            F.eid[m * 2] = ea; F.eid[m * 2 + 1] = eb; F.gatev[m * 2] = g1 * gprob; F.gatev[m * 2 + 1] = g2 * gprob;
        }
    }
    __syncthreads();
    if (F.tid < NE) base[F.tid] = __hip_atomic_fetch_add(F.ctl + CW_CNT + 64 * F.tid, hist[F.tid], RLX_AGENT);
    __syncthreads();
    if (F.tid < 256) F.rank[blockIdx.x * 256 + F.tid] = rankL[F.tid] + (int)base[eidL[F.tid]];
}
__device__ __forceinline__ void p6_slots_gather(Frame& F) {
    build_pstart(F);
    const LAS int* pst = (const LAS int*)(F.lds + PST_OFF);
    for (int r = F.wave; r < 128; r += NWAVES) {
        const int m = blockIdx.x * 128 + r; int s = 0;
        if (F.lane < 2) { const int e = F.eid[m * 2 + F.lane]; s = pst[e] + F.rank[m * 2 + F.lane]; F.slot[m * 2 + F.lane] = s; F.gslot[s] = F.gatev[m * 2 + F.lane]; }
        const int s0 = __shfl(s, 0), s1 = __shfl(s, 1);
        const GAS v4u* src = (const GAS v4u*)(F.hb + (size_t)m * D); const v4u a = src[F.lane], b = src[F.lane + 64];
        GAS v4u* d0 = (GAS v4u*)(F.xs + (size_t)s0 * D); GAS v4u* d1 = (GAS v4u*)(F.xs + (size_t)s1 * D);
        d0[F.lane] = a; d0[F.lane + 64] = b; d1[F.lane] = a; d1[F.lane + 64] = b;
    }
}
__device__ __forceinline__ void p10_final_ln(Frame& F, bool poison) {
    f32x4 gv[4], bv[4];
#pragma unroll
    for (int j = 0; j < 4; ++j) { gv[j] = *(const GAS f32x4*)(F.ln2g + 4 * F.lane + 256 * j); bv[j] = *(const GAS f32x4*)(F.ln2b + 4 * F.lane + 256 * j); }
    const int gw = blockIdx.x * NWAVES + F.wave, NGW = F.G * NWAVES; const float qn = __builtin_nanf("");
    for (int m = gw; m < M; m += NGW) {
        GAS f32x4* pr = (GAS f32x4*)(F.out + (size_t)m * D) + F.lane;
        f32x4 v[4]; float s = 0.f;
#pragma unroll
        for (int j = 0; j < 4; ++j) { v[j] = pr[64 * j]; s += (v[j].x + v[j].y) + (v[j].z + v[j].w); }
        const float mean = wave_sum(s) * (1.f / D); float s2 = 0.f;
#pragma unroll
        for (int j = 0; j < 4; ++j) { v[j] = v[j] - mean; s2 += (v[j].x * v[j].x + v[j].y * v[j].y) + (v[j].z * v[j].z + v[j].w * v[j].w); }
        const float rstd = 1.f / sqrtf(wave_sum(s2) * (1.f / D) + LN_EPS);
#pragma unroll
        for (int j = 0; j < 4; ++j) { f32x4 o = v[j] * rstd * gv[j] + bv[j]; if (poison) o = (f32x4){qn, qn, qn, qn}; pr[64 * j] = o; }
    }
}


namespace att {
typedef float f32x16 __attribute__((ext_vector_type(16)));
typedef short s16x4 __attribute__((ext_vector_type(4)));
typedef short v4i16_t __attribute__((ext_vector_type(4)));
constexpr int BUFB = 16384 + 512, A_WS = 2 * BUFB, A_FLAG = A_WS + 2048, A_CAR = A_FLAG + 64, A_END = A_CAR + 64;
constexpr float STOP2 = -48.f;
__device__ __forceinline__ int crow(int r, int hi) { return (r & 3) + 8 * (r >> 2) + 4 * hi; }
__device__ __forceinline__ unsigned cvtpk(float lo, float hi) { typedef float f2 __attribute__((ext_vector_type(2))); typedef __bf16 b2 __attribute__((ext_vector_type(2))); f2 v = {lo, hi}; b2 b = __builtin_convertvector(v, b2); return __builtin_bit_cast(unsigned, b); }

template <int MODE> __device__ __forceinline__ void attn_unit(Frame& F, int bh, int qb) {
    const int tid = F.tid, lane = F.lane, r32 = lane & 31, hi = lane >> 5, wid = F.wave;
    const int b = bh >> 3, h = bh & 7;
    const bf16* Qg = F.qkv + (size_t)(MODE ? 3 : 0) * M * HW; const bf16* Kg = F.qkv + (size_t)(MODE ? 4 : 1) * M * HW; const bf16* Vg = F.qkv + (size_t)(MODE ? 5 : 2) * M * HW;
    const size_t rowbase = (size_t)b * SEQ; const int q0 = qb * 256;
    const bf16* Qw = Qg + (rowbase + q0 + wid * 32) * HW + h * HD;
    const bf16* Kh = Kg + rowbase * HW + h * HD; const bf16* Vh = Vg + rowbase * HW + h * HD;
    LAS unsigned char* L = F.lds + RING_OFF;
    LAS float* wsf = (LAS float*)(L + A_WS) + wid * 64;
    LAS unsigned* flg = (LAS unsigned*)(L + A_FLAG);
    LAS float* car = (LAS float*)(L + A_CAR);
    const int jt = (q0 >> 6) + 3, jw = (q0 >> 6) + (wid >> 1);
    const bf16* ksrc = Kh + (size_t)lane * HW + wid * 8;
    const bf16* vsrc = Vh + (size_t)(16 * (wid & 3) + (lane >> 2)) * HW + (wid >> 2) * 32 + (lane & 3) * 8;
    const int kdst = wid * 1024 + lane * 16, vdst = 8192 + wid * 1024 + lane * 16;
    const float* cfsrc = F.cfl + (size_t)bh * SEQ + tid * 4;
    float KNu = 0.f;
    if (MODE) {
        if (tid < 8) { float c = 0.f; for (int k = 0; k < tid; ++k) c += F.ctot[bh * 8 + k]; car[tid] = c; }
        float kn = (lane <= jt) ? F.knt[bh * 128 + lane] : 0.f; if (lane + 64 <= jt) kn = fmaxf(kn, F.knt[bh * 128 + lane + 64]);
        KNu = wave_max(kn);
    }
    bf16x8 qr[4];
#pragma unroll
    for (int d0 = 0; d0 < 4; ++d0) qr[d0] = *(const GAS bf16x8*)(Qw + (size_t)r32 * HW + d0 * 16 + hi * 8);
    __syncthreads();
    v4u kreg = *(const GAS v4u*)(ksrc + (size_t)jt * 64 * HW), vreg = *(const GAS v4u*)(vsrc + (size_t)jt * 64 * HW); f32x4 cfreg = {0.f, 0.f, 0.f, 0.f};
    if (MODE && tid < 16) { cfreg = *(const GAS f32x4*)(cfsrc + jt * 64); const float c = car[jt >> 4]; cfreg = cfreg + c; }
    *(LAS v4u*)(L + kdst) = kreg; *(LAS v4u*)(L + vdst) = vreg; if (MODE && tid < 16) *(LAS f32x4*)(L + 16384 + tid * 16) = cfreg;
    float cq = 0.f, qnb = 0.f;
    if (MODE) {
        cq = F.cfl[(size_t)bh * SEQ + q0 + wid * 32 + r32] + car[q0 >> 10];
        float n2 = 0.f;
#pragma unroll
        for (int d0 = 0; d0 < 4; ++d0)
#pragma unroll
            for (int e = 0; e < 8; ++e) { const float qv = __builtin_bit_cast(float, (unsigned)(unsigned short)qr[d0][e] << 16); n2 += qv * qv; }
        n2 += __shfl_xor(n2, 32);
        qnb = sqrtf(n2) * KNu * (LOG2E * 1.01f) + cq;
    }
    __syncthreads();
    f32x16 o[2]; o[0] = f32x16{}; o[1] = f32x16{};
    float C2 = 0.f, mhat = -1e30f, lsum = 0.f;
    bool wdone = false; int cur = 0;
    const LAS unsigned char* vb0 = L + 8192 + ((lane >> 4) & 1) * 32 + (lane & 3) * 8 + (4 * hi + ((lane & 15) >> 2)) * 64;
    for (int j = jt;; --j) {
        const bool more = j > 0;
        if (more) { kreg = *(const GAS v4u*)(ksrc + (size_t)(j - 1) * 64 * HW); vreg = *(const GAS v4u*)(vsrc + (size_t)(j - 1) * 64 * HW);
            if (MODE && tid < 16) cfreg = *(const GAS f32x4*)(cfsrc + (j - 1) * 64); }
        if (!wdone && j <= jw) {
            const LAS unsigned char* Kb = L + cur * BUFB;
            f32x16 p0 = f32x16{}, p1 = f32x16{};
            { const LAS unsigned char* kb = Kb + hi * 1024 + r32 * 16;
#pragma unroll
              for (int d0 = 0; d0 < 4; ++d0) { const bf16x8 b0 = *(const LAS bf16x8*)(kb + d0 * 2048), b1 = *(const LAS bf16x8*)(kb + d0 * 2048 + 512);
                  p0 = __builtin_amdgcn_mfma_f32_32x32x16_bf16(b0, qr[d0], p0, 0, 0, 0); p1 = __builtin_amdgcn_mfma_f32_32x32x16_bf16(b1, qr[d0], p1, 0, 0, 0); } }
            const bool diag = (j == jw); const int qrel = 32 * (wid & 1) + r32;
            if (MODE == 0) {
                float Lg[32];
#pragma unroll
                for (int r = 0; r < 16; ++r) {
                    const float z0 = p0[r], z1 = p1[r];
                    float l0 = -(fmaxf(z0, 0.f) * LOG2E + __builtin_amdgcn_logf(1.f + __builtin_amdgcn_exp2f(-fabsf(z0) * LOG2E)));
                    float l1 = -(fmaxf(z1, 0.f) * LOG2E + __builtin_amdgcn_logf(1.f + __builtin_amdgcn_exp2f(-fabsf(z1) * LOG2E)));
                    if (diag) { if (crow(r, hi) >= qrel) l0 = 0.f; if (crow(r, hi) + 32 >= qrel) l1 = 0.f; }
                    Lg[r] = l0; Lg[16 + r] = l1;
                }
                float Os[8], Ps[8];
#pragma unroll
                for (int i = 0; i < 8; ++i) { Os[i] = (Lg[4 * i] + Lg[4 * i + 1]) + (Lg[4 * i + 2] + Lg[4 * i + 3]); Ps[i] = __shfl_xor(Os[i], 32); }
                float T = 0.f;
#pragma unroll
                for (int i = 7; i >= 0; --i) {
                    float s = T + (hi ? 0.f : Ps[i]) + C2;
#pragma unroll
                    for (int e = 3; e >= 0; --e) { s += Lg[4 * i + e]; const int r = (4 * i + e) & 15; const float zz = (i < 4) ? p0[r] : p1[r];
                        float w = __builtin_amdgcn_exp2f(zz * LOG2E + s);
                        if (diag) { const int kk = crow(r, hi) + (i < 4 ? 0 : 32); if (kk >= qrel) w = 0.f; }
                        if (i < 4) p0[r] = w; else p1[r] = w; }
                    T += Os[i] + Ps[i];
                }
                C2 += T;
                wdone = __all(C2 < STOP2);
            } else {
                const LAS float* cfp = (const LAS float*)(Kb + 16384);
                float rm = -INFINITY;
#pragma unroll
                for (int g = 0; g < 4; ++g) { const f32x4 c0 = *(const LAS f32x4*)(cfp + 8 * g + 4 * hi), c1 = *(const LAS f32x4*)(cfp + 32 + 8 * g + 4 * hi);
#pragma unroll
                    for (int e = 0; e < 4; ++e) { const int r = 4 * g + e; float s0 = p0[r] * LOG2E + (cq - c0[e]), s1 = p1[r] * LOG2E + (cq - c1[e]);
                        if (diag) { if (crow(r, hi) > qrel) s0 = -INFINITY; if (crow(r, hi) + 32 > qrel) s1 = -INFINITY; }
                        p0[r] = s0; p1[r] = s1; rm = fmaxf(rm, fmaxf(s0, s1)); } }
                rm = fmaxf(rm, __shfl_xor(rm, 32));
                const float mnew = fmaxf(mhat, rm);
                if (__any(mnew > mhat)) {
                    const float f = __builtin_amdgcn_exp2f(mhat - mnew); lsum *= f;
                    if (hi == 0) wsf[r32] = f;
                    asm volatile("s_waitcnt lgkmcnt(0)" ::: "memory");
#pragma unroll
                    for (int r = 0; r < 16; ++r) { const float fr = wsf[crow(r, hi)]; o[0][r] *= fr; o[1][r] *= fr; }
                    mhat = mnew;
                }
                float sacc = 0.f;
#pragma unroll
                for (int r = 0; r < 16; ++r) { p0[r] = __builtin_amdgcn_exp2f(p0[r] - mhat); p1[r] = __builtin_amdgcn_exp2f(p1[r] - mhat); sacc += p0[r] + p1[r]; }
                lsum += sacc;
                const float c00 = cfp[0];
                wdone = __all(qnb - c00 - mhat < STOP2);
            }
            v4u pw0, pw1, pw2, pw3;
#pragma unroll
            for (int e = 0; e < 4; ++e) { pw0[e] = cvtpk(p0[2 * e], p0[2 * e + 1]); pw1[e] = cvtpk(p0[8 + 2 * e], p0[8 + 2 * e + 1]); pw2[e] = cvtpk(p1[2 * e], p1[2 * e + 1]); pw3[e] = cvtpk(p1[8 + 2 * e], p1[8 + 2 * e + 1]); }
            const LAS unsigned char* vb = vb0 + cur * BUFB;
#pragma unroll
            for (int d0 = 0; d0 < 2; ++d0) { s16x4 lo[4], hh[4];
#pragma unroll
                for (int ks = 0; ks < 4; ++ks) {
                    lo[ks] = __builtin_bit_cast(s16x4, __builtin_amdgcn_ds_read_tr16_b64_v4i16((LAS v4i16_t*)(vb + d0 * 4096 + ks * 1024)));
                    hh[ks] = __builtin_bit_cast(s16x4, __builtin_amdgcn_ds_read_tr16_b64_v4i16((LAS v4i16_t*)(vb + d0 * 4096 + ks * 1024 + 512))); }
#define ATT_PK(k) (bf16x8){lo[k][0], lo[k][1], lo[k][2], lo[k][3], hh[k][0], hh[k][1], hh[k][2], hh[k][3]}
                o[d0] = __builtin_amdgcn_mfma_f32_32x32x16_bf16(__builtin_bit_cast(bf16x8, pw0), ATT_PK(0), o[d0], 0, 0, 0);
                o[d0] = __builtin_amdgcn_mfma_f32_32x32x16_bf16(__builtin_bit_cast(bf16x8, pw1), ATT_PK(1), o[d0], 0, 0, 0);
                o[d0] = __builtin_amdgcn_mfma_f32_32x32x16_bf16(__builtin_bit_cast(bf16x8, pw2), ATT_PK(2), o[d0], 0, 0, 0);
                o[d0] = __builtin_amdgcn_mfma_f32_32x32x16_bf16(__builtin_bit_cast(bf16x8, pw3), ATT_PK(3), o[d0], 0, 0, 0);
#undef ATT_PK
            }
        }
        if (more) { const int nb = (cur ^ 1) * BUFB;
            if (MODE && tid < 16) { const float c = car[(j - 1) >> 4]; cfreg = cfreg + c; *(LAS f32x4*)(L + nb + 16384 + tid * 16) = cfreg; }
            *(LAS v4u*)(L + nb + kdst) = kreg; *(LAS v4u*)(L + nb + vdst) = vreg; }
        if (lane == 0) flg[cur * 8 + wid] = wdone ? 1u : 0u;
        __syncthreads();
        if (!more) break;
        unsigned alld = 1u;
#pragma unroll
        for (int w = 0; w < 8; ++w) alld &= flg[cur * 8 + w];
        if (alld) break;
        cur ^= 1;
    }
    float rli[16];
    if (MODE) {
        lsum += __shfl_xor(lsum, 32);
        if (hi == 0) wsf[r32] = lsum;
        asm volatile("s_waitcnt lgkmcnt(0)" ::: "memory");
#pragma unroll
        for (int r = 0; r < 16; ++r) rli[r] = 1.f / wsf[crow(r, hi)];
    } else {
#pragma unroll
        for (int r = 0; r < 16; ++r) rli[r] = 1.f;
    }
    bf16* Ow = F.mixed + (rowbase + q0 + wid * 32) * D + (MODE ? HW : 0) + h * HD;
#pragma unroll
    for (int r = 0; r < 16; ++r) {
        bf16* rowp = Ow + (size_t)crow(r, hi) * D + r32;
        rowp[0] = (bf16)f2bf(o[0][r] * rli[r]); rowp[32] = (bf16)f2bf(o[1][r] * rli[r]);
    }
}
}

__device__ __forceinline__ void p3_attn_fast(Frame& F) {
    for (int i = 3; i >= 0; --i) { const int id = (int)blockIdx.x + F.G * i; if (id < 1024) att::attn_unit<1>(F, id & 31, id >> 5); }
    for (int i = 3; i >= 0; --i) { const int id = (int)blockIdx.x + F.G * i; if (id < 1024) att::attn_unit<0>(F, id & 31, id >> 5); }
}

struct Args { const float* in[18]; float* out; unsigned char* ws; int ph_lo, ph_hi; };
__global__ void __launch_bounds__(NTHR, 2) mk_fwd(Args args) {
    extern __shared__ __attribute__((aligned(16))) unsigned char lds[];
    Frame F;
    F.lds = (LAS unsigned char*)lds; F.MISC = (volatile LAS unsigned*)(F.lds + MISC_OFF);
    F.tid = threadIdx.x; F.lane = F.tid & 63; F.wave = __builtin_amdgcn_readfirstlane(F.tid >> 6);
    F.G = gridDim.x; { const int bx = blockIdx.x; F.vcu = (F.G % 8 == 0) ? (bx % 8) * (F.G / 8) + bx / 8 : bx; }
    unsigned char* ws = args.ws;
    F.ctl = (gu32*)(ws + WS_CTL);
    F.x = args.in[0]; F.p = args.in[1]; F.w_in = args.in[2]; F.b_forget = args.in[3]; F.w_out = args.in[4]; F.ln1g = args.in[5]; F.ln1b = args.in[6]; F.w_group = args.in[7]; F.b_group = args.in[8];
    F.w_router = args.in[9]; F.b_router = args.in[10]; F.w_gate = args.in[11]; F.w_up = args.in[12]; F.w_down = args.in[13]; F.w_ple = args.in[14]; F.w_pg = args.in[15]; F.ln2g = args.in[16]; F.ln2b = args.in[17];
    F.out = args.out;
    F.Win_t = (bf16*)(ws + WS_WIN); F.Wout_t = (bf16*)(ws + WS_WOUT); F.Wple_t = (bf16*)(ws + WS_WPLE); F.Wpg_t = (bf16*)(ws + WS_WPG); F.Wgu_t = (bf16*)(ws + WS_WGU); F.Wd_t = (bf16*)(ws + WS_WD);
    F.pple = (bf16*)(ws + WS_PPLE); F.qkv = (bf16*)(ws + WS_R1); F.xs = (bf16*)(ws + WS_R1); F.y = (bf16*)(ws + WS_R1);
    F.xb = (bf16*)(ws + WS_R2); F.mixed = (bf16*)(ws + WS_R2); F.hb = (bf16*)(ws + WS_R2); F.pb = (bf16*)(ws + WS_R3); F.hdn = (bf16*)(ws + WS_R3);
    F.ls = (float*)(ws + WS_LS); F.cfl = (float*)(ws + WS_CFL); F.ctot = (float*)(ws + WS_CTOT); F.knt = (float*)(ws + WS_KNT); F.gatev = (float*)(ws + WS_GATE); F.gslot = (float*)(ws + WS_GSLOT);
    F.eid = (int*)(ws + WS_EID); F.rank = (int*)(ws + WS_RANK); F.slot = (int*)(ws + WS_SLOT);
    for (int u = F.tid; u < (LDS_BYTES - LDSCTL_OFF) / 4; u += NTHR) ((LAS unsigned*)(F.lds + LDSCTL_OFF))[u] = 0u;
    __syncthreads();
    XcdBarrier bar = xcd_barrier_post((unsigned*)(F.ctl + CW_BAR), F.MISC + 8);
    const int lo = args.ph_lo, hi = args.ph_hi;
#ifndef PH_MASK
#define PH_MASK 0x7ff
#endif
#define IN(k) (((PH_MASK >> (k)) & 1) && lo <= (k) && (k) < hi)
#define SEAM(k) do { if (IN(k) && IN((k) + 1)) xcd_barrier(bar); } while (0)

    if (IN(0)) { p0_prologue(F); } SEAM(0);

    if (IN(1)) {
        { pg8::Gemm g{F.xb, F.Win_t, M, NPROJ, D}; pg8::StaticOrder S; S.init(M, NPROJ, F.G, (int)blockIdx.x);
          pg8::EpiBf16<0> E{F.qkv, HW, nullptr, HW, (size_t)M * HW, 1.f};
          pg8::gemm_phase<pg8::EpiBf16<0>, pg8::StaticOrder, true, true>(F.lds + RING_OFF, g, S, E); }
        { pg8::Gemm g{F.pb, F.Wple_t, M, D, PLED}; pg8::StaticOrder S; S.init(M, D, F.G, (int)blockIdx.x);
          pg8::EpiBf16<0> E{F.pple, D, nullptr, 0, 0, 1.f};
          pg8::gemm_phase<pg8::EpiBf16<0>, pg8::StaticOrder, true, true>(F.lds + RING_OFF, g, S, E); }
    } SEAM(1);

    if (IN(2)) { p2_scan(F); } SEAM(2);

#if ATT_FAST
    if (IN(3)) { p3_attn_fast(F); } SEAM(3);
#else
    if (IN(3)) { p3_attn_simple(F); } SEAM(3);
#endif

    if (IN(4)) {
        pg8::Gemm g{F.mixed, F.Wout_t, M, D, D}; pg8::StaticOrder S; S.init(M, D, F.G, (int)blockIdx.x);
        pg8::EpiScalar<FPre> E{FPre{F.x, F.out}};
        pg8::gemm_phase<pg8::EpiScalar<FPre>, pg8::StaticOrder, true, true>(F.lds + RING_OFF, g, S, E);
    } SEAM(4);

    if (IN(5)) { p5_ln_route(F); } SEAM(5);

    if (IN(6)) { p6_slots_gather(F); } SEAM(6);

    if (IN(7)) {
        build_pstart(F);
        const LAS int* pst = (const LAS int*)(F.lds + PST_OFF);
        pg8::Gemm g{F.xs, F.Wgu_t, SPAD, NE * 1024, D}; MoeOrder S{pst, (pst[NE] >> 8) * 4, F.G, (int)blockIdx.x};
        pg8::EpiScalarPair<FSwiglu> E{FSwiglu{F.hdn, F.gslot}};
        pg8::gemm_phase<pg8::EpiScalarPair<FSwiglu>, MoeOrder, true, true>(F.lds + RING_OFF, g, S, E);
    } SEAM(7);

    if (IN(8)) {
        build_pstart(F);
        const LAS int* pst = (const LAS int*)(F.lds + PST_OFF);
        pg8::Gemm g{F.hdn, F.Wd_t, SPAD, NE * 1024, DF}; MoeOrder S{pst, (pst[NE] >> 8) * 4, F.G, (int)blockIdx.x};
        pg8::EpiScalar<FBf16> E{FBf16{F.y, D, 1023}};
        pg8::gemm_phase<pg8::EpiScalar<FBf16>, MoeOrder, true, true>(F.lds + RING_OFF, g, S, E);
    } SEAM(8);

    if (IN(9)) {
        pg8::Gemm g{F.hb, F.Wpg_t, M, D, D}; pg8::StaticOrder S; S.init(M, D, F.G, (int)blockIdx.x);
        pg8::EpiScalar<FComb> E{FComb{F.out, F.pple, F.y, F.slot}};
        pg8::gemm_phase<pg8::EpiScalar<FComb>, pg8::StaticOrder, true, true>(F.lds + RING_OFF, g, S, E);
    } SEAM(9);

    if (IN(10)) {
        const bool poison = __hip_atomic_load((gu32*)((unsigned*)(F.ctl + CW_BAR) + XB_TMO), RLX_AGENT) != 0u || F.G != 256;
        p10_final_ln(F, poison);
    }
#undef IN
#undef SEAM
}

#ifndef MK_CUTS
#define MK_CUTS 0
#endif
extern "C" void kernel_launch(void* const* d_in, const int* in_sizes, int n_in, void* d_out, int out_size, void* d_ws, size_t ws_size, hipStream_t stream) {
    static int grid = 0;
    if (grid == 0) {
        if (n_in != 18 || in_sizes[0] != M * D || out_size != M * D || ws_size < WS_END) { fprintf(stderr, "kernel_launch: shape/workspace mismatch (n_in %d, in0 %d, out %d, ws %zu)\n", n_in, n_in > 0 ? in_sizes[0] : -1, out_size, ws_size); grid = -1; return; }
        int dev = 0, cus = 0, per_cu = 0;
        if (hipGetDevice(&dev) != hipSuccess || hipDeviceGetAttribute(&cus, hipDeviceAttributeMultiprocessorCount, dev) != hipSuccess) { grid = -1; return; }
        if (hipFuncSetAttribute((const void*)mk_fwd, hipFuncAttributeMaxDynamicSharedMemorySize, LDS_BYTES) != hipSuccess) { fprintf(stderr, "kernel_launch: hipFuncSetAttribute failed\n"); grid = -1; return; }
        if (hipOccupancyMaxActiveBlocksPerMultiprocessor(&per_cu, (const void*)mk_fwd, NTHR, LDS_BYTES) != hipSuccess || per_cu < 1) fprintf(stderr, "kernel_launch: occupancy query reports %d\n", per_cu);
        (void)hipGetLastError();
        grid = cus;
        if (grid != 256) fprintf(stderr, "kernel_launch: %d CUs; this kernel is built for 256\n", grid);
    }
    if (grid < 0) return;
    if (hipMemsetAsync((char*)d_ws + WS_CTL, 0, CTL_ZERO_BYTES, stream) != hipSuccess) return;
    Args a{};
    for (int i = 0; i < 18; ++i) a.in[i] = (const float*)d_in[i];
    a.out = (float*)d_out; a.ws = (unsigned char*)d_ws;
#if MK_CUTS
    for (int ph = 0; ph < NPH; ++ph) { a.ph_lo = ph; a.ph_hi = ph + 1; hipLaunchKernelGGL(mk_fwd, dim3(grid), dim3(NTHR), LDS_BYTES, stream, a); }
#else
    a.ph_lo = 0; a.ph_hi = NPH;
    hipLaunchKernelGGL(mk_fwd, dim3(grid), dim3(NTHR), LDS_BYTES, stream, a);
#endif
}
```

```cpp
#include <hip/hip_runtime.h>
#include <hip/hip_bf16.h>
#include <cstdio>
#include <cstdint>
#include <cmath>
namespace pg8 {
#define PG8_LAS __attribute__((address_space(3)))
typedef unsigned short bf16_t;
typedef short bf16x8 __attribute__((ext_vector_type(8)));
typedef float f32x4 __attribute__((ext_vector_type(4)));
typedef unsigned u32x4 __attribute__((ext_vector_type(4)));
constexpr int BM = 256, BK = 64, HALF = 128, HTB = HALF * BK * 2  , STAGE_BYTES = 8 * HTB, NXCD = 8, WGM = 8;

__host__ __device__ __forceinline__ int lds_byte(int r, int c) { const int st = (r >> 4) * 2 + (c >> 5), rr = r & 15, cc = c & 31, ob = rr * 64 + cc * 2; return st * 1024 + (ob ^ (((ob >> 9) & 1) << 5)); }
__host__ __device__ __forceinline__ void stage_rc(int b, int& R, int& C) { const int st = b / 1024, sb = b % 1024, swz = sb ^ (((sb >> 9) & 1) << 5); R = (st >> 1) * 16 + swz / 64; C = (st & 1) * 32 + (swz % 64) / 2; }
__host__ __device__ __forceinline__ int perm32(int rho) { const int n = rho >> 4, i = rho & 15; return 8 * (i >> 2) + 4 * n + (i & 3); }

struct Unit { int pm, pn; };
struct Gemm { const bf16_t* A; const bf16_t* Bt; int M, N, K; };

struct StaticOrder {
    int nM, nN, nwg, G, c;
    __host__ __device__ void init(int M, int N, int G_, int c_) { nM = M / BM; nN = N / BM; nwg = nM * nN; G = G_; c = c_; }
    __host__ __device__ bool next(int i, Unit& u) const {
        const long L = (long)i * G + c; if (L >= nwg) return false;
        int wgid = (int)L; { const int q = nwg / NXCD, r = nwg % NXCD, xcd = wgid % NXCD, off = wgid / NXCD; wgid = (xcd < r ? xcd * (q + 1) : r * (q + 1) + (xcd - r) * q) + off; }
        const int nig = WGM * nN, gid = wgid / nig, fm = gid * WGM, gsz = (nM - fm) < WGM ? (nM - fm) : WGM;
        u.pm = fm + ((wgid % nig) % gsz); u.pn = (wgid % nig) / gsz; return true;
    }
    __device__ __forceinline__ void a_ready(const Unit&) const {}
    __device__ __forceinline__ void done(const Unit&) const {}
};

__device__ __forceinline__ unsigned cvt_pk_bf16(float lo, float hi) { unsigned r; asm volatile("v_cvt_pk_bf16_f32 %0, %1, %2" : "=v"(r) : "v"(lo), "v"(hi)); return r; }
typedef float f32x2 __attribute__((ext_vector_type(2)));
__device__ __forceinline__ f32x2 gelu_pk(f32x2 v) {
    const f32x2 av = __builtin_elementwise_abs(v), d = av * 0.2316418882f + 1.0f;
    f32x2 t; t.x = __builtin_amdgcn_rcpf(d.x); t.y = __builtin_amdgcn_rcpf(d.y);
    f32x2 q = t * 0.5307027145f + (-0.7265760135f); q = q * t + 0.7107068705f; q = q * t + (-0.142248368f); q = q * t + 0.127414796f; q = q * t;
    const f32x2 s = (v * v) * (-0.72134752044f);
    f32x2 e; e.x = __builtin_amdgcn_exp2f(s.x); e.y = __builtin_amdgcn_exp2f(s.y);
    const f32x2 m = v * (q * e), r = v - m;
    f32x2 o; o.x = v.x < 0.f ? m.x : r.x; o.y = v.y < 0.f ? m.y : r.y; return o;
}

template <int ACT  > struct EpiBf16 {
    static constexpr bool PERM = true, AFTER_DRAIN = false; static_assert(ACT == 0 || ACT == 1, "EpiBf16: ACT is 0 (none) or 1 (gelu_pk)");
    bf16_t* O; int ldc; const float* bias; int split_cols; size_t split_stride; float scale0;
    __device__ __forceinline__ void operator()(const f32x4 (&acc)[2][2][4][2], const Unit& u, int wr, int wc, int fr, int fq) const {
        const int row0 = u.pm * BM + wr * 64 + fr; int colt = u.pn * BM; bf16_t* base = O;
        float sc = 1.f; if (split_cols) { const int t = colt / split_cols; base += (size_t)t * split_stride; colt -= t * split_cols; if (t == 0) sc = scale0; }
        const int col0 = colt + wc * 32 + 8 * fq, bcol0 = u.pn * BM + wc * 32 + 8 * fq;
        f32x4 bv[2][2];
#pragma unroll
        for (int bj = 0; bj < 2; ++bj)
#pragma unroll
            for (int n = 0; n < 2; ++n) bv[bj][n] = bias ? *(const f32x4*)(bias + bcol0 + bj * HALF + 4 * n) : (f32x4){0.f, 0.f, 0.f, 0.f};
#pragma unroll
        for (int ai = 0; ai < 2; ++ai)
#pragma unroll
            for (int m = 0; m < 4; ++m) { bf16_t* rowp = base + (size_t)(row0 + ai * HALF + m * 16) * ldc + col0;
#pragma unroll
                for (int bj = 0; bj < 2; ++bj) { f32x4 v0 = acc[ai][bj][m][0] + bv[bj][0], v1 = acc[ai][bj][m][1] + bv[bj][1];
                    if (ACT == 1) { f32x2 a = gelu_pk((f32x2){v0[0], v0[1]}), b = gelu_pk((f32x2){v0[2], v0[3]}), c = gelu_pk((f32x2){v1[0], v1[1]}), d = gelu_pk((f32x2){v1[2], v1[3]});
                        v0 = (f32x4){a.x, a.y, b.x, b.y}; v1 = (f32x4){c.x, c.y, d.x, d.y}; }
                    v0 = v0 * sc; v1 = v1 * sc; u32x4 w; w.x = cvt_pk_bf16(v0[0], v0[1]); w.y = cvt_pk_bf16(v0[2], v0[3]); w.z = cvt_pk_bf16(v1[0], v1[1]); w.w = cvt_pk_bf16(v1[2], v1[3]);
                    *(u32x4*)(rowp + bj * HALF) = w; } }
    }
};

struct PanelStats {
    unsigned* xbuf;
    unsigned* cnt;
    unsigned* tmo;
    int ntn; float eps;
    unsigned code;
    __device__ __forceinline__ bool run(const f32x4 (&v)[2][2][4][2], const Unit& u, int wr, int wc, int fr, int fq, PG8_LAS unsigned char* lds, int wid, int lane) const {
        typedef float f32x2v __attribute__((ext_vector_type(2)));
        PG8_LAS f32x2v* P = (PG8_LAS f32x2v*)lds;
        PG8_LAS f32x2v* S = (PG8_LAS f32x2v*)(lds + 8192);
        PG8_LAS unsigned* flag = (PG8_LAS unsigned*)(lds + 8192 + 2048);
#pragma unroll
        for (int ai = 0; ai < 2; ++ai)
#pragma unroll
            for (int m = 0; m < 4; ++m) {
                float s = 0.f;
#pragma unroll
                for (int bj = 0; bj < 2; ++bj)
#pragma unroll
                    for (int n = 0; n < 2; ++n) { const f32x4 x = v[ai][bj][m][n]; s += (x[0] + x[1]) + (x[2] + x[3]); }
                s += __shfl_xor(s, 16); s += __shfl_xor(s, 32);
                const float mw = s * (1.0f / 64.0f); float q = 0.f;
#pragma unroll
                for (int bj = 0; bj < 2; ++bj)
#pragma unroll
                    for (int n = 0; n < 2; ++n) { const f32x4 d = v[ai][bj][m][n] - mw; q += (d[0] * d[0] + d[1] * d[1]) + (d[2] * d[2] + d[3] * d[3]); }
                q += __shfl_xor(q, 16); q += __shfl_xor(q, 32);
                if (fq == 0) P[(ai * HALF + wr * 64 + m * 16 + fr) * 4 + wc] = (f32x2v){mw, q};
            }
        asm volatile("s_waitcnt lgkmcnt(0)" ::: "memory"); __builtin_amdgcn_s_barrier(); asm volatile("" ::: "memory");
#if defined(BROKEN_EXCHANGE_NO_WAIT)
#warning BROKEN CONTROL BUILD: the row-statistics exchange does not wait; results are wrong by design
        if (blockIdx.x >= 64) { const long long t0_ = clock64(); while (clock64() - t0_ < 60000) __builtin_amdgcn_s_sleep(8); }
#endif
        const int row = wid * 32 + (lane & 31);
        if (lane < 32) {
            const f32x2v a = P[row * 4 + 0], b = P[row * 4 + 1], c = P[row * 4 + 2], d = P[row * 4 + 3];
            const float mt = (a.x + b.x + c.x + d.x) * 0.25f;
            const float da = a.x - mt, db = b.x - mt, dc = c.x - mt, dd = d.x - mt;
            const float m2 = (a.y + b.y) + (c.y + d.y) + 64.0f * ((da * da + db * db) + (dc * dc + dd * dd));
            unsigned long long* slot = (unsigned long long*)xbuf + ((size_t)(u.pm * BM + row) * 4 + u.pn);
            __hip_atomic_store(slot, ((unsigned long long)__float_as_uint(m2) << 32) | __float_as_uint(mt), __ATOMIC_RELAXED, __HIP_MEMORY_SCOPE_AGENT);
        }
        asm volatile("s_waitcnt vmcnt(0)" ::: "memory");
        if (lane == 0) __hip_atomic_fetch_add(cnt + 64 * u.pm, 1u, __ATOMIC_RELAXED, __HIP_MEMORY_SCOPE_AGENT);
        if (wid == 0) {
            bool dead = false; const unsigned long long t0 = __builtin_amdgcn_s_memrealtime(); const unsigned want = 8u * (unsigned)ntn;
            for (;;) {
#if defined(BROKEN_EXCHANGE_NO_WAIT)
                break;
#endif
                if ((unsigned)__builtin_amdgcn_readfirstlane(__hip_atomic_load(cnt + 64 * u.pm, __ATOMIC_RELAXED, __HIP_MEMORY_SCOPE_AGENT)) >= want) break;
                if (__builtin_amdgcn_s_memrealtime() - t0 > 2000000ull) {
                    if (lane == 0) { unsigned expect = 0u; __hip_atomic_compare_exchange_strong(tmo + 1, &expect, code | (unsigned)(u.pm & 0xff), __ATOMIC_RELAXED, __ATOMIC_RELAXED, __HIP_MEMORY_SCOPE_AGENT);
                                     __hip_atomic_store(tmo, 1u, __ATOMIC_RELAXED, __HIP_MEMORY_SCOPE_AGENT); }
                    dead = true; break; }
                __builtin_amdgcn_s_sleep(2);
            }
            __builtin_amdgcn_fence(__ATOMIC_ACQUIRE, "agent");
            if (lane == 0) flag[0] = dead ? 1u : 0u;
        }
        asm volatile("s_waitcnt vmcnt(0) lgkmcnt(0)" ::: "memory"); __builtin_amdgcn_s_barrier(); asm volatile("" ::: "memory");
        const bool bad = flag[0] != 0u;
        if (lane < 32) {
            const unsigned long long* slot = (const unsigned long long*)xbuf + (size_t)(u.pm * BM + row) * 4; float mt[4], m2[4]; float ms = 0.f;
#pragma unroll
            for (int t = 0; t < 4; ++t) { if (t < ntn) { const unsigned long long w = __hip_atomic_load(slot + t, __ATOMIC_RELAXED, __HIP_MEMORY_SCOPE_AGENT); mt[t] = __uint_as_float((unsigned)w); m2[t] = __uint_as_float((unsigned)(w >> 32)); } else { mt[t] = 0.f; m2[t] = 0.f; } ms += mt[t]; }
            const float mean = ms / (float)ntn; float q = 0.f;
#pragma unroll
            for (int t = 0; t < 4; ++t) if (t < ntn) { const float dm = mt[t] - mean; q += m2[t] + 256.0f * dm * dm; }
            S[row] = (f32x2v){mean, 1.0f / sqrtf(q / (256.0f * (float)ntn) + eps)};
        }
        asm volatile("s_waitcnt lgkmcnt(0)" ::: "memory"); __builtin_amdgcn_s_barrier(); asm volatile("" ::: "memory");
        return bad;
    }
};
struct EpiLnRes {
    static constexpr bool PERM = false, AFTER_DRAIN = true;
    const float* base; float* out; int ldc; const float* bias; PanelStats st; unsigned poison;
    __device__ __forceinline__ void fused(f32x4 (&acc)[2][2][4][2], const Unit& u, int wr, int wc, int fr, int fq, PG8_LAS unsigned char* lds, int wid, int lane) const {
        typedef float f32x2v __attribute__((ext_vector_type(2)));
        const PG8_LAS f32x2v* S = (const PG8_LAS f32x2v*)(lds + 8192);
        const int col0 = u.pn * BM + wc * 32 + 4 * fq;
#pragma unroll
        for (int bj = 0; bj < 2; ++bj)
#pragma unroll
            for (int n = 0; n < 2; ++n) { const f32x4 bv = bias ? *(const f32x4*)(bias + col0 + bj * HALF + n * 16) : (f32x4){0.f, 0.f, 0.f, 0.f};
#pragma unroll
                for (int ai = 0; ai < 2; ++ai)
#pragma unroll
                    for (int m = 0; m < 4; ++m) acc[ai][bj][m][n] += bv; }
        f32x4 pre[4][2][2];
#pragma unroll
        for (int m = 0; m < 4; ++m) { const size_t off = (size_t)(u.pm * BM + wr * 64 + m * 16 + fr) * ldc + col0;
#pragma unroll
            for (int bj = 0; bj < 2; ++bj)
#pragma unroll
                for (int n = 0; n < 2; ++n) pre[m][bj][n] = *(const f32x4*)(base + off + bj * HALF + n * 16); }
        const bool bad = st.run(acc, u, wr, wc, fr, fq, lds, wid, lane) || poison != 0u;
        const float qnan = __builtin_nanf("");
#pragma unroll
        for (int ai = 0; ai < 2; ++ai)
#pragma unroll
            for (int m = 0; m < 4; ++m) { const int r = ai * HALF + wr * 64 + m * 16 + fr; const f32x2v sr = S[r]; const size_t off = (size_t)(u.pm * BM + r) * ldc + col0;
#pragma unroll
                for (int bj = 0; bj < 2; ++bj)
#pragma unroll
                    for (int n = 0; n < 2; ++n) { const f32x4 bs = ai == 0 ? pre[m][bj][n] : *(const f32x4*)(base + off + bj * HALF + n * 16); f32x4 o = bs + (acc[ai][bj][m][n] - sr.x) * sr.y;
                        if (bad) o = (f32x4){qnan, qnan, qnan, qnan}; *(f32x4*)(out + off + bj * HALF + n * 16) = o; }
                if (m & 1) asm volatile("" ::: "memory"); }
    }
};
struct EpiLnResLn {
    static constexpr bool PERM = false, AFTER_DRAIN = true;
    const float* base; float* out; bf16_t* xn; int ldc; const float* bias; PanelStats st1, st2; unsigned poison;
    __device__ __forceinline__ void fused(f32x4 (&acc)[2][2][4][2], const Unit& u, int wr, int wc, int fr, int fq, PG8_LAS unsigned char* lds, int wid, int lane) const {
        typedef float f32x2v __attribute__((ext_vector_type(2))); typedef unsigned u32x2v __attribute__((ext_vector_type(2)));
        const PG8_LAS f32x2v* S = (const PG8_LAS f32x2v*)(lds + 8192);
        const int col0 = u.pn * BM + wc * 32 + 4 * fq;
#pragma unroll
        for (int bj = 0; bj < 2; ++bj)
#pragma unroll
            for (int n = 0; n < 2; ++n) { const f32x4 bv = bias ? *(const f32x4*)(bias + col0 + bj * HALF + n * 16) : (f32x4){0.f, 0.f, 0.f, 0.f};
#pragma unroll
                for (int ai = 0; ai < 2; ++ai)
#pragma unroll
                    for (int m = 0; m < 4; ++m) acc[ai][bj][m][n] += bv; }
        bool bad = st1.run(acc, u, wr, wc, fr, fq, lds, wid, lane) || poison != 0u;
        const float qnan = __builtin_nanf("");
#pragma unroll
        for (int ai = 0; ai < 2; ++ai)
#pragma unroll
            for (int m = 0; m < 4; ++m) { const int r = ai * HALF + wr * 64 + m * 16 + fr; const f32x2v sr = S[r]; const size_t off = (size_t)(u.pm * BM + r) * ldc + col0;
#pragma unroll
                for (int bj = 0; bj < 2; ++bj)
#pragma unroll
                    for (int n = 0; n < 2; ++n) { const f32x4 bs = *(const f32x4*)(base + off + bj * HALF + n * 16); acc[ai][bj][m][n] = bs + (acc[ai][bj][m][n] - sr.x) * sr.y; }
                asm volatile("" : "+v"(acc[ai][0][m][0]), "+v"(acc[ai][0][m][1]), "+v"(acc[ai][1][m][0]), "+v"(acc[ai][1][m][1]));
                if (m & 1) asm volatile("" ::: "memory"); }
        const bool bad1 = bad;
        bad = st2.run(acc, u, wr, wc, fr, fq, lds, wid, lane) || bad;
#pragma unroll
        for (int ai = 0; ai < 2; ++ai)
#pragma unroll
            for (int m = 0; m < 4; ++m) { const int r = ai * HALF + wr * 64 + m * 16 + fr; const f32x2v sr = S[r]; const size_t off = (size_t)(u.pm * BM + r) * ldc + col0;
#pragma unroll
                for (int bj = 0; bj < 2; ++bj)
#pragma unroll
                    for (int n = 0; n < 2; ++n) { const f32x4 x1 = acc[ai][bj][m][n]; *(f32x4*)(out + off + bj * HALF + n * 16) = bad1 ? (f32x4){qnan, qnan, qnan, qnan} : x1;
                        const f32x4 o = (x1 - sr.x) * sr.y; u32x2v w; w.x = cvt_pk_bf16(o[0], o[1]); w.y = cvt_pk_bf16(o[2], o[3]);
                        if (bad) { w.x = 0x7fc07fc0u; w.y = 0x7fc07fc0u; } *(u32x2v*)(xn + off + bj * HALF + n * 16) = w; }
                asm volatile("" ::: "memory"); }
    }
};

template <class Epi, class Sched, bool ALIGN_EPI = false, bool SP2 = false>
__device__ __forceinline__ void gemm_phase(PG8_LAS unsigned char* lds, const Gemm g, const Sched& S, const Epi& E) {
    const int tid = threadIdx.x, wid = __builtin_amdgcn_readfirstlane(tid >> 6), lane = tid & 63, wr = wid >> 2, wc = wid & 3, fr = lane & 15, fq = lane >> 4;
    const int K = g.K, nt = K / BK;
    unsigned voffA[2], voffB[2];
#pragma unroll
    for (int i = 0; i < 2; ++i) { int R, C; stage_rc(tid * 16 + i * 8192, R, C); const int Rb = Epi::PERM ? ((R & ~31) + perm32(R & 31)) : R;
        voffA[i] = (unsigned)(R * K + C) * 2u; voffB[i] = (unsigned)(Rb * K + C) * 2u; }
    const size_t kstep = (size_t)(BK * 2);
    const size_t hstep = (size_t)HALF * K * 2;
    const size_t tstep = 2 * hstep;
    const unsigned ldsw = (unsigned)wid * 1024u;
    const int aoff = lds_byte(wr * 64 + fr, fq * 8), boff = lds_byte(wc * 32 + fr, fq * 8);
#define PG8_SA(b, h) (((b) * 2 + (h)) * HTB)
#define PG8_SB(b, h) ((4 + (b) * 2 + (h)) * HTB)
#define PG8_STAGE(bufoff, gbase, voff) do { _Pragma("unroll") for (int _i = 0; _i < 2; ++_i) \
        __builtin_amdgcn_global_load_lds((const unsigned*)((const char*)(gbase) + (voff)[_i]), (PG8_LAS unsigned*)(lds + (bufoff) + ldsw + _i * 8192), 16, 0, 0); } while (0)
#define PG8_LDA(dst, b, h) do { _Pragma("unroll") for (int m = 0; m < 4; ++m) _Pragma("unroll") for (int k = 0; k < 2; ++k) dst[m][k] = *(const PG8_LAS bf16x8*)(lds + PG8_SA(b, h) + aoff + m * 2048 + k * 1024); } while (0)
#define PG8_LDB(dst, b, h) do { _Pragma("unroll") for (int n = 0; n < 2; ++n) _Pragma("unroll") for (int k = 0; k < 2; ++k) dst[n][k] = *(const PG8_LAS bf16x8*)(lds + PG8_SB(b, h) + boff + n * 2048 + k * 1024); } while (0)
#define PG8_MMA(ai, bj, At, Bt) do { __builtin_amdgcn_s_setprio(1); _Pragma("unroll") for (int m = 0; m < 4; ++m) _Pragma("unroll") for (int n = 0; n < 2; ++n) _Pragma("unroll") for (int k = 0; k < 2; ++k) \
        acc[ai][bj][m][n] = __builtin_amdgcn_mfma_f32_16x16x32_bf16(Bt[n][k], At[m][k], acc[ai][bj][m][n], 0, 0, 0); __builtin_amdgcn_s_setprio(0); } while (0)
#define PG8_WAIT_V(n) asm volatile("s_waitcnt vmcnt(" #n ")" ::: "memory")
#define PG8_WAIT_L(n) asm volatile("s_waitcnt lgkmcnt(" #n ")" ::: "memory")
#define PG8_BAR __builtin_amdgcn_s_barrier()
#define PG8_SCHED __builtin_amdgcn_sched_barrier(0)
    Unit cur, nxt; int ui = 0;
    if (!S.next(0, cur)) return;
    f32x4 acc[2][2][4][2];
#pragma unroll
    for (int a = 0; a < 2; ++a)
#pragma unroll
        for (int b = 0; b < 2; ++b)
#pragma unroll
            for (int m = 0; m < 4; ++m)
#pragma unroll
                for (int n = 0; n < 2; ++n) acc[a][b][m][n] = (f32x4){0.f, 0.f, 0.f, 0.f};
    bf16x8 At[4][2], B0[2][2], B1[2][2];
    const char* cA = (const char*)g.A + (size_t)cur.pm * tstep; const char* cB = (const char*)g.Bt + (size_t)cur.pn * tstep;
    S.a_ready(cur);
    if constexpr (SP2) {
        PG8_STAGE(PG8_SB(0, 0), cB, voffB); PG8_STAGE(PG8_SB(0, 1), cB + hstep, voffB); PG8_STAGE(PG8_SA(0, 0), cA, voffA); PG8_STAGE(PG8_SA(0, 1), cA + hstep, voffA);
        if (wr == 1) PG8_BAR;
        PG8_WAIT_V(2); PG8_BAR;
        PG8_STAGE(PG8_SB(1, 0), cB + kstep, voffB); PG8_STAGE(PG8_SA(1, 0), cA + kstep, voffA); PG8_STAGE(PG8_SB(1, 1), cB + hstep + kstep, voffB);
        PG8_WAIT_V(6); PG8_BAR;
    } else {
        PG8_STAGE(PG8_SB(0, 0), cB, voffB); PG8_STAGE(PG8_SA(0, 0), cA, voffA); PG8_STAGE(PG8_SB(0, 1), cB + hstep, voffB); PG8_STAGE(PG8_SA(0, 1), cA + hstep, voffA);
        if (wr == 1) PG8_BAR;
        PG8_WAIT_V(4); PG8_BAR;
        PG8_STAGE(PG8_SB(1, 0), cB + kstep, voffB); PG8_STAGE(PG8_SA(1, 0), cA + kstep, voffA); PG8_STAGE(PG8_SB(1, 1), cB + hstep + kstep, voffB);
        PG8_WAIT_V(6); PG8_BAR;
    }
    for (;;) {
        const bool has_next = S.next(ui + 1, nxt);
        const char* nA = has_next ? (const char*)g.A + (size_t)nxt.pm * tstep : cA; const char* nB = has_next ? (const char*)g.Bt + (size_t)nxt.pn * tstep : cB;
        for (int t = 0; t < nt; t += 2) {
            const bool last = (t == nt - 2);
            const char* a1 = cA + (size_t)(t + 1) * kstep;
            const char* a2 = last ? nA : cA + (size_t)(t + 2) * kstep; const char* b2 = last ? nB : cB + (size_t)(t + 2) * kstep;
            const char* a3 = a2 + kstep; const char* b3 = b2 + kstep;
            if (last && has_next) S.a_ready(nxt);
            if constexpr (SP2) {
            PG8_LDB(B0, 0, 0); PG8_LDB(B1, 0, 1); PG8_SCHED; PG8_LDA(At, 0, 0); PG8_STAGE(PG8_SA(1, 1), a1 + hstep, voffA);
            PG8_WAIT_V(8); PG8_WAIT_L(0); PG8_BAR; PG8_MMA(0, 0, At, B0); PG8_MMA(0, 1, At, B1); PG8_BAR; PG8_SCHED;
            PG8_LDA(At, 0, 1); PG8_STAGE(PG8_SB(0, 0), b2, voffB); PG8_STAGE(PG8_SB(0, 1), b2 + hstep, voffB); PG8_STAGE(PG8_SA(0, 0), a2, voffA);
            PG8_WAIT_V(8); PG8_WAIT_L(0); PG8_BAR; PG8_MMA(1, 0, At, B0); PG8_MMA(1, 1, At, B1); PG8_BAR; PG8_SCHED;
            PG8_LDB(B0, 1, 0); PG8_LDB(B1, 1, 1); PG8_SCHED; PG8_LDA(At, 1, 0); PG8_STAGE(PG8_SA(0, 1), a2 + hstep, voffA);
            PG8_WAIT_V(8); PG8_WAIT_L(0); PG8_BAR; PG8_MMA(0, 0, At, B0); PG8_MMA(0, 1, At, B1); PG8_BAR; PG8_SCHED;
            PG8_LDA(At, 1, 1); PG8_STAGE(PG8_SB(1, 0), b3, voffB); PG8_STAGE(PG8_SB(1, 1), b3 + hstep, voffB); PG8_STAGE(PG8_SA(1, 0), a3, voffA);
            PG8_WAIT_V(8); PG8_WAIT_L(0); PG8_BAR; PG8_MMA(1, 0, At, B0); PG8_MMA(1, 1, At, B1); PG8_BAR; PG8_SCHED;
            } else {
            PG8_LDB(B0, 0, 0); PG8_SCHED; PG8_LDA(At, 0, 0); PG8_STAGE(PG8_SA(1, 1), a1 + hstep, voffA);
            PG8_WAIT_L(8); PG8_BAR; PG8_WAIT_L(0); PG8_MMA(0, 0, At, B0); PG8_BAR; PG8_SCHED;
            PG8_LDB(B1, 0, 1); PG8_STAGE(PG8_SB(0, 0), b2, voffB);
            PG8_BAR; PG8_WAIT_L(0); PG8_MMA(0, 1, At, B1); PG8_BAR;
            PG8_LDA(At, 0, 1); PG8_STAGE(PG8_SA(0, 0), a2, voffA);
            PG8_BAR; PG8_WAIT_L(0); PG8_MMA(1, 0, At, B0); PG8_BAR; PG8_SCHED;
            PG8_STAGE(PG8_SB(0, 1), b2 + hstep, voffB);
            PG8_WAIT_V(6); PG8_BAR; PG8_MMA(1, 1, At, B1); PG8_BAR;
            PG8_LDB(B0, 1, 0); PG8_SCHED; PG8_LDA(At, 1, 0); PG8_STAGE(PG8_SA(0, 1), a2 + hstep, voffA);
            PG8_WAIT_L(8); PG8_BAR; PG8_WAIT_L(0); PG8_MMA(0, 0, At, B0); PG8_BAR; PG8_SCHED;
            PG8_LDB(B1, 1, 1); PG8_STAGE(PG8_SB(1, 0), b3, voffB);
            PG8_BAR; PG8_WAIT_L(0); PG8_MMA(0, 1, At, B1); PG8_BAR;
            PG8_LDA(At, 1, 1); PG8_STAGE(PG8_SA(1, 0), a3, voffA);
            PG8_BAR; PG8_WAIT_L(0); PG8_MMA(1, 0, At, B0); PG8_BAR; PG8_SCHED;
            PG8_STAGE(PG8_SB(1, 1), b3 + hstep, voffB);
            PG8_WAIT_V(6); PG8_BAR; PG8_MMA(1, 1, At, B1); PG8_BAR;
            }
        }
        if constexpr (ALIGN_EPI) { if (wr == 0) PG8_BAR; }
        if constexpr (!Epi::AFTER_DRAIN) { E(acc, cur, wr, wc, fr, fq); S.done(cur); }
        if (!has_next) break;
#pragma unroll
        for (int a = 0; a < 2; ++a)
#pragma unroll
            for (int b = 0; b < 2; ++b)
#pragma unroll
                for (int m = 0; m < 4; ++m)
#pragma unroll
                    for (int n = 0; n < 2; ++n) acc[a][b][m][n] = (f32x4){0.f, 0.f, 0.f, 0.f};
        cur = nxt; cA = nA; cB = nB; ++ui;
        if constexpr (ALIGN_EPI) { if (wr == 1) PG8_BAR; }
    }
    PG8_WAIT_V(0);
    if constexpr (!ALIGN_EPI) { if (wr == 0) PG8_BAR; }
    PG8_BAR;
    if constexpr (Epi::AFTER_DRAIN) { E.fused(acc, cur, wr, wc, fr, fq, lds, wid, lane); S.done(cur); }
#undef PG8_SA
#undef PG8_SB
#undef PG8_STAGE
#undef PG8_LDA
#undef PG8_LDB
#undef PG8_MMA
#undef PG8_WAIT_V
#undef PG8_WAIT_L
#undef PG8_BAR
#undef PG8_SCHED
}
}
namespace pg8 {
template <class F> struct EpiScalar {
    static constexpr bool PERM = true, AFTER_DRAIN = false; F f;
    __device__ __forceinline__ void operator()(const f32x4 (&acc)[2][2][4][2], const Unit& u, int wr, int wc, int fr, int fq) const {
        const int row0 = u.pm * BM + wr * 64 + fr, col0 = u.pn * BM + wc * 32 + 8 * fq;
#pragma unroll
        for (int ai = 0; ai < 2; ++ai)
#pragma unroll
            for (int m = 0; m < 4; ++m) {
#pragma unroll
                for (int bj = 0; bj < 2; ++bj)
#pragma unroll
                    for (int n = 0; n < 2; ++n)
#pragma unroll
                        for (int e = 0; e < 4; ++e) f(row0 + ai * HALF + m * 16, col0 + bj * HALF + 4 * n + e, acc[ai][bj][m][n][e]);
                asm volatile("" ::: "memory"); }
    }
};
template <class F> struct EpiScalarPair {
    static constexpr bool PERM = true, AFTER_DRAIN = false; F f;
    __device__ __forceinline__ void operator()(const f32x4 (&acc)[2][2][4][2], const Unit& u, int wr, int wc, int fr, int fq) const {
        const int row0 = u.pm * BM + wr * 64 + fr, cl0 = wc * 32 + 8 * fq;
#pragma unroll
        for (int ai = 0; ai < 2; ++ai)
#pragma unroll
            for (int m = 0; m < 4; ++m) {
#pragma unroll
                for (int n = 0; n < 2; ++n)
#pragma unroll
                    for (int e = 0; e < 4; ++e) f(row0 + ai * HALF + m * 16, u.pn, cl0 + 4 * n + e, acc[ai][0][m][n][e], acc[ai][1][m][n][e]);
                asm volatile("" ::: "memory"); }
    }
};
}
#define GAS __attribute__((address_space(1)))
#define LAS __attribute__((address_space(3)))
typedef unsigned short bf16;
typedef unsigned v4u __attribute__((ext_vector_type(4)));
typedef float f32x4 __attribute__((ext_vector_type(4)));
typedef short bf16x8 __attribute__((ext_vector_type(8)));
typedef GAS unsigned gu32;
typedef GAS unsigned long long gu64;
#define RLX_AGENT __ATOMIC_RELAXED, __HIP_MEMORY_SCOPE_AGENT
#define LDS_WAIT() asm volatile("s_waitcnt lgkmcnt(0)" ::: "memory")
#define VM_WAIT() asm volatile("s_waitcnt vmcnt(0)" ::: "memory")
__device__ __forceinline__ unsigned long long rt() { return __builtin_amdgcn_s_memrealtime(); }
__device__ __forceinline__ unsigned f2bf(float f) { unsigned u = __builtin_bit_cast(unsigned, f); return (u + 0x7fffu + ((u >> 16) & 1u)) >> 16; }
__device__ __forceinline__ unsigned pk2(float lo, float hi) { return f2bf(lo) | (f2bf(hi) << 16); }

#define XB_TMO      128
#define XB_XCNT(j)  (256  + 64 * (j))
#define XB_XSUB(j)  (1280 + 64 * (j))
#define XB_XGEN(j)  (2304 + 64 * (j))
#define XB_TOP      3328
#define XB_TOPGEN   3392
#define XCD_BAR_WORDS 3456
#define XB_SPIN_CAP (1u << 18)

__device__ __forceinline__ unsigned xb_ld(unsigned* p)              { return __hip_atomic_load(p, __ATOMIC_RELAXED, __HIP_MEMORY_SCOPE_AGENT); }
__device__ __forceinline__ unsigned xb_add(unsigned* p, unsigned v) { return __hip_atomic_fetch_add(p, v, __ATOMIC_RELAXED, __HIP_MEMORY_SCOPE_AGENT); }
__device__ __forceinline__ unsigned xb_xcc_id() { return (unsigned)__builtin_amdgcn_s_getreg((3 << 11) | 20) & 0xFu; }
#define XB_SPIN(cond, bar) do { unsigned _sp = 0; while (cond) { __builtin_amdgcn_s_sleep(1); \
    if ((++_sp & 255u) == 0u) { if (xb_ld(&(bar)[XB_TMO])) break; if (_sp > XB_SPIN_CAP) { atomicAdd(&(bar)[XB_TMO], 1u); break; } } } } while (0)

struct XcdBarrier {
    unsigned* bar; unsigned x;
    volatile LAS unsigned* st;
};

__device__ __forceinline__ XcdBarrier xcd_barrier_post(unsigned* bar, volatile LAS unsigned* st) {
    XcdBarrier b; b.bar = bar; b.x = xb_xcc_id(); b.st = st;
    if (threadIdx.x == 0) (void)xb_add(&bar[XB_XCNT(b.x)], 1u);
    return b;
}
__device__ __forceinline__ void xcd_barrier_complete(unsigned* bar, unsigned x, unsigned& nloc, unsigned& nx) {
    const unsigned G = gridDim.x * gridDim.y * gridDim.z;
    unsigned sum, cnt, mine, sp = 0u;
    for (;;) {
        sum = 0u; cnt = 0u; mine = 0u;
#pragma unroll
        for (unsigned j = 0; j < 16; ++j) { const unsigned c = xb_ld(&bar[XB_XCNT(j)]); sum += c; cnt += (c > 0u) ? 1u : 0u; mine = (j == x) ? c : mine; }
        if (sum == G) break;
        __builtin_amdgcn_s_sleep(1);
        if ((++sp & 255u) == 0u) { if (xb_ld(&bar[XB_TMO])) break; if (sp > XB_SPIN_CAP) { atomicAdd(&bar[XB_TMO], 1u); break; } }
    }
    nloc = mine > 0u ? mine : 1u; nx = cnt > 0u ? cnt : 1u;
}

__device__ __forceinline__ void xcd_barrier(const XcdBarrier& b) {
    asm volatile("s_waitcnt vmcnt(0)" ::: "memory");
    __syncthreads();
    if (threadIdx.x == 0) {
        unsigned* bar = b.bar;
        __builtin_amdgcn_s_waitcnt(0);
        unsigned nloc = b.st[0], nx = b.st[1];
        if (nloc == 0u) { xcd_barrier_complete(bar, b.x, nloc, nx); b.st[0] = nloc; b.st[1] = nx; }
        const unsigned old = xb_add(&bar[XB_XSUB(b.x)], 1u);
        const unsigned gen = old / nloc;
        if (old + 1u == (gen + 1u) * nloc) {
            __builtin_amdgcn_fence(__ATOMIC_RELEASE, "agent");
            asm volatile("s_waitcnt vmcnt(0)" ::: "memory");
            const unsigned og = xb_add(&bar[XB_TOP], 1u);
            const unsigned tg = og / nx;
            if (og + 1u == (tg + 1u) * nx) xb_add(&bar[XB_TOPGEN], 1u);
            else XB_SPIN(xb_ld(&bar[XB_TOPGEN]) == tg, bar);
            __builtin_amdgcn_fence(__ATOMIC_ACQUIRE, "agent");
            xb_add(&bar[XB_XGEN(b.x)], 1u);
            asm volatile("s_waitcnt vmcnt(0)" ::: "memory");
        } else {
            XB_SPIN(xb_ld(&bar[XB_XGEN(b.x)]) == gen, bar);
            __builtin_amdgcn_fence(__ATOMIC_ACQUIRE, "agent");
            asm volatile("s_waitcnt vmcnt(0)" ::: "memory");
        }
    }
    __syncthreads();
}
#ifndef ATT_FAST
#define ATT_FAST 1
#endif

constexpr int NWAVES = 8, NTHR = NWAVES * 64;
constexpr int BATCH = 4, SEQ = 8192, D = 1024, M = BATCH * SEQ;
constexpr int NHG = 8, HD = 64, HW = NHG * HD;
constexpr int INCOLS = 3080, NPROJ = 3072;
constexpr int NE = 32, NGRP = 4, EPG = 8, DF = 512, PLED = 256;
constexpr int SPAD = 2 * M + NE * 256;
constexpr float ALPHA = 1.189207115002721f, LN_EPS = 1e-5f, LOG2E = 1.4426950408889634f;
constexpr int NPH = 11;

constexpr size_t MiB = 1u << 20;
constexpr size_t WS_CTL = 0, CTL_ZERO_BYTES = 256 * 1024;
constexpr size_t WS_LS = 1 * MiB, WS_CFL = 2 * MiB, WS_CTOT = 3 * MiB, WS_KNT = 3 * MiB + 4096, WS_EID = 3 * MiB + 256 * 1024, WS_GATE = 3 * MiB + 512 * 1024, WS_RANK = 3 * MiB + 768 * 1024,
                 WS_SLOT = 4 * MiB, WS_GSLOT = 4 * MiB + 256 * 1024;
constexpr size_t WS_WIN = 5 * MiB, WS_WOUT = 11 * MiB, WS_WPLE = 13 * MiB, WS_WPG = 14 * MiB, WS_WGU = 16 * MiB, WS_WD = 80 * MiB, WS_PPLE = 112 * MiB;
constexpr size_t WS_R1 = 176 * MiB;
constexpr size_t WS_R2 = 368 * MiB;
constexpr size_t WS_R3 = 432 * MiB;
constexpr size_t WS_END = 504 * MiB;
static_assert(WS_GSLOT + (size_t)SPAD * 4 <= WS_WIN && WS_R1 + (size_t)SPAD * 2048 <= WS_R2 && WS_R3 + (size_t)SPAD * 1024 <= WS_END, "ws map");
constexpr int CW_TMO = 0, CW_BAR = 4096, CW_CNT = 8192;

constexpr int RING_OFF = 0, RING_BYTES = 131072;
constexpr int LDSCTL_OFF = RING_BYTES, MISC_OFF = LDSCTL_OFF + 320, PST_OFF = LDSCTL_OFF + 1024, HIST_OFF = LDSCTL_OFF + 1280, BASE_OFF = LDSCTL_OFF + 1408, ROWL_OFF = LDSCTL_OFF + 2048;
constexpr int LDS_BYTES = 147456;

__device__ __forceinline__ float bf2f(unsigned short v) { return __builtin_bit_cast(float, (unsigned)v << 16); }
__device__ __forceinline__ float wave_sum(float v) {
#pragma unroll
    for (int o = 1; o < 64; o <<= 1) v += __shfl_xor(v, o);
    return v;
}
__device__ __forceinline__ float wave_max(float v) {
#pragma unroll
    for (int o = 1; o < 64; o <<= 1) v = fmaxf(v, __shfl_xor(v, o));
    return v;
}

struct Frame {
    LAS unsigned char* lds; volatile LAS unsigned* MISC; gu32* ctl;
    int tid, lane, wave, vcu, G;
    const float *x, *p, *w_in, *b_forget, *w_out, *ln1g, *ln1b, *w_group, *b_group, *w_router, *b_router, *w_gate, *w_up, *w_down, *w_ple, *w_pg, *ln2g, *ln2b;
    float* out;
    bf16 *Win_t, *Wout_t, *Wple_t, *Wpg_t, *Wgu_t, *Wd_t, *pple, *qkv, *xs, *y, *xb, *mixed, *hb, *pb, *hdn;
    float *ls, *cfl, *ctot, *knt, *gatev, *gslot; int *eid, *rank, *slot;
};

__device__ __forceinline__ void transpose_tile(const float* Wt, int ldw, bf16* WTt, int ldt, LAS float* scr, int lane, float sc = 1.f) {
#pragma unroll 8
    for (int i = 0; i < 32; ++i) { const int kk = 2 * i + (lane >> 5); scr[kk * 33 + (lane & 31)] = Wt[(size_t)kk * ldw + (lane & 31)] * sc; }
    LDS_WAIT(); asm volatile("" ::: "memory");
    const int c = lane & 7;
#pragma unroll
    for (int j = 0; j < 4; ++j) { const int n = (lane >> 3) + 8 * j; const LAS float* s = scr + (8 * c) * 33 + n;
        v4u o; o.x = pk2(s[0 * 33], s[1 * 33]); o.y = pk2(s[2 * 33], s[3 * 33]); o.z = pk2(s[4 * 33], s[5 * 33]); o.w = pk2(s[6 * 33], s[7 * 33]);
        *(GAS v4u*)(WTt + (size_t)n * ldt + 8 * c) = o; }
    LDS_WAIT(); asm volatile("" ::: "memory");
}
__device__ __forceinline__ float log_sigmoid_f(float v) { return fminf(v, 0.f) - log1pf(expf(-fabsf(v))); }

__device__ __forceinline__ void p0_prologue(Frame& F) {
    LAS float* scr = (LAS float*)(F.lds + RING_OFF + F.wave * 16384);
    const int gw = F.vcu * NWAVES + F.wave, NGW = F.G * NWAVES;
    constexpr int I_IN = 16 * 96, I_OUT = 16 * 32, I_PLE = 4 * 32, I_PG = 16 * 32, I_GU = NE * 2 * 16 * 16, I_DN = NE * 8 * 32;
    constexpr int NITEMS = I_IN + I_OUT + I_PLE + I_PG + I_GU + I_DN;
    for (int it = gw; it < NITEMS; it += NGW) {
        int r = it;
        if (r < I_IN) { const int kb = r / 96, nb = r % 96; const int t = nb >> 4;
            transpose_tile(F.w_in + (size_t)kb * 64 * INCOLS + nb * 32, INCOLS, F.Win_t + (size_t)nb * 32 * D + kb * 64, D, scr, F.lane, (t == 0 || t == 3) ? 0.125f : 1.f); continue; } r -= I_IN;
        if (r < I_OUT) { const int kb = r / 32, nb = r % 32; transpose_tile(F.w_out + (size_t)kb * 64 * D + nb * 32, D, F.Wout_t + (size_t)nb * 32 * D + kb * 64, D, scr, F.lane); continue; } r -= I_OUT;
        if (r < I_PLE) { const int kb = r / 32, nb = r % 32; transpose_tile(F.w_ple + (size_t)kb * 64 * D + nb * 32, D, F.Wple_t + (size_t)nb * 32 * PLED + kb * 64, PLED, scr, F.lane); continue; } r -= I_PLE;
        if (r < I_PG) { const int kb = r / 32, nb = r % 32; transpose_tile(F.w_pg + (size_t)kb * 64 * D + nb * 32, D, F.Wpg_t + (size_t)nb * 32 * D + kb * 64, D, scr, F.lane); continue; } r -= I_PG;
        if (r < I_GU) { const int e = r / 512, gu = (r >> 8) & 1, kb = (r >> 4) & 15, nb = r & 15;
            const float* src = (gu ? F.w_up : F.w_gate) + (size_t)e * D * DF + (size_t)kb * 64 * DF + nb * 32;
            const int row = e * 1024 + (nb >> 2) * 256 + gu * 128 + (nb & 3) * 32;
            transpose_tile(src, DF, F.Wgu_t + (size_t)row * D + kb * 64, D, scr, F.lane); continue; } r -= I_GU;
        { const int e = r / 256, kb = (r >> 5) & 7, nb = r & 31;
            transpose_tile(F.w_down + (size_t)e * DF * D + (size_t)kb * 64 * D + nb * 32, D, F.Wd_t + (size_t)(e * 1024 + nb * 32) * DF + kb * 64, DF, scr, F.lane); }
    }
    __syncthreads();
    LAS float* wf = (LAS float*)(F.lds + RING_OFF);
    for (int i = F.tid; i < 2048; i += NTHR) { const int c = i >> 1, j0 = (i & 1) * 4; const f32x4 w = *(const GAS f32x4*)(F.w_in + (size_t)c * INCOLS + NPROJ + j0);
        wf[(j0 + 0) * 1024 + c] = w.x; wf[(j0 + 1) * 1024 + c] = w.y; wf[(j0 + 2) * 1024 + c] = w.z; wf[(j0 + 3) * 1024 + c] = w.w; }
    __syncthreads();
    for (int m = gw; m < M; m += NGW) {
        const GAS f32x4* xr = (const GAS f32x4*)(F.x + (size_t)m * D) + F.lane;
        f32x4 v[4];
#pragma unroll
        for (int j = 0; j < 4; ++j) v[j] = xr[64 * j];
        GAS unsigned long long* o8 = (GAS unsigned long long*)(F.xb + (size_t)m * D) + F.lane;
#pragma unroll
        for (int j = 0; j < 4; ++j) o8[64 * j] = (unsigned long long)pk2(v[j].x, v[j].y) | ((unsigned long long)pk2(v[j].z, v[j].w) << 32);
        float acc[8];
#pragma unroll
        for (int g = 0; g < 8; ++g) { float a = 0.f;
#pragma unroll
            for (int j = 0; j < 4; ++j) { const f32x4 w = *(const LAS f32x4*)(wf + g * 1024 + 4 * F.lane + 256 * j); a += (v[j].x * w.x + v[j].y * w.y) + (v[j].z * w.z + v[j].w * w.w); }
            acc[g] = wave_sum(a); }
        float mine = 0.f;
#pragma unroll
        for (int g = 0; g < 8; ++g) if (F.lane == g) mine = acc[g];
        if (F.lane < 8) F.ls[(size_t)m * 8 + F.lane] = log_sigmoid_f(mine + F.b_forget[F.lane]);
    }
    { const int gtid = blockIdx.x * NTHR + F.tid, NT = F.G * NTHR;
      for (int i = gtid; i < M * PLED / 8; i += NT) { const GAS f32x4* s = (const GAS f32x4*)(F.p) + 2 * (size_t)i; const f32x4 a = s[0], b = s[1];
          v4u o; o.x = pk2(a.x, a.y); o.y = pk2(a.z, a.w); o.z = pk2(b.x, b.y); o.w = pk2(b.z, b.w); ((GAS v4u*)F.pb)[i] = o; } }
}

__device__ __forceinline__ void p2_scan(Frame& F) {
    LAS float* wt = (LAS float*)(F.lds + RING_OFF);
    for (int it = blockIdx.x; it < 256; it += F.G) {
        const int bh = it >> 3, chunk = it & 7, b = bh >> 3, h = bh & 7, t = chunk * 1024 + 2 * F.tid;
        const float a0 = F.ls[(size_t)(b * SEQ + t) * 8 + h] * LOG2E, a1 = F.ls[(size_t)(b * SEQ + t + 1) * 8 + h] * LOG2E;
        float s = a0 + a1;
#pragma unroll
        for (int o = 1; o < 64; o <<= 1) { const float u = __shfl_up(s, o); if (F.lane >= o) s += u; }
        __syncthreads();
        if (F.lane == 63) wt[F.wave] = s;
        __syncthreads();
        float off = 0.f, tot = 0.f;
#pragma unroll
        for (int w = 0; w < 8; ++w) { const float u = wt[w]; if (w < F.wave) off += u; tot += u; }
        const float i1 = off + s, i0 = i1 - a1;
        F.cfl[(size_t)bh * SEQ + t] = i0; F.cfl[(size_t)bh * SEQ + t + 1] = i1;
        if (F.tid == 0) F.ctot[bh * 8 + chunk] = tot;
        const bf16* kf = F.qkv + (size_t)4 * M * HW;
        float nmax = 0.f;
#pragma unroll
        for (int rr = 0; rr < 2; ++rr) { const GAS v4u* kp = (const GAS v4u*)(kf + (size_t)(b * SEQ + t + rr) * HW + h * HD); float n2 = 0.f;
#pragma unroll
            for (int c = 0; c < 8; ++c) { const v4u w = kp[c];
#pragma unroll
                for (int e = 0; e < 4; ++e) { const float lo = __builtin_bit_cast(float, w[e] << 16), hi = __builtin_bit_cast(float, w[e] & 0xffff0000u); n2 += lo * lo + hi * hi; } }
            nmax = fmaxf(nmax, n2); }
#pragma unroll
        for (int o = 1; o < 32; o <<= 1) nmax = fmaxf(nmax, __shfl_xor(nmax, o));
        if ((F.lane & 31) == 0) F.knt[bh * 128 + chunk * 16 + F.wave * 2 + (F.lane >> 5)] = sqrtf(nmax);
    }
}

#if !defined(ATT_FAST) || !ATT_FAST
#define BFLO(w) __builtin_bit_cast(float, (w) << 16)
#define BFHI(w) __builtin_bit_cast(float, (w) & 0xffff0000u)
__device__ __forceinline__ void ld64(float (&d)[64], const bf16* p) {
    const GAS v4u* s = (const GAS v4u*)p;
#pragma unroll
    for (int c = 0; c < 8; ++c) { const v4u w = s[c];
#pragma unroll
        for (int e = 0; e < 4; ++e) { d[c * 8 + 2 * e] = BFLO(w[e]); d[c * 8 + 2 * e + 1] = BFHI(w[e]); } }
}
__device__ __forceinline__ float dot64(const float (&q)[64], const bf16* p) {
    const GAS v4u* s = (const GAS v4u*)p; float z = 0.f;
#pragma unroll
    for (int c = 0; c < 8; ++c) { const v4u w = s[c];
#pragma unroll
        for (int e = 0; e < 4; ++e) { z += q[c * 8 + 2 * e] * BFLO(w[e]); z += q[c * 8 + 2 * e + 1] * BFHI(w[e]); } }
    return z;
}
__device__ __forceinline__ void axpy64(float (&o)[64], float a, const bf16* p) {
    const GAS v4u* s = (const GAS v4u*)p;
#pragma unroll
    for (int c = 0; c < 8; ++c) { const v4u w = s[c];
#pragma unroll
        for (int e = 0; e < 4; ++e) { o[c * 8 + 2 * e] += a * BFLO(w[e]); o[c * 8 + 2 * e + 1] += a * BFHI(w[e]); } }
}
__device__ __forceinline__ void st64(bf16* p, const float (&d)[64], float sc) {
    GAS v4u* s = (GAS v4u*)p;
#pragma unroll
    for (int c = 0; c < 8; ++c) { v4u w;
#pragma unroll
        for (int e = 0; e < 4; ++e) w[e] = pk2(d[c * 8 + 2 * e] * sc, d[c * 8 + 2 * e + 1] * sc);
        s[c] = w; }
}
__device__ __forceinline__ void p3_attn_simple(Frame& F) {
    const int gtid = blockIdx.x * NTHR + F.tid, NT = F.G * NTHR;
    const bf16 *Qs = F.qkv, *Ks = F.qkv + (size_t)1 * M * HW, *Vs = F.qkv + (size_t)2 * M * HW, *Qf = F.qkv + (size_t)3 * M * HW, *Kf = F.qkv + (size_t)4 * M * HW, *Vf = F.qkv + (size_t)5 * M * HW;
    for (int idx = gtid; idx < M * NHG; idx += NT) {
        const int h = idx >> 15, m = idx & (M - 1), b = m >> 13, t = m & (SEQ - 1);
        float q[64], o[64];
        ld64(q, Qs + (size_t)m * HW + h * HD);
#pragma unroll
        for (int d = 0; d < 64; ++d) o[d] = 0.f;
        float C2 = 0.f;
        for (int s = t - 1; s >= 0; --s) {
            const float z = dot64(q, Ks + (size_t)(b * SEQ + s) * HW + h * HD);
            const float L2 = -(fmaxf(z, 0.f) * LOG2E + log2f(1.f + exp2f(-fabsf(z) * LOG2E)));
            const float w = exp2f(z * LOG2E + L2 + C2);
            axpy64(o, w, Vs + (size_t)(b * SEQ + s) * HW + h * HD);
            C2 += L2;
            if (C2 < -160.f) break;
        }
        st64(F.mixed + (size_t)m * D + h * HD, o, 1.f);
    }
    for (int idx = gtid; idx < M * NHG; idx += NT) {
        const int h = idx >> 15, m = idx & (M - 1), b = m >> 13, t = m & (SEQ - 1), bh = b * 8 + h;
        float q[64], o[64];
        ld64(q, Qf + (size_t)m * HW + h * HD);
#pragma unroll
        for (int d = 0; d < 64; ++d) o[d] = 0.f;
        float cq = F.cfl[(size_t)bh * SEQ + t];
        for (int c = 0; c < (t >> 10); ++c) cq += F.ctot[bh * 8 + c];
        float carry = 0.f, mr = -1e30f, l = 0.f;
        for (int s = 0; s <= t; ++s) {
            if ((s & 1023) == 0 && s > 0) carry += F.ctot[bh * 8 + (s >> 10) - 1];
            const float z = dot64(q, Kf + (size_t)(b * SEQ + s) * HW + h * HD);
            const float s2 = z * LOG2E + (cq - (F.cfl[(size_t)bh * SEQ + s] + carry));
            if (s2 > mr) { const float f = exp2f(mr - s2); l *= f;
#pragma unroll
                for (int d = 0; d < 64; ++d) o[d] *= f;
                mr = s2; }
            const float pw = exp2f(s2 - mr); l += pw;
            axpy64(o, pw, Vf + (size_t)(b * SEQ + s) * HW + h * HD);
        }
        st64(F.mixed + (size_t)m * D + HW + h * HD, o, 1.f / l);
    }
}

#endif
struct FProj { bf16* qkv; __device__ __forceinline__ void operator()(int row, int col, float v) const { const int t = col >> 9, cc = col & 511; const float sc = (t == 0 || t == 3) ? 0.125f : 1.f;
    qkv[(size_t)t * M * HW + (size_t)row * HW + cc] = (bf16)f2bf(v * sc); } };
struct FBf16 { bf16* O; int ldc; int cmask; __device__ __forceinline__ void operator()(int row, int col, float v) const { O[(size_t)row * ldc + (col & cmask)] = (bf16)f2bf(v); } };
struct FPre { const float* x; float* out; __device__ __forceinline__ void operator()(int row, int col, float v) const { const size_t i = (size_t)row * D + col; out[i] = ALPHA * x[i] + v; } };
struct FSwiglu { bf16* hdn; const float* gslot; __device__ __forceinline__ void operator()(int row, int pn, int cl, float g, float u) const {
    const int f = (pn & 3) * 128 + cl; const float s = g / (1.f + __expf(-g)); hdn[(size_t)row * DF + f] = (bf16)f2bf(s * u * gslot[row]); } };
struct FComb { float* out; const bf16* pple; const bf16* y; const int* slot; __device__ __forceinline__ void operator()(int row, int col, float v) const {
    const size_t i = (size_t)row * D + col; const int s0 = slot[row * 2], s1 = slot[row * 2 + 1]; const float sig = 1.f / (1.f + __expf(-v));
    out[i] = ALPHA * out[i] + bf2f(pple[i]) * sig + bf2f(y[(size_t)s0 * D + col]) + bf2f(y[(size_t)s1 * D + col]); } };

#ifndef PROBE_TWICE
#define PROBE_TWICE -1
#endif
template <class S> struct Rep2T : S {
    __device__ __forceinline__ bool next(int i, pg8::Unit& u) const { return S::next(i >> 1, u); }
};
template <class S, bool ON> struct Rep2Sel { typedef S type; };
template <class S> struct Rep2Sel<S, true> { typedef Rep2T<S> type; };
#define Rep2(S, ON) typename Rep2Sel<S, ON>::type

namespace pg8 {
struct EpiPre {
    static constexpr bool PERM = true, AFTER_DRAIN = false; const float* x; float* out;
    __device__ __forceinline__ void operator()(const f32x4 (&acc)[2][2][4][2], const Unit& u, int wr, int wc, int fr, int fq) const {
        const int row0 = u.pm * BM + wr * 64 + fr, col0 = u.pn * BM + wc * 32 + 8 * fq;
#pragma unroll
        for (int ai = 0; ai < 2; ++ai)
#pragma unroll
            for (int m = 0; m < 4; ++m) { const size_t off = (size_t)(row0 + ai * HALF + m * 16) * D + col0;
#pragma unroll
                for (int bj = 0; bj < 2; ++bj) { const f32x4 x0 = *(const f32x4*)(x + off + bj * HALF), x1 = *(const f32x4*)(x + off + bj * HALF + 4);
                    *(f32x4*)(out + off + bj * HALF) = x0 * ALPHA + acc[ai][bj][m][0]; *(f32x4*)(out + off + bj * HALF + 4) = x1 * ALPHA + acc[ai][bj][m][1]; }
                asm volatile("" ::: "memory"); }
    }
};
struct EpiSwiglu {
    static constexpr bool PERM = true, AFTER_DRAIN = false; bf16_t* hdn; const float* gslot;
    __device__ __forceinline__ void operator()(const f32x4 (&acc)[2][2][4][2], const Unit& u, int wr, int wc, int fr, int fq) const {
        const int row0 = u.pm * BM + wr * 64 + fr, f0 = (u.pn & 3) * 128 + wc * 32 + 8 * fq;
#pragma unroll
        for (int ai = 0; ai < 2; ++ai)
#pragma unroll
            for (int m = 0; m < 4; ++m) { const int r = row0 + ai * HALF + m * 16; const float gs = gslot[r]; float v[8];
#pragma unroll
                for (int n = 0; n < 2; ++n)
#pragma unroll
                    for (int e = 0; e < 4; ++e) { const float g = acc[ai][0][m][n][e], up = acc[ai][1][m][n][e]; v[4 * n + e] = g * __builtin_amdgcn_rcpf(1.f + __expf(-g)) * up * gs; }
                u32x4 w; w.x = cvt_pk_bf16(v[0], v[1]); w.y = cvt_pk_bf16(v[2], v[3]); w.z = cvt_pk_bf16(v[4], v[5]); w.w = cvt_pk_bf16(v[6], v[7]);
                *(u32x4*)(hdn + (size_t)r * DF + f0) = w; }
    }
};
struct EpiComb {
    static constexpr bool PERM = true, AFTER_DRAIN = false; float* out; const bf16_t* pple; const bf16_t* y; const int* slot;
    __device__ __forceinline__ void operator()(const f32x4 (&acc)[2][2][4][2], const Unit& u, int wr, int wc, int fr, int fq) const {
        const int row0 = u.pm * BM + wr * 64 + fr, col0 = u.pn * BM + wc * 32 + 8 * fq;
#pragma unroll
        for (int ai = 0; ai < 2; ++ai)
#pragma unroll
            for (int m = 0; m < 4; ++m) { const int r = row0 + ai * HALF + m * 16; const size_t off = (size_t)r * D + col0;
                const int s0 = slot[2 * r], s1 = slot[2 * r + 1];
#pragma unroll
                for (int bj = 0; bj < 2; ++bj) {
                    const f32x4 h0 = *(const f32x4*)(out + off + bj * HALF), h1 = *(const f32x4*)(out + off + bj * HALF + 4);
                    const u32x4 pp = *(const u32x4*)(pple + off + bj * HALF), y0 = *(const u32x4*)(y + (size_t)s0 * D + col0 + bj * HALF), y1 = *(const u32x4*)(y + (size_t)s1 * D + col0 + bj * HALF);
                    float res[8];
#pragma unroll
                    for (int e = 0; e < 8; ++e) { const float g = acc[ai][bj][m][e >> 2][e & 3]; const float sg = __builtin_amdgcn_rcpf(1.f + __expf(-g));
                        const unsigned pw = pp[e >> 1], a = y0[e >> 1], b = y1[e >> 1];
                        const float pv = (e & 1) ? __builtin_bit_cast(float, pw & 0xffff0000u) : __builtin_bit_cast(float, pw << 16);
                        const float av = (e & 1) ? __builtin_bit_cast(float, a & 0xffff0000u) : __builtin_bit_cast(float, a << 16);
                        const float bv = (e & 1) ? __builtin_bit_cast(float, b & 0xffff0000u) : __builtin_bit_cast(float, b << 16);
                        const float hv = (e < 4) ? h0[e & 3] : h1[e & 3];
                        res[e] = hv * ALPHA + pv * sg + (av + bv); }
                    *(f32x4*)(out + off + bj * HALF) = (f32x4){res[0], res[1], res[2], res[3]}; *(f32x4*)(out + off + bj * HALF + 4) = (f32x4){res[4], res[5], res[6], res[7]}; }
                asm volatile("" ::: "memory"); }
    }
};
}

struct MoeOrder {
    const LAS int* pst; int nunits, G, c;
    __device__ __forceinline__ bool next(int i, pg8::Unit& u) const {
        const int L = i * G + c; if (L >= nunits) return false;
        const int pm = L >> 2, r0 = pm * 256; int e = 0;
        for (int k = 0; k < NE - 1; ++k) if (r0 >= pst[k + 1]) e = k + 1;
        u.pm = pm; u.pn = e * 4 + (L & 3); return true;
    }
    __device__ __forceinline__ void a_ready(const pg8::Unit&) const {}
    __device__ __forceinline__ void done(const pg8::Unit&) const {}
};
__device__ __forceinline__ void build_pstart(Frame& F) {
    LAS int* pst = (LAS int*)(F.lds + PST_OFF);
    if (F.tid == 0) { int acc = 0; for (int e = 0; e < NE; ++e) { const int c = (int)__hip_atomic_load(F.ctl + CW_CNT + 64 * e, RLX_AGENT); pst[e] = acc; acc += (c + 255) & ~255; } pst[NE] = acc; }
    __syncthreads();
}

__device__ __forceinline__ void p5_ln_route(Frame& F) {
    LAS unsigned* hist = (LAS unsigned*)(F.lds + HIST_OFF); LAS unsigned* base = (LAS unsigned*)(F.lds + BASE_OFF);
    LAS int* eidL = (LAS int*)(F.lds + ROWL_OFF); LAS int* rankL = eidL + 256;
    if (F.tid < NE) hist[F.tid] = 0u;
    __syncthreads();
    f32x4 gv[4], bv[4];
#pragma unroll
    for (int j = 0; j < 4; ++j) { gv[j] = *(const GAS f32x4*)(F.ln1g + 4 * F.lane + 256 * j); bv[j] = *(const GAS f32x4*)(F.ln1b + 4 * F.lane + 256 * j); }
    for (int r = F.wave; r < 128; r += NWAVES) {
        const int m = blockIdx.x * 128 + r;
        GAS f32x4* pr = (GAS f32x4*)(F.out + (size_t)m * D) + F.lane;
        f32x4 v[4]; float s = 0.f;
#pragma unroll
        for (int j = 0; j < 4; ++j) { v[j] = pr[64 * j]; s += (v[j].x + v[j].y) + (v[j].z + v[j].w); }
        const float mean = wave_sum(s) * (1.f / D); float s2 = 0.f;
#pragma unroll
        for (int j = 0; j < 4; ++j) { v[j] = v[j] - mean; s2 += (v[j].x * v[j].x + v[j].y * v[j].y) + (v[j].z * v[j].z + v[j].w * v[j].w); }
        const float rstd = 1.f / sqrtf(wave_sum(s2) * (1.f / D) + LN_EPS);
        GAS unsigned long long* o8 = (GAS unsigned long long*)(F.hb + (size_t)m * D) + F.lane;
#pragma unroll
        for (int j = 0; j < 4; ++j) { v[j] = v[j] * rstd * gv[j] + bv[j]; pr[64 * j] = v[j]; o8[64 * j] = (unsigned long long)pk2(v[j].x, v[j].y) | ((unsigned long long)pk2(v[j].z, v[j].w) << 32); }
        float gl[4] = {0.f, 0.f, 0.f, 0.f};
#pragma unroll
        for (int j = 0; j < 4; ++j)
#pragma unroll
            for (int e = 0; e < 4; ++e) { const int c = 4 * F.lane + 256 * j + e; const f32x4 w = *(const GAS f32x4*)(F.w_group + (size_t)c * 4); const float hv = v[j][e];
                gl[0] += hv * w.x; gl[1] += hv * w.y; gl[2] += hv * w.z; gl[3] += hv * w.w; }
#pragma unroll
        for (int i = 0; i < 4; ++i) gl[i] = wave_sum(gl[i]) + F.b_group[i];
        int gs = 0; float gm = gl[0];
#pragma unroll
        for (int i = 1; i < 4; ++i) if (gl[i] > gm) { gm = gl[i]; gs = i; }
        gs = __builtin_amdgcn_readfirstlane(gs);
        float gden = 0.f;
#pragma unroll
        for (int i = 0; i < 4; ++i) gden += expf(gl[i] - gm);
        const float gprob = 1.f / gden;
        float el[8] = {0.f, 0.f, 0.f, 0.f, 0.f, 0.f, 0.f, 0.f};
#pragma unroll
        for (int j = 0; j < 4; ++j)
#pragma unroll
            for (int e = 0; e < 4; ++e) { const int c = 4 * F.lane + 256 * j + e; const GAS f32x4* wp = (const GAS f32x4*)(F.w_router + (size_t)c * NE + gs * EPG); const f32x4 w0 = wp[0], w1 = wp[1]; const float hv = v[j][e];
                el[0] += hv * w0.x; el[1] += hv * w0.y; el[2] += hv * w0.z; el[3] += hv * w0.w; el[4] += hv * w1.x; el[5] += hv * w1.y; el[6] += hv * w1.z; el[7] += hv * w1.w; }
#pragma unroll
        for (int i = 0; i < 8; ++i) el[i] = wave_sum(el[i]) + F.b_router[gs * EPG + i];
        int i1 = 0; float v1 = el[0];
#pragma unroll
        for (int i = 1; i < 8; ++i) if (el[i] > v1) { v1 = el[i]; i1 = i; }
        int i2 = (i1 == 0) ? 1 : 0; float v2 = (i1 == 0) ? el[1] : el[0];
#pragma unroll
        for (int i = 1; i < 8; ++i) if (i != i1 && el[i] > v2) { v2 = el[i]; i2 = i; }
        const float e2 = expf(v2 - v1), g1 = 1.f / (1.f + e2), g2 = e2 * g1;
        if (F.lane == 0) {
            const int ea = gs * EPG + i1, eb = gs * EPG + i2;
            const unsigned ra = __hip_atomic_fetch_add(hist + ea, 1u, __ATOMIC_RELAXED, __HIP_MEMORY_SCOPE_WORKGROUP);
            const unsigned rb = __hip_atomic_fetch_add(hist + eb, 1u, __ATOMIC_RELAXED, __HIP_MEMORY_SCOPE_WORKGROUP);
            eidL[r * 2] = ea; eidL[r * 2 + 1] = eb; rankL[r * 2] = (int)ra; rankL[r * 2 + 1] = (int)rb;
            F.eid[m * 2] = ea; F.eid[m * 2 + 1] = eb; F.gatev[m * 2] = g1 * gprob; F.gatev[m * 2 + 1] = g2 * gprob;
        }
    }
    __syncthreads();
    if (F.tid < NE) base[F.tid] = __hip_atomic_fetch_add(F.ctl + CW_CNT + 64 * F.tid, hist[F.tid], RLX_AGENT);
    __syncthreads();
    if (F.tid < 256) F.rank[blockIdx.x * 256 + F.tid] = rankL[F.tid] + (int)base[eidL[F.tid]];
}
__device__ __forceinline__ void p6_slots_gather(Frame& F) {
    build_pstart(F);
    const LAS int* pst = (const LAS int*)(F.lds + PST_OFF);
    for (int r = F.wave; r < 128; r += NWAVES) {
        const int m = blockIdx.x * 128 + r; int s = 0;
        if (F.lane < 2) { const int e = F.eid[m * 2 + F.lane]; s = pst[e] + F.rank[m * 2 + F.lane]; F.slot[m * 2 + F.lane] = s; F.gslot[s] = F.gatev[m * 2 + F.lane]; }
        const int s0 = __shfl(s, 0), s1 = __shfl(s, 1);
        const GAS v4u* src = (const GAS v4u*)(F.hb + (size_t)m * D); const v4u a = src[F.lane], b = src[F.lane + 64];
        GAS v4u* d0 = (GAS v4u*)(F.xs + (size_t)s0 * D); GAS v4u* d1 = (GAS v4u*)(F.xs + (size_t)s1 * D);
        d0[F.lane] = a; d0[F.lane + 64] = b; d1[F.lane] = a; d1[F.lane + 64] = b;
    }
}
__device__ __forceinline__ void p10_final_ln(Frame& F, bool poison) {
    f32x4 gv[4], bv[4];
#pragma unroll
    for (int j = 0; j < 4; ++j) { gv[j] = *(const GAS f32x4*)(F.ln2g + 4 * F.lane + 256 * j); bv[j] = *(const GAS f32x4*)(F.ln2b + 4 * F.lane + 256 * j); }
    const int gw = blockIdx.x * NWAVES + F.wave, NGW = F.G * NWAVES; const float qn = __builtin_nanf("");
    for (int m = gw; m < M; m += NGW) {
        GAS f32x4* pr = (GAS f32x4*)(F.out + (size_t)m * D) + F.lane;
        f32x4 v[4]; float s = 0.f;
#pragma unroll
        for (int j = 0; j < 4; ++j) { v[j] = pr[64 * j]; s += (v[j].x + v[j].y) + (v[j].z + v[j].w); }
        const float mean = wave_sum(s) * (1.f / D); float s2 = 0.f;
#pragma unroll
        for (int j = 0; j < 4; ++j) { v[j] = v[j] - mean; s2 += (v[j].x * v[j].x + v[j].y * v[j].y) + (v[j].z * v[j].z + v[j].w * v[j].w); }
        const float rstd = 1.f / sqrtf(wave_sum(s2) * (1.f / D) + LN_EPS);
#pragma unroll
        for (int j = 0; j < 4; ++j) { f32x4 o = v[j] * rstd * gv[j] + bv[j]; if (poison) o = (f32x4){qn, qn, qn, qn}; pr[64 * j] = o; }
    }
}


namespace att {
typedef float f32x16 __attribute__((ext_vector_type(16)));
typedef short s16x4 __attribute__((ext_vector_type(4)));
typedef short v4i16_t __attribute__((ext_vector_type(4)));
constexpr int BUFB = 16384 + 512, A_WS = 2 * BUFB, A_FLAG = A_WS + 2048, A_CAR = A_FLAG + 64, A_END = A_CAR + 64;
constexpr float STOP2 = -48.f;
__device__ __forceinline__ int crow(int r, int hi) { return (r & 3) + 8 * (r >> 2) + 4 * hi; }
__device__ __forceinline__ unsigned cvtpk(float lo, float hi) { typedef float f2 __attribute__((ext_vector_type(2))); typedef __bf16 b2 __attribute__((ext_vector_type(2))); f2 v = {lo, hi}; b2 b = __builtin_convertvector(v, b2); return __builtin_bit_cast(unsigned, b); }

template <int MODE> __device__ __forceinline__ void attn_unit(Frame& F, int bh, int qb) {
    const int tid = F.tid, lane = F.lane, r32 = lane & 31, hi = lane >> 5, wid = F.wave;
    const int b = bh >> 3, h = bh & 7;
    const bf16* Qg = F.qkv + (size_t)(MODE ? 3 : 0) * M * HW; const bf16* Kg = F.qkv + (size_t)(MODE ? 4 : 1) * M * HW; const bf16* Vg = F.qkv + (size_t)(MODE ? 5 : 2) * M * HW;
    const size_t rowbase = (size_t)b * SEQ; const int q0 = qb * 256;
    const bf16* Qw = Qg + (rowbase + q0 + wid * 32) * HW + h * HD;
    const bf16* Kh = Kg + rowbase * HW + h * HD; const bf16* Vh = Vg + rowbase * HW + h * HD;
    LAS unsigned char* L = F.lds + RING_OFF;
    LAS float* wsf = (LAS float*)(L + A_WS) + wid * 64;
    LAS unsigned* flg = (LAS unsigned*)(L + A_FLAG);
    LAS float* car = (LAS float*)(L + A_CAR);
    const int jt = (q0 >> 6) + 3, jw = (q0 >> 6) + (wid >> 1);
    const bf16* ksrc = Kh + (size_t)lane * HW + wid * 8;
    const bf16* vsrc = Vh + (size_t)(16 * (wid & 3) + (lane >> 2)) * HW + (wid >> 2) * 32 + (lane & 3) * 8;
    const int kdst = wid * 1024 + lane * 16, vdst = 8192 + wid * 1024 + lane * 16;
    const float* cfsrc = F.cfl + (size_t)bh * SEQ + tid * 4;
    float KNu = 0.f;
    if (MODE) {
        if (tid < 8) { float c = 0.f; for (int k = 0; k < tid; ++k) c += F.ctot[bh * 8 + k]; car[tid] = c; }
        float kn = (lane <= jt) ? F.knt[bh * 128 + lane] : 0.f; if (lane + 64 <= jt) kn = fmaxf(kn, F.knt[bh * 128 + lane + 64]);
        KNu = wave_max(kn);
    }
    bf16x8 qr[4];
#pragma unroll
    for (int d0 = 0; d0 < 4; ++d0) qr[d0] = *(const GAS bf16x8*)(Qw + (size_t)r32 * HW + d0 * 16 + hi * 8);
    __syncthreads();
    v4u kreg = *(const GAS v4u*)(ksrc + (size_t)jt * 64 * HW), vreg = *(const GAS v4u*)(vsrc + (size_t)jt * 64 * HW); f32x4 cfreg = {0.f, 0.f, 0.f, 0.f};
    if (MODE && tid < 16) { cfreg = *(const GAS f32x4*)(cfsrc + jt * 64); const float c = car[jt >> 4]; cfreg = cfreg + c; }
    *(LAS v4u*)(L + kdst) = kreg; *(LAS v4u*)(L + vdst) = vreg; if (MODE && tid < 16) *(LAS f32x4*)(L + 16384 + tid * 16) = cfreg;
    float cq = 0.f, qnb = 0.f;
    if (MODE) {
        cq = F.cfl[(size_t)bh * SEQ + q0 + wid * 32 + r32] + car[q0 >> 10];
        float n2 = 0.f;
#pragma unroll
        for (int d0 = 0; d0 < 4; ++d0)
#pragma unroll
            for (int e = 0; e < 8; ++e) { const float qv = __builtin_bit_cast(float, (unsigned)(unsigned short)qr[d0][e] << 16); n2 += qv * qv; }
        n2 += __shfl_xor(n2, 32);
        qnb = sqrtf(n2) * KNu * (LOG2E * 1.01f) + cq;
    }
    __syncthreads();
    f32x16 o[2]; o[0] = f32x16{}; o[1] = f32x16{};
    float C2 = 0.f, mhat = -1e30f, lsum = 0.f;
    bool wdone = false; int cur = 0;
    const LAS unsigned char* vb0 = L + 8192 + ((lane >> 4) & 1) * 32 + (lane & 3) * 8 + (4 * hi + ((lane & 15) >> 2)) * 64;
    for (int j = jt;; --j) {
        const bool more = j > 0;
        if (more) { kreg = *(const GAS v4u*)(ksrc + (size_t)(j - 1) * 64 * HW); vreg = *(const GAS v4u*)(vsrc + (size_t)(j - 1) * 64 * HW);
            if (MODE && tid < 16) cfreg = *(const GAS f32x4*)(cfsrc + (j - 1) * 64); }
        if (!wdone && j <= jw) {
            const LAS unsigned char* Kb = L + cur * BUFB;
            f32x16 p0 = f32x16{}, p1 = f32x16{};
            { const LAS unsigned char* kb = Kb + hi * 1024 + r32 * 16;
#pragma unroll
              for (int d0 = 0; d0 < 4; ++d0) { const bf16x8 b0 = *(const LAS bf16x8*)(kb + d0 * 2048), b1 = *(const LAS bf16x8*)(kb + d0 * 2048 + 512);
                  p0 = __builtin_amdgcn_mfma_f32_32x32x16_bf16(b0, qr[d0], p0, 0, 0, 0); p1 = __builtin_amdgcn_mfma_f32_32x32x16_bf16(b1, qr[d0], p1, 0, 0, 0); } }
            const bool diag = (j == jw); const int qrel = 32 * (wid & 1) + r32;
            if (MODE == 0) {
                float Lg[32];
#pragma unroll
                for (int r = 0; r < 16; ++r) {
                    const float z0 = p0[r], z1 = p1[r];
                    float l0 = -(fmaxf(z0, 0.f) * LOG2E + __builtin_amdgcn_logf(1.f + __builtin_amdgcn_exp2f(-fabsf(z0) * LOG2E)));
                    float l1 = -(fmaxf(z1, 0.f) * LOG2E + __builtin_amdgcn_logf(1.f + __builtin_amdgcn_exp2f(-fabsf(z1) * LOG2E)));
                    if (diag) { if (crow(r, hi) >= qrel) l0 = 0.f; if (crow(r, hi) + 32 >= qrel) l1 = 0.f; }
                    Lg[r] = l0; Lg[16 + r] = l1;
                }
                float Os[8], Ps[8];
#pragma unroll
                for (int i = 0; i < 8; ++i) { Os[i] = (Lg[4 * i] + Lg[4 * i + 1]) + (Lg[4 * i + 2] + Lg[4 * i + 3]); Ps[i] = __shfl_xor(Os[i], 32); }
                float T = 0.f;
#pragma unroll
                for (int i = 7; i >= 0; --i) {
                    float s = T + (hi ? 0.f : Ps[i]) + C2;
#pragma unroll
                    for (int e = 3; e >= 0; --e) { s += Lg[4 * i + e]; const int r = (4 * i + e) & 15; const float zz = (i < 4) ? p0[r] : p1[r];
                        float w = __builtin_amdgcn_exp2f(zz * LOG2E + s);
                        if (diag) { const int kk = crow(r, hi) + (i < 4 ? 0 : 32); if (kk >= qrel) w = 0.f; }
                        if (i < 4) p0[r] = w; else p1[r] = w; }
                    T += Os[i] + Ps[i];
                }
                C2 += T;
                wdone = __all(C2 < STOP2);
            } else {
                const LAS float* cfp = (const LAS float*)(Kb + 16384);
                float rm = -INFINITY;
#pragma unroll
                for (int g = 0; g < 4; ++g) { const f32x4 c0 = *(const LAS f32x4*)(cfp + 8 * g + 4 * hi), c1 = *(const LAS f32x4*)(cfp + 32 + 8 * g + 4 * hi);
#pragma unroll
                    for (int e = 0; e < 4; ++e) { const int r = 4 * g + e; float s0 = p0[r] * LOG2E + (cq - c0[e]), s1 = p1[r] * LOG2E + (cq - c1[e]);
                        if (diag) { if (crow(r, hi) > qrel) s0 = -INFINITY; if (crow(r, hi) + 32 > qrel) s1 = -INFINITY; }
                        p0[r] = s0; p1[r] = s1; rm = fmaxf(rm, fmaxf(s0, s1)); } }
                rm = fmaxf(rm, __shfl_xor(rm, 32));
                const float mnew = fmaxf(mhat, rm);
                if (__any(mnew > mhat)) {
                    const float f = __builtin_amdgcn_exp2f(mhat - mnew); lsum *= f;
                    if (hi == 0) wsf[r32] = f;
                    asm volatile("s_waitcnt lgkmcnt(0)" ::: "memory");
#pragma unroll
                    for (int r = 0; r < 16; ++r) { const float fr = wsf[crow(r, hi)]; o[0][r] *= fr; o[1][r] *= fr; }
                    mhat = mnew;
                }
                float sacc = 0.f;
#pragma unroll
                for (int r = 0; r < 16; ++r) { p0[r] = __builtin_amdgcn_exp2f(p0[r] - mhat); p1[r] = __builtin_amdgcn_exp2f(p1[r] - mhat); sacc += p0[r] + p1[r]; }
                lsum += sacc;
                const float c00 = cfp[0];
                wdone = __all(qnb - c00 - mhat < STOP2);
            }
            v4u pw0, pw1, pw2, pw3;
#pragma unroll
            for (int e = 0; e < 4; ++e) { pw0[e] = cvtpk(p0[2 * e], p0[2 * e + 1]); pw1[e] = cvtpk(p0[8 + 2 * e], p0[8 + 2 * e + 1]); pw2[e] = cvtpk(p1[2 * e], p1[2 * e + 1]); pw3[e] = cvtpk(p1[8 + 2 * e], p1[8 + 2 * e + 1]); }
            const LAS unsigned char* vb = vb0 + cur * BUFB;
#pragma unroll
            for (int d0 = 0; d0 < 2; ++d0) { s16x4 lo[4], hh[4];
#pragma unroll
                for (int ks = 0; ks < 4; ++ks) {
                    lo[ks] = __builtin_bit_cast(s16x4, __builtin_amdgcn_ds_read_tr16_b64_v4i16((LAS v4i16_t*)(vb + d0 * 4096 + ks * 1024)));
                    hh[ks] = __builtin_bit_cast(s16x4, __builtin_amdgcn_ds_read_tr16_b64_v4i16((LAS v4i16_t*)(vb + d0 * 4096 + ks * 1024 + 512))); }
#define ATT_PK(k) (bf16x8){lo[k][0], lo[k][1], lo[k][2], lo[k][3], hh[k][0], hh[k][1], hh[k][2], hh[k][3]}
                o[d0] = __builtin_amdgcn_mfma_f32_32x32x16_bf16(__builtin_bit_cast(bf16x8, pw0), ATT_PK(0), o[d0], 0, 0, 0);
                o[d0] = __builtin_amdgcn_mfma_f32_32x32x16_bf16(__builtin_bit_cast(bf16x8, pw1), ATT_PK(1), o[d0], 0, 0, 0);
                o[d0] = __builtin_amdgcn_mfma_f32_32x32x16_bf16(__builtin_bit_cast(bf16x8, pw2), ATT_PK(2), o[d0], 0, 0, 0);
                o[d0] = __builtin_amdgcn_mfma_f32_32x32x16_bf16(__builtin_bit_cast(bf16x8, pw3), ATT_PK(3), o[d0], 0, 0, 0);
#undef ATT_PK
            }
        }
        if (more) { const int nb = (cur ^ 1) * BUFB;
            if (MODE && tid < 16) { const float c = car[(j - 1) >> 4]; cfreg = cfreg + c; *(LAS f32x4*)(L + nb + 16384 + tid * 16) = cfreg; }
            *(LAS v4u*)(L + nb + kdst) = kreg; *(LAS v4u*)(L + nb + vdst) = vreg; }
        if (lane == 0) flg[cur * 8 + wid] = wdone ? 1u : 0u;
        __syncthreads();
        if (!more) break;
        unsigned alld = 1u;
#pragma unroll
        for (int w = 0; w < 8; ++w) alld &= flg[cur * 8 + w];
        if (alld) break;
        cur ^= 1;
    }
    float rli[16];
    if (MODE) {
        lsum += __shfl_xor(lsum, 32);
        if (hi == 0) wsf[r32] = lsum;
        asm volatile("s_waitcnt lgkmcnt(0)" ::: "memory");
#pragma unroll
        for (int r = 0; r < 16; ++r) rli[r] = 1.f / wsf[crow(r, hi)];
    } else {
#pragma unroll
        for (int r = 0; r < 16; ++r) rli[r] = 1.f;
    }
    bf16* Ow = F.mixed + (rowbase + q0 + wid * 32) * D + (MODE ? HW : 0) + h * HD;
#pragma unroll
    for (int r = 0; r < 16; ++r) {
        bf16* rowp = Ow + (size_t)crow(r, hi) * D + r32;
        rowp[0] = (bf16)f2bf(o[0][r] * rli[r]); rowp[32] = (bf16)f2bf(o[1][r] * rli[r]);
    }
}
}

template <int MODE> __device__ __forceinline__ void p3_attn_fast(Frame& F) {
    for (int i = 3; i >= 0; --i) { const int id = (int)blockIdx.x + F.G * i; if (id < 1024) att::attn_unit<MODE>(F, id & 31, id >> 5); }
}

struct Args { const float* in[18]; float* out; unsigned char* ws; int ph_lo, ph_hi; };
__global__ void __launch_bounds__(NTHR, 2) mk_fwd(Args args) {
    extern __shared__ __attribute__((aligned(16))) unsigned char lds[];
    Frame F;
    F.lds = (LAS unsigned char*)lds; F.MISC = (volatile LAS unsigned*)(F.lds + MISC_OFF);
    F.tid = threadIdx.x; F.lane = F.tid & 63; F.wave = __builtin_amdgcn_readfirstlane(F.tid >> 6);
    F.G = gridDim.x; { const int bx = blockIdx.x; F.vcu = (F.G % 8 == 0) ? (bx % 8) * (F.G / 8) + bx / 8 : bx; }
    unsigned char* ws = args.ws;
    F.ctl = (gu32*)(ws + WS_CTL);
    F.x = args.in[0]; F.p = args.in[1]; F.w_in = args.in[2]; F.b_forget = args.in[3]; F.w_out = args.in[4]; F.ln1g = args.in[5]; F.ln1b = args.in[6]; F.w_group = args.in[7]; F.b_group = args.in[8];
    F.w_router = args.in[9]; F.b_router = args.in[10]; F.w_gate = args.in[11]; F.w_up = args.in[12]; F.w_down = args.in[13]; F.w_ple = args.in[14]; F.w_pg = args.in[15]; F.ln2g = args.in[16]; F.ln2b = args.in[17];
    F.out = args.out;
    F.Win_t = (bf16*)(ws + WS_WIN); F.Wout_t = (bf16*)(ws + WS_WOUT); F.Wple_t = (bf16*)(ws + WS_WPLE); F.Wpg_t = (bf16*)(ws + WS_WPG); F.Wgu_t = (bf16*)(ws + WS_WGU); F.Wd_t = (bf16*)(ws + WS_WD);
    F.pple = (bf16*)(ws + WS_PPLE); F.qkv = (bf16*)(ws + WS_R1); F.xs = (bf16*)(ws + WS_R1); F.y = (bf16*)(ws + WS_R1);
    F.xb = (bf16*)(ws + WS_R2); F.mixed = (bf16*)(ws + WS_R2); F.hb = (bf16*)(ws + WS_R2); F.pb = (bf16*)(ws + WS_R3); F.hdn = (bf16*)(ws + WS_R3);
    F.ls = (float*)(ws + WS_LS); F.cfl = (float*)(ws + WS_CFL); F.ctot = (float*)(ws + WS_CTOT); F.knt = (float*)(ws + WS_KNT); F.gatev = (float*)(ws + WS_GATE); F.gslot = (float*)(ws + WS_GSLOT);
    F.eid = (int*)(ws + WS_EID); F.rank = (int*)(ws + WS_RANK); F.slot = (int*)(ws + WS_SLOT);
    for (int u = F.tid; u < (LDS_BYTES - LDSCTL_OFF) / 4; u += NTHR) ((LAS unsigned*)(F.lds + LDSCTL_OFF))[u] = 0u;
    __syncthreads();
    XcdBarrier bar = xcd_barrier_post((unsigned*)(F.ctl + CW_BAR), F.MISC + 8);
    const int lo = args.ph_lo, hi = args.ph_hi;
#ifndef PH_MASK
#define PH_MASK 0x7ff
#endif
#define IN(k) (((PH_MASK >> (k)) & 1) && lo <= (k) && (k) < hi)
#define SEAM(k) do { if (IN(k) && IN((k) + 1)) xcd_barrier(bar); } while (0)

#ifndef REPEAT_PH
#define REPEAT_PH -1
#endif
#define REP(k) _Pragma("unroll") for (int rep_ = 0; rep_ < ((k) == REPEAT_PH ? 2 : 1); ++rep_)
    REP(0) { if (IN(0)) { p0_prologue(F); } SEAM(0); }

    if (IN(1)) {
        { pg8::Gemm g{F.xb, F.Win_t, M, NPROJ, D}; pg8::StaticOrder S; S.init(M, NPROJ, F.G, (int)blockIdx.x);
          pg8::EpiBf16<0> E{F.qkv, HW, nullptr, HW, (size_t)M * HW, 1.f};
          typedef Rep2Sel<pg8::StaticOrder, PROBE_TWICE == 1>::type SS; SS S2; *(pg8::StaticOrder*)&S2 = S;
          pg8::gemm_phase<pg8::EpiBf16<0>, SS, true, true>(F.lds + RING_OFF, g, S2, E); }
        { pg8::Gemm g{F.pb, F.Wple_t, M, D, PLED}; pg8::StaticOrder S; S.init(M, D, F.G, (int)blockIdx.x);
          pg8::EpiBf16<0> E{F.pple, D, nullptr, 0, 0, 1.f};
          pg8::gemm_phase<pg8::EpiBf16<0>, pg8::StaticOrder, true, true>(F.lds + RING_OFF, g, S, E); }
    } SEAM(1);

    if (IN(2)) { p2_scan(F); } SEAM(2);

#if ATT_FAST
    REP(31) { if (IN(3)) { p3_attn_fast<1>(F); } }
    REP(32) { if (IN(3)) { p3_attn_fast<0>(F); } }
    SEAM(3);
#else
    if (IN(3)) { p3_attn_simple(F); } SEAM(3);
#endif

    if (IN(4)) {
        pg8::Gemm g{F.mixed, F.Wout_t, M, D, D}; pg8::StaticOrder S; S.init(M, D, F.G, (int)blockIdx.x);
        pg8::EpiPre E{F.x, F.out};
        typedef Rep2Sel<pg8::StaticOrder, PROBE_TWICE == 4>::type SS; SS S2; *(pg8::StaticOrder*)&S2 = S;
        pg8::gemm_phase<pg8::EpiPre, SS, true, true>(F.lds + RING_OFF, g, S2, E);
    } SEAM(4);

    if (IN(5)) { p5_ln_route(F); } SEAM(5);

    if (IN(6)) { p6_slots_gather(F); } SEAM(6);

    if (IN(7)) {
        build_pstart(F);
        const LAS int* pst = (const LAS int*)(F.lds + PST_OFF);
        pg8::Gemm g{F.xs, F.Wgu_t, SPAD, NE * 1024, D}; MoeOrder S{pst, (pst[NE] >> 8) * 4, F.G, (int)blockIdx.x};
        pg8::EpiSwiglu E{F.hdn, F.gslot};
        typedef Rep2Sel<MoeOrder, PROBE_TWICE == 7>::type SS; SS S2; *(MoeOrder*)&S2 = S;
        pg8::gemm_phase<pg8::EpiSwiglu, SS, true, true>(F.lds + RING_OFF, g, S2, E);
    } SEAM(7);

    if (IN(8)) {
        build_pstart(F);
        const LAS int* pst = (const LAS int*)(F.lds + PST_OFF);
        pg8::Gemm g{F.hdn, F.Wd_t, SPAD, NE * 1024, DF}; MoeOrder S{pst, (pst[NE] >> 8) * 4, F.G, (int)blockIdx.x};
        pg8::EpiBf16<0> E{F.y, D, nullptr, 1024, 0, 1.f};
        typedef Rep2Sel<MoeOrder, PROBE_TWICE == 8>::type SS; SS S2; *(MoeOrder*)&S2 = S;
        pg8::gemm_phase<pg8::EpiBf16<0>, SS, true, true>(F.lds + RING_OFF, g, S2, E);
    } SEAM(8);

    if (IN(9)) {
        pg8::Gemm g{F.hb, F.Wpg_t, M, D, D}; pg8::StaticOrder S; S.init(M, D, F.G, (int)blockIdx.x);
        pg8::EpiComb E{F.out, F.pple, F.y, F.slot};
        pg8::gemm_phase<pg8::EpiComb, pg8::StaticOrder, true, true>(F.lds + RING_OFF, g, S, E);
    } SEAM(9);

    if (IN(10)) {
        const bool poison = __hip_atomic_load((gu32*)((unsigned*)(F.ctl + CW_BAR) + XB_TMO), RLX_AGENT) != 0u || F.G != 256;
        p10_final_ln(F, poison);
    }
#undef IN
#undef SEAM
}

#ifndef MK_CUTS
#define MK_CUTS 0
#endif
extern "C" void kernel_launch(void* const* d_in, const int* in_sizes, int n_in, void* d_out, int out_size, void* d_ws, size_t ws_size, hipStream_t stream) {
    static int grid = 0;
    if (grid == 0) {
        if (n_in != 18 || in_sizes[0] != M * D || out_size != M * D || ws_size < WS_END) { fprintf(stderr, "kernel_launch: shape/workspace mismatch (n_in %d, in0 %d, out %d, ws %zu)\n", n_in, n_in > 0 ? in_sizes[0] : -1, out_size, ws_size); grid = -1; return; }
        int dev = 0, cus = 0, per_cu = 0;
        if (hipGetDevice(&dev) != hipSuccess || hipDeviceGetAttribute(&cus, hipDeviceAttributeMultiprocessorCount, dev) != hipSuccess) { grid = -1; return; }
        if (hipFuncSetAttribute((const void*)mk_fwd, hipFuncAttributeMaxDynamicSharedMemorySize, LDS_BYTES) != hipSuccess) { fprintf(stderr, "kernel_launch: hipFuncSetAttribute failed\n"); grid = -1; return; }
        if (hipOccupancyMaxActiveBlocksPerMultiprocessor(&per_cu, (const void*)mk_fwd, NTHR, LDS_BYTES) != hipSuccess || per_cu < 1) fprintf(stderr, "kernel_launch: occupancy query reports %d\n", per_cu);
        (void)hipGetLastError();
        grid = cus;
        if (grid != 256) fprintf(stderr, "kernel_launch: %d CUs; this kernel is built for 256\n", grid);
    }
    if (grid < 0) return;
    if (hipMemsetAsync((char*)d_ws + WS_CTL, 0, CTL_ZERO_BYTES, stream) != hipSuccess) return;
    Args a{};
    for (int i = 0; i < 18; ++i) a.in[i] = (const float*)d_in[i];
    a.out = (float*)d_out; a.ws = (unsigned char*)d_ws;
#if MK_CUTS
    for (int ph = 0; ph < NPH; ++ph) { a.ph_lo = ph; a.ph_hi = ph + 1; hipLaunchKernelGGL(mk_fwd, dim3(grid), dim3(NTHR), LDS_BYTES, stream, a); }
#else
    a.ph_lo = 0; a.ph_hi = NPH;
    hipLaunchKernelGGL(mk_fwd, dim3(grid), dim3(NTHR), LDS_BYTES, stream, a);
#endif
}
```

```cpp
#include <hip/hip_runtime.h>
#include <hip/hip_bf16.h>
#include <cstdio>
#include <cstdint>
#include <cmath>
namespace pg8 {
#define PG8_LAS __attribute__((address_space(3)))
typedef unsigned short bf16_t;
typedef short bf16x8 __attribute__((ext_vector_type(8)));
typedef float f32x4 __attribute__((ext_vector_type(4)));
typedef unsigned u32x4 __attribute__((ext_vector_type(4)));
constexpr int BM = 256, BK = 64, HALF = 128, HTB = HALF * BK * 2  , STAGE_BYTES = 8 * HTB, NXCD = 8, WGM = 8;

__host__ __device__ __forceinline__ int lds_byte(int r, int c) { const int st = (r >> 4) * 2 + (c >> 5), rr = r & 15, cc = c & 31, ob = rr * 64 + cc * 2; return st * 1024 + (ob ^ (((ob >> 9) & 1) << 5)); }
__host__ __device__ __forceinline__ void stage_rc(int b, int& R, int& C) { const int st = b / 1024, sb = b % 1024, swz = sb ^ (((sb >> 9) & 1) << 5); R = (st >> 1) * 16 + swz / 64; C = (st & 1) * 32 + (swz % 64) / 2; }
__host__ __device__ __forceinline__ int perm32(int rho) { const int n = rho >> 4, i = rho & 15; return 8 * (i >> 2) + 4 * n + (i & 3); }

struct Unit { int pm, pn; };
struct Gemm { const bf16_t* A; const bf16_t* Bt; int M, N, K; };

struct StaticOrder {
    int nM, nN, nwg, G, c;
    __host__ __device__ void init(int M, int N, int G_, int c_) { nM = M / BM; nN = N / BM; nwg = nM * nN; G = G_; c = c_; }
    __host__ __device__ bool next(int i, Unit& u) const {
        const long L = (long)i * G + c; if (L >= nwg) return false;
        int wgid = (int)L; { const int q = nwg / NXCD, r = nwg % NXCD, xcd = wgid % NXCD, off = wgid / NXCD; wgid = (xcd < r ? xcd * (q + 1) : r * (q + 1) + (xcd - r) * q) + off; }
        const int nig = WGM * nN, gid = wgid / nig, fm = gid * WGM, gsz = (nM - fm) < WGM ? (nM - fm) : WGM;
        u.pm = fm + ((wgid % nig) % gsz); u.pn = (wgid % nig) / gsz; return true;
    }
    __device__ __forceinline__ void a_ready(const Unit&) const {}
    __device__ __forceinline__ void done(const Unit&) const {}
};

__device__ __forceinline__ unsigned cvt_pk_bf16(float lo, float hi) { unsigned r; asm volatile("v_cvt_pk_bf16_f32 %0, %1, %2" : "=v"(r) : "v"(lo), "v"(hi)); return r; }
typedef float f32x2 __attribute__((ext_vector_type(2)));
__device__ __forceinline__ f32x2 gelu_pk(f32x2 v) {
    const f32x2 av = __builtin_elementwise_abs(v), d = av * 0.2316418882f + 1.0f;
    f32x2 t; t.x = __builtin_amdgcn_rcpf(d.x); t.y = __builtin_amdgcn_rcpf(d.y);
    f32x2 q = t * 0.5307027145f + (-0.7265760135f); q = q * t + 0.7107068705f; q = q * t + (-0.142248368f); q = q * t + 0.127414796f; q = q * t;
    const f32x2 s = (v * v) * (-0.72134752044f);
    f32x2 e; e.x = __builtin_amdgcn_exp2f(s.x); e.y = __builtin_amdgcn_exp2f(s.y);
    const f32x2 m = v * (q * e), r = v - m;
    f32x2 o; o.x = v.x < 0.f ? m.x : r.x; o.y = v.y < 0.f ? m.y : r.y; return o;
}

template <int ACT  > struct EpiBf16 {
    static constexpr bool PERM = true, AFTER_DRAIN = false; static_assert(ACT == 0 || ACT == 1, "EpiBf16: ACT is 0 (none) or 1 (gelu_pk)");
    bf16_t* O; int ldc; const float* bias; int split_cols; size_t split_stride; float scale0;
    __device__ __forceinline__ void operator()(const f32x4 (&acc)[2][2][4][2], const Unit& u, int wr, int wc, int fr, int fq) const {
        const int row0 = u.pm * BM + wr * 64 + fr; int colt = u.pn * BM; bf16_t* base = O;
        float sc = 1.f; if (split_cols) { const int t = colt / split_cols; base += (size_t)t * split_stride; colt -= t * split_cols; if (t == 0) sc = scale0; }
        const int col0 = colt + wc * 32 + 8 * fq, bcol0 = u.pn * BM + wc * 32 + 8 * fq;
        f32x4 bv[2][2];
#pragma unroll
        for (int bj = 0; bj < 2; ++bj)
#pragma unroll
            for (int n = 0; n < 2; ++n) bv[bj][n] = bias ? *(const f32x4*)(bias + bcol0 + bj * HALF + 4 * n) : (f32x4){0.f, 0.f, 0.f, 0.f};
#pragma unroll
        for (int ai = 0; ai < 2; ++ai)
#pragma unroll
            for (int m = 0; m < 4; ++m) { bf16_t* rowp = base + (size_t)(row0 + ai * HALF + m * 16) * ldc + col0;
#pragma unroll
                for (int bj = 0; bj < 2; ++bj) { f32x4 v0 = acc[ai][bj][m][0] + bv[bj][0], v1 = acc[ai][bj][m][1] + bv[bj][1];
                    if (ACT == 1) { f32x2 a = gelu_pk((f32x2){v0[0], v0[1]}), b = gelu_pk((f32x2){v0[2], v0[3]}), c = gelu_pk((f32x2){v1[0], v1[1]}), d = gelu_pk((f32x2){v1[2], v1[3]});
                        v0 = (f32x4){a.x, a.y, b.x, b.y}; v1 = (f32x4){c.x, c.y, d.x, d.y}; }
                    v0 = v0 * sc; v1 = v1 * sc; u32x4 w; w.x = cvt_pk_bf16(v0[0], v0[1]); w.y = cvt_pk_bf16(v0[2], v0[3]); w.z = cvt_pk_bf16(v1[0], v1[1]); w.w = cvt_pk_bf16(v1[2], v1[3]);
                    *(u32x4*)(rowp + bj * HALF) = w; } }
    }
};

struct PanelStats {
    unsigned* xbuf;
    unsigned* cnt;
    unsigned* tmo;
    int ntn; float eps;
    unsigned code;
    __device__ __forceinline__ bool run(const f32x4 (&v)[2][2][4][2], const Unit& u, int wr, int wc, int fr, int fq, PG8_LAS unsigned char* lds, int wid, int lane) const {
        typedef float f32x2v __attribute__((ext_vector_type(2)));
        PG8_LAS f32x2v* P = (PG8_LAS f32x2v*)lds;
        PG8_LAS f32x2v* S = (PG8_LAS f32x2v*)(lds + 8192);
        PG8_LAS unsigned* flag = (PG8_LAS unsigned*)(lds + 8192 + 2048);
#pragma unroll
        for (int ai = 0; ai < 2; ++ai)
#pragma unroll
            for (int m = 0; m < 4; ++m) {
                float s = 0.f;
#pragma unroll
                for (int bj = 0; bj < 2; ++bj)
#pragma unroll
                    for (int n = 0; n < 2; ++n) { const f32x4 x = v[ai][bj][m][n]; s += (x[0] + x[1]) + (x[2] + x[3]); }
                s += __shfl_xor(s, 16); s += __shfl_xor(s, 32);
                const float mw = s * (1.0f / 64.0f); float q = 0.f;
#pragma unroll
                for (int bj = 0; bj < 2; ++bj)
#pragma unroll
                    for (int n = 0; n < 2; ++n) { const f32x4 d = v[ai][bj][m][n] - mw; q += (d[0] * d[0] + d[1] * d[1]) + (d[2] * d[2] + d[3] * d[3]); }
                q += __shfl_xor(q, 16); q += __shfl_xor(q, 32);
                if (fq == 0) P[(ai * HALF + wr * 64 + m * 16 + fr) * 4 + wc] = (f32x2v){mw, q};
            }
        asm volatile("s_waitcnt lgkmcnt(0)" ::: "memory"); __builtin_amdgcn_s_barrier(); asm volatile("" ::: "memory");
#if defined(BROKEN_EXCHANGE_NO_WAIT)
#warning BROKEN CONTROL BUILD: the row-statistics exchange does not wait; results are wrong by design
        if (blockIdx.x >= 64) { const long long t0_ = clock64(); while (clock64() - t0_ < 60000) __builtin_amdgcn_s_sleep(8); }
#endif
        const int row = wid * 32 + (lane & 31);
        if (lane < 32) {
            const f32x2v a = P[row * 4 + 0], b = P[row * 4 + 1], c = P[row * 4 + 2], d = P[row * 4 + 3];
            const float mt = (a.x + b.x + c.x + d.x) * 0.25f;
            const float da = a.x - mt, db = b.x - mt, dc = c.x - mt, dd = d.x - mt;
            const float m2 = (a.y + b.y) + (c.y + d.y) + 64.0f * ((da * da + db * db) + (dc * dc + dd * dd));
            unsigned long long* slot = (unsigned long long*)xbuf + ((size_t)(u.pm * BM + row) * 4 + u.pn);
            __hip_atomic_store(slot, ((unsigned long long)__float_as_uint(m2) << 32) | __float_as_uint(mt), __ATOMIC_RELAXED, __HIP_MEMORY_SCOPE_AGENT);
        }
        asm volatile("s_waitcnt vmcnt(0)" ::: "memory");
        if (lane == 0) __hip_atomic_fetch_add(cnt + 64 * u.pm, 1u, __ATOMIC_RELAXED, __HIP_MEMORY_SCOPE_AGENT);
        if (wid == 0) {
            bool dead = false; const unsigned long long t0 = __builtin_amdgcn_s_memrealtime(); const unsigned want = 8u * (unsigned)ntn;
            for (;;) {
#if defined(BROKEN_EXCHANGE_NO_WAIT)
                break;
#endif
                if ((unsigned)__builtin_amdgcn_readfirstlane(__hip_atomic_load(cnt + 64 * u.pm, __ATOMIC_RELAXED, __HIP_MEMORY_SCOPE_AGENT)) >= want) break;
                if (__builtin_amdgcn_s_memrealtime() - t0 > 2000000ull) {
                    if (lane == 0) { unsigned expect = 0u; __hip_atomic_compare_exchange_strong(tmo + 1, &expect, code | (unsigned)(u.pm & 0xff), __ATOMIC_RELAXED, __ATOMIC_RELAXED, __HIP_MEMORY_SCOPE_AGENT);
                                     __hip_atomic_store(tmo, 1u, __ATOMIC_RELAXED, __HIP_MEMORY_SCOPE_AGENT); }
                    dead = true; break; }
                __builtin_amdgcn_s_sleep(2);
            }
            __builtin_amdgcn_fence(__ATOMIC_ACQUIRE, "agent");
            if (lane == 0) flag[0] = dead ? 1u : 0u;
        }
        asm volatile("s_waitcnt vmcnt(0) lgkmcnt(0)" ::: "memory"); __builtin_amdgcn_s_barrier(); asm volatile("" ::: "memory");
        const bool bad = flag[0] != 0u;
        if (lane < 32) {
            const unsigned long long* slot = (const unsigned long long*)xbuf + (size_t)(u.pm * BM + row) * 4; float mt[4], m2[4]; float ms = 0.f;
#pragma unroll
            for (int t = 0; t < 4; ++t) { if (t < ntn) { const unsigned long long w = __hip_atomic_load(slot + t, __ATOMIC_RELAXED, __HIP_MEMORY_SCOPE_AGENT); mt[t] = __uint_as_float((unsigned)w); m2[t] = __uint_as_float((unsigned)(w >> 32)); } else { mt[t] = 0.f; m2[t] = 0.f; } ms += mt[t]; }
            const float mean = ms / (float)ntn; float q = 0.f;
#pragma unroll
            for (int t = 0; t < 4; ++t) if (t < ntn) { const float dm = mt[t] - mean; q += m2[t] + 256.0f * dm * dm; }
            S[row] = (f32x2v){mean, 1.0f / sqrtf(q / (256.0f * (float)ntn) + eps)};
        }
        asm volatile("s_waitcnt lgkmcnt(0)" ::: "memory"); __builtin_amdgcn_s_barrier(); asm volatile("" ::: "memory");
        return bad;
    }
};
struct EpiLnRes {
    static constexpr bool PERM = false, AFTER_DRAIN = true;
    const float* base; float* out; int ldc; const float* bias; PanelStats st; unsigned poison;
    __device__ __forceinline__ void fused(f32x4 (&acc)[2][2][4][2], const Unit& u, int wr, int wc, int fr, int fq, PG8_LAS unsigned char* lds, int wid, int lane) const {
        typedef float f32x2v __attribute__((ext_vector_type(2)));
        const PG8_LAS f32x2v* S = (const PG8_LAS f32x2v*)(lds + 8192);
        const int col0 = u.pn * BM + wc * 32 + 4 * fq;
#pragma unroll
        for (int bj = 0; bj < 2; ++bj)
#pragma unroll
            for (int n = 0; n < 2; ++n) { const f32x4 bv = bias ? *(const f32x4*)(bias + col0 + bj * HALF + n * 16) : (f32x4){0.f, 0.f, 0.f, 0.f};
#pragma unroll
                for (int ai = 0; ai < 2; ++ai)
#pragma unroll
                    for (int m = 0; m < 4; ++m) acc[ai][bj][m][n] += bv; }
        f32x4 pre[4][2][2];
#pragma unroll
        for (int m = 0; m < 4; ++m) { const size_t off = (size_t)(u.pm * BM + wr * 64 + m * 16 + fr) * ldc + col0;
#pragma unroll
            for (int bj = 0; bj < 2; ++bj)
#pragma unroll
                for (int n = 0; n < 2; ++n) pre[m][bj][n] = *(const f32x4*)(base + off + bj * HALF + n * 16); }
        const bool bad = st.run(acc, u, wr, wc, fr, fq, lds, wid, lane) || poison != 0u;
        const float qnan = __builtin_nanf("");
#pragma unroll
        for (int ai = 0; ai < 2; ++ai)
#pragma unroll
            for (int m = 0; m < 4; ++m) { const int r = ai * HALF + wr * 64 + m * 16 + fr; const f32x2v sr = S[r]; const size_t off = (size_t)(u.pm * BM + r) * ldc + col0;
#pragma unroll
                for (int bj = 0; bj < 2; ++bj)
#pragma unroll
                    for (int n = 0; n < 2; ++n) { const f32x4 bs = ai == 0 ? pre[m][bj][n] : *(const f32x4*)(base + off + bj * HALF + n * 16); f32x4 o = bs + (acc[ai][bj][m][n] - sr.x) * sr.y;
                        if (bad) o = (f32x4){qnan, qnan, qnan, qnan}; *(f32x4*)(out + off + bj * HALF + n * 16) = o; }
                if (m & 1) asm volatile("" ::: "memory"); }
    }
};
struct EpiLnResLn {
    static constexpr bool PERM = false, AFTER_DRAIN = true;
    const float* base; float* out; bf16_t* xn; int ldc; const float* bias; PanelStats st1, st2; unsigned poison;
    __device__ __forceinline__ void fused(f32x4 (&acc)[2][2][4][2], const Unit& u, int wr, int wc, int fr, int fq, PG8_LAS unsigned char* lds, int wid, int lane) const {
        typedef float f32x2v __attribute__((ext_vector_type(2))); typedef unsigned u32x2v __attribute__((ext_vector_type(2)));
        const PG8_LAS f32x2v* S = (const PG8_LAS f32x2v*)(lds + 8192);
        const int col0 = u.pn * BM + wc * 32 + 4 * fq;
#pragma unroll
        for (int bj = 0; bj < 2; ++bj)
#pragma unroll
            for (int n = 0; n < 2; ++n) { const f32x4 bv = bias ? *(const f32x4*)(bias + col0 + bj * HALF + n * 16) : (f32x4){0.f, 0.f, 0.f, 0.f};
#pragma unroll
                for (int ai = 0; ai < 2; ++ai)
#pragma unroll
                    for (int m = 0; m < 4; ++m) acc[ai][bj][m][n] += bv; }
        bool bad = st1.run(acc, u, wr, wc, fr, fq, lds, wid, lane) || poison != 0u;
        const float qnan = __builtin_nanf("");
#pragma unroll
        for (int ai = 0; ai < 2; ++ai)
#pragma unroll
            for (int m = 0; m < 4; ++m) { const int r = ai * HALF + wr * 64 + m * 16 + fr; const f32x2v sr = S[r]; const size_t off = (size_t)(u.pm * BM + r) * ldc + col0;
#pragma unroll
                for (int bj = 0; bj < 2; ++bj)
#pragma unroll
                    for (int n = 0; n < 2; ++n) { const f32x4 bs = *(const f32x4*)(base + off + bj * HALF + n * 16); acc[ai][bj][m][n] = bs + (acc[ai][bj][m][n] - sr.x) * sr.y; }
                asm volatile("" : "+v"(acc[ai][0][m][0]), "+v"(acc[ai][0][m][1]), "+v"(acc[ai][1][m][0]), "+v"(acc[ai][1][m][1]));
                if (m & 1) asm volatile("" ::: "memory"); }
        const bool bad1 = bad;
        bad = st2.run(acc, u, wr, wc, fr, fq, lds, wid, lane) || bad;
#pragma unroll
        for (int ai = 0; ai < 2; ++ai)
#pragma unroll
            for (int m = 0; m < 4; ++m) { const int r = ai * HALF + wr * 64 + m * 16 + fr; const f32x2v sr = S[r]; const size_t off = (size_t)(u.pm * BM + r) * ldc + col0;
#pragma unroll
                for (int bj = 0; bj < 2; ++bj)
#pragma unroll
                    for (int n = 0; n < 2; ++n) { const f32x4 x1 = acc[ai][bj][m][n]; *(f32x4*)(out + off + bj * HALF + n * 16) = bad1 ? (f32x4){qnan, qnan, qnan, qnan} : x1;
                        const f32x4 o = (x1 - sr.x) * sr.y; u32x2v w; w.x = cvt_pk_bf16(o[0], o[1]); w.y = cvt_pk_bf16(o[2], o[3]);
                        if (bad) { w.x = 0x7fc07fc0u; w.y = 0x7fc07fc0u; } *(u32x2v*)(xn + off + bj * HALF + n * 16) = w; }
                asm volatile("" ::: "memory"); }
    }
};

template <class Epi, class Sched, bool ALIGN_EPI = false, bool SP2 = false>
__device__ __forceinline__ void gemm_phase(PG8_LAS unsigned char* lds, const Gemm g, const Sched& S, const Epi& E) {
    const int tid = threadIdx.x, wid = __builtin_amdgcn_readfirstlane(tid >> 6), lane = tid & 63, wr = wid >> 2, wc = wid & 3, fr = lane & 15, fq = lane >> 4;
    const int K = g.K, nt = K / BK;
    unsigned voffA[2], voffB[2];
#pragma unroll
    for (int i = 0; i < 2; ++i) { int R, C; stage_rc(tid * 16 + i * 8192, R, C); const int Rb = Epi::PERM ? ((R & ~31) + perm32(R & 31)) : R;
        voffA[i] = (unsigned)(R * K + C) * 2u; voffB[i] = (unsigned)(Rb * K + C) * 2u; }
    const size_t kstep = (size_t)(BK * 2);
    const size_t hstep = (size_t)HALF * K * 2;
    const size_t tstep = 2 * hstep;
    const unsigned ldsw = (unsigned)wid * 1024u;
    const int aoff = lds_byte(wr * 64 + fr, fq * 8), boff = lds_byte(wc * 32 + fr, fq * 8);
#define PG8_SA(b, h) (((b) * 2 + (h)) * HTB)
#define PG8_SB(b, h) ((4 + (b) * 2 + (h)) * HTB)
#define PG8_STAGE(bufoff, gbase, voff) do { _Pragma("unroll") for (int _i = 0; _i < 2; ++_i) \
        __builtin_amdgcn_global_load_lds((const unsigned*)((const char*)(gbase) + (voff)[_i]), (PG8_LAS unsigned*)(lds + (bufoff) + ldsw + _i * 8192), 16, 0, 0); } while (0)
#define PG8_LDA(dst, b, h) do { _Pragma("unroll") for (int m = 0; m < 4; ++m) _Pragma("unroll") for (int k = 0; k < 2; ++k) dst[m][k] = *(const PG8_LAS bf16x8*)(lds + PG8_SA(b, h) + aoff + m * 2048 + k * 1024); } while (0)
#define PG8_LDB(dst, b, h) do { _Pragma("unroll") for (int n = 0; n < 2; ++n) _Pragma("unroll") for (int k = 0; k < 2; ++k) dst[n][k] = *(const PG8_LAS bf16x8*)(lds + PG8_SB(b, h) + boff + n * 2048 + k * 1024); } while (0)
#define PG8_MMA(ai, bj, At, Bt) do { __builtin_amdgcn_s_setprio(1); _Pragma("unroll") for (int m = 0; m < 4; ++m) _Pragma("unroll") for (int n = 0; n < 2; ++n) _Pragma("unroll") for (int k = 0; k < 2; ++k) \
        acc[ai][bj][m][n] = __builtin_amdgcn_mfma_f32_16x16x32_bf16(Bt[n][k], At[m][k], acc[ai][bj][m][n], 0, 0, 0); __builtin_amdgcn_s_setprio(0); } while (0)
#define PG8_WAIT_V(n) asm volatile("s_waitcnt vmcnt(" #n ")" ::: "memory")
#define PG8_WAIT_L(n) asm volatile("s_waitcnt lgkmcnt(" #n ")" ::: "memory")
#define PG8_BAR __builtin_amdgcn_s_barrier()
#define PG8_SCHED __builtin_amdgcn_sched_barrier(0)
    Unit cur, nxt; int ui = 0;
    if (!S.next(0, cur)) return;
    f32x4 acc[2][2][4][2];
#pragma unroll
    for (int a = 0; a < 2; ++a)
#pragma unroll
        for (int b = 0; b < 2; ++b)
#pragma unroll
            for (int m = 0; m < 4; ++m)
#pragma unroll
                for (int n = 0; n < 2; ++n) acc[a][b][m][n] = (f32x4){0.f, 0.f, 0.f, 0.f};
    bf16x8 At[4][2], B0[2][2], B1[2][2];
    const char* cA = (const char*)g.A + (size_t)cur.pm * tstep; const char* cB = (const char*)g.Bt + (size_t)cur.pn * tstep;
    S.a_ready(cur);
    if constexpr (SP2) {
        PG8_STAGE(PG8_SB(0, 0), cB, voffB); PG8_STAGE(PG8_SB(0, 1), cB + hstep, voffB); PG8_STAGE(PG8_SA(0, 0), cA, voffA); PG8_STAGE(PG8_SA(0, 1), cA + hstep, voffA);
        if (wr == 1) PG8_BAR;
        PG8_WAIT_V(2); PG8_BAR;
        PG8_STAGE(PG8_SB(1, 0), cB + kstep, voffB); PG8_STAGE(PG8_SA(1, 0), cA + kstep, voffA); PG8_STAGE(PG8_SB(1, 1), cB + hstep + kstep, voffB);
        PG8_WAIT_V(6); PG8_BAR;
    } else {
        PG8_STAGE(PG8_SB(0, 0), cB, voffB); PG8_STAGE(PG8_SA(0, 0), cA, voffA); PG8_STAGE(PG8_SB(0, 1), cB + hstep, voffB); PG8_STAGE(PG8_SA(0, 1), cA + hstep, voffA);
        if (wr == 1) PG8_BAR;
        PG8_WAIT_V(4); PG8_BAR;
        PG8_STAGE(PG8_SB(1, 0), cB + kstep, voffB); PG8_STAGE(PG8_SA(1, 0), cA + kstep, voffA); PG8_STAGE(PG8_SB(1, 1), cB + hstep + kstep, voffB);
        PG8_WAIT_V(6); PG8_BAR;
    }
    for (;;) {
        const bool has_next = S.next(ui + 1, nxt);
        const char* nA = has_next ? (const char*)g.A + (size_t)nxt.pm * tstep : cA; const char* nB = has_next ? (const char*)g.Bt + (size_t)nxt.pn * tstep : cB;
        for (int t = 0; t < nt; t += 2) {
            const bool last = (t == nt - 2);
            const char* a1 = cA + (size_t)(t + 1) * kstep;
            const char* a2 = last ? nA : cA + (size_t)(t + 2) * kstep; const char* b2 = last ? nB : cB + (size_t)(t + 2) * kstep;
            const char* a3 = a2 + kstep; const char* b3 = b2 + kstep;
            if (last && has_next) S.a_ready(nxt);
            if constexpr (SP2) {
            PG8_LDB(B0, 0, 0); PG8_LDB(B1, 0, 1); PG8_SCHED; PG8_LDA(At, 0, 0); PG8_STAGE(PG8_SA(1, 1), a1 + hstep, voffA);
            PG8_WAIT_V(8); PG8_WAIT_L(0); PG8_BAR; PG8_MMA(0, 0, At, B0); PG8_MMA(0, 1, At, B1); PG8_BAR; PG8_SCHED;
            PG8_LDA(At, 0, 1); PG8_STAGE(PG8_SB(0, 0), b2, voffB); PG8_STAGE(PG8_SB(0, 1), b2 + hstep, voffB); PG8_STAGE(PG8_SA(0, 0), a2, voffA);
            PG8_WAIT_V(8); PG8_WAIT_L(0); PG8_BAR; PG8_MMA(1, 0, At, B0); PG8_MMA(1, 1, At, B1); PG8_BAR; PG8_SCHED;
            PG8_LDB(B0, 1, 0); PG8_LDB(B1, 1, 1); PG8_SCHED; PG8_LDA(At, 1, 0); PG8_STAGE(PG8_SA(0, 1), a2 + hstep, voffA);
            PG8_WAIT_V(8); PG8_WAIT_L(0); PG8_BAR; PG8_MMA(0, 0, At, B0); PG8_MMA(0, 1, At, B1); PG8_BAR; PG8_SCHED;
            PG8_LDA(At, 1, 1); PG8_STAGE(PG8_SB(1, 0), b3, voffB); PG8_STAGE(PG8_SB(1, 1), b3 + hstep, voffB); PG8_STAGE(PG8_SA(1, 0), a3, voffA);
            PG8_WAIT_V(8); PG8_WAIT_L(0); PG8_BAR; PG8_MMA(1, 0, At, B0); PG8_MMA(1, 1, At, B1); PG8_BAR; PG8_SCHED;
            } else {
            PG8_LDB(B0, 0, 0); PG8_SCHED; PG8_LDA(At, 0, 0); PG8_STAGE(PG8_SA(1, 1), a1 + hstep, voffA);
            PG8_WAIT_L(8); PG8_BAR; PG8_WAIT_L(0); PG8_MMA(0, 0, At, B0); PG8_BAR; PG8_SCHED;
            PG8_LDB(B1, 0, 1); PG8_STAGE(PG8_SB(0, 0), b2, voffB);
            PG8_BAR; PG8_WAIT_L(0); PG8_MMA(0, 1, At, B1); PG8_BAR;
            PG8_LDA(At, 0, 1); PG8_STAGE(PG8_SA(0, 0), a2, voffA);
            PG8_BAR; PG8_WAIT_L(0); PG8_MMA(1, 0, At, B0); PG8_BAR; PG8_SCHED;
            PG8_STAGE(PG8_SB(0, 1), b2 + hstep, voffB);
            PG8_WAIT_V(6); PG8_BAR; PG8_MMA(1, 1, At, B1); PG8_BAR;
            PG8_LDB(B0, 1, 0); PG8_SCHED; PG8_LDA(At, 1, 0); PG8_STAGE(PG8_SA(0, 1), a2 + hstep, voffA);
            PG8_WAIT_L(8); PG8_BAR; PG8_WAIT_L(0); PG8_MMA(0, 0, At, B0); PG8_BAR; PG8_SCHED;
            PG8_LDB(B1, 1, 1); PG8_STAGE(PG8_SB(1, 0), b3, voffB);
            PG8_BAR; PG8_WAIT_L(0); PG8_MMA(0, 1, At, B1); PG8_BAR;
            PG8_LDA(At, 1, 1); PG8_STAGE(PG8_SA(1, 0), a3, voffA);
            PG8_BAR; PG8_WAIT_L(0); PG8_MMA(1, 0, At, B0); PG8_BAR; PG8_SCHED;
            PG8_STAGE(PG8_SB(1, 1), b3 + hstep, voffB);
            PG8_WAIT_V(6); PG8_BAR; PG8_MMA(1, 1, At, B1); PG8_BAR;
            }
        }
        if constexpr (ALIGN_EPI) { if (wr == 0) PG8_BAR; }
        if constexpr (!Epi::AFTER_DRAIN) { E(acc, cur, wr, wc, fr, fq); S.done(cur); }
        if (!has_next) break;
#pragma unroll
        for (int a = 0; a < 2; ++a)
#pragma unroll
            for (int b = 0; b < 2; ++b)
#pragma unroll
                for (int m = 0; m < 4; ++m)
#pragma unroll
                    for (int n = 0; n < 2; ++n) acc[a][b][m][n] = (f32x4){0.f, 0.f, 0.f, 0.f};
        cur = nxt; cA = nA; cB = nB; ++ui;
        if constexpr (ALIGN_EPI) { if (wr == 1) PG8_BAR; }
    }
    PG8_WAIT_V(0);
    if constexpr (!ALIGN_EPI) { if (wr == 0) PG8_BAR; }
    PG8_BAR;
    if constexpr (Epi::AFTER_DRAIN) { E.fused(acc, cur, wr, wc, fr, fq, lds, wid, lane); S.done(cur); }
#undef PG8_SA
#undef PG8_SB
#undef PG8_STAGE
#undef PG8_LDA
#undef PG8_LDB
#undef PG8_MMA
#undef PG8_WAIT_V
#undef PG8_WAIT_L
#undef PG8_BAR
#undef PG8_SCHED
}
}
namespace pg8 {
template <class F> struct EpiScalar {
    static constexpr bool PERM = true, AFTER_DRAIN = false; F f;
    __device__ __forceinline__ void operator()(const f32x4 (&acc)[2][2][4][2], const Unit& u, int wr, int wc, int fr, int fq) const {
        const int row0 = u.pm * BM + wr * 64 + fr, col0 = u.pn * BM + wc * 32 + 8 * fq;
#pragma unroll
        for (int ai = 0; ai < 2; ++ai)
#pragma unroll
            for (int m = 0; m < 4; ++m) {
#pragma unroll
                for (int bj = 0; bj < 2; ++bj)
#pragma unroll
                    for (int n = 0; n < 2; ++n)
#pragma unroll
                        for (int e = 0; e < 4; ++e) f(row0 + ai * HALF + m * 16, col0 + bj * HALF + 4 * n + e, acc[ai][bj][m][n][e]);
                asm volatile("" ::: "memory"); }
    }
};
template <class F> struct EpiScalarPair {
    static constexpr bool PERM = true, AFTER_DRAIN = false; F f;
    __device__ __forceinline__ void operator()(const f32x4 (&acc)[2][2][4][2], const Unit& u, int wr, int wc, int fr, int fq) const {
        const int row0 = u.pm * BM + wr * 64 + fr, cl0 = wc * 32 + 8 * fq;
#pragma unroll
        for (int ai = 0; ai < 2; ++ai)
#pragma unroll
            for (int m = 0; m < 4; ++m) {
#pragma unroll
                for (int n = 0; n < 2; ++n)
#pragma unroll
                    for (int e = 0; e < 4; ++e) f(row0 + ai * HALF + m * 16, u.pn, cl0 + 4 * n + e, acc[ai][0][m][n][e], acc[ai][1][m][n][e]);
                asm volatile("" ::: "memory"); }
    }
};
}
#define GAS __attribute__((address_space(1)))
#define LAS __attribute__((address_space(3)))
typedef unsigned short bf16;
typedef unsigned v4u __attribute__((ext_vector_type(4)));
typedef float f32x4 __attribute__((ext_vector_type(4)));
typedef short bf16x8 __attribute__((ext_vector_type(8)));
typedef GAS unsigned gu32;
typedef GAS unsigned long long gu64;
#define RLX_AGENT __ATOMIC_RELAXED, __HIP_MEMORY_SCOPE_AGENT
#define LDS_WAIT() asm volatile("s_waitcnt lgkmcnt(0)" ::: "memory")
#define VM_WAIT() asm volatile("s_waitcnt vmcnt(0)" ::: "memory")
__device__ __forceinline__ unsigned long long rt() { return __builtin_amdgcn_s_memrealtime(); }
__device__ __forceinline__ unsigned f2bf(float f) { unsigned u = __builtin_bit_cast(unsigned, f); return (u + 0x7fffu + ((u >> 16) & 1u)) >> 16; }
__device__ __forceinline__ unsigned pk2(float lo, float hi) { return f2bf(lo) | (f2bf(hi) << 16); }

#define XB_TMO      128
#define XB_XCNT(j)  (256  + 64 * (j))
#define XB_XSUB(j)  (1280 + 64 * (j))
#define XB_XGEN(j)  (2304 + 64 * (j))
#define XB_TOP      3328
#define XB_TOPGEN   3392
#define XCD_BAR_WORDS 3456
#define XB_SPIN_CAP (1u << 18)

__device__ __forceinline__ unsigned xb_ld(unsigned* p)              { return __hip_atomic_load(p, __ATOMIC_RELAXED, __HIP_MEMORY_SCOPE_AGENT); }
__device__ __forceinline__ unsigned xb_add(unsigned* p, unsigned v) { return __hip_atomic_fetch_add(p, v, __ATOMIC_RELAXED, __HIP_MEMORY_SCOPE_AGENT); }
__device__ __forceinline__ unsigned xb_xcc_id() { return (unsigned)__builtin_amdgcn_s_getreg((3 << 11) | 20) & 0xFu; }
#define XB_SPIN(cond, bar) do { unsigned _sp = 0; while (cond) { __builtin_amdgcn_s_sleep(1); \
    if ((++_sp & 255u) == 0u) { if (xb_ld(&(bar)[XB_TMO])) break; if (_sp > XB_SPIN_CAP) { atomicAdd(&(bar)[XB_TMO], 1u); break; } } } } while (0)

struct XcdBarrier {
    unsigned* bar; unsigned x;
    volatile LAS unsigned* st;
};

__device__ __forceinline__ XcdBarrier xcd_barrier_post(unsigned* bar, volatile LAS unsigned* st) {
    XcdBarrier b; b.bar = bar; b.x = xb_xcc_id(); b.st = st;
    if (threadIdx.x == 0) (void)xb_add(&bar[XB_XCNT(b.x)], 1u);
    return b;
}
__device__ __forceinline__ void xcd_barrier_complete(unsigned* bar, unsigned x, unsigned& nloc, unsigned& nx) {
    const unsigned G = gridDim.x * gridDim.y * gridDim.z;
    unsigned sum, cnt, mine, sp = 0u;
    for (;;) {
        sum = 0u; cnt = 0u; mine = 0u;
#pragma unroll
        for (unsigned j = 0; j < 16; ++j) { const unsigned c = xb_ld(&bar[XB_XCNT(j)]); sum += c; cnt += (c > 0u) ? 1u : 0u; mine = (j == x) ? c : mine; }
        if (sum == G) break;
        __builtin_amdgcn_s_sleep(1);
        if ((++sp & 255u) == 0u) { if (xb_ld(&bar[XB_TMO])) break; if (sp > XB_SPIN_CAP) { atomicAdd(&bar[XB_TMO], 1u); break; } }
    }
    nloc = mine > 0u ? mine : 1u; nx = cnt > 0u ? cnt : 1u;
}

__device__ __forceinline__ void xcd_barrier(const XcdBarrier& b) {
    asm volatile("s_waitcnt vmcnt(0)" ::: "memory");
    __syncthreads();
    if (threadIdx.x == 0) {
        unsigned* bar = b.bar;
        __builtin_amdgcn_s_waitcnt(0);
        unsigned nloc = b.st[0], nx = b.st[1];
        if (nloc == 0u) { xcd_barrier_complete(bar, b.x, nloc, nx); b.st[0] = nloc; b.st[1] = nx; }
        const unsigned old = xb_add(&bar[XB_XSUB(b.x)], 1u);
        const unsigned gen = old / nloc;
        if (old + 1u == (gen + 1u) * nloc) {
            __builtin_amdgcn_fence(__ATOMIC_RELEASE, "agent");
            asm volatile("s_waitcnt vmcnt(0)" ::: "memory");
            const unsigned og = xb_add(&bar[XB_TOP], 1u);
            const unsigned tg = og / nx;
            if (og + 1u == (tg + 1u) * nx) xb_add(&bar[XB_TOPGEN], 1u);
            else XB_SPIN(xb_ld(&bar[XB_TOPGEN]) == tg, bar);
            __builtin_amdgcn_fence(__ATOMIC_ACQUIRE, "agent");
            xb_add(&bar[XB_XGEN(b.x)], 1u);
            asm volatile("s_waitcnt vmcnt(0)" ::: "memory");
        } else {
            XB_SPIN(xb_ld(&bar[XB_XGEN(b.x)]) == gen, bar);
            __builtin_amdgcn_fence(__ATOMIC_ACQUIRE, "agent");
            asm volatile("s_waitcnt vmcnt(0)" ::: "memory");
        }
    }
    __syncthreads();
}
#ifndef ATT_FAST
#define ATT_FAST 1
#endif

constexpr int NWAVES = 8, NTHR = NWAVES * 64;
constexpr int BATCH = 4, SEQ = 8192, D = 1024, M = BATCH * SEQ;
constexpr int NHG = 8, HD = 64, HW = NHG * HD;
constexpr int INCOLS = 3080, NPROJ = 3072;
constexpr int NE = 32, NGRP = 4, EPG = 8, DF = 512, PLED = 256;
constexpr int SPAD = 2 * M + NE * 256;
constexpr float ALPHA = 1.189207115002721f, LN_EPS = 1e-5f, LOG2E = 1.4426950408889634f;
constexpr int NPH = 10;

constexpr size_t MiB = 1u << 20;
constexpr size_t WS_CTL = 0, CTL_ZERO_BYTES = 256 * 1024;
constexpr size_t WS_LS = 1 * MiB, WS_CFL = 2 * MiB, WS_CTOT = 3 * MiB, WS_KNT = 3 * MiB + 4096, WS_EID = 3 * MiB + 256 * 1024, WS_GATE = 3 * MiB + 512 * 1024, WS_RANK = 3 * MiB + 768 * 1024,
                 WS_SLOT = 4 * MiB, WS_GSLOT = 4 * MiB + 256 * 1024;
constexpr size_t WS_WIN = 5 * MiB, WS_WOUT = 11 * MiB, WS_WPLE = 13 * MiB, WS_WPG = 14 * MiB, WS_WGU = 16 * MiB, WS_WD = 80 * MiB, WS_PPLE = 112 * MiB;
constexpr size_t WS_R1 = 176 * MiB;
constexpr size_t WS_R2 = 368 * MiB;
constexpr size_t WS_R3 = 432 * MiB;
constexpr size_t WS_END = 504 * MiB;
static_assert(WS_GSLOT + (size_t)SPAD * 4 <= WS_WIN && WS_R1 + (size_t)SPAD * 2048 <= WS_R2 && WS_R3 + (size_t)SPAD * 1024 <= WS_END, "ws map");
constexpr int CW_TMO = 0, CW_BAR = 4096, CW_CNT = 8192;

constexpr int RING_OFF = 0, RING_BYTES = 131072;
constexpr int LDSCTL_OFF = RING_BYTES, MISC_OFF = LDSCTL_OFF + 320, PST_OFF = LDSCTL_OFF + 1024, HIST_OFF = LDSCTL_OFF + 1280, BASE_OFF = LDSCTL_OFF + 1408, ROWL_OFF = LDSCTL_OFF + 2048;
constexpr int LDS_BYTES = 147456;

#define BFLO(w) __builtin_bit_cast(float, (w) << 16)
#define BFHI(w) __builtin_bit_cast(float, (w) & 0xffff0000u)
__device__ __forceinline__ float bf2f(unsigned short v) { return __builtin_bit_cast(float, (unsigned)v << 16); }
__device__ __forceinline__ float wave_sum(float v) {
#pragma unroll
    for (int o = 1; o < 64; o <<= 1) v += __shfl_xor(v, o);
    return v;
}
__device__ __forceinline__ float wave_max(float v) {
#pragma unroll
    for (int o = 1; o < 64; o <<= 1) v = fmaxf(v, __shfl_xor(v, o));
    return v;
}

struct Frame {
    LAS unsigned char* lds; volatile LAS unsigned* MISC; gu32* ctl;
    int tid, lane, wave, vcu, G;
    const float *x, *p, *w_in, *b_forget, *w_out, *ln1g, *ln1b, *w_group, *b_group, *w_router, *b_router, *w_gate, *w_up, *w_down, *w_ple, *w_pg, *ln2g, *ln2b;
    float* out;
    bf16 *Win_t, *Wout_t, *Wple_t, *Wpg_t, *Wgu_t, *Wd_t, *pple, *qkv, *xs, *y, *xb, *mixed, *hb, *pb, *hdn;
    float *ls, *cfl, *ctot, *knt, *gatev, *gslot; int *eid, *rank, *slot;
};

struct TileRef { const float* src; bf16* dst; int ldw, ldt; float sc; };
__device__ __forceinline__ void tile_load(f32x4 (&r)[8], const TileRef& t, int lane) {
    const GAS float* p = (const GAS float*)t.src + (size_t)(lane >> 4) * t.ldw + 4 * (lane & 15);
#pragma unroll
    for (int i = 0; i < 8; ++i) r[i] = *(const GAS f32x4*)(p + (size_t)(4 * i) * t.ldw);
}
__device__ __forceinline__ void tile_store(const f32x4 (&r)[8], const TileRef& t, LAS float* scr, int lane) {
#pragma unroll
    for (int i = 0; i < 8; ++i) { LAS float* s = scr + (4 * i + (lane >> 4)) * 65 + 4 * (lane & 15); s[0] = r[i].x * t.sc; s[1] = r[i].y * t.sc; s[2] = r[i].z * t.sc; s[3] = r[i].w * t.sc; }
    LDS_WAIT(); asm volatile("" ::: "memory");
    const int c = lane & 3;
#pragma unroll
    for (int j = 0; j < 4; ++j) { const int n = 16 * j + (lane >> 2); const LAS float* s = scr + (8 * c) * 65 + n;
        v4u o; o.x = pk2(s[0 * 65], s[1 * 65]); o.y = pk2(s[2 * 65], s[3 * 65]); o.z = pk2(s[4 * 65], s[5 * 65]); o.w = pk2(s[6 * 65], s[7 * 65]);
        *(GAS v4u*)(t.dst + (size_t)n * t.ldt + 8 * c) = o; }
    LDS_WAIT(); asm volatile("" ::: "memory");
}
__device__ __forceinline__ float log_sigmoid_f(float v) { return fminf(v, 0.f) - log1pf(expf(-fabsf(v))); }
constexpr int I_IN = 32 * 48, I_OUT = 32 * 16, I_PLE = 8 * 16, I_PG = 32 * 16, I_GU = NE * 2 * 32 * 8, I_DN = NE * 16 * 16;
constexpr int P0_ITEMS = I_IN + I_OUT + I_PLE + I_PG + I_GU + I_DN;
__device__ __forceinline__ TileRef p0_item(Frame& F, int it) {
    int r = it; TileRef t; t.sc = 1.f;
    if (r < I_IN) { const int kb = r / 48, nb = r % 48, s = nb >> 3;
        t.src = F.w_in + (size_t)kb * 32 * INCOLS + nb * 64; t.ldw = INCOLS; t.dst = F.Win_t + (size_t)nb * 64 * D + kb * 32; t.ldt = D; t.sc = (s == 0 || s == 3) ? 0.125f : 1.f; return t; } r -= I_IN;
    if (r < I_OUT) { const int kb = r / 16, nb = r % 16; t.src = F.w_out + (size_t)kb * 32 * D + nb * 64; t.ldw = D; t.dst = F.Wout_t + (size_t)nb * 64 * D + kb * 32; t.ldt = D; return t; } r -= I_OUT;
    if (r < I_PLE) { const int kb = r / 16, nb = r % 16; t.src = F.w_ple + (size_t)kb * 32 * D + nb * 64; t.ldw = D; t.dst = F.Wple_t + (size_t)nb * 64 * PLED + kb * 32; t.ldt = PLED; return t; } r -= I_PLE;
    if (r < I_PG) { const int kb = r / 16, nb = r % 16; t.src = F.w_pg + (size_t)kb * 32 * D + nb * 64; t.ldw = D; t.dst = F.Wpg_t + (size_t)nb * 64 * D + kb * 32; t.ldt = D; return t; } r -= I_PG;
    if (r < I_GU) { const int e = r / 512, gu = (r >> 8) & 1, kb = (r >> 3) & 31, nb = r & 7;
        t.src = (gu ? F.w_up : F.w_gate) + (size_t)e * D * DF + (size_t)kb * 32 * DF + nb * 64; t.ldw = DF;
        const int row = e * 1024 + (nb >> 1) * 256 + gu * 128 + (nb & 1) * 64;
        t.dst = F.Wgu_t + (size_t)row * D + kb * 32; t.ldt = D; return t; } r -= I_GU;
    { const int e = r / 256, kb = (r >> 4) & 15, nb = r & 15;
        t.src = F.w_down + (size_t)e * DF * D + (size_t)kb * 32 * D + nb * 64; t.ldw = D; t.dst = F.Wd_t + (size_t)(e * 1024 + nb * 64) * DF + kb * 32; t.ldt = DF; return t; }
}
template <int PART> __device__ __forceinline__ void p0_prologue(Frame& F) {
    LAS float* scr = (LAS float*)(F.lds + RING_OFF + F.wave * 16384);
    const int gw = F.vcu * NWAVES + F.wave, NGW = F.G * NWAVES;
    if (PART == 0) {
        f32x4 ra[8], rb[8]; int it = gw;
        TileRef ta = p0_item(F, it < P0_ITEMS ? it : 0), tb = ta;
        if (it < P0_ITEMS) tile_load(ra, ta, F.lane);
        while (it < P0_ITEMS) {
            const int i2 = it + NGW; if (i2 < P0_ITEMS) { tb = p0_item(F, i2); tile_load(rb, tb, F.lane); }
            tile_store(ra, ta, scr, F.lane);
            if (i2 >= P0_ITEMS) break;
            const int i3 = i2 + NGW; if (i3 < P0_ITEMS) { ta = p0_item(F, i3); tile_load(ra, ta, F.lane); }
            tile_store(rb, tb, scr, F.lane);
            it = i3;
        }
    }
    if (PART == 1) {
    __syncthreads();
    LAS float* wf = (LAS float*)(F.lds + RING_OFF);
    for (int i = F.tid; i < 2048; i += NTHR) { const int c = i >> 1, j0 = (i & 1) * 4; const f32x4 w = *(const GAS f32x4*)(F.w_in + (size_t)c * INCOLS + NPROJ + j0);
        wf[(j0 + 0) * 1024 + c] = w.x; wf[(j0 + 1) * 1024 + c] = w.y; wf[(j0 + 2) * 1024 + c] = w.z; wf[(j0 + 3) * 1024 + c] = w.w; }
    __syncthreads();
    {
        f32x4 v[4], vn[4]; int m = gw;
        if (m < M) { const GAS f32x4* xr = (const GAS f32x4*)(F.x + (size_t)m * D) + F.lane;
#pragma unroll
            for (int j = 0; j < 4; ++j) v[j] = xr[64 * j]; }
        const float bfg = (F.lane < 8) ? F.b_forget[F.lane] : 0.f;
        for (; m < M; m += NGW) {
            const int mn = m + NGW;
            if (mn < M) { const GAS f32x4* xr = (const GAS f32x4*)(F.x + (size_t)mn * D) + F.lane;
#pragma unroll
                for (int j = 0; j < 4; ++j) vn[j] = xr[64 * j]; }
            GAS unsigned long long* o8 = (GAS unsigned long long*)(F.xb + (size_t)m * D) + F.lane;
#pragma unroll
            for (int j = 0; j < 4; ++j) o8[64 * j] = (unsigned long long)pk2(v[j].x, v[j].y) | ((unsigned long long)pk2(v[j].z, v[j].w) << 32);
            float mine = 0.f;
#pragma unroll
            for (int g = 0; g < 8; ++g) { float a = 0.f;
#pragma unroll
                for (int j = 0; j < 4; ++j) { const f32x4 w = *(const LAS f32x4*)(wf + g * 1024 + 4 * F.lane + 256 * j); a += (v[j].x * w.x + v[j].y * w.y) + (v[j].z * w.z + v[j].w * w.w); }
                a = wave_sum(a); if (F.lane == g) mine = a; }
            if (F.lane < 8) F.ls[(size_t)m * 8 + F.lane] = log_sigmoid_f(mine + bfg);
#pragma unroll
            for (int j = 0; j < 4; ++j) v[j] = vn[j];
        }
    }
    __syncthreads(); }
    if (PART == 2) { const int gtid = blockIdx.x * NTHR + F.tid, NT = F.G * NTHR;
      for (int i = gtid; i < M * PLED / 8; i += NT) { const GAS f32x4* s = (const GAS f32x4*)(F.p) + 2 * (size_t)i; const f32x4 a = s[0], b = s[1];
          v4u o; o.x = pk2(a.x, a.y); o.y = pk2(a.z, a.w); o.z = pk2(b.x, b.y); o.w = pk2(b.z, b.w); ((GAS v4u*)F.pb)[i] = o; } }
}

__device__ __forceinline__ void p2_scan(Frame& F) {
    LAS float* wt = (LAS float*)(F.lds + RING_OFF);
    for (int it = blockIdx.x; it < 256; it += F.G) {
        const int bh = it >> 3, chunk = it & 7, b = bh >> 3, h = bh & 7, t = chunk * 1024 + 2 * F.tid;
        const float a0 = F.ls[(size_t)(b * SEQ + t) * 8 + h] * LOG2E, a1 = F.ls[(size_t)(b * SEQ + t + 1) * 8 + h] * LOG2E;
        float s = a0 + a1;
#pragma unroll
        for (int o = 1; o < 64; o <<= 1) { const float u = __shfl_up(s, o); if (F.lane >= o) s += u; }
        __syncthreads();
        if (F.lane == 63) wt[F.wave] = s;
        __syncthreads();
        float off = 0.f, tot = 0.f;
#pragma unroll
        for (int w = 0; w < 8; ++w) { const float u = wt[w]; if (w < F.wave) off += u; tot += u; }
        const float i1 = off + s, i0 = i1 - a1;
        F.cfl[(size_t)bh * SEQ + t] = i0; F.cfl[(size_t)bh * SEQ + t + 1] = i1;
        if (F.tid == 0) F.ctot[bh * 8 + chunk] = tot;
        const bf16* kf = F.qkv + (size_t)4 * M * HW;
        float nmax = 0.f;
#pragma unroll
        for (int rr = 0; rr < 2; ++rr) { const GAS v4u* kp = (const GAS v4u*)(kf + (size_t)(b * SEQ + t + rr) * HW + h * HD); float n2 = 0.f;
#pragma unroll
            for (int c = 0; c < 8; ++c) { const v4u w = kp[c];
#pragma unroll
                for (int e = 0; e < 4; ++e) { const float lo = __builtin_bit_cast(float, w[e] << 16), hi = __builtin_bit_cast(float, w[e] & 0xffff0000u); n2 += lo * lo + hi * hi; } }
            nmax = fmaxf(nmax, n2); }
#pragma unroll
        for (int o = 1; o < 32; o <<= 1) nmax = fmaxf(nmax, __shfl_xor(nmax, o));
        if ((F.lane & 31) == 0) F.knt[bh * 128 + chunk * 16 + F.wave * 2 + (F.lane >> 5)] = sqrtf(nmax);
    }
}

#if !defined(ATT_FAST) || !ATT_FAST
__device__ __forceinline__ void ld64(float (&d)[64], const bf16* p) {
    const GAS v4u* s = (const GAS v4u*)p;
#pragma unroll
    for (int c = 0; c < 8; ++c) { const v4u w = s[c];
#pragma unroll
        for (int e = 0; e < 4; ++e) { d[c * 8 + 2 * e] = BFLO(w[e]); d[c * 8 + 2 * e + 1] = BFHI(w[e]); } }
}
__device__ __forceinline__ float dot64(const float (&q)[64], const bf16* p) {
    const GAS v4u* s = (const GAS v4u*)p; float z = 0.f;
#pragma unroll
    for (int c = 0; c < 8; ++c) { const v4u w = s[c];
#pragma unroll
        for (int e = 0; e < 4; ++e) { z += q[c * 8 + 2 * e] * BFLO(w[e]); z += q[c * 8 + 2 * e + 1] * BFHI(w[e]); } }
    return z;
}
__device__ __forceinline__ void axpy64(float (&o)[64], float a, const bf16* p) {
    const GAS v4u* s = (const GAS v4u*)p;
#pragma unroll
    for (int c = 0; c < 8; ++c) { const v4u w = s[c];
#pragma unroll
        for (int e = 0; e < 4; ++e) { o[c * 8 + 2 * e] += a * BFLO(w[e]); o[c * 8 + 2 * e + 1] += a * BFHI(w[e]); } }
}
__device__ __forceinline__ void st64(bf16* p, const float (&d)[64], float sc) {
    GAS v4u* s = (GAS v4u*)p;
#pragma unroll
    for (int c = 0; c < 8; ++c) { v4u w;
#pragma unroll
        for (int e = 0; e < 4; ++e) w[e] = pk2(d[c * 8 + 2 * e] * sc, d[c * 8 + 2 * e + 1] * sc);
        s[c] = w; }
}
__device__ __forceinline__ void p3_attn_simple(Frame& F) {
    const int gtid = blockIdx.x * NTHR + F.tid, NT = F.G * NTHR;
    const bf16 *Qs = F.qkv, *Ks = F.qkv + (size_t)1 * M * HW, *Vs = F.qkv + (size_t)2 * M * HW, *Qf = F.qkv + (size_t)3 * M * HW, *Kf = F.qkv + (size_t)4 * M * HW, *Vf = F.qkv + (size_t)5 * M * HW;
    for (int idx = gtid; idx < M * NHG; idx += NT) {
        const int h = idx >> 15, m = idx & (M - 1), b = m >> 13, t = m & (SEQ - 1);
        float q[64], o[64];
        ld64(q, Qs + (size_t)m * HW + h * HD);
#pragma unroll
        for (int d = 0; d < 64; ++d) o[d] = 0.f;
        float C2 = 0.f;
        for (int s = t - 1; s >= 0; --s) {
            const float z = dot64(q, Ks + (size_t)(b * SEQ + s) * HW + h * HD);
            const float L2 = -(fmaxf(z, 0.f) * LOG2E + log2f(1.f + exp2f(-fabsf(z) * LOG2E)));
            const float w = exp2f(z * LOG2E + L2 + C2);
            axpy64(o, w, Vs + (size_t)(b * SEQ + s) * HW + h * HD);
            C2 += L2;
            if (C2 < -160.f) break;
        }
        st64(F.mixed + (size_t)m * D + h * HD, o, 1.f);
    }
    for (int idx = gtid; idx < M * NHG; idx += NT) {
        const int h = idx >> 15, m = idx & (M - 1), b = m >> 13, t = m & (SEQ - 1), bh = b * 8 + h;
        float q[64], o[64];
        ld64(q, Qf + (size_t)m * HW + h * HD);
#pragma unroll
        for (int d = 0; d < 64; ++d) o[d] = 0.f;
        float cq = F.cfl[(size_t)bh * SEQ + t];
        for (int c = 0; c < (t >> 10); ++c) cq += F.ctot[bh * 8 + c];
        float carry = 0.f, mr = -1e30f, l = 0.f;
        for (int s = 0; s <= t; ++s) {
            if ((s & 1023) == 0 && s > 0) carry += F.ctot[bh * 8 + (s >> 10) - 1];
            const float z = dot64(q, Kf + (size_t)(b * SEQ + s) * HW + h * HD);
            const float s2 = z * LOG2E + (cq - (F.cfl[(size_t)bh * SEQ + s] + carry));
            if (s2 > mr) { const float f = exp2f(mr - s2); l *= f;
#pragma unroll
                for (int d = 0; d < 64; ++d) o[d] *= f;
                mr = s2; }
            const float pw = exp2f(s2 - mr); l += pw;
            axpy64(o, pw, Vf + (size_t)(b * SEQ + s) * HW + h * HD);
        }
        st64(F.mixed + (size_t)m * D + HW + h * HD, o, 1.f / l);
    }
}

#endif
struct FProj { bf16* qkv; __device__ __forceinline__ void operator()(int row, int col, float v) const { const int t = col >> 9, cc = col & 511; const float sc = (t == 0 || t == 3) ? 0.125f : 1.f;
    qkv[(size_t)t * M * HW + (size_t)row * HW + cc] = (bf16)f2bf(v * sc); } };
struct FBf16 { bf16* O; int ldc; int cmask; __device__ __forceinline__ void operator()(int row, int col, float v) const { O[(size_t)row * ldc + (col & cmask)] = (bf16)f2bf(v); } };
struct FPre { const float* x; float* out; __device__ __forceinline__ void operator()(int row, int col, float v) const { const size_t i = (size_t)row * D + col; out[i] = ALPHA * x[i] + v; } };
struct FSwiglu { bf16* hdn; const float* gslot; __device__ __forceinline__ void operator()(int row, int pn, int cl, float g, float u) const {
    const int f = (pn & 3) * 128 + cl; const float s = g / (1.f + __expf(-g)); hdn[(size_t)row * DF + f] = (bf16)f2bf(s * u * gslot[row]); } };
struct FComb { float* out; const bf16* pple; const bf16* y; const int* slot; __device__ __forceinline__ void operator()(int row, int col, float v) const {
    const size_t i = (size_t)row * D + col; const int s0 = slot[row * 2], s1 = slot[row * 2 + 1]; const float sig = 1.f / (1.f + __expf(-v));
    out[i] = ALPHA * out[i] + bf2f(pple[i]) * sig + bf2f(y[(size_t)s0 * D + col]) + bf2f(y[(size_t)s1 * D + col]); } };

#ifndef PROBE_TWICE
#define PROBE_TWICE -1
#endif
template <class S> struct Rep2T : S {
    __device__ __forceinline__ bool next(int i, pg8::Unit& u) const { return S::next(i >> 1, u); }
};
template <class S, bool ON> struct Rep2Sel { typedef S type; };
template <class S> struct Rep2Sel<S, true> { typedef Rep2T<S> type; };
#define Rep2(S, ON) typename Rep2Sel<S, ON>::type

namespace pg8 {
struct EpiPre {
    static constexpr bool PERM = true, AFTER_DRAIN = false; const float* x; float* out;
    __device__ __forceinline__ void operator()(const f32x4 (&acc)[2][2][4][2], const Unit& u, int wr, int wc, int fr, int fq) const {
        const int row0 = u.pm * BM + wr * 64 + fr, col0 = u.pn * BM + wc * 32 + 8 * fq;
#pragma unroll
        for (int ai = 0; ai < 2; ++ai)
#pragma unroll
            for (int m = 0; m < 4; ++m) { const size_t off = (size_t)(row0 + ai * HALF + m * 16) * D + col0;
#pragma unroll
                for (int bj = 0; bj < 2; ++bj) { const f32x4 x0 = *(const f32x4*)(x + off + bj * HALF), x1 = *(const f32x4*)(x + off + bj * HALF + 4);
                    *(f32x4*)(out + off + bj * HALF) = x0 * ALPHA + acc[ai][bj][m][0]; *(f32x4*)(out + off + bj * HALF + 4) = x1 * ALPHA + acc[ai][bj][m][1]; }
                asm volatile("" ::: "memory"); }
    }
};
struct EpiSwiglu {
    static constexpr bool PERM = true, AFTER_DRAIN = false; bf16_t* hdn; const float* gslot;
    __device__ __forceinline__ void operator()(const f32x4 (&acc)[2][2][4][2], const Unit& u, int wr, int wc, int fr, int fq) const {
        const int row0 = u.pm * BM + wr * 64 + fr, f0 = (u.pn & 3) * 128 + wc * 32 + 8 * fq;
#pragma unroll
        for (int ai = 0; ai < 2; ++ai)
#pragma unroll
            for (int m = 0; m < 4; ++m) { const int r = row0 + ai * HALF + m * 16; const float gs = gslot[r]; float v[8];
#pragma unroll
                for (int n = 0; n < 2; ++n)
#pragma unroll
                    for (int e = 0; e < 4; ++e) { const float g = acc[ai][0][m][n][e], up = acc[ai][1][m][n][e]; v[4 * n + e] = g * __builtin_amdgcn_rcpf(1.f + __expf(-g)) * up * gs; }
                u32x4 w; w.x = cvt_pk_bf16(v[0], v[1]); w.y = cvt_pk_bf16(v[2], v[3]); w.z = cvt_pk_bf16(v[4], v[5]); w.w = cvt_pk_bf16(v[6], v[7]);
                *(u32x4*)(hdn + (size_t)r * DF + f0) = w; }
    }
};
struct EpiPle {
    static constexpr bool PERM = true, AFTER_DRAIN = false; bf16_t* pple;
    __device__ __forceinline__ void operator()(const f32x4 (&acc)[2][2][4][2], const Unit& u, int wr, int wc, int fr, int fq) const {
        const int row0 = u.pm * BM + wr * 64 + fr, col0 = u.pn * BM + wc * 32 + 8 * fq;
#pragma unroll
        for (int ai = 0; ai < 2; ++ai)
#pragma unroll
            for (int m = 0; m < 4; ++m) { const size_t off = (size_t)(row0 + ai * HALF + m * 16) * D + col0;
#pragma unroll
                for (int bj = 0; bj < 2; ++bj) { const u32x4 pp = *(const u32x4*)(pple + off + bj * HALF); float v[8];
#pragma unroll
                    for (int e = 0; e < 8; ++e) { const float g = acc[ai][bj][m][e >> 2][e & 3]; const unsigned pw = pp[e >> 1];
                        const float pv = (e & 1) ? __builtin_bit_cast(float, pw & 0xffff0000u) : __builtin_bit_cast(float, pw << 16);
                        v[e] = pv * __builtin_amdgcn_rcpf(1.f + __expf(-g)); }
                    u32x4 w; w.x = cvt_pk_bf16(v[0], v[1]); w.y = cvt_pk_bf16(v[2], v[3]); w.z = cvt_pk_bf16(v[4], v[5]); w.w = cvt_pk_bf16(v[6], v[7]);
                    *(u32x4*)(pple + off + bj * HALF) = w; }
                asm volatile("" ::: "memory"); }
    }
};
}

struct MoeOrder {
    const LAS int* pst; int nunits, G, c;
    __device__ __forceinline__ bool next(int i, pg8::Unit& u) const {
        const int L = i * G + c; if (L >= nunits) return false;
        const int pm = L >> 2, r0 = pm * 256; int e = 0;
        for (int k = 0; k < NE - 1; ++k) if (r0 >= pst[k + 1]) e = k + 1;
        u.pm = pm; u.pn = e * 4 + (L & 3); return true;
    }
    __device__ __forceinline__ void a_ready(const pg8::Unit&) const {}
    __device__ __forceinline__ void done(const pg8::Unit&) const {}
};
__device__ __forceinline__ void build_pstart(Frame& F) {
    LAS int* pst = (LAS int*)(F.lds + PST_OFF);
    if (F.tid == 0) { int acc = 0; for (int e = 0; e < NE; ++e) { const int c = (int)__hip_atomic_load(F.ctl + CW_CNT + 64 * e, RLX_AGENT); pst[e] = acc; acc += (c + 255) & ~255; } pst[NE] = acc; }
    __syncthreads();
}

constexpr int RB = 2;
__device__ __forceinline__ unsigned long long pk4(const f32x4 v) { return (unsigned long long)pk2(v.x, v.y) | ((unsigned long long)pk2(v.z, v.w) << 32); }
__device__ __forceinline__ void p5_ln_route(Frame& F) {
    LAS unsigned* hist = (LAS unsigned*)(F.lds + HIST_OFF); LAS unsigned* base = (LAS unsigned*)(F.lds + BASE_OFF);
    LAS int* eidL = (LAS int*)(F.lds + ROWL_OFF); LAS int* rankL = eidL + 256;
    if (F.tid < NE) hist[F.tid] = 0u;
    __syncthreads();
    f32x4 gv[4], bv[4];
#pragma unroll
    for (int j = 0; j < 4; ++j) { gv[j] = *(const GAS f32x4*)(F.ln1g + 4 * F.lane + 256 * j); bv[j] = *(const GAS f32x4*)(F.ln1b + 4 * F.lane + 256 * j); }
    float bg[4], brt[32 / 64 + 1]; (void)brt;
#pragma unroll
    for (int i = 0; i < 4; ++i) bg[i] = F.b_group[i];
    for (int r0 = F.wave * RB; r0 < 128; r0 += NWAVES * RB) {
        f32x4 v[RB][4]; float mean[RB], rstd[RB];
#pragma unroll
        for (int rr = 0; rr < RB; ++rr) { const GAS f32x4* pr = (const GAS f32x4*)(F.out + (size_t)(blockIdx.x * 128 + r0 + rr) * D) + F.lane;
#pragma unroll
            for (int j = 0; j < 4; ++j) v[rr][j] = pr[64 * j]; }
#pragma unroll
        for (int rr = 0; rr < RB; ++rr) { float s = 0.f;
#pragma unroll
            for (int j = 0; j < 4; ++j) s += (v[rr][j].x + v[rr][j].y) + (v[rr][j].z + v[rr][j].w);
            mean[rr] = s; }
#pragma unroll
        for (int o = 1; o < 64; o <<= 1)
#pragma unroll
            for (int rr = 0; rr < RB; ++rr) mean[rr] += __shfl_xor(mean[rr], o);
#pragma unroll
        for (int rr = 0; rr < RB; ++rr) { mean[rr] *= (1.f / D); float s2 = 0.f;
#pragma unroll
            for (int j = 0; j < 4; ++j) { v[rr][j] = v[rr][j] - mean[rr]; s2 += (v[rr][j].x * v[rr][j].x + v[rr][j].y * v[rr][j].y) + (v[rr][j].z * v[rr][j].z + v[rr][j].w * v[rr][j].w); }
            rstd[rr] = s2; }
#pragma unroll
        for (int o = 1; o < 64; o <<= 1)
#pragma unroll
            for (int rr = 0; rr < RB; ++rr) rstd[rr] += __shfl_xor(rstd[rr], o);
        float gl[RB][4];
#pragma unroll
        for (int rr = 0; rr < RB; ++rr) { const int m = blockIdx.x * 128 + r0 + rr; rstd[rr] = 1.f / sqrtf(rstd[rr] * (1.f / D) + LN_EPS);
            GAS f32x4* pr = (GAS f32x4*)(F.out + (size_t)m * D) + F.lane; GAS unsigned long long* o8 = (GAS unsigned long long*)(F.hb + (size_t)m * D) + F.lane;
#pragma unroll
            for (int j = 0; j < 4; ++j) { v[rr][j] = v[rr][j] * rstd[rr] * gv[j] + bv[j]; pr[64 * j] = v[rr][j]; o8[64 * j] = pk4(v[rr][j]); }
#pragma unroll
            for (int i = 0; i < 4; ++i) gl[rr][i] = 0.f; }
#pragma unroll
        for (int j = 0; j < 4; ++j)
#pragma unroll
            for (int e = 0; e < 4; ++e) { const int c = 4 * F.lane + 256 * j + e; const f32x4 w = *(const GAS f32x4*)(F.w_group + (size_t)c * 4);
#pragma unroll
                for (int rr = 0; rr < RB; ++rr) { const float hv = v[rr][j][e]; gl[rr][0] += hv * w.x; gl[rr][1] += hv * w.y; gl[rr][2] += hv * w.z; gl[rr][3] += hv * w.w; } }
#pragma unroll
        for (int o = 1; o < 64; o <<= 1)
#pragma unroll
            for (int rr = 0; rr < RB; ++rr)
#pragma unroll
                for (int i = 0; i < 4; ++i) gl[rr][i] += __shfl_xor(gl[rr][i], o);
        int gs[RB]; float gprob[RB]; float el[RB][8];
#pragma unroll
        for (int rr = 0; rr < RB; ++rr) {
#pragma unroll
            for (int i = 0; i < 4; ++i) gl[rr][i] += bg[i];
            int g = 0; float gm = gl[rr][0];
#pragma unroll
            for (int i = 1; i < 4; ++i) if (gl[rr][i] > gm) { gm = gl[rr][i]; g = i; }
            gs[rr] = __builtin_amdgcn_readfirstlane(g);
            float gden = 0.f;
#pragma unroll
            for (int i = 0; i < 4; ++i) gden += expf(gl[rr][i] - gm);
            gprob[rr] = 1.f / gden;
#pragma unroll
            for (int i = 0; i < 8; ++i) el[rr][i] = 0.f; }
#pragma unroll
        for (int j = 0; j < 4; ++j)
#pragma unroll
            for (int e = 0; e < 4; ++e) { const int c = 4 * F.lane + 256 * j + e;
#pragma unroll
                for (int rr = 0; rr < RB; ++rr) { const GAS f32x4* wp = (const GAS f32x4*)(F.w_router + (size_t)c * NE + gs[rr] * EPG); const f32x4 w0 = wp[0], w1 = wp[1]; const float hv = v[rr][j][e];
                    el[rr][0] += hv * w0.x; el[rr][1] += hv * w0.y; el[rr][2] += hv * w0.z; el[rr][3] += hv * w0.w; el[rr][4] += hv * w1.x; el[rr][5] += hv * w1.y; el[rr][6] += hv * w1.z; el[rr][7] += hv * w1.w; } }
#pragma unroll
        for (int o = 1; o < 64; o <<= 1)
#pragma unroll
            for (int rr = 0; rr < RB; ++rr)
#pragma unroll
                for (int i = 0; i < 8; ++i) el[rr][i] += __shfl_xor(el[rr][i], o);
#pragma unroll
        for (int rr = 0; rr < RB; ++rr) { const int r = r0 + rr, m = blockIdx.x * 128 + r;
#pragma unroll
            for (int i = 0; i < 8; ++i) el[rr][i] += F.b_router[gs[rr] * EPG + i];
            int i1 = 0; float v1 = el[rr][0];
#pragma unroll
            for (int i = 1; i < 8; ++i) if (el[rr][i] > v1) { v1 = el[rr][i]; i1 = i; }
            int i2 = (i1 == 0) ? 1 : 0; float v2 = (i1 == 0) ? el[rr][1] : el[rr][0];
#pragma unroll
            for (int i = 1; i < 8; ++i) if (i != i1 && el[rr][i] > v2) { v2 = el[rr][i]; i2 = i; }
            const float e2 = expf(v2 - v1), g1 = 1.f / (1.f + e2), g2 = e2 * g1;
            if (F.lane == 0) {
                const int ea = gs[rr] * EPG + i1, eb = gs[rr] * EPG + i2;
                const unsigned ra = __hip_atomic_fetch_add(hist + ea, 1u, __ATOMIC_RELAXED, __HIP_MEMORY_SCOPE_WORKGROUP);
                const unsigned rb = __hip_atomic_fetch_add(hist + eb, 1u, __ATOMIC_RELAXED, __HIP_MEMORY_SCOPE_WORKGROUP);
                eidL[r * 2] = ea; eidL[r * 2 + 1] = eb; rankL[r * 2] = (int)ra; rankL[r * 2 + 1] = (int)rb;
                F.eid[m * 2] = ea; F.eid[m * 2 + 1] = eb; F.gatev[m * 2] = g1 * gprob[rr]; F.gatev[m * 2 + 1] = g2 * gprob[rr];
            } }
    }
    __syncthreads();
    if (F.tid < NE) base[F.tid] = __hip_atomic_fetch_add(F.ctl + CW_CNT + 64 * F.tid, hist[F.tid], RLX_AGENT);
    __syncthreads();
    if (F.tid < 256) F.rank[blockIdx.x * 256 + F.tid] = rankL[F.tid] + (int)base[eidL[F.tid]];
}
__device__ __forceinline__ void p6_slots_gather(Frame& F) {
    build_pstart(F);
    const LAS int* pst = (const LAS int*)(F.lds + PST_OFF);
    for (int r0 = F.wave * 4; r0 < 128; r0 += NWAVES * 4) {
        v4u a[4], b[4]; int s0[4], s1[4];
#pragma unroll
        for (int rr = 0; rr < 4; ++rr) { const int m = blockIdx.x * 128 + r0 + rr; int s = 0;
            if (F.lane < 2) { const int e = F.eid[m * 2 + F.lane]; s = pst[e] + F.rank[m * 2 + F.lane]; F.slot[m * 2 + F.lane] = s; F.gslot[s] = F.gatev[m * 2 + F.lane]; }
            s0[rr] = __shfl(s, 0); s1[rr] = __shfl(s, 1);
            const GAS v4u* src = (const GAS v4u*)(F.hb + (size_t)m * D); a[rr] = src[F.lane]; b[rr] = src[F.lane + 64]; }
#pragma unroll
        for (int rr = 0; rr < 4; ++rr) { GAS v4u* d0 = (GAS v4u*)(F.xs + (size_t)s0[rr] * D); GAS v4u* d1 = (GAS v4u*)(F.xs + (size_t)s1[rr] * D);
            d0[F.lane] = a[rr]; d0[F.lane + 64] = b[rr]; d1[F.lane] = a[rr]; d1[F.lane + 64] = b[rr]; }
    }
}
__device__ __forceinline__ void p9_final(Frame& F, bool poison) {
    f32x4 gv[4], bv[4];
#pragma unroll
    for (int j = 0; j < 4; ++j) { gv[j] = *(const GAS f32x4*)(F.ln2g + 4 * F.lane + 256 * j); bv[j] = *(const GAS f32x4*)(F.ln2b + 4 * F.lane + 256 * j); }
    const int gw = blockIdx.x * NWAVES + F.wave, NGW = F.G * NWAVES; const float qn = __builtin_nanf("");
    for (int m0 = gw * RB; m0 < M; m0 += NGW * RB) {
        f32x4 v[RB][4]; float mean[RB], rstd[RB];
#pragma unroll
        for (int rr = 0; rr < RB; ++rr) { const int m = m0 + rr; const int s0 = F.slot[2 * m], s1 = F.slot[2 * m + 1];
            const GAS f32x4* pr = (const GAS f32x4*)(F.out + (size_t)m * D) + F.lane;
            const GAS unsigned long long* pp = (const GAS unsigned long long*)(F.pple + (size_t)m * D) + F.lane;
            const GAS unsigned long long* y0 = (const GAS unsigned long long*)(F.y + (size_t)s0 * D) + F.lane; const GAS unsigned long long* y1 = (const GAS unsigned long long*)(F.y + (size_t)s1 * D) + F.lane;
#pragma unroll
            for (int j = 0; j < 4; ++j) { const f32x4 h = pr[64 * j]; const unsigned long long pw = pp[64 * j], aw = y0[64 * j], bw = y1[64 * j];
                const unsigned p0 = (unsigned)pw, p1 = (unsigned)(pw >> 32), a0 = (unsigned)aw, a1 = (unsigned)(aw >> 32), b0 = (unsigned)bw, b1 = (unsigned)(bw >> 32);
                f32x4 t;
                t.x = h.x * ALPHA + BFLO(p0) + (BFLO(a0) + BFLO(b0)); t.y = h.y * ALPHA + BFHI(p0) + (BFHI(a0) + BFHI(b0));
                t.z = h.z * ALPHA + BFLO(p1) + (BFLO(a1) + BFLO(b1)); t.w = h.w * ALPHA + BFHI(p1) + (BFHI(a1) + BFHI(b1));
                v[rr][j] = t; } }
#pragma unroll
        for (int rr = 0; rr < RB; ++rr) { float s = 0.f;
#pragma unroll
            for (int j = 0; j < 4; ++j) s += (v[rr][j].x + v[rr][j].y) + (v[rr][j].z + v[rr][j].w);
            mean[rr] = s; }
#pragma unroll
        for (int o = 1; o < 64; o <<= 1)
#pragma unroll
            for (int rr = 0; rr < RB; ++rr) mean[rr] += __shfl_xor(mean[rr], o);
#pragma unroll
        for (int rr = 0; rr < RB; ++rr) { mean[rr] *= (1.f / D); float s2 = 0.f;
#pragma unroll
            for (int j = 0; j < 4; ++j) { v[rr][j] = v[rr][j] - mean[rr]; s2 += (v[rr][j].x * v[rr][j].x + v[rr][j].y * v[rr][j].y) + (v[rr][j].z * v[rr][j].z + v[rr][j].w * v[rr][j].w); }
            rstd[rr] = s2; }
#pragma unroll
        for (int o = 1; o < 64; o <<= 1)
#pragma unroll
            for (int rr = 0; rr < RB; ++rr) rstd[rr] += __shfl_xor(rstd[rr], o);
#pragma unroll
        for (int rr = 0; rr < RB; ++rr) { const float rs = 1.f / sqrtf(rstd[rr] * (1.f / D) + LN_EPS); GAS f32x4* pr = (GAS f32x4*)(F.out + (size_t)(m0 + rr) * D) + F.lane;
#pragma unroll
            for (int j = 0; j < 4; ++j) { f32x4 o = v[rr][j] * rs * gv[j] + bv[j]; if (poison) o = (f32x4){qn, qn, qn, qn}; pr[64 * j] = o; } }
    }
}


namespace att {
typedef float f32x16 __attribute__((ext_vector_type(16)));
typedef short s16x4 __attribute__((ext_vector_type(4)));
typedef short v4i16_t __attribute__((ext_vector_type(4)));
constexpr int BUFB = 16384 + 512, A_WS = 2 * BUFB, A_FLAG = A_WS + 2048, A_CAR = A_FLAG + 64, A_END = A_CAR + 64;
constexpr float STOP2 = -48.f;
__device__ __forceinline__ int crow(int r, int hi) { return (r & 3) + 8 * (r >> 2) + 4 * hi; }
__device__ __forceinline__ unsigned cvtpk(float lo, float hi) { typedef float f2 __attribute__((ext_vector_type(2))); typedef __bf16 b2 __attribute__((ext_vector_type(2))); f2 v = {lo, hi}; b2 b = __builtin_convertvector(v, b2); return __builtin_bit_cast(unsigned, b); }

template <int MODE> __device__ __forceinline__ void attn_unit(Frame& F, int bh, int qb) {
    const int tid = F.tid, lane = F.lane, r32 = lane & 31, hi = lane >> 5, wid = F.wave;
    const int b = bh >> 3, h = bh & 7;
    const bf16* Qg = F.qkv + (size_t)(MODE ? 3 : 0) * M * HW; const bf16* Kg = F.qkv + (size_t)(MODE ? 4 : 1) * M * HW; const bf16* Vg = F.qkv + (size_t)(MODE ? 5 : 2) * M * HW;
    const size_t rowbase = (size_t)b * SEQ; const int q0 = qb * 256;
    const bf16* Qw = Qg + (rowbase + q0 + wid * 32) * HW + h * HD;
    const bf16* Kh = Kg + rowbase * HW + h * HD; const bf16* Vh = Vg + rowbase * HW + h * HD;
    LAS unsigned char* L = F.lds + RING_OFF;
    LAS float* wsf = (LAS float*)(L + A_WS) + wid * 64;
    LAS unsigned* flg = (LAS unsigned*)(L + A_FLAG);
    LAS float* car = (LAS float*)(L + A_CAR);
    const int jt = (q0 >> 6) + 3, jw = (q0 >> 6) + (wid >> 1);
    const bf16* ksrc = Kh + (size_t)lane * HW + wid * 8;
    const bf16* vsrc = Vh + (size_t)(16 * (wid & 3) + (lane >> 2)) * HW + (wid >> 2) * 32 + (lane & 3) * 8;
    const int kdst = wid * 1024 + lane * 16, vdst = 8192 + wid * 1024 + lane * 16;
    const float* cfsrc = F.cfl + (size_t)bh * SEQ + tid * 4;
    float KNu = 0.f;
    if (MODE) {
        if (tid < 8) { float c = 0.f; for (int k = 0; k < tid; ++k) c += F.ctot[bh * 8 + k]; car[tid] = c; }
        float kn = (lane <= jt) ? F.knt[bh * 128 + lane] : 0.f; if (lane + 64 <= jt) kn = fmaxf(kn, F.knt[bh * 128 + lane + 64]);
        KNu = wave_max(kn);
    }
    bf16x8 qr[4];
#pragma unroll
    for (int d0 = 0; d0 < 4; ++d0) qr[d0] = *(const GAS bf16x8*)(Qw + (size_t)r32 * HW + d0 * 16 + hi * 8);
    __syncthreads();
    v4u kreg = *(const GAS v4u*)(ksrc + (size_t)jt * 64 * HW), vreg = *(const GAS v4u*)(vsrc + (size_t)jt * 64 * HW); f32x4 cfreg = {0.f, 0.f, 0.f, 0.f};
    if (MODE && tid < 16) { cfreg = *(const GAS f32x4*)(cfsrc + jt * 64); const float c = car[jt >> 4]; cfreg = cfreg + c; }
    *(LAS v4u*)(L + kdst) = kreg; *(LAS v4u*)(L + vdst) = vreg; if (MODE && tid < 16) *(LAS f32x4*)(L + 16384 + tid * 16) = cfreg;
    float cq = 0.f, qnb = 0.f;
    if (MODE) {
        cq = F.cfl[(size_t)bh * SEQ + q0 + wid * 32 + r32] + car[q0 >> 10];
        float n2 = 0.f;
#pragma unroll
        for (int d0 = 0; d0 < 4; ++d0)
#pragma unroll
            for (int e = 0; e < 8; ++e) { const float qv = __builtin_bit_cast(float, (unsigned)(unsigned short)qr[d0][e] << 16); n2 += qv * qv; }
        n2 += __shfl_xor(n2, 32);
        qnb = sqrtf(n2) * KNu * (LOG2E * 1.01f) + cq;
    }
    __syncthreads();
    f32x16 o[2]; o[0] = f32x16{}; o[1] = f32x16{};
    float C2 = 0.f, mhat = -1e30f, lsum = 0.f;
    bool wdone = false; int cur = 0;
    const LAS unsigned char* vb0 = L + 8192 + ((lane >> 4) & 1) * 32 + (lane & 3) * 8 + (4 * hi + ((lane & 15) >> 2)) * 64;
    for (int j = jt;; --j) {
        const bool more = j > 0;
        if (more) { kreg = *(const GAS v4u*)(ksrc + (size_t)(j - 1) * 64 * HW); vreg = *(const GAS v4u*)(vsrc + (size_t)(j - 1) * 64 * HW);
            if (MODE && tid < 16) cfreg = *(const GAS f32x4*)(cfsrc + (j - 1) * 64); }
        if (!wdone && j <= jw) {
            const LAS unsigned char* Kb = L + cur * BUFB;
            f32x16 p0 = f32x16{}, p1 = f32x16{};
            { const LAS unsigned char* kb = Kb + hi * 1024 + r32 * 16;
#pragma unroll
              for (int d0 = 0; d0 < 4; ++d0) { const bf16x8 b0 = *(const LAS bf16x8*)(kb + d0 * 2048), b1 = *(const LAS bf16x8*)(kb + d0 * 2048 + 512);
                  p0 = __builtin_amdgcn_mfma_f32_32x32x16_bf16(b0, qr[d0], p0, 0, 0, 0); p1 = __builtin_amdgcn_mfma_f32_32x32x16_bf16(b1, qr[d0], p1, 0, 0, 0); } }
            const bool diag = (j == jw); const int qrel = 32 * (wid & 1) + r32;
            if (MODE == 0) {
                float Lg[32];
#pragma unroll
                for (int r = 0; r < 16; ++r) {
                    const float z0 = p0[r], z1 = p1[r];
                    float l0 = -(fmaxf(z0, 0.f) * LOG2E + __builtin_amdgcn_logf(1.f + __builtin_amdgcn_exp2f(-fabsf(z0) * LOG2E)));
                    float l1 = -(fmaxf(z1, 0.f) * LOG2E + __builtin_amdgcn_logf(1.f + __builtin_amdgcn_exp2f(-fabsf(z1) * LOG2E)));
                    if (diag) { if (crow(r, hi) >= qrel) l0 = 0.f; if (crow(r, hi) + 32 >= qrel) l1 = 0.f; }
                    Lg[r] = l0; Lg[16 + r] = l1;
                }
                float Os[8], Ps[8];
#pragma unroll
                for (int i = 0; i < 8; ++i) { Os[i] = (Lg[4 * i] + Lg[4 * i + 1]) + (Lg[4 * i + 2] + Lg[4 * i + 3]); Ps[i] = __shfl_xor(Os[i], 32); }
                float T = 0.f;
#pragma unroll
                for (int i = 7; i >= 0; --i) {
                    float s = T + (hi ? 0.f : Ps[i]) + C2;
#pragma unroll
                    for (int e = 3; e >= 0; --e) { s += Lg[4 * i + e]; const int r = (4 * i + e) & 15; const float zz = (i < 4) ? p0[r] : p1[r];
                        float w = __builtin_amdgcn_exp2f(zz * LOG2E + s);
                        if (diag) { const int kk = crow(r, hi) + (i < 4 ? 0 : 32); if (kk >= qrel) w = 0.f; }
                        if (i < 4) p0[r] = w; else p1[r] = w; }
                    T += Os[i] + Ps[i];
                }
                C2 += T;
                wdone = __all(C2 < STOP2);
            } else {
                const LAS float* cfp = (const LAS float*)(Kb + 16384);
                float rm = -INFINITY;
#pragma unroll
                for (int g = 0; g < 4; ++g) { const f32x4 c0 = *(const LAS f32x4*)(cfp + 8 * g + 4 * hi), c1 = *(const LAS f32x4*)(cfp + 32 + 8 * g + 4 * hi);
#pragma unroll
                    for (int e = 0; e < 4; ++e) { const int r = 4 * g + e; float s0 = p0[r] * LOG2E + (cq - c0[e]), s1 = p1[r] * LOG2E + (cq - c1[e]);
                        if (diag) { if (crow(r, hi) > qrel) s0 = -INFINITY; if (crow(r, hi) + 32 > qrel) s1 = -INFINITY; }
                        p0[r] = s0; p1[r] = s1; rm = fmaxf(rm, fmaxf(s0, s1)); } }
                rm = fmaxf(rm, __shfl_xor(rm, 32));
                const float mnew = fmaxf(mhat, rm);
                if (__any(mnew > mhat)) {
                    const float f = __builtin_amdgcn_exp2f(mhat - mnew); lsum *= f;
                    if (hi == 0) wsf[r32] = f;
                    asm volatile("s_waitcnt lgkmcnt(0)" ::: "memory");
#pragma unroll
                    for (int r = 0; r < 16; ++r) { const float fr = wsf[crow(r, hi)]; o[0][r] *= fr; o[1][r] *= fr; }
                    mhat = mnew;
                }
                float sacc = 0.f;
#pragma unroll
                for (int r = 0; r < 16; ++r) { p0[r] = __builtin_amdgcn_exp2f(p0[r] - mhat); p1[r] = __builtin_amdgcn_exp2f(p1[r] - mhat); sacc += p0[r] + p1[r]; }
                lsum += sacc;
                const float c00 = cfp[0];
                wdone = __all(qnb - c00 - mhat < STOP2);
            }
            v4u pw0, pw1, pw2, pw3;
#pragma unroll
            for (int e = 0; e < 4; ++e) { pw0[e] = cvtpk(p0[2 * e], p0[2 * e + 1]); pw1[e] = cvtpk(p0[8 + 2 * e], p0[8 + 2 * e + 1]); pw2[e] = cvtpk(p1[2 * e], p1[2 * e + 1]); pw3[e] = cvtpk(p1[8 + 2 * e], p1[8 + 2 * e + 1]); }
            const LAS unsigned char* vb = vb0 + cur * BUFB;
#pragma unroll
            for (int d0 = 0; d0 < 2; ++d0) { s16x4 lo[4], hh[4];
#pragma unroll
                for (int ks = 0; ks < 4; ++ks) {
                    lo[ks] = __builtin_bit_cast(s16x4, __builtin_amdgcn_ds_read_tr16_b64_v4i16((LAS v4i16_t*)(vb + d0 * 4096 + ks * 1024)));
                    hh[ks] = __builtin_bit_cast(s16x4, __builtin_amdgcn_ds_read_tr16_b64_v4i16((LAS v4i16_t*)(vb + d0 * 4096 + ks * 1024 + 512))); }
#define ATT_PK(k) (bf16x8){lo[k][0], lo[k][1], lo[k][2], lo[k][3], hh[k][0], hh[k][1], hh[k][2], hh[k][3]}
                o[d0] = __builtin_amdgcn_mfma_f32_32x32x16_bf16(__builtin_bit_cast(bf16x8, pw0), ATT_PK(0), o[d0], 0, 0, 0);
                o[d0] = __builtin_amdgcn_mfma_f32_32x32x16_bf16(__builtin_bit_cast(bf16x8, pw1), ATT_PK(1), o[d0], 0, 0, 0);
                o[d0] = __builtin_amdgcn_mfma_f32_32x32x16_bf16(__builtin_bit_cast(bf16x8, pw2), ATT_PK(2), o[d0], 0, 0, 0);
                o[d0] = __builtin_amdgcn_mfma_f32_32x32x16_bf16(__builtin_bit_cast(bf16x8, pw3), ATT_PK(3), o[d0], 0, 0, 0);
#undef ATT_PK
            }
        }
        if (more) { const int nb = (cur ^ 1) * BUFB;
            if (MODE && tid < 16) { const float c = car[(j - 1) >> 4]; cfreg = cfreg + c; *(LAS f32x4*)(L + nb + 16384 + tid * 16) = cfreg; }
            *(LAS v4u*)(L + nb + kdst) = kreg; *(LAS v4u*)(L + nb + vdst) = vreg; }
        if (lane == 0) flg[cur * 8 + wid] = wdone ? 1u : 0u;
        __syncthreads();
        if (!more) break;
        unsigned alld = 1u;
#pragma unroll
        for (int w = 0; w < 8; ++w) alld &= flg[cur * 8 + w];
        if (alld) break;
        cur ^= 1;
    }
    float rli[16];
    if (MODE) {
        lsum += __shfl_xor(lsum, 32);
        if (hi == 0) wsf[r32] = lsum;
        asm volatile("s_waitcnt lgkmcnt(0)" ::: "memory");
#pragma unroll
        for (int r = 0; r < 16; ++r) rli[r] = 1.f / wsf[crow(r, hi)];
    } else {
#pragma unroll
        for (int r = 0; r < 16; ++r) rli[r] = 1.f;
    }
    bf16* Ow = F.mixed + (rowbase + q0 + wid * 32) * D + (MODE ? HW : 0) + h * HD;
#pragma unroll
    for (int r = 0; r < 16; ++r) {
        bf16* rowp = Ow + (size_t)crow(r, hi) * D + r32;
        rowp[0] = (bf16)f2bf(o[0][r] * rli[r]); rowp[32] = (bf16)f2bf(o[1][r] * rli[r]);
    }
}
}

template <int MODE> __device__ __forceinline__ void p3_attn_fast(Frame& F) {
    for (int i = 3; i >= 0; --i) { const int id = (int)blockIdx.x + F.G * i; if (id < 1024) att::attn_unit<MODE>(F, id & 31, id >> 5); }
}

struct Args { const float* in[18]; float* out; unsigned char* ws; int ph_lo, ph_hi; };
__global__ void __launch_bounds__(NTHR, 2) mk_fwd(Args args) {
    extern __shared__ __attribute__((aligned(16))) unsigned char lds[];
    Frame F;
    F.lds = (LAS unsigned char*)lds; F.MISC = (volatile LAS unsigned*)(F.lds + MISC_OFF);
    F.tid = threadIdx.x; F.lane = F.tid & 63; F.wave = __builtin_amdgcn_readfirstlane(F.tid >> 6);
    F.G = gridDim.x; { const int bx = blockIdx.x; F.vcu = (F.G % 8 == 0) ? (bx % 8) * (F.G / 8) + bx / 8 : bx; }
    unsigned char* ws = args.ws;
    F.ctl = (gu32*)(ws + WS_CTL);
    F.x = args.in[0]; F.p = args.in[1]; F.w_in = args.in[2]; F.b_forget = args.in[3]; F.w_out = args.in[4]; F.ln1g = args.in[5]; F.ln1b = args.in[6]; F.w_group = args.in[7]; F.b_group = args.in[8];
    F.w_router = args.in[9]; F.b_router = args.in[10]; F.w_gate = args.in[11]; F.w_up = args.in[12]; F.w_down = args.in[13]; F.w_ple = args.in[14]; F.w_pg = args.in[15]; F.ln2g = args.in[16]; F.ln2b = args.in[17];
    F.out = args.out;
    F.Win_t = (bf16*)(ws + WS_WIN); F.Wout_t = (bf16*)(ws + WS_WOUT); F.Wple_t = (bf16*)(ws + WS_WPLE); F.Wpg_t = (bf16*)(ws + WS_WPG); F.Wgu_t = (bf16*)(ws + WS_WGU); F.Wd_t = (bf16*)(ws + WS_WD);
    F.pple = (bf16*)(ws + WS_PPLE); F.qkv = (bf16*)(ws + WS_R1); F.xs = (bf16*)(ws + WS_R1); F.y = (bf16*)(ws + WS_R1);
    F.xb = (bf16*)(ws + WS_R2); F.mixed = (bf16*)(ws + WS_R2); F.hb = (bf16*)(ws + WS_R2); F.pb = (bf16*)(ws + WS_R3); F.hdn = (bf16*)(ws + WS_R3);
    F.ls = (float*)(ws + WS_LS); F.cfl = (float*)(ws + WS_CFL); F.ctot = (float*)(ws + WS_CTOT); F.knt = (float*)(ws + WS_KNT); F.gatev = (float*)(ws + WS_GATE); F.gslot = (float*)(ws + WS_GSLOT);
    F.eid = (int*)(ws + WS_EID); F.rank = (int*)(ws + WS_RANK); F.slot = (int*)(ws + WS_SLOT);
    for (int u = F.tid; u < (LDS_BYTES - LDSCTL_OFF) / 4; u += NTHR) ((LAS unsigned*)(F.lds + LDSCTL_OFF))[u] = 0u;
    __syncthreads();
    XcdBarrier bar = xcd_barrier_post((unsigned*)(F.ctl + CW_BAR), F.MISC + 8);
    const int lo = args.ph_lo, hi = args.ph_hi;
#ifndef PH_MASK
#define PH_MASK 0x3ff
#endif
#define IN(k) (((PH_MASK >> (k)) & 1) && lo <= (k) && (k) < hi)
#define SEAM(k) do { if (IN(k) && IN((k) + 1)) xcd_barrier(bar); } while (0)

#ifndef REPEAT_PH
#define REPEAT_PH -1
#endif
#define REP(k) _Pragma("unroll") for (int rep_ = 0; rep_ < ((k) == REPEAT_PH ? 2 : 1); ++rep_)
    REP(100) { if (IN(0)) { p0_prologue<0>(F); } }
    REP(101) { if (IN(0)) { p0_prologue<1>(F); } }
    REP(102) { if (IN(0)) { p0_prologue<2>(F); } }
    SEAM(0);

    if (IN(1)) {
        { pg8::Gemm g{F.xb, F.Win_t, M, NPROJ, D}; pg8::StaticOrder S; S.init(M, NPROJ, F.G, (int)blockIdx.x);
          pg8::EpiBf16<0> E{F.qkv, HW, nullptr, HW, (size_t)M * HW, 1.f};
          pg8::gemm_phase<pg8::EpiBf16<0>, pg8::StaticOrder, true, true>(F.lds + RING_OFF, g, S, E); }
        { pg8::Gemm g{F.pb, F.Wple_t, M, D, PLED}; pg8::StaticOrder S; S.init(M, D, F.G, (int)blockIdx.x);
          pg8::EpiBf16<0> E{F.pple, D, nullptr, 0, 0, 1.f};
          pg8::gemm_phase<pg8::EpiBf16<0>, pg8::StaticOrder, true, true>(F.lds + RING_OFF, g, S, E); }
    } SEAM(1);

    if (IN(2)) { p2_scan(F); } SEAM(2);

#if ATT_FAST
    REP(31) { if (IN(3)) { p3_attn_fast<1>(F); } }
    REP(32) { if (IN(3)) { p3_attn_fast<0>(F); } }
    SEAM(3);
#else
    if (IN(3)) { p3_attn_simple(F); } SEAM(3);
#endif

    if (IN(4)) {
        pg8::Gemm g{F.mixed, F.Wout_t, M, D, D}; pg8::StaticOrder S; S.init(M, D, F.G, (int)blockIdx.x);
        pg8::EpiPre E{F.x, F.out};
        pg8::gemm_phase<pg8::EpiPre, pg8::StaticOrder, true, true>(F.lds + RING_OFF, g, S, E);
    } SEAM(4);

    if (IN(5)) { p5_ln_route(F); } SEAM(5);

    if (IN(6)) {
        p6_slots_gather(F);
        { pg8::Gemm g{F.hb, F.Wpg_t, M, D, D}; pg8::StaticOrder S; S.init(M, D, F.G, (int)blockIdx.x);
          pg8::EpiPle E{F.pple};
          pg8::gemm_phase<pg8::EpiPle, pg8::StaticOrder, true, true>(F.lds + RING_OFF, g, S, E); }
    } SEAM(6);

    if (IN(7)) {
        build_pstart(F);
        const LAS int* pst = (const LAS int*)(F.lds + PST_OFF);
        pg8::Gemm g{F.xs, F.Wgu_t, SPAD, NE * 1024, D}; MoeOrder S{pst, (pst[NE] >> 8) * 4, F.G, (int)blockIdx.x};
        pg8::EpiSwiglu E{F.hdn, F.gslot};
        pg8::gemm_phase<pg8::EpiSwiglu, MoeOrder, true, true>(F.lds + RING_OFF, g, S, E);
    } SEAM(7);

    if (IN(8)) {
        build_pstart(F);
        const LAS int* pst = (const LAS int*)(F.lds + PST_OFF);
        pg8::Gemm g{F.hdn, F.Wd_t, SPAD, NE * 1024, DF}; MoeOrder S{pst, (pst[NE] >> 8) * 4, F.G, (int)blockIdx.x};
        pg8::EpiBf16<0> E{F.y, D, nullptr, 1024, 0, 1.f};
        pg8::gemm_phase<pg8::EpiBf16<0>, MoeOrder, true, true>(F.lds + RING_OFF, g, S, E);
    } SEAM(8);

    if (IN(9)) {
        const bool poison = __hip_atomic_load((gu32*)((unsigned*)(F.ctl + CW_BAR) + XB_TMO), RLX_AGENT) != 0u || F.G != 256;
        p9_final(F, poison);
    }
#undef IN
#undef SEAM
}

#ifndef MK_CUTS
#define MK_CUTS 0
#endif
extern "C" void kernel_launch(void* const* d_in, const int* in_sizes, int n_in, void* d_out, int out_size, void* d_ws, size_t ws_size, hipStream_t stream) {
    static int grid = 0;
    if (grid == 0) {
        if (n_in != 18 || in_sizes[0] != M * D || out_size != M * D || ws_size < WS_END) { fprintf(stderr, "kernel_launch: shape/workspace mismatch (n_in %d, in0 %d, out %d, ws %zu)\n", n_in, n_in > 0 ? in_sizes[0] : -1, out_size, ws_size); grid = -1; return; }
        int dev = 0, cus = 0, per_cu = 0;
        if (hipGetDevice(&dev) != hipSuccess || hipDeviceGetAttribute(&cus, hipDeviceAttributeMultiprocessorCount, dev) != hipSuccess) { grid = -1; return; }
        if (hipFuncSetAttribute((const void*)mk_fwd, hipFuncAttributeMaxDynamicSharedMemorySize, LDS_BYTES) != hipSuccess) { fprintf(stderr, "kernel_launch: hipFuncSetAttribute failed\n"); grid = -1; return; }
        if (hipOccupancyMaxActiveBlocksPerMultiprocessor(&per_cu, (const void*)mk_fwd, NTHR, LDS_BYTES) != hipSuccess || per_cu < 1) fprintf(stderr, "kernel_launch: occupancy query reports %d\n", per_cu);
        (void)hipGetLastError();
        grid = cus;
        if (grid != 256) fprintf(stderr, "kernel_launch: %d CUs; this kernel is built for 256\n", grid);
    }
    if (grid < 0) return;
    if (hipMemsetAsync((char*)d_ws + WS_CTL, 0, CTL_ZERO_BYTES, stream) != hipSuccess) return;
    Args a{};
    for (int i = 0; i < 18; ++i) a.in[i] = (const float*)d_in[i];
    a.out = (float*)d_out; a.ws = (unsigned char*)d_ws;
#if MK_CUTS
    for (int ph = 0; ph < NPH; ++ph) { a.ph_lo = ph; a.ph_hi = ph + 1; hipLaunchKernelGGL(mk_fwd, dim3(grid), dim3(NTHR), LDS_BYTES, stream, a); }
#else
    a.ph_lo = 0; a.ph_hi = NPH;
    hipLaunchKernelGGL(mk_fwd, dim3(grid), dim3(NTHR), LDS_BYTES, stream, a);
#endif
}
```

```cpp
#include <hip/hip_runtime.h>
#include <hip/hip_bf16.h>
#include <cstdio>
#include <cstdint>
#include <cmath>
namespace pg8 {
#define PG8_LAS __attribute__((address_space(3)))
typedef unsigned short bf16_t;
typedef short bf16x8 __attribute__((ext_vector_type(8)));
typedef float f32x4 __attribute__((ext_vector_type(4)));
typedef unsigned u32x4 __attribute__((ext_vector_type(4)));
constexpr int BM = 256, BK = 64, HALF = 128, HTB = HALF * BK * 2  , STAGE_BYTES = 8 * HTB, NXCD = 8, WGM = 8;

__host__ __device__ __forceinline__ int lds_byte(int r, int c) { const int st = (r >> 4) * 2 + (c >> 5), rr = r & 15, cc = c & 31, ob = rr * 64 + cc * 2; return st * 1024 + (ob ^ (((ob >> 9) & 1) << 5)); }
__host__ __device__ __forceinline__ void stage_rc(int b, int& R, int& C) { const int st = b / 1024, sb = b % 1024, swz = sb ^ (((sb >> 9) & 1) << 5); R = (st >> 1) * 16 + swz / 64; C = (st & 1) * 32 + (swz % 64) / 2; }
__host__ __device__ __forceinline__ int perm32(int rho) { const int n = rho >> 4, i = rho & 15; return 8 * (i >> 2) + 4 * n + (i & 3); }

struct Unit { int pm, pn; };
struct Gemm { const bf16_t* A; const bf16_t* Bt; int M, N, K; };

struct StaticOrder {
    int nM, nN, nwg, G, c;
    __host__ __device__ void init(int M, int N, int G_, int c_) { nM = M / BM; nN = N / BM; nwg = nM * nN; G = G_; c = c_; }
    __host__ __device__ bool next(int i, Unit& u) const {
        const long L = (long)i * G + c; if (L >= nwg) return false;
        int wgid = (int)L; { const int q = nwg / NXCD, r = nwg % NXCD, xcd = wgid % NXCD, off = wgid / NXCD; wgid = (xcd < r ? xcd * (q + 1) : r * (q + 1) + (xcd - r) * q) + off; }
        const int nig = WGM * nN, gid = wgid / nig, fm = gid * WGM, gsz = (nM - fm) < WGM ? (nM - fm) : WGM;
        u.pm = fm + ((wgid % nig) % gsz); u.pn = (wgid % nig) / gsz; return true;
    }
    __device__ __forceinline__ void a_ready(const Unit&) const {}
    __device__ __forceinline__ void done(const Unit&) const {}
};

__device__ __forceinline__ unsigned cvt_pk_bf16(float lo, float hi) { unsigned r; asm volatile("v_cvt_pk_bf16_f32 %0, %1, %2" : "=v"(r) : "v"(lo), "v"(hi)); return r; }
typedef float f32x2 __attribute__((ext_vector_type(2)));
__device__ __forceinline__ f32x2 gelu_pk(f32x2 v) {
    const f32x2 av = __builtin_elementwise_abs(v), d = av * 0.2316418882f + 1.0f;
    f32x2 t; t.x = __builtin_amdgcn_rcpf(d.x); t.y = __builtin_amdgcn_rcpf(d.y);
    f32x2 q = t * 0.5307027145f + (-0.7265760135f); q = q * t + 0.7107068705f; q = q * t + (-0.142248368f); q = q * t + 0.127414796f; q = q * t;
    const f32x2 s = (v * v) * (-0.72134752044f);
    f32x2 e; e.x = __builtin_amdgcn_exp2f(s.x); e.y = __builtin_amdgcn_exp2f(s.y);
    const f32x2 m = v * (q * e), r = v - m;
    f32x2 o; o.x = v.x < 0.f ? m.x : r.x; o.y = v.y < 0.f ? m.y : r.y; return o;
}

template <int ACT  > struct EpiBf16 {
    static constexpr bool PERM = true, AFTER_DRAIN = false; static_assert(ACT == 0 || ACT == 1, "EpiBf16: ACT is 0 (none) or 1 (gelu_pk)");
    bf16_t* O; int ldc; const float* bias; int split_cols; size_t split_stride; float scale0;
    __device__ __forceinline__ void operator()(const f32x4 (&acc)[2][2][4][2], const Unit& u, int wr, int wc, int fr, int fq) const {
        const int row0 = u.pm * BM + wr * 64 + fr; int colt = u.pn * BM; bf16_t* base = O;
        float sc = 1.f; if (split_cols) { const int t = colt / split_cols; base += (size_t)t * split_stride; colt -= t * split_cols; if (t == 0) sc = scale0; }
        const int col0 = colt + wc * 32 + 8 * fq, bcol0 = u.pn * BM + wc * 32 + 8 * fq;
        f32x4 bv[2][2];
#pragma unroll
        for (int bj = 0; bj < 2; ++bj)
#pragma unroll
            for (int n = 0; n < 2; ++n) bv[bj][n] = bias ? *(const f32x4*)(bias + bcol0 + bj * HALF + 4 * n) : (f32x4){0.f, 0.f, 0.f, 0.f};
#pragma unroll
        for (int ai = 0; ai < 2; ++ai)
#pragma unroll
            for (int m = 0; m < 4; ++m) { bf16_t* rowp = base + (size_t)(row0 + ai * HALF + m * 16) * ldc + col0;
#pragma unroll
                for (int bj = 0; bj < 2; ++bj) { f32x4 v0 = acc[ai][bj][m][0] + bv[bj][0], v1 = acc[ai][bj][m][1] + bv[bj][1];
                    if (ACT == 1) { f32x2 a = gelu_pk((f32x2){v0[0], v0[1]}), b = gelu_pk((f32x2){v0[2], v0[3]}), c = gelu_pk((f32x2){v1[0], v1[1]}), d = gelu_pk((f32x2){v1[2], v1[3]});
                        v0 = (f32x4){a.x, a.y, b.x, b.y}; v1 = (f32x4){c.x, c.y, d.x, d.y}; }
                    v0 = v0 * sc; v1 = v1 * sc; u32x4 w; w.x = cvt_pk_bf16(v0[0], v0[1]); w.y = cvt_pk_bf16(v0[2], v0[3]); w.z = cvt_pk_bf16(v1[0], v1[1]); w.w = cvt_pk_bf16(v1[2], v1[3]);
                    *(u32x4*)(rowp + bj * HALF) = w; } }
    }
};

struct PanelStats {
    unsigned* xbuf;
    unsigned* cnt;
    unsigned* tmo;
    int ntn; float eps;
    unsigned code;
    __device__ __forceinline__ bool run(const f32x4 (&v)[2][2][4][2], const Unit& u, int wr, int wc, int fr, int fq, PG8_LAS unsigned char* lds, int wid, int lane) const {
        typedef float f32x2v __attribute__((ext_vector_type(2)));
        PG8_LAS f32x2v* P = (PG8_LAS f32x2v*)lds;
        PG8_LAS f32x2v* S = (PG8_LAS f32x2v*)(lds + 8192);
        PG8_LAS unsigned* flag = (PG8_LAS unsigned*)(lds + 8192 + 2048);
#pragma unroll
        for (int ai = 0; ai < 2; ++ai)
#pragma unroll
            for (int m = 0; m < 4; ++m) {
                float s = 0.f;
#pragma unroll
                for (int bj = 0; bj < 2; ++bj)
#pragma unroll
                    for (int n = 0; n < 2; ++n) { const f32x4 x = v[ai][bj][m][n]; s += (x[0] + x[1]) + (x[2] + x[3]); }
                s += __shfl_xor(s, 16); s += __shfl_xor(s, 32);
                const float mw = s * (1.0f / 64.0f); float q = 0.f;
#pragma unroll
                for (int bj = 0; bj < 2; ++bj)
#pragma unroll
                    for (int n = 0; n < 2; ++n) { const f32x4 d = v[ai][bj][m][n] - mw; q += (d[0] * d[0] + d[1] * d[1]) + (d[2] * d[2] + d[3] * d[3]); }
                q += __shfl_xor(q, 16); q += __shfl_xor(q, 32);
                if (fq == 0) P[(ai * HALF + wr * 64 + m * 16 + fr) * 4 + wc] = (f32x2v){mw, q};
            }
        asm volatile("s_waitcnt lgkmcnt(0)" ::: "memory"); __builtin_amdgcn_s_barrier(); asm volatile("" ::: "memory");
#if defined(BROKEN_EXCHANGE_NO_WAIT)
#warning BROKEN CONTROL BUILD: the row-statistics exchange does not wait; results are wrong by design
        if (blockIdx.x >= 64) { const long long t0_ = clock64(); while (clock64() - t0_ < 60000) __builtin_amdgcn_s_sleep(8); }
#endif
        const int row = wid * 32 + (lane & 31);
        if (lane < 32) {
            const f32x2v a = P[row * 4 + 0], b = P[row * 4 + 1], c = P[row * 4 + 2], d = P[row * 4 + 3];
            const float mt = (a.x + b.x + c.x + d.x) * 0.25f;
            const float da = a.x - mt, db = b.x - mt, dc = c.x - mt, dd = d.x - mt;
            const float m2 = (a.y + b.y) + (c.y + d.y) + 64.0f * ((da * da + db * db) + (dc * dc + dd * dd));
            unsigned long long* slot = (unsigned long long*)xbuf + ((size_t)(u.pm * BM + row) * 4 + u.pn);
            __hip_atomic_store(slot, ((unsigned long long)__float_as_uint(m2) << 32) | __float_as_uint(mt), __ATOMIC_RELAXED, __HIP_MEMORY_SCOPE_AGENT);
        }
        asm volatile("s_waitcnt vmcnt(0)" ::: "memory");
        if (lane == 0) __hip_atomic_fetch_add(cnt + 64 * u.pm, 1u, __ATOMIC_RELAXED, __HIP_MEMORY_SCOPE_AGENT);
        if (wid == 0) {
            bool dead = false; const unsigned long long t0 = __builtin_amdgcn_s_memrealtime(); const unsigned want = 8u * (unsigned)ntn;
            for (;;) {
#if defined(BROKEN_EXCHANGE_NO_WAIT)
                break;
#endif
                if ((unsigned)__builtin_amdgcn_readfirstlane(__hip_atomic_load(cnt + 64 * u.pm, __ATOMIC_RELAXED, __HIP_MEMORY_SCOPE_AGENT)) >= want) break;
                if (__builtin_amdgcn_s_memrealtime() - t0 > 2000000ull) {
                    if (lane == 0) { unsigned expect = 0u; __hip_atomic_compare_exchange_strong(tmo + 1, &expect, code | (unsigned)(u.pm & 0xff), __ATOMIC_RELAXED, __ATOMIC_RELAXED, __HIP_MEMORY_SCOPE_AGENT);
                                     __hip_atomic_store(tmo, 1u, __ATOMIC_RELAXED, __HIP_MEMORY_SCOPE_AGENT); }
                    dead = true; break; }
                __builtin_amdgcn_s_sleep(2);
            }
            __builtin_amdgcn_fence(__ATOMIC_ACQUIRE, "agent");
            if (lane == 0) flag[0] = dead ? 1u : 0u;
        }
        asm volatile("s_waitcnt vmcnt(0) lgkmcnt(0)" ::: "memory"); __builtin_amdgcn_s_barrier(); asm volatile("" ::: "memory");
        const bool bad = flag[0] != 0u;
        if (lane < 32) {
            const unsigned long long* slot = (const unsigned long long*)xbuf + (size_t)(u.pm * BM + row) * 4; float mt[4], m2[4]; float ms = 0.f;
#pragma unroll
            for (int t = 0; t < 4; ++t) { if (t < ntn) { const unsigned long long w = __hip_atomic_load(slot + t, __ATOMIC_RELAXED, __HIP_MEMORY_SCOPE_AGENT); mt[t] = __uint_as_float((unsigned)w); m2[t] = __uint_as_float((unsigned)(w >> 32)); } else { mt[t] = 0.f; m2[t] = 0.f; } ms += mt[t]; }
            const float mean = ms / (float)ntn; float q = 0.f;
#pragma unroll
            for (int t = 0; t < 4; ++t) if (t < ntn) { const float dm = mt[t] - mean; q += m2[t] + 256.0f * dm * dm; }
            S[row] = (f32x2v){mean, 1.0f / sqrtf(q / (256.0f * (float)ntn) + eps)};
        }
        asm volatile("s_waitcnt lgkmcnt(0)" ::: "memory"); __builtin_amdgcn_s_barrier(); asm volatile("" ::: "memory");
        return bad;
    }
};
struct EpiLnRes {
    static constexpr bool PERM = false, AFTER_DRAIN = true;
    const float* base; float* out; int ldc; const float* bias; PanelStats st; unsigned poison;
    __device__ __forceinline__ void fused(f32x4 (&acc)[2][2][4][2], const Unit& u, int wr, int wc, int fr, int fq, PG8_LAS unsigned char* lds, int wid, int lane) const {
        typedef float f32x2v __attribute__((ext_vector_type(2)));
        const PG8_LAS f32x2v* S = (const PG8_LAS f32x2v*)(lds + 8192);
        const int col0 = u.pn * BM + wc * 32 + 4 * fq;
#pragma unroll
        for (int bj = 0; bj < 2; ++bj)
#pragma unroll
            for (int n = 0; n < 2; ++n) { const f32x4 bv = bias ? *(const f32x4*)(bias + col0 + bj * HALF + n * 16) : (f32x4){0.f, 0.f, 0.f, 0.f};
#pragma unroll
                for (int ai = 0; ai < 2; ++ai)
#pragma unroll
                    for (int m = 0; m < 4; ++m) acc[ai][bj][m][n] += bv; }
        f32x4 pre[4][2][2];
#pragma unroll
        for (int m = 0; m < 4; ++m) { const size_t off = (size_t)(u.pm * BM + wr * 64 + m * 16 + fr) * ldc + col0;
#pragma unroll
            for (int bj = 0; bj < 2; ++bj)
#pragma unroll
                for (int n = 0; n < 2; ++n) pre[m][bj][n] = *(const f32x4*)(base + off + bj * HALF + n * 16); }
        const bool bad = st.run(acc, u, wr, wc, fr, fq, lds, wid, lane) || poison != 0u;
        const float qnan = __builtin_nanf("");
#pragma unroll
        for (int ai = 0; ai < 2; ++ai)
#pragma unroll
            for (int m = 0; m < 4; ++m) { const int r = ai * HALF + wr * 64 + m * 16 + fr; const f32x2v sr = S[r]; const size_t off = (size_t)(u.pm * BM + r) * ldc + col0;
#pragma unroll
                for (int bj = 0; bj < 2; ++bj)
#pragma unroll
                    for (int n = 0; n < 2; ++n) { const f32x4 bs = ai == 0 ? pre[m][bj][n] : *(const f32x4*)(base + off + bj * HALF + n * 16); f32x4 o = bs + (acc[ai][bj][m][n] - sr.x) * sr.y;
                        if (bad) o = (f32x4){qnan, qnan, qnan, qnan}; *(f32x4*)(out + off + bj * HALF + n * 16) = o; }
                if (m & 1) asm volatile("" ::: "memory"); }
    }
};
struct EpiLnResLn {
    static constexpr bool PERM = false, AFTER_DRAIN = true;
    const float* base; float* out; bf16_t* xn; int ldc; const float* bias; PanelStats st1, st2; unsigned poison;
    __device__ __forceinline__ void fused(f32x4 (&acc)[2][2][4][2], const Unit& u, int wr, int wc, int fr, int fq, PG8_LAS unsigned char* lds, int wid, int lane) const {
        typedef float f32x2v __attribute__((ext_vector_type(2))); typedef unsigned u32x2v __attribute__((ext_vector_type(2)));
        const PG8_LAS f32x2v* S = (const PG8_LAS f32x2v*)(lds + 8192);
        const int col0 = u.pn * BM + wc * 32 + 4 * fq;
#pragma unroll
        for (int bj = 0; bj < 2; ++bj)
#pragma unroll
            for (int n = 0; n < 2; ++n) { const f32x4 bv = bias ? *(const f32x4*)(bias + col0 + bj * HALF + n * 16) : (f32x4){0.f, 0.f, 0.f, 0.f};
#pragma unroll
                for (int ai = 0; ai < 2; ++ai)
#pragma unroll
                    for (int m = 0; m < 4; ++m) acc[ai][bj][m][n] += bv; }
        bool bad = st1.run(acc, u, wr, wc, fr, fq, lds, wid, lane) || poison != 0u;
        const float qnan = __builtin_nanf("");
#pragma unroll
        for (int ai = 0; ai < 2; ++ai)
#pragma unroll
            for (int m = 0; m < 4; ++m) { const int r = ai * HALF + wr * 64 + m * 16 + fr; const f32x2v sr = S[r]; const size_t off = (size_t)(u.pm * BM + r) * ldc + col0;
#pragma unroll
                for (int bj = 0; bj < 2; ++bj)
#pragma unroll
                    for (int n = 0; n < 2; ++n) { const f32x4 bs = *(const f32x4*)(base + off + bj * HALF + n * 16); acc[ai][bj][m][n] = bs + (acc[ai][bj][m][n] - sr.x) * sr.y; }
                asm volatile("" : "+v"(acc[ai][0][m][0]), "+v"(acc[ai][0][m][1]), "+v"(acc[ai][1][m][0]), "+v"(acc[ai][1][m][1]));
                if (m & 1) asm volatile("" ::: "memory"); }
        const bool bad1 = bad;
        bad = st2.run(acc, u, wr, wc, fr, fq, lds, wid, lane) || bad;
#pragma unroll
        for (int ai = 0; ai < 2; ++ai)
#pragma unroll
            for (int m = 0; m < 4; ++m) { const int r = ai * HALF + wr * 64 + m * 16 + fr; const f32x2v sr = S[r]; const size_t off = (size_t)(u.pm * BM + r) * ldc + col0;
#pragma unroll
                for (int bj = 0; bj < 2; ++bj)
#pragma unroll
                    for (int n = 0; n < 2; ++n) { const f32x4 x1 = acc[ai][bj][m][n]; *(f32x4*)(out + off + bj * HALF + n * 16) = bad1 ? (f32x4){qnan, qnan, qnan, qnan} : x1;
                        const f32x4 o = (x1 - sr.x) * sr.y; u32x2v w; w.x = cvt_pk_bf16(o[0], o[1]); w.y = cvt_pk_bf16(o[2], o[3]);
                        if (bad) { w.x = 0x7fc07fc0u; w.y = 0x7fc07fc0u; } *(u32x2v*)(xn + off + bj * HALF + n * 16) = w; }
                asm volatile("" ::: "memory"); }
    }
};

template <class Epi, class Sched, bool ALIGN_EPI = false, bool SP2 = false>
__device__ __forceinline__ void gemm_phase(PG8_LAS unsigned char* lds, const Gemm g, const Sched& S, const Epi& E) {
    const int tid = threadIdx.x, wid = __builtin_amdgcn_readfirstlane(tid >> 6), lane = tid & 63, wr = wid >> 2, wc = wid & 3, fr = lane & 15, fq = lane >> 4;
    const int K = g.K, nt = K / BK;
    unsigned voffA[2], voffB[2];
#pragma unroll
    for (int i = 0; i < 2; ++i) { int R, C; stage_rc(tid * 16 + i * 8192, R, C); const int Rb = Epi::PERM ? ((R & ~31) + perm32(R & 31)) : R;
        voffA[i] = (unsigned)(R * K + C) * 2u; voffB[i] = (unsigned)(Rb * K + C) * 2u; }
    const size_t kstep = (size_t)(BK * 2);
    const size_t hstep = (size_t)HALF * K * 2;
    const size_t tstep = 2 * hstep;
    const unsigned ldsw = (unsigned)wid * 1024u;
    const int aoff = lds_byte(wr * 64 + fr, fq * 8), boff = lds_byte(wc * 32 + fr, fq * 8);
#define PG8_SA(b, h) (((b) * 2 + (h)) * HTB)
#define PG8_SB(b, h) ((4 + (b) * 2 + (h)) * HTB)
#define PG8_STAGE(bufoff, gbase, voff) do { _Pragma("unroll") for (int _i = 0; _i < 2; ++_i) \
        __builtin_amdgcn_global_load_lds((const unsigned*)((const char*)(gbase) + (voff)[_i]), (PG8_LAS unsigned*)(lds + (bufoff) + ldsw + _i * 8192), 16, 0, 0); } while (0)
#define PG8_LDA(dst, b, h) do { _Pragma("unroll") for (int m = 0; m < 4; ++m) _Pragma("unroll") for (int k = 0; k < 2; ++k) dst[m][k] = *(const PG8_LAS bf16x8*)(lds + PG8_SA(b, h) + aoff + m * 2048 + k * 1024); } while (0)
#define PG8_LDB(dst, b, h) do { _Pragma("unroll") for (int n = 0; n < 2; ++n) _Pragma("unroll") for (int k = 0; k < 2; ++k) dst[n][k] = *(const PG8_LAS bf16x8*)(lds + PG8_SB(b, h) + boff + n * 2048 + k * 1024); } while (0)
#define PG8_MMA(ai, bj, At, Bt) do { __builtin_amdgcn_s_setprio(1); _Pragma("unroll") for (int m = 0; m < 4; ++m) _Pragma("unroll") for (int n = 0; n < 2; ++n) _Pragma("unroll") for (int k = 0; k < 2; ++k) \
        acc[ai][bj][m][n] = __builtin_amdgcn_mfma_f32_16x16x32_bf16(Bt[n][k], At[m][k], acc[ai][bj][m][n], 0, 0, 0); __builtin_amdgcn_s_setprio(0); } while (0)
#define PG8_WAIT_V(n) asm volatile("s_waitcnt vmcnt(" #n ")" ::: "memory")
#define PG8_WAIT_L(n) asm volatile("s_waitcnt lgkmcnt(" #n ")" ::: "memory")
#define PG8_BAR __builtin_amdgcn_s_barrier()
#define PG8_SCHED __builtin_amdgcn_sched_barrier(0)
    Unit cur, nxt; int ui = 0;
    if (!S.next(0, cur)) return;
    f32x4 acc[2][2][4][2];
#pragma unroll
    for (int a = 0; a < 2; ++a)
#pragma unroll
        for (int b = 0; b < 2; ++b)
#pragma unroll
            for (int m = 0; m < 4; ++m)
#pragma unroll
                for (int n = 0; n < 2; ++n) acc[a][b][m][n] = (f32x4){0.f, 0.f, 0.f, 0.f};
    bf16x8 At[4][2], B0[2][2], B1[2][2];
    const char* cA = (const char*)g.A + (size_t)cur.pm * tstep; const char* cB = (const char*)g.Bt + (size_t)cur.pn * tstep;
    S.a_ready(cur);
    if constexpr (SP2) {
        PG8_STAGE(PG8_SB(0, 0), cB, voffB); PG8_STAGE(PG8_SB(0, 1), cB + hstep, voffB); PG8_STAGE(PG8_SA(0, 0), cA, voffA); PG8_STAGE(PG8_SA(0, 1), cA + hstep, voffA);
        if (wr == 1) PG8_BAR;
        PG8_WAIT_V(2); PG8_BAR;
        PG8_STAGE(PG8_SB(1, 0), cB + kstep, voffB); PG8_STAGE(PG8_SA(1, 0), cA + kstep, voffA); PG8_STAGE(PG8_SB(1, 1), cB + hstep + kstep, voffB);
        PG8_WAIT_V(6); PG8_BAR;
    } else {
        PG8_STAGE(PG8_SB(0, 0), cB, voffB); PG8_STAGE(PG8_SA(0, 0), cA, voffA); PG8_STAGE(PG8_SB(0, 1), cB + hstep, voffB); PG8_STAGE(PG8_SA(0, 1), cA + hstep, voffA);
        if (wr == 1) PG8_BAR;
        PG8_WAIT_V(4); PG8_BAR;
        PG8_STAGE(PG8_SB(1, 0), cB + kstep, voffB); PG8_STAGE(PG8_SA(1, 0), cA + kstep, voffA); PG8_STAGE(PG8_SB(1, 1), cB + hstep + kstep, voffB);
        PG8_WAIT_V(6); PG8_BAR;
    }
    for (;;) {
        const bool has_next = S.next(ui + 1, nxt);
        const char* nA = has_next ? (const char*)g.A + (size_t)nxt.pm * tstep : cA; const char* nB = has_next ? (const char*)g.Bt + (size_t)nxt.pn * tstep : cB;
        for (int t = 0; t < nt; t += 2) {
            const bool last = (t == nt - 2);
            const char* a1 = cA + (size_t)(t + 1) * kstep;
            const char* a2 = last ? nA : cA + (size_t)(t + 2) * kstep; const char* b2 = last ? nB : cB + (size_t)(t + 2) * kstep;
            const char* a3 = a2 + kstep; const char* b3 = b2 + kstep;
            if (last && has_next) S.a_ready(nxt);
            if constexpr (SP2) {
            PG8_LDB(B0, 0, 0); PG8_LDB(B1, 0, 1); PG8_SCHED; PG8_LDA(At, 0, 0); PG8_STAGE(PG8_SA(1, 1), a1 + hstep, voffA);
            PG8_WAIT_V(8); PG8_WAIT_L(0); PG8_BAR; PG8_MMA(0, 0, At, B0); PG8_MMA(0, 1, At, B1); PG8_BAR; PG8_SCHED;
            PG8_LDA(At, 0, 1); PG8_STAGE(PG8_SB(0, 0), b2, voffB); PG8_STAGE(PG8_SB(0, 1), b2 + hstep, voffB); PG8_STAGE(PG8_SA(0, 0), a2, voffA);
            PG8_WAIT_V(8); PG8_WAIT_L(0); PG8_BAR; PG8_MMA(1, 0, At, B0); PG8_MMA(1, 1, At, B1); PG8_BAR; PG8_SCHED;
            PG8_LDB(B0, 1, 0); PG8_LDB(B1, 1, 1); PG8_SCHED; PG8_LDA(At, 1, 0); PG8_STAGE(PG8_SA(0, 1), a2 + hstep, voffA);
            PG8_WAIT_V(8); PG8_WAIT_L(0); PG8_BAR; PG8_MMA(0, 0, At, B0); PG8_MMA(0, 1, At, B1); PG8_BAR; PG8_SCHED;
            PG8_LDA(At, 1, 1); PG8_STAGE(PG8_SB(1, 0), b3, voffB); PG8_STAGE(PG8_SB(1, 1), b3 + hstep, voffB); PG8_STAGE(PG8_SA(1, 0), a3, voffA);
            PG8_WAIT_V(8); PG8_WAIT_L(0); PG8_BAR; PG8_MMA(1, 0, At, B0); PG8_MMA(1, 1, At, B1); PG8_BAR; PG8_SCHED;
            } else {
            PG8_LDB(B0, 0, 0); PG8_SCHED; PG8_LDA(At, 0, 0); PG8_STAGE(PG8_SA(1, 1), a1 + hstep, voffA);
            PG8_WAIT_L(8); PG8_BAR; PG8_WAIT_L(0); PG8_MMA(0, 0, At, B0); PG8_BAR; PG8_SCHED;
            PG8_LDB(B1, 0, 1); PG8_STAGE(PG8_SB(0, 0), b2, voffB);
            PG8_BAR; PG8_WAIT_L(0); PG8_MMA(0, 1, At, B1); PG8_BAR;
            PG8_LDA(At, 0, 1); PG8_STAGE(PG8_SA(0, 0), a2, voffA);
            PG8_BAR; PG8_WAIT_L(0); PG8_MMA(1, 0, At, B0); PG8_BAR; PG8_SCHED;
            PG8_STAGE(PG8_SB(0, 1), b2 + hstep, voffB);
            PG8_WAIT_V(6); PG8_BAR; PG8_MMA(1, 1, At, B1); PG8_BAR;
            PG8_LDB(B0, 1, 0); PG8_SCHED; PG8_LDA(At, 1, 0); PG8_STAGE(PG8_SA(0, 1), a2 + hstep, voffA);
            PG8_WAIT_L(8); PG8_BAR; PG8_WAIT_L(0); PG8_MMA(0, 0, At, B0); PG8_BAR; PG8_SCHED;
            PG8_LDB(B1, 1, 1); PG8_STAGE(PG8_SB(1, 0), b3, voffB);
            PG8_BAR; PG8_WAIT_L(0); PG8_MMA(0, 1, At, B1); PG8_BAR;
            PG8_LDA(At, 1, 1); PG8_STAGE(PG8_SA(1, 0), a3, voffA);
            PG8_BAR; PG8_WAIT_L(0); PG8_MMA(1, 0, At, B0); PG8_BAR; PG8_SCHED;
            PG8_STAGE(PG8_SB(1, 1), b3 + hstep, voffB);
            PG8_WAIT_V(6); PG8_BAR; PG8_MMA(1, 1, At, B1); PG8_BAR;
            }
        }
        if constexpr (ALIGN_EPI) { if (wr == 0) PG8_BAR; }
        if constexpr (!Epi::AFTER_DRAIN) { E(acc, cur, wr, wc, fr, fq); S.done(cur); }
        if (!has_next) break;
#pragma unroll
        for (int a = 0; a < 2; ++a)
#pragma unroll
            for (int b = 0; b < 2; ++b)
#pragma unroll
                for (int m = 0; m < 4; ++m)
#pragma unroll
                    for (int n = 0; n < 2; ++n) acc[a][b][m][n] = (f32x4){0.f, 0.f, 0.f, 0.f};
        cur = nxt; cA = nA; cB = nB; ++ui;
        if constexpr (ALIGN_EPI) { if (wr == 1) PG8_BAR; }
    }
    PG8_WAIT_V(0);
    if constexpr (!ALIGN_EPI) { if (wr == 0) PG8_BAR; }
    PG8_BAR;
    if constexpr (Epi::AFTER_DRAIN) { E.fused(acc, cur, wr, wc, fr, fq, lds, wid, lane); S.done(cur); }
#undef PG8_SA
#undef PG8_SB
#undef PG8_STAGE
#undef PG8_LDA
#undef PG8_LDB
#undef PG8_MMA
#undef PG8_WAIT_V
#undef PG8_WAIT_L
#undef PG8_BAR
#undef PG8_SCHED
}
}
namespace pg8 {
template <class F> struct EpiScalar {
    static constexpr bool PERM = true, AFTER_DRAIN = false; F f;
    __device__ __forceinline__ void operator()(const f32x4 (&acc)[2][2][4][2], const Unit& u, int wr, int wc, int fr, int fq) const {
        const int row0 = u.pm * BM + wr * 64 + fr, col0 = u.pn * BM + wc * 32 + 8 * fq;
#pragma unroll
        for (int ai = 0; ai < 2; ++ai)
#pragma unroll
            for (int m = 0; m < 4; ++m) {
#pragma unroll
                for (int bj = 0; bj < 2; ++bj)
#pragma unroll
                    for (int n = 0; n < 2; ++n)
#pragma unroll
                        for (int e = 0; e < 4; ++e) f(row0 + ai * HALF + m * 16, col0 + bj * HALF + 4 * n + e, acc[ai][bj][m][n][e]);
                asm volatile("" ::: "memory"); }
    }
};
template <class F> struct EpiScalarPair {
    static constexpr bool PERM = true, AFTER_DRAIN = false; F f;
    __device__ __forceinline__ void operator()(const f32x4 (&acc)[2][2][4][2], const Unit& u, int wr, int wc, int fr, int fq) const {
        const int row0 = u.pm * BM + wr * 64 + fr, cl0 = wc * 32 + 8 * fq;
#pragma unroll
        for (int ai = 0; ai < 2; ++ai)
#pragma unroll
            for (int m = 0; m < 4; ++m) {
#pragma unroll
                for (int n = 0; n < 2; ++n)
#pragma unroll
                    for (int e = 0; e < 4; ++e) f(row0 + ai * HALF + m * 16, u.pn, cl0 + 4 * n + e, acc[ai][0][m][n][e], acc[ai][1][m][n][e]);
                asm volatile("" ::: "memory"); }
    }
};
}
#define GAS __attribute__((address_space(1)))
#define LAS __attribute__((address_space(3)))
typedef unsigned short bf16;
typedef unsigned v4u __attribute__((ext_vector_type(4)));
typedef float f32x4 __attribute__((ext_vector_type(4)));
typedef short bf16x8 __attribute__((ext_vector_type(8)));
typedef GAS unsigned gu32;
typedef GAS unsigned long long gu64;
#define RLX_AGENT __ATOMIC_RELAXED, __HIP_MEMORY_SCOPE_AGENT
#define LDS_WAIT() asm volatile("s_waitcnt lgkmcnt(0)" ::: "memory")
#define VM_WAIT() asm volatile("s_waitcnt vmcnt(0)" ::: "memory")
__device__ __forceinline__ unsigned long long rt() { return __builtin_amdgcn_s_memrealtime(); }
__device__ __forceinline__ unsigned f2bf(float f) { unsigned u = __builtin_bit_cast(unsigned, f); return (u + 0x7fffu + ((u >> 16) & 1u)) >> 16; }
__device__ __forceinline__ unsigned pk2(float lo, float hi) { return f2bf(lo) | (f2bf(hi) << 16); }

#define XB_TMO      128
#define XB_XCNT(j)  (256  + 64 * (j))
#define XB_XSUB(j)  (1280 + 64 * (j))
#define XB_XGEN(j)  (2304 + 64 * (j))
#define XB_TOP      3328
#define XB_TOPGEN   3392
#define XCD_BAR_WORDS 3456
#define XB_SPIN_CAP (1u << 18)

__device__ __forceinline__ unsigned xb_ld(unsigned* p)              { return __hip_atomic_load(p, __ATOMIC_RELAXED, __HIP_MEMORY_SCOPE_AGENT); }
__device__ __forceinline__ unsigned xb_add(unsigned* p, unsigned v) { return __hip_atomic_fetch_add(p, v, __ATOMIC_RELAXED, __HIP_MEMORY_SCOPE_AGENT); }
__device__ __forceinline__ unsigned xb_xcc_id() { return (unsigned)__builtin_amdgcn_s_getreg((3 << 11) | 20) & 0xFu; }
#define XB_SPIN(cond, bar) do { unsigned _sp = 0; while (cond) { __builtin_amdgcn_s_sleep(1); \
    if ((++_sp & 255u) == 0u) { if (xb_ld(&(bar)[XB_TMO])) break; if (_sp > XB_SPIN_CAP) { atomicAdd(&(bar)[XB_TMO], 1u); break; } } } } while (0)

struct XcdBarrier {
    unsigned* bar; unsigned x;
    volatile LAS unsigned* st;
};

__device__ __forceinline__ XcdBarrier xcd_barrier_post(unsigned* bar, volatile LAS unsigned* st) {
    XcdBarrier b; b.bar = bar; b.x = xb_xcc_id(); b.st = st;
    if (threadIdx.x == 0) (void)xb_add(&bar[XB_XCNT(b.x)], 1u);
    return b;
}
__device__ __forceinline__ void xcd_barrier_complete(unsigned* bar, unsigned x, unsigned& nloc, unsigned& nx) {
    const unsigned G = gridDim.x * gridDim.y * gridDim.z;
    unsigned sum, cnt, mine, sp = 0u;
    for (;;) {
        sum = 0u; cnt = 0u; mine = 0u;
#pragma unroll
        for (unsigned j = 0; j < 16; ++j) { const unsigned c = xb_ld(&bar[XB_XCNT(j)]); sum += c; cnt += (c > 0u) ? 1u : 0u; mine = (j == x) ? c : mine; }
        if (sum == G) break;
        __builtin_amdgcn_s_sleep(1);
        if ((++sp & 255u) == 0u) { if (xb_ld(&bar[XB_TMO])) break; if (sp > XB_SPIN_CAP) { atomicAdd(&bar[XB_TMO], 1u); break; } }
    }
    nloc = mine > 0u ? mine : 1u; nx = cnt > 0u ? cnt : 1u;
}

__device__ __forceinline__ void xcd_barrier(const XcdBarrier& b) {
    asm volatile("s_waitcnt vmcnt(0)" ::: "memory");
    __syncthreads();
    if (threadIdx.x == 0) {
        unsigned* bar = b.bar;
        __builtin_amdgcn_s_waitcnt(0);
        unsigned nloc = b.st[0], nx = b.st[1];
        if (nloc == 0u) { xcd_barrier_complete(bar, b.x, nloc, nx); b.st[0] = nloc; b.st[1] = nx; }
        const unsigned old = xb_add(&bar[XB_XSUB(b.x)], 1u);
        const unsigned gen = old / nloc;
        if (old + 1u == (gen + 1u) * nloc) {
            __builtin_amdgcn_fence(__ATOMIC_RELEASE, "agent");
            asm volatile("s_waitcnt vmcnt(0)" ::: "memory");
            const unsigned og = xb_add(&bar[XB_TOP], 1u);
            const unsigned tg = og / nx;
            if (og + 1u == (tg + 1u) * nx) xb_add(&bar[XB_TOPGEN], 1u);
            else XB_SPIN(xb_ld(&bar[XB_TOPGEN]) == tg, bar);
            __builtin_amdgcn_fence(__ATOMIC_ACQUIRE, "agent");
            xb_add(&bar[XB_XGEN(b.x)], 1u);
            asm volatile("s_waitcnt vmcnt(0)" ::: "memory");
        } else {
            XB_SPIN(xb_ld(&bar[XB_XGEN(b.x)]) == gen, bar);
            __builtin_amdgcn_fence(__ATOMIC_ACQUIRE, "agent");
            asm volatile("s_waitcnt vmcnt(0)" ::: "memory");
        }
    }
    __syncthreads();
}
#ifndef ATT_FAST
#define ATT_FAST 1
#endif

constexpr int NWAVES = 8, NTHR = NWAVES * 64;
constexpr int BATCH = 4, SEQ = 8192, D = 1024, M = BATCH * SEQ;
constexpr int NHG = 8, HD = 64, HW = NHG * HD;
constexpr int INCOLS = 3080, NPROJ = 3072;
constexpr int NE = 32, NGRP = 4, EPG = 8, DF = 512, PLED = 256;
constexpr int SPAD = 2 * M + NE * 256;
constexpr float ALPHA = 1.189207115002721f, LN_EPS = 1e-5f, LOG2E = 1.4426950408889634f;
constexpr int NPH = 10;

constexpr size_t MiB = 1u << 20;
constexpr size_t WS_CTL = 0, CTL_ZERO_BYTES = 256 * 1024;
constexpr size_t WS_LS = 1 * MiB, WS_CFL = 2 * MiB, WS_CTOT = 3 * MiB, WS_KNT = 3 * MiB + 4096, WS_EID = 3 * MiB + 256 * 1024, WS_GATE = 3 * MiB + 512 * 1024, WS_RANK = 3 * MiB + 768 * 1024,
                 WS_SLOT = 4 * MiB, WS_GSLOT = 4 * MiB + 256 * 1024;
constexpr size_t WS_WIN = 5 * MiB, WS_WOUT = 11 * MiB, WS_WPLE = 13 * MiB, WS_WPG = 14 * MiB, WS_WGU = 16 * MiB, WS_WD = 80 * MiB, WS_PPLE = 112 * MiB;
constexpr size_t WS_R1 = 176 * MiB;
constexpr size_t WS_R2 = 368 * MiB;
constexpr size_t WS_R3 = 432 * MiB;
constexpr size_t WS_END = 504 * MiB;
static_assert(WS_GSLOT + (size_t)SPAD * 4 <= WS_WIN && WS_R1 + (size_t)SPAD * 2048 <= WS_R2 && WS_R3 + (size_t)SPAD * 1024 <= WS_END, "ws map");
constexpr int CW_TMO = 0, CW_BAR = 4096, CW_CNT = 8192;

constexpr int RING_OFF = 0, RING_BYTES = 131072;
constexpr int WGRP_OFF = RING_BYTES;
constexpr int LDSCTL_OFF = RING_BYTES + 16384, MISC_OFF = LDSCTL_OFF + 320, PST_OFF = LDSCTL_OFF + 1024, HIST_OFF = LDSCTL_OFF + 1280, BASE_OFF = LDSCTL_OFF + 1408, ROWL_OFF = LDSCTL_OFF + 2048;
constexpr int LDS_BYTES = 163840;

#define BFLO(w) __builtin_bit_cast(float, (w) << 16)
#define BFHI(w) __builtin_bit_cast(float, (w) & 0xffff0000u)
__device__ __forceinline__ float bf2f(unsigned short v) { return __builtin_bit_cast(float, (unsigned)v << 16); }
__device__ __forceinline__ float wave_sum(float v) {
#pragma unroll
    for (int o = 1; o < 64; o <<= 1) v += __shfl_xor(v, o);
    return v;
}
__device__ __forceinline__ float wave_max(float v) {
#pragma unroll
    for (int o = 1; o < 64; o <<= 1) v = fmaxf(v, __shfl_xor(v, o));
    return v;
}

struct Frame {
    LAS unsigned char* lds; volatile LAS unsigned* MISC; gu32* ctl;
    int tid, lane, wave, vcu, G;
    const float *x, *p, *w_in, *b_forget, *w_out, *ln1g, *ln1b, *w_group, *b_group, *w_router, *b_router, *w_gate, *w_up, *w_down, *w_ple, *w_pg, *ln2g, *ln2b;
    float* out;
    bf16 *Win_t, *Wout_t, *Wple_t, *Wpg_t, *Wgu_t, *Wd_t, *pple, *qkv, *xs, *y, *xb, *mixed, *hb, *pb, *hdn;
    float *ls, *cfl, *ctot, *knt, *gatev, *gslot; int *eid, *rank, *slot;
};

struct TileRef { const float* src; bf16* dst; int ldw, ldt; float sc; };
__device__ __forceinline__ void tile_load(f32x4 (&r)[8], const TileRef& t, int lane) {
    const GAS float* p = (const GAS float*)t.src + (size_t)(lane >> 4) * t.ldw + 4 * (lane & 15);
#pragma unroll
    for (int i = 0; i < 8; ++i) r[i] = *(const GAS f32x4*)(p + (size_t)(4 * i) * t.ldw);
}
__device__ __forceinline__ void tile_store(const f32x4 (&r)[8], const TileRef& t, LAS float* scr, int lane) {
#pragma unroll
    for (int i = 0; i < 8; ++i) { LAS float* s = scr + (4 * i + (lane >> 4)) * 65 + 4 * (lane & 15); s[0] = r[i].x * t.sc; s[1] = r[i].y * t.sc; s[2] = r[i].z * t.sc; s[3] = r[i].w * t.sc; }
    LDS_WAIT(); asm volatile("" ::: "memory");
    const int c = lane & 3;
#pragma unroll
    for (int j = 0; j < 4; ++j) { const int n = 16 * j + (lane >> 2); const LAS float* s = scr + (8 * c) * 65 + n;
        v4u o; o.x = pk2(s[0 * 65], s[1 * 65]); o.y = pk2(s[2 * 65], s[3 * 65]); o.z = pk2(s[4 * 65], s[5 * 65]); o.w = pk2(s[6 * 65], s[7 * 65]);
        *(GAS v4u*)(t.dst + (size_t)n * t.ldt + 8 * c) = o; }
    LDS_WAIT(); asm volatile("" ::: "memory");
}
__device__ __forceinline__ float log_sigmoid_f(float v) { return fminf(v, 0.f) - log1pf(expf(-fabsf(v))); }
constexpr int I_IN = 32 * 48, I_OUT = 32 * 16, I_PLE = 8 * 16, I_PG = 32 * 16, I_GU = NE * 2 * 32 * 8, I_DN = NE * 16 * 16;
constexpr int P0_ITEMS = I_IN + I_OUT + I_PLE + I_PG + I_GU + I_DN;
__device__ __forceinline__ TileRef p0_item(Frame& F, int it) {
    int r = it; TileRef t; t.sc = 1.f;
    if (r < I_IN) { const int kb = r / 48, nb = r % 48, s = nb >> 3;
        t.src = F.w_in + (size_t)kb * 32 * INCOLS + nb * 64; t.ldw = INCOLS; t.dst = F.Win_t + (size_t)nb * 64 * D + kb * 32; t.ldt = D; t.sc = (s == 0 || s == 3) ? 0.125f : 1.f; return t; } r -= I_IN;
    if (r < I_OUT) { const int kb = r / 16, nb = r % 16; t.src = F.w_out + (size_t)kb * 32 * D + nb * 64; t.ldw = D; t.dst = F.Wout_t + (size_t)nb * 64 * D + kb * 32; t.ldt = D; return t; } r -= I_OUT;
    if (r < I_PLE) { const int kb = r / 16, nb = r % 16; t.src = F.w_ple + (size_t)kb * 32 * D + nb * 64; t.ldw = D; t.dst = F.Wple_t + (size_t)nb * 64 * PLED + kb * 32; t.ldt = PLED; return t; } r -= I_PLE;
    if (r < I_PG) { const int kb = r / 16, nb = r % 16; t.src = F.w_pg + (size_t)kb * 32 * D + nb * 64; t.ldw = D; t.dst = F.Wpg_t + (size_t)nb * 64 * D + kb * 32; t.ldt = D; return t; } r -= I_PG;
    if (r < I_GU) { const int e = r / 512, gu = (r >> 8) & 1, kb = (r >> 3) & 31, nb = r & 7;
        t.src = (gu ? F.w_up : F.w_gate) + (size_t)e * D * DF + (size_t)kb * 32 * DF + nb * 64; t.ldw = DF;
        const int row = e * 1024 + (nb >> 1) * 256 + gu * 128 + (nb & 1) * 64;
        t.dst = F.Wgu_t + (size_t)row * D + kb * 32; t.ldt = D; return t; } r -= I_GU;
    { const int e = r / 256, kb = (r >> 4) & 15, nb = r & 15;
        t.src = F.w_down + (size_t)e * DF * D + (size_t)kb * 32 * D + nb * 64; t.ldw = D; t.dst = F.Wd_t + (size_t)(e * 1024 + nb * 64) * DF + kb * 32; t.ldt = DF; return t; }
}
template <int PART> __device__ __forceinline__ void p0_prologue(Frame& F) {
    LAS float* scr = (LAS float*)(F.lds + RING_OFF + F.wave * 16384);
    const int gw = F.vcu * NWAVES + F.wave, NGW = F.G * NWAVES;
    if (PART == 0) {
        f32x4 ra[8], rb[8]; int it = gw;
        TileRef ta = p0_item(F, it < P0_ITEMS ? it : 0), tb = ta;
        if (it < P0_ITEMS) tile_load(ra, ta, F.lane);
        while (it < P0_ITEMS) {
            const int i2 = it + NGW; if (i2 < P0_ITEMS) { tb = p0_item(F, i2); tile_load(rb, tb, F.lane); }
            tile_store(ra, ta, scr, F.lane);
            if (i2 >= P0_ITEMS) break;
            const int i3 = i2 + NGW; if (i3 < P0_ITEMS) { ta = p0_item(F, i3); tile_load(ra, ta, F.lane); }
            tile_store(rb, tb, scr, F.lane);
            it = i3;
        }
    }
    if (PART == 1) {
    __syncthreads();
    LAS float* wf = (LAS float*)(F.lds + RING_OFF);
    for (int i = F.tid; i < 2048; i += NTHR) { const int c = i >> 1, j0 = (i & 1) * 4; const f32x4 w = *(const GAS f32x4*)(F.w_in + (size_t)c * INCOLS + NPROJ + j0);
        wf[(j0 + 0) * 1024 + c] = w.x; wf[(j0 + 1) * 1024 + c] = w.y; wf[(j0 + 2) * 1024 + c] = w.z; wf[(j0 + 3) * 1024 + c] = w.w; }
    __syncthreads();
    {
        f32x4 v[4], vn[4]; int m = gw;
        if (m < M) { const GAS f32x4* xr = (const GAS f32x4*)(F.x + (size_t)m * D) + F.lane;
#pragma unroll
            for (int j = 0; j < 4; ++j) v[j] = xr[64 * j]; }
        const float bfg = (F.lane < 8) ? F.b_forget[F.lane] : 0.f;
        for (; m < M; m += NGW) {
            const int mn = m + NGW;
            if (mn < M) { const GAS f32x4* xr = (const GAS f32x4*)(F.x + (size_t)mn * D) + F.lane;
#pragma unroll
                for (int j = 0; j < 4; ++j) vn[j] = xr[64 * j]; }
            GAS unsigned long long* o8 = (GAS unsigned long long*)(F.xb + (size_t)m * D) + F.lane;
#pragma unroll
            for (int j = 0; j < 4; ++j) o8[64 * j] = (unsigned long long)pk2(v[j].x, v[j].y) | ((unsigned long long)pk2(v[j].z, v[j].w) << 32);
            float mine = 0.f;
#pragma unroll
            for (int g = 0; g < 8; ++g) { float a = 0.f;
#pragma unroll
                for (int j = 0; j < 4; ++j) { const f32x4 w = *(const LAS f32x4*)(wf + g * 1024 + 4 * F.lane + 256 * j); a += (v[j].x * w.x + v[j].y * w.y) + (v[j].z * w.z + v[j].w * w.w); }
                a = wave_sum(a); if (F.lane == g) mine = a; }
            if (F.lane < 8) F.ls[(size_t)m * 8 + F.lane] = log_sigmoid_f(mine + bfg);
#pragma unroll
            for (int j = 0; j < 4; ++j) v[j] = vn[j];
        }
    }
    __syncthreads(); }
    if (PART == 2) { const int gtid = blockIdx.x * NTHR + F.tid, NT = F.G * NTHR;
      for (int i = gtid; i < M * PLED / 8; i += NT) { const GAS f32x4* s = (const GAS f32x4*)(F.p) + 2 * (size_t)i; const f32x4 a = s[0], b = s[1];
          v4u o; o.x = pk2(a.x, a.y); o.y = pk2(a.z, a.w); o.z = pk2(b.x, b.y); o.w = pk2(b.z, b.w); ((GAS v4u*)F.pb)[i] = o; } }
}

__device__ __forceinline__ void p2_scan(Frame& F) {
    LAS float* wt = (LAS float*)(F.lds + RING_OFF);
    for (int it = blockIdx.x; it < 256; it += F.G) {
        const int bh = it >> 3, chunk = it & 7, b = bh >> 3, h = bh & 7, t = chunk * 1024 + 2 * F.tid;
        const float a0 = F.ls[(size_t)(b * SEQ + t) * 8 + h] * LOG2E, a1 = F.ls[(size_t)(b * SEQ + t + 1) * 8 + h] * LOG2E;
        float s = a0 + a1;
#pragma unroll
        for (int o = 1; o < 64; o <<= 1) { const float u = __shfl_up(s, o); if (F.lane >= o) s += u; }
        __syncthreads();
        if (F.lane == 63) wt[F.wave] = s;
        __syncthreads();
        float off = 0.f, tot = 0.f;
#pragma unroll
        for (int w = 0; w < 8; ++w) { const float u = wt[w]; if (w < F.wave) off += u; tot += u; }
        const float i1 = off + s, i0 = i1 - a1;
        F.cfl[(size_t)bh * SEQ + t] = i0; F.cfl[(size_t)bh * SEQ + t + 1] = i1;
        if (F.tid == 0) F.ctot[bh * 8 + chunk] = tot;
        const bf16* kf = F.qkv + (size_t)4 * M * HW;
        float nmax = 0.f;
#pragma unroll
        for (int rr = 0; rr < 2; ++rr) { const GAS v4u* kp = (const GAS v4u*)(kf + (size_t)(b * SEQ + t + rr) * HW + h * HD); float n2 = 0.f;
#pragma unroll
            for (int c = 0; c < 8; ++c) { const v4u w = kp[c];
#pragma unroll
                for (int e = 0; e < 4; ++e) { const float lo = __builtin_bit_cast(float, w[e] << 16), hi = __builtin_bit_cast(float, w[e] & 0xffff0000u); n2 += lo * lo + hi * hi; } }
            nmax = fmaxf(nmax, n2); }
#pragma unroll
        for (int o = 1; o < 32; o <<= 1) nmax = fmaxf(nmax, __shfl_xor(nmax, o));
        if ((F.lane & 31) == 0) F.knt[bh * 128 + chunk * 16 + F.wave * 2 + (F.lane >> 5)] = sqrtf(nmax);
    }
}

#if !defined(ATT_FAST) || !ATT_FAST
__device__ __forceinline__ void ld64(float (&d)[64], const bf16* p) {
    const GAS v4u* s = (const GAS v4u*)p;
#pragma unroll
    for (int c = 0; c < 8; ++c) { const v4u w = s[c];
#pragma unroll
        for (int e = 0; e < 4; ++e) { d[c * 8 + 2 * e] = BFLO(w[e]); d[c * 8 + 2 * e + 1] = BFHI(w[e]); } }
}
__device__ __forceinline__ float dot64(const float (&q)[64], const bf16* p) {
    const GAS v4u* s = (const GAS v4u*)p; float z = 0.f;
#pragma unroll
    for (int c = 0; c < 8; ++c) { const v4u w = s[c];
#pragma unroll
        for (int e = 0; e < 4; ++e) { z += q[c * 8 + 2 * e] * BFLO(w[e]); z += q[c * 8 + 2 * e + 1] * BFHI(w[e]); } }
    return z;
}
__device__ __forceinline__ void axpy64(float (&o)[64], float a, const bf16* p) {
    const GAS v4u* s = (const GAS v4u*)p;
#pragma unroll
    for (int c = 0; c < 8; ++c) { const v4u w = s[c];
#pragma unroll
        for (int e = 0; e < 4; ++e) { o[c * 8 + 2 * e] += a * BFLO(w[e]); o[c * 8 + 2 * e + 1] += a * BFHI(w[e]); } }
}
__device__ __forceinline__ void st64(bf16* p, const float (&d)[64], float sc) {
    GAS v4u* s = (GAS v4u*)p;
#pragma unroll
    for (int c = 0; c < 8; ++c) { v4u w;
#pragma unroll
        for (int e = 0; e < 4; ++e) w[e] = pk2(d[c * 8 + 2 * e] * sc, d[c * 8 + 2 * e + 1] * sc);
        s[c] = w; }
}
__device__ __forceinline__ void p3_attn_simple(Frame& F) {
    const int gtid = blockIdx.x * NTHR + F.tid, NT = F.G * NTHR;
    const bf16 *Qs = F.qkv, *Ks = F.qkv + (size_t)1 * M * HW, *Vs = F.qkv + (size_t)2 * M * HW, *Qf = F.qkv + (size_t)3 * M * HW, *Kf = F.qkv + (size_t)4 * M * HW, *Vf = F.qkv + (size_t)5 * M * HW;
    for (int idx = gtid; idx < M * NHG; idx += NT) {
        const int h = idx >> 15, m = idx & (M - 1), b = m >> 13, t = m & (SEQ - 1);
        float q[64], o[64];
        ld64(q, Qs + (size_t)m * HW + h * HD);
#pragma unroll
        for (int d = 0; d < 64; ++d) o[d] = 0.f;
        float C2 = 0.f;
        for (int s = t - 1; s >= 0; --s) {
            const float z = dot64(q, Ks + (size_t)(b * SEQ + s) * HW + h * HD);
            const float L2 = -(fmaxf(z, 0.f) * LOG2E + log2f(1.f + exp2f(-fabsf(z) * LOG2E)));
            const float w = exp2f(z * LOG2E + L2 + C2);
            axpy64(o, w, Vs + (size_t)(b * SEQ + s) * HW + h * HD);
            C2 += L2;
            if (C2 < -160.f) break;
        }
        st64(F.mixed + (size_t)m * D + h * HD, o, 1.f);
    }
    for (int idx = gtid; idx < M * NHG; idx += NT) {
        const int h = idx >> 15, m = idx & (M - 1), b = m >> 13, t = m & (SEQ - 1), bh = b * 8 + h;
        float q[64], o[64];
        ld64(q, Qf + (size_t)m * HW + h * HD);
#pragma unroll
        for (int d = 0; d < 64; ++d) o[d] = 0.f;
        float cq = F.cfl[(size_t)bh * SEQ + t];
        for (int c = 0; c < (t >> 10); ++c) cq += F.ctot[bh * 8 + c];
        float carry = 0.f, mr = -1e30f, l = 0.f;
        for (int s = 0; s <= t; ++s) {
            if ((s & 1023) == 0 && s > 0) carry += F.ctot[bh * 8 + (s >> 10) - 1];
            const float z = dot64(q, Kf + (size_t)(b * SEQ + s) * HW + h * HD);
            const float s2 = z * LOG2E + (cq - (F.cfl[(size_t)bh * SEQ + s] + carry));
            if (s2 > mr) { const float f = exp2f(mr - s2); l *= f;
#pragma unroll
                for (int d = 0; d < 64; ++d) o[d] *= f;
                mr = s2; }
            const float pw = exp2f(s2 - mr); l += pw;
            axpy64(o, pw, Vf + (size_t)(b * SEQ + s) * HW + h * HD);
        }
        st64(F.mixed + (size_t)m * D + HW + h * HD, o, 1.f / l);
    }
}

#endif
struct FProj { bf16* qkv; __device__ __forceinline__ void operator()(int row, int col, float v) const { const int t = col >> 9, cc = col & 511; const float sc = (t == 0 || t == 3) ? 0.125f : 1.f;
    qkv[(size_t)t * M * HW + (size_t)row * HW + cc] = (bf16)f2bf(v * sc); } };
struct FBf16 { bf16* O; int ldc; int cmask; __device__ __forceinline__ void operator()(int row, int col, float v) const { O[(size_t)row * ldc + (col & cmask)] = (bf16)f2bf(v); } };
struct FPre { const float* x; float* out; __device__ __forceinline__ void operator()(int row, int col, float v) const { const size_t i = (size_t)row * D + col; out[i] = ALPHA * x[i] + v; } };
struct FSwiglu { bf16* hdn; const float* gslot; __device__ __forceinline__ void operator()(int row, int pn, int cl, float g, float u) const {
    const int f = (pn & 3) * 128 + cl; const float s = g / (1.f + __expf(-g)); hdn[(size_t)row * DF + f] = (bf16)f2bf(s * u * gslot[row]); } };
struct FComb { float* out; const bf16* pple; const bf16* y; const int* slot; __device__ __forceinline__ void operator()(int row, int col, float v) const {
    const size_t i = (size_t)row * D + col; const int s0 = slot[row * 2], s1 = slot[row * 2 + 1]; const float sig = 1.f / (1.f + __expf(-v));
    out[i] = ALPHA * out[i] + bf2f(pple[i]) * sig + bf2f(y[(size_t)s0 * D + col]) + bf2f(y[(size_t)s1 * D + col]); } };

#ifndef PROBE_TWICE
#define PROBE_TWICE -1
#endif
template <class S> struct Rep2T : S {
    __device__ __forceinline__ bool next(int i, pg8::Unit& u) const { return S::next(i >> 1, u); }
};
template <class S, bool ON> struct Rep2Sel { typedef S type; };
template <class S> struct Rep2Sel<S, true> { typedef Rep2T<S> type; };
#define Rep2(S, ON) typename Rep2Sel<S, ON>::type

namespace pg8 {
struct EpiPre {
    static constexpr bool PERM = true, AFTER_DRAIN = false; const float* x; float* out;
    __device__ __forceinline__ void operator()(const f32x4 (&acc)[2][2][4][2], const Unit& u, int wr, int wc, int fr, int fq) const {
        const int row0 = u.pm * BM + wr * 64 + fr, col0 = u.pn * BM + wc * 32 + 8 * fq;
#pragma unroll
        for (int ai = 0; ai < 2; ++ai)
#pragma unroll
            for (int m = 0; m < 4; ++m) { const size_t off = (size_t)(row0 + ai * HALF + m * 16) * D + col0;
#pragma unroll
                for (int bj = 0; bj < 2; ++bj) { const f32x4 x0 = *(const f32x4*)(x + off + bj * HALF), x1 = *(const f32x4*)(x + off + bj * HALF + 4);
                    *(f32x4*)(out + off + bj * HALF) = x0 * ALPHA + acc[ai][bj][m][0]; *(f32x4*)(out + off + bj * HALF + 4) = x1 * ALPHA + acc[ai][bj][m][1]; }
                asm volatile("" ::: "memory"); }
    }
};
struct EpiSwiglu {
    static constexpr bool PERM = true, AFTER_DRAIN = false; bf16_t* hdn; const float* gslot;
    __device__ __forceinline__ void operator()(const f32x4 (&acc)[2][2][4][2], const Unit& u, int wr, int wc, int fr, int fq) const {
        const int row0 = u.pm * BM + wr * 64 + fr, f0 = (u.pn & 3) * 128 + wc * 32 + 8 * fq;
#pragma unroll
        for (int ai = 0; ai < 2; ++ai)
#pragma unroll
            for (int m = 0; m < 4; ++m) { const int r = row0 + ai * HALF + m * 16; const float gs = gslot[r]; float v[8];
#pragma unroll
                for (int n = 0; n < 2; ++n)
#pragma unroll
                    for (int e = 0; e < 4; ++e) { const float g = acc[ai][0][m][n][e], up = acc[ai][1][m][n][e]; v[4 * n + e] = g * __builtin_amdgcn_rcpf(1.f + __expf(-g)) * up * gs; }
                u32x4 w; w.x = cvt_pk_bf16(v[0], v[1]); w.y = cvt_pk_bf16(v[2], v[3]); w.z = cvt_pk_bf16(v[4], v[5]); w.w = cvt_pk_bf16(v[6], v[7]);
                *(u32x4*)(hdn + (size_t)r * DF + f0) = w; }
    }
};
struct EpiPle {
    static constexpr bool PERM = true, AFTER_DRAIN = false; bf16_t* pple;
    __device__ __forceinline__ void operator()(const f32x4 (&acc)[2][2][4][2], const Unit& u, int wr, int wc, int fr, int fq) const {
        const int row0 = u.pm * BM + wr * 64 + fr, col0 = u.pn * BM + wc * 32 + 8 * fq;
#pragma unroll
        for (int ai = 0; ai < 2; ++ai)
#pragma unroll
            for (int m = 0; m < 4; ++m) { const size_t off = (size_t)(row0 + ai * HALF + m * 16) * D + col0;
#pragma unroll
                for (int bj = 0; bj < 2; ++bj) { const u32x4 pp = *(const u32x4*)(pple + off + bj * HALF); float v[8];
#pragma unroll
                    for (int e = 0; e < 8; ++e) { const float g = acc[ai][bj][m][e >> 2][e & 3]; const unsigned pw = pp[e >> 1];
                        const float pv = (e & 1) ? __builtin_bit_cast(float, pw & 0xffff0000u) : __builtin_bit_cast(float, pw << 16);
                        v[e] = pv * __builtin_amdgcn_rcpf(1.f + __expf(-g)); }
                    u32x4 w; w.x = cvt_pk_bf16(v[0], v[1]); w.y = cvt_pk_bf16(v[2], v[3]); w.z = cvt_pk_bf16(v[4], v[5]); w.w = cvt_pk_bf16(v[6], v[7]);
                    *(u32x4*)(pple + off + bj * HALF) = w; }
                asm volatile("" ::: "memory"); }
    }
};
}

struct MoeOrder {
    const LAS int* pst; int nunits, G, c;
    __device__ __forceinline__ bool next(int i, pg8::Unit& u) const {
        const int L = i * G + c; if (L >= nunits) return false;
        const int pm = L >> 2, r0 = pm * 256; int e = 0;
        for (int k = 0; k < NE - 1; ++k) if (r0 >= pst[k + 1]) e = k + 1;
        u.pm = pm; u.pn = e * 4 + (L & 3); return true;
    }
    __device__ __forceinline__ void a_ready(const pg8::Unit&) const {}
    __device__ __forceinline__ void done(const pg8::Unit&) const {}
};
__device__ __forceinline__ void build_pstart(Frame& F) {
    LAS int* pst = (LAS int*)(F.lds + PST_OFF);
    if (F.tid == 0) { int acc = 0; for (int e = 0; e < NE; ++e) { const int c = (int)__hip_atomic_load(F.ctl + CW_CNT + 64 * e, RLX_AGENT); pst[e] = acc; acc += (c + 255) & ~255; } pst[NE] = acc; }
    __syncthreads();
}

constexpr int RB = 2;
__device__ __forceinline__ unsigned long long pk4(const f32x4 v) { return (unsigned long long)pk2(v.x, v.y) | ((unsigned long long)pk2(v.z, v.w) << 32); }
__device__ __forceinline__ float rdl(float v, int l) { return __builtin_bit_cast(float, __builtin_amdgcn_readlane(__builtin_bit_cast(int, v), l)); }
template <int H, int K> __device__ __forceinline__ void rs_step(float* a, int lane) {
    const bool up = (lane >> K) & 1;
#pragma unroll
    for (int i = 0; i < H; ++i) { const float keep = up ? a[H + i] : a[i], send = up ? a[i] : a[H + i]; a[i] = keep + __shfl_xor(send, 1 << K); }
}
__device__ __forceinline__ void p5_ln_route(Frame& F) {
    LAS unsigned* hist = (LAS unsigned*)(F.lds + HIST_OFF); LAS unsigned* base = (LAS unsigned*)(F.lds + BASE_OFF);
    LAS int* eidL = (LAS int*)(F.lds + ROWL_OFF); LAS int* rankL = eidL + 256;
    LAS f32x4* wr = (LAS f32x4*)(F.lds + RING_OFF); LAS f32x4* wg = (LAS f32x4*)(F.lds + WGRP_OFF);
    for (int i = F.tid; i < 8192; i += NTHR) { const int c = i >> 3, pc = i & 7, g = pc >> 1, half = pc & 1, ln = (c & 255) >> 2, j = c >> 8, e = c & 3;
        wr[((((g * 4 + j) * 4 + e) * 2 + half) << 6) + ln] = *(const GAS f32x4*)(F.w_router + (size_t)c * NE + pc * 4); }
    for (int c = F.tid; c < 1024; c += NTHR) { const int ln = (c & 255) >> 2, j = c >> 8, e = c & 3; wg[((j * 4 + e) << 6) + ln] = *(const GAS f32x4*)(F.w_group + (size_t)c * 4); }
    if (F.tid < NE) hist[F.tid] = 0u;
    __syncthreads();
    f32x4 gv[4], bv[4];
#pragma unroll
    for (int j = 0; j < 4; ++j) { gv[j] = *(const GAS f32x4*)(F.ln1g + 4 * F.lane + 256 * j); bv[j] = *(const GAS f32x4*)(F.ln1b + 4 * F.lane + 256 * j); }
    for (int r0 = F.wave * 2; r0 < 128; r0 += NWAVES * 2) {
        f32x4 v[2][4]; float st[4];
#pragma unroll
        for (int rr = 0; rr < 2; ++rr) { const GAS f32x4* pr = (const GAS f32x4*)(F.out + (size_t)(blockIdx.x * 128 + r0 + rr) * D) + F.lane;
#pragma unroll
            for (int j = 0; j < 4; ++j) v[rr][j] = pr[64 * j]; }
#pragma unroll
        for (int rr = 0; rr < 2; ++rr) { float s = 0.f, q = 0.f;
#pragma unroll
            for (int j = 0; j < 4; ++j) { s += (v[rr][j].x + v[rr][j].y) + (v[rr][j].z + v[rr][j].w); q += (v[rr][j].x * v[rr][j].x + v[rr][j].y * v[rr][j].y) + (v[rr][j].z * v[rr][j].z + v[rr][j].w * v[rr][j].w); }
            st[2 * rr] = s; st[2 * rr + 1] = q; }
        rs_step<2, 5>(st, F.lane); rs_step<1, 4>(st, F.lane);
#pragma unroll
        for (int o = 1; o < 16; o <<= 1) st[0] += __shfl_xor(st[0], o);
        float gl[8];
#pragma unroll
        for (int i = 0; i < 8; ++i) gl[i] = 0.f;
#pragma unroll
        for (int rr = 0; rr < 2; ++rr) { const int m = blockIdx.x * 128 + r0 + rr;
            const float sum = rdl(st[0], 32 * rr), sq = rdl(st[0], 32 * rr + 16);
            const float mean = sum * (1.f / D), rstd = 1.f / sqrtf(fmaxf(sq * (1.f / D) - mean * mean, 0.f) + LN_EPS);
            GAS f32x4* pr = (GAS f32x4*)(F.out + (size_t)m * D) + F.lane; GAS unsigned long long* o8 = (GAS unsigned long long*)(F.hb + (size_t)m * D) + F.lane;
#pragma unroll
            for (int j = 0; j < 4; ++j) { v[rr][j] = (v[rr][j] - mean) * rstd * gv[j] + bv[j]; pr[64 * j] = v[rr][j]; o8[64 * j] = pk4(v[rr][j]); } }
#pragma unroll
        for (int j = 0; j < 4; ++j)
#pragma unroll
            for (int e = 0; e < 4; ++e) { const f32x4 w = wg[((j * 4 + e) << 6) + F.lane];
#pragma unroll
                for (int rr = 0; rr < 2; ++rr) { const float hv = v[rr][j][e]; gl[4 * rr] += hv * w.x; gl[4 * rr + 1] += hv * w.y; gl[4 * rr + 2] += hv * w.z; gl[4 * rr + 3] += hv * w.w; } }
        rs_step<4, 5>(gl, F.lane); rs_step<2, 4>(gl, F.lane); rs_step<1, 3>(gl, F.lane);
#pragma unroll
        for (int o = 1; o < 8; o <<= 1) gl[0] += __shfl_xor(gl[0], o);
        int gs[2]; float gprob[2]; float el[16];
#pragma unroll
        for (int rr = 0; rr < 2; ++rr) { float t[4];
#pragma unroll
            for (int i = 0; i < 4; ++i) t[i] = rdl(gl[0], 8 * (4 * rr + i)) + F.b_group[i];
            int g = 0; float gm = t[0];
#pragma unroll
            for (int i = 1; i < 4; ++i) if (t[i] > gm) { gm = t[i]; g = i; }
            gs[rr] = g; float gden = 0.f;
#pragma unroll
            for (int i = 0; i < 4; ++i) gden += expf(t[i] - gm);
            gprob[rr] = 1.f / gden; }
#pragma unroll
        for (int i = 0; i < 16; ++i) el[i] = 0.f;
#pragma unroll
        for (int j = 0; j < 4; ++j)
#pragma unroll
            for (int e = 0; e < 4; ++e)
#pragma unroll
                for (int rr = 0; rr < 2; ++rr) { const LAS f32x4* wp = wr + ((((gs[rr] * 4 + j) * 4 + e) * 2) << 6) + F.lane; const f32x4 w0 = wp[0], w1 = wp[64]; const float hv = v[rr][j][e];
                    el[8 * rr + 0] += hv * w0.x; el[8 * rr + 1] += hv * w0.y; el[8 * rr + 2] += hv * w0.z; el[8 * rr + 3] += hv * w0.w;
                    el[8 * rr + 4] += hv * w1.x; el[8 * rr + 5] += hv * w1.y; el[8 * rr + 6] += hv * w1.z; el[8 * rr + 7] += hv * w1.w; }
        rs_step<8, 5>(el, F.lane); rs_step<4, 4>(el, F.lane); rs_step<2, 3>(el, F.lane); rs_step<1, 2>(el, F.lane);
#pragma unroll
        for (int o = 1; o < 4; o <<= 1) el[0] += __shfl_xor(el[0], o);
#pragma unroll
        for (int rr = 0; rr < 2; ++rr) { const int r = r0 + rr, m = blockIdx.x * 128 + r; float t[8];
#pragma unroll
            for (int i = 0; i < 8; ++i) t[i] = rdl(el[0], 4 * (8 * rr + i)) + F.b_router[gs[rr] * EPG + i];
            int i1 = 0; float v1 = t[0];
#pragma unroll
            for (int i = 1; i < 8; ++i) if (t[i] > v1) { v1 = t[i]; i1 = i; }
            int i2 = (i1 == 0) ? 1 : 0; float v2 = (i1 == 0) ? t[1] : t[0];
#pragma unroll
            for (int i = 1; i < 8; ++i) if (i != i1 && t[i] > v2) { v2 = t[i]; i2 = i; }
            const float e2 = expf(v2 - v1), g1 = 1.f / (1.f + e2), g2 = e2 * g1;
            if (F.lane == 0) {
                const int ea = gs[rr] * EPG + i1, eb = gs[rr] * EPG + i2;
                const unsigned ra = __hip_atomic_fetch_add(hist + ea, 1u, __ATOMIC_RELAXED, __HIP_MEMORY_SCOPE_WORKGROUP);
                const unsigned rb = __hip_atomic_fetch_add(hist + eb, 1u, __ATOMIC_RELAXED, __HIP_MEMORY_SCOPE_WORKGROUP);
                eidL[r * 2] = ea; eidL[r * 2 + 1] = eb; rankL[r * 2] = (int)ra; rankL[r * 2 + 1] = (int)rb;
                F.eid[m * 2] = ea; F.eid[m * 2 + 1] = eb; F.gatev[m * 2] = g1 * gprob[rr]; F.gatev[m * 2 + 1] = g2 * gprob[rr];
            } }
    }
    __syncthreads();
    if (F.tid < NE) base[F.tid] = __hip_atomic_fetch_add(F.ctl + CW_CNT + 64 * F.tid, hist[F.tid], RLX_AGENT);
    __syncthreads();
    if (F.tid < 256) F.rank[blockIdx.x * 256 + F.tid] = rankL[F.tid] + (int)base[eidL[F.tid]];
}
__device__ __forceinline__ void p6_slots_gather(Frame& F) {
    build_pstart(F);
    const LAS int* pst = (const LAS int*)(F.lds + PST_OFF);
    for (int r0 = F.wave * 4; r0 < 128; r0 += NWAVES * 4) {
        v4u a[4], b[4]; int s0[4], s1[4];
#pragma unroll
        for (int rr = 0; rr < 4; ++rr) { const int m = blockIdx.x * 128 + r0 + rr; int s = 0;
            if (F.lane < 2) { const int e = F.eid[m * 2 + F.lane]; s = pst[e] + F.rank[m * 2 + F.lane]; F.slot[m * 2 + F.lane] = s; F.gslot[s] = F.gatev[m * 2 + F.lane]; }
            s0[rr] = __shfl(s, 0); s1[rr] = __shfl(s, 1);
            const GAS v4u* src = (const GAS v4u*)(F.hb + (size_t)m * D); a[rr] = src[F.lane]; b[rr] = src[F.lane + 64]; }
#pragma unroll
        for (int rr = 0; rr < 4; ++rr) { GAS v4u* d0 = (GAS v4u*)(F.xs + (size_t)s0[rr] * D); GAS v4u* d1 = (GAS v4u*)(F.xs + (size_t)s1[rr] * D);
            d0[F.lane] = a[rr]; d0[F.lane + 64] = b[rr]; d1[F.lane] = a[rr]; d1[F.lane + 64] = b[rr]; }
    }
}
__device__ __forceinline__ void p9_final(Frame& F, bool poison) {
    f32x4 gv[4], bv[4];
#pragma unroll
    for (int j = 0; j < 4; ++j) { gv[j] = *(const GAS f32x4*)(F.ln2g + 4 * F.lane + 256 * j); bv[j] = *(const GAS f32x4*)(F.ln2b + 4 * F.lane + 256 * j); }
    const int gw = blockIdx.x * NWAVES + F.wave, NGW = F.G * NWAVES; const float qn = __builtin_nanf("");
    for (int m0 = gw * RB; m0 < M; m0 += NGW * RB) {
        f32x4 v[RB][4]; float mean[RB], rstd[RB];
#pragma unroll
        for (int rr = 0; rr < RB; ++rr) { const int m = m0 + rr; const int s0 = F.slot[2 * m], s1 = F.slot[2 * m + 1];
            const GAS f32x4* pr = (const GAS f32x4*)(F.out + (size_t)m * D) + F.lane;
            const GAS unsigned long long* pp = (const GAS unsigned long long*)(F.pple + (size_t)m * D) + F.lane;
            const GAS unsigned long long* y0 = (const GAS unsigned long long*)(F.y + (size_t)s0 * D) + F.lane; const GAS unsigned long long* y1 = (const GAS unsigned long long*)(F.y + (size_t)s1 * D) + F.lane;
#pragma unroll
            for (int j = 0; j < 4; ++j) { const f32x4 h = pr[64 * j]; const unsigned long long pw = pp[64 * j], aw = y0[64 * j], bw = y1[64 * j];
                const unsigned p0 = (unsigned)pw, p1 = (unsigned)(pw >> 32), a0 = (unsigned)aw, a1 = (unsigned)(aw >> 32), b0 = (unsigned)bw, b1 = (unsigned)(bw >> 32);
                f32x4 t;
                t.x = h.x * ALPHA + BFLO(p0) + (BFLO(a0) + BFLO(b0)); t.y = h.y * ALPHA + BFHI(p0) + (BFHI(a0) + BFHI(b0));
                t.z = h.z * ALPHA + BFLO(p1) + (BFLO(a1) + BFLO(b1)); t.w = h.w * ALPHA + BFHI(p1) + (BFHI(a1) + BFHI(b1));
                v[rr][j] = t; } }
#pragma unroll
        for (int rr = 0; rr < RB; ++rr) { float s = 0.f;
#pragma unroll
            for (int j = 0; j < 4; ++j) s += (v[rr][j].x + v[rr][j].y) + (v[rr][j].z + v[rr][j].w);
            mean[rr] = s; }
#pragma unroll
        for (int o = 1; o < 64; o <<= 1)
#pragma unroll
            for (int rr = 0; rr < RB; ++rr) mean[rr] += __shfl_xor(mean[rr], o);
#pragma unroll
        for (int rr = 0; rr < RB; ++rr) { mean[rr] *= (1.f / D); float s2 = 0.f;
#pragma unroll
            for (int j = 0; j < 4; ++j) { v[rr][j] = v[rr][j] - mean[rr]; s2 += (v[rr][j].x * v[rr][j].x + v[rr][j].y * v[rr][j].y) + (v[rr][j].z * v[rr][j].z + v[rr][j].w * v[rr][j].w); }
            rstd[rr] = s2; }
#pragma unroll
        for (int o = 1; o < 64; o <<= 1)
#pragma unroll
            for (int rr = 0; rr < RB; ++rr) rstd[rr] += __shfl_xor(rstd[rr], o);
#pragma unroll
        for (int rr = 0; rr < RB; ++rr) { const float rs = 1.f / sqrtf(rstd[rr] * (1.f / D) + LN_EPS); GAS f32x4* pr = (GAS f32x4*)(F.out + (size_t)(m0 + rr) * D) + F.lane;
#pragma unroll
            for (int j = 0; j < 4; ++j) { f32x4 o = v[rr][j] * rs * gv[j] + bv[j]; if (poison) o = (f32x4){qn, qn, qn, qn}; pr[64 * j] = o; } }
    }
}


namespace att {
typedef float f32x16 __attribute__((ext_vector_type(16)));
typedef short s16x4 __attribute__((ext_vector_type(4)));
typedef short v4i16_t __attribute__((ext_vector_type(4)));
constexpr int BUFB = 16384 + 512, A_WS = 2 * BUFB, A_FLAG = A_WS + 2048, A_CAR = A_FLAG + 64, A_END = A_CAR + 64;
constexpr float STOP2 = -48.f;
__device__ __forceinline__ int crow(int r, int hi) { return (r & 3) + 8 * (r >> 2) + 4 * hi; }
__device__ __forceinline__ unsigned cvtpk(float lo, float hi) { typedef float f2 __attribute__((ext_vector_type(2))); typedef __bf16 b2 __attribute__((ext_vector_type(2))); f2 v = {lo, hi}; b2 b = __builtin_convertvector(v, b2); return __builtin_bit_cast(unsigned, b); }

template <int MODE> __device__ __forceinline__ void attn_unit(Frame& F, int bh, int qb) {
    const int tid = F.tid, lane = F.lane, r32 = lane & 31, hi = lane >> 5, wid = F.wave;
    const int b = bh >> 3, h = bh & 7;
    const bf16* Qg = F.qkv + (size_t)(MODE ? 3 : 0) * M * HW; const bf16* Kg = F.qkv + (size_t)(MODE ? 4 : 1) * M * HW; const bf16* Vg = F.qkv + (size_t)(MODE ? 5 : 2) * M * HW;
    const size_t rowbase = (size_t)b * SEQ; const int q0 = qb * 256;
    const bf16* Qw = Qg + (rowbase + q0 + wid * 32) * HW + h * HD;
    const bf16* Kh = Kg + rowbase * HW + h * HD; const bf16* Vh = Vg + rowbase * HW + h * HD;
    LAS unsigned char* L = F.lds + RING_OFF;
    LAS float* wsf = (LAS float*)(L + A_WS) + wid * 64;
    LAS unsigned* flg = (LAS unsigned*)(L + A_FLAG);
    LAS float* car = (LAS float*)(L + A_CAR);
    const int jt = (q0 >> 6) + 3, jw = (q0 >> 6) + (wid >> 1);
    const bf16* ksrc = Kh + (size_t)lane * HW + wid * 8;
    const bf16* vsrc = Vh + (size_t)(16 * (wid & 3) + (lane >> 2)) * HW + (wid >> 2) * 32 + (lane & 3) * 8;
    const int kdst = wid * 1024 + lane * 16, vdst = 8192 + wid * 1024 + lane * 16;
    const float* cfsrc = F.cfl + (size_t)bh * SEQ + tid * 4;
    float KNu = 0.f;
    if (MODE) {
        if (tid < 8) { float c = 0.f; for (int k = 0; k < tid; ++k) c += F.ctot[bh * 8 + k]; car[tid] = c; }
        float kn = (lane <= jt) ? F.knt[bh * 128 + lane] : 0.f; if (lane + 64 <= jt) kn = fmaxf(kn, F.knt[bh * 128 + lane + 64]);
        KNu = wave_max(kn);
    }
    bf16x8 qr[4];
#pragma unroll
    for (int d0 = 0; d0 < 4; ++d0) qr[d0] = *(const GAS bf16x8*)(Qw + (size_t)r32 * HW + d0 * 16 + hi * 8);
    __syncthreads();
    v4u kreg = *(const GAS v4u*)(ksrc + (size_t)jt * 64 * HW), vreg = *(const GAS v4u*)(vsrc + (size_t)jt * 64 * HW); f32x4 cfreg = {0.f, 0.f, 0.f, 0.f};
    if (MODE && tid < 16) { cfreg = *(const GAS f32x4*)(cfsrc + jt * 64); const float c = car[jt >> 4]; cfreg = cfreg + c; }
    *(LAS v4u*)(L + kdst) = kreg; *(LAS v4u*)(L + vdst) = vreg; if (MODE && tid < 16) *(LAS f32x4*)(L + 16384 + tid * 16) = cfreg;
    float cq = 0.f, qnb = 0.f;
    if (MODE) {
        cq = F.cfl[(size_t)bh * SEQ + q0 + wid * 32 + r32] + car[q0 >> 10];
        float n2 = 0.f;
#pragma unroll
        for (int d0 = 0; d0 < 4; ++d0)
#pragma unroll
            for (int e = 0; e < 8; ++e) { const float qv = __builtin_bit_cast(float, (unsigned)(unsigned short)qr[d0][e] << 16); n2 += qv * qv; }
        n2 += __shfl_xor(n2, 32);
        qnb = sqrtf(n2) * KNu * (LOG2E * 1.01f) + cq;
    }
    __syncthreads();
    f32x16 o[2]; o[0] = f32x16{}; o[1] = f32x16{};
    float C2 = 0.f, mhat = -1e30f, lsum = 0.f;
    bool wdone = false; int cur = 0;
    const LAS unsigned char* vb0 = L + 8192 + ((lane >> 4) & 1) * 32 + (lane & 3) * 8 + (4 * hi + ((lane & 15) >> 2)) * 64;
    for (int j = jt;; --j) {
        const bool more = j > 0;
        if (more) { kreg = *(const GAS v4u*)(ksrc + (size_t)(j - 1) * 64 * HW); vreg = *(const GAS v4u*)(vsrc + (size_t)(j - 1) * 64 * HW);
            if (MODE && tid < 16) cfreg = *(const GAS f32x4*)(cfsrc + (j - 1) * 64); }
        if (!wdone && j <= jw) {
            const LAS unsigned char* Kb = L + cur * BUFB;
            f32x16 p0 = f32x16{}, p1 = f32x16{};
            { const LAS unsigned char* kb = Kb + hi * 1024 + r32 * 16;
#pragma unroll
              for (int d0 = 0; d0 < 4; ++d0) { const bf16x8 b0 = *(const LAS bf16x8*)(kb + d0 * 2048), b1 = *(const LAS bf16x8*)(kb + d0 * 2048 + 512);
                  p0 = __builtin_amdgcn_mfma_f32_32x32x16_bf16(b0, qr[d0], p0, 0, 0, 0); p1 = __builtin_amdgcn_mfma_f32_32x32x16_bf16(b1, qr[d0], p1, 0, 0, 0); } }
            const bool diag = (j == jw); const int qrel = 32 * (wid & 1) + r32;
            if (MODE == 0) {
                float Lg[32];
#pragma unroll
                for (int r = 0; r < 16; ++r) {
                    const float z0 = p0[r], z1 = p1[r];
                    float l0 = -(fmaxf(z0, 0.f) * LOG2E + __builtin_amdgcn_logf(1.f + __builtin_amdgcn_exp2f(-fabsf(z0) * LOG2E)));
                    float l1 = -(fmaxf(z1, 0.f) * LOG2E + __builtin_amdgcn_logf(1.f + __builtin_amdgcn_exp2f(-fabsf(z1) * LOG2E)));
                    if (diag) { if (crow(r, hi) >= qrel) l0 = 0.f; if (crow(r, hi) + 32 >= qrel) l1 = 0.f; }
                    Lg[r] = l0; Lg[16 + r] = l1;
                }
                float Os[8], Ps[8];
#pragma unroll
                for (int i = 0; i < 8; ++i) { Os[i] = (Lg[4 * i] + Lg[4 * i + 1]) + (Lg[4 * i + 2] + Lg[4 * i + 3]); Ps[i] = __shfl_xor(Os[i], 32); }
                float T = 0.f;
#pragma unroll
                for (int i = 7; i >= 0; --i) {
                    float s = T + (hi ? 0.f : Ps[i]) + C2;
#pragma unroll
                    for (int e = 3; e >= 0; --e) { s += Lg[4 * i + e]; const int r = (4 * i + e) & 15; const float zz = (i < 4) ? p0[r] : p1[r];
                        float w = __builtin_amdgcn_exp2f(zz * LOG2E + s);
                        if (diag) { const int kk = crow(r, hi) + (i < 4 ? 0 : 32); if (kk >= qrel) w = 0.f; }
                        if (i < 4) p0[r] = w; else p1[r] = w; }
                    T += Os[i] + Ps[i];
                }
                C2 += T;
                wdone = __all(C2 < STOP2);
            } else {
                const LAS float* cfp = (const LAS float*)(Kb + 16384);
                float rm = -INFINITY;
#pragma unroll
                for (int g = 0; g < 4; ++g) { const f32x4 c0 = *(const LAS f32x4*)(cfp + 8 * g + 4 * hi), c1 = *(const LAS f32x4*)(cfp + 32 + 8 * g + 4 * hi);
#pragma unroll
                    for (int e = 0; e < 4; ++e) { const int r = 4 * g + e; float s0 = p0[r] * LOG2E + (cq - c0[e]), s1 = p1[r] * LOG2E + (cq - c1[e]);
                        if (diag) { if (crow(r, hi) > qrel) s0 = -INFINITY; if (crow(r, hi) + 32 > qrel) s1 = -INFINITY; }
                        p0[r] = s0; p1[r] = s1; rm = fmaxf(rm, fmaxf(s0, s1)); } }
                rm = fmaxf(rm, __shfl_xor(rm, 32));
                const float mnew = fmaxf(mhat, rm);
                if (__any(mnew > mhat)) {
                    const float f = __builtin_amdgcn_exp2f(mhat - mnew); lsum *= f;
                    if (hi == 0) wsf[r32] = f;
                    asm volatile("s_waitcnt lgkmcnt(0)" ::: "memory");
#pragma unroll
                    for (int r = 0; r < 16; ++r) { const float fr = wsf[crow(r, hi)]; o[0][r] *= fr; o[1][r] *= fr; }
                    mhat = mnew;
                }
                float sacc = 0.f;
#pragma unroll
                for (int r = 0; r < 16; ++r) { p0[r] = __builtin_amdgcn_exp2f(p0[r] - mhat); p1[r] = __builtin_amdgcn_exp2f(p1[r] - mhat); sacc += p0[r] + p1[r]; }
                lsum += sacc;
                const float c00 = cfp[0];
                wdone = __all(qnb - c00 - mhat < STOP2);
            }
            v4u pw0, pw1, pw2, pw3;
#pragma unroll
            for (int e = 0; e < 4; ++e) { pw0[e] = cvtpk(p0[2 * e], p0[2 * e + 1]); pw1[e] = cvtpk(p0[8 + 2 * e], p0[8 + 2 * e + 1]); pw2[e] = cvtpk(p1[2 * e], p1[2 * e + 1]); pw3[e] = cvtpk(p1[8 + 2 * e], p1[8 + 2 * e + 1]); }
            const LAS unsigned char* vb = vb0 + cur * BUFB;
#pragma unroll
            for (int d0 = 0; d0 < 2; ++d0) { s16x4 lo[4], hh[4];
#pragma unroll
                for (int ks = 0; ks < 4; ++ks) {
                    lo[ks] = __builtin_bit_cast(s16x4, __builtin_amdgcn_ds_read_tr16_b64_v4i16((LAS v4i16_t*)(vb + d0 * 4096 + ks * 1024)));
                    hh[ks] = __builtin_bit_cast(s16x4, __builtin_amdgcn_ds_read_tr16_b64_v4i16((LAS v4i16_t*)(vb + d0 * 4096 + ks * 1024 + 512))); }
#define ATT_PK(k) (bf16x8){lo[k][0], lo[k][1], lo[k][2], lo[k][3], hh[k][0], hh[k][1], hh[k][2], hh[k][3]}
                o[d0] = __builtin_amdgcn_mfma_f32_32x32x16_bf16(__builtin_bit_cast(bf16x8, pw0), ATT_PK(0), o[d0], 0, 0, 0);
                o[d0] = __builtin_amdgcn_mfma_f32_32x32x16_bf16(__builtin_bit_cast(bf16x8, pw1), ATT_PK(1), o[d0], 0, 0, 0);
                o[d0] = __builtin_amdgcn_mfma_f32_32x32x16_bf16(__builtin_bit_cast(bf16x8, pw2), ATT_PK(2), o[d0], 0, 0, 0);
                o[d0] = __builtin_amdgcn_mfma_f32_32x32x16_bf16(__builtin_bit_cast(bf16x8, pw3), ATT_PK(3), o[d0], 0, 0, 0);
#undef ATT_PK
            }
        }
        if (more) { const int nb = (cur ^ 1) * BUFB;
            if (MODE && tid < 16) { const float c = car[(j - 1) >> 4]; cfreg = cfreg + c; *(LAS f32x4*)(L + nb + 16384 + tid * 16) = cfreg; }
            *(LAS v4u*)(L + nb + kdst) = kreg; *(LAS v4u*)(L + nb + vdst) = vreg; }
        if (lane == 0) flg[cur * 8 + wid] = wdone ? 1u : 0u;
        __syncthreads();
        if (!more) break;
        unsigned alld = 1u;
#pragma unroll
        for (int w = 0; w < 8; ++w) alld &= flg[cur * 8 + w];
        if (alld) break;
        cur ^= 1;
    }
    float rli[16];
    if (MODE) {
        lsum += __shfl_xor(lsum, 32);
        if (hi == 0) wsf[r32] = lsum;
        asm volatile("s_waitcnt lgkmcnt(0)" ::: "memory");
#pragma unroll
        for (int r = 0; r < 16; ++r) rli[r] = 1.f / wsf[crow(r, hi)];
    } else {
#pragma unroll
        for (int r = 0; r < 16; ++r) rli[r] = 1.f;
    }
    bf16* Ow = F.mixed + (rowbase + q0 + wid * 32) * D + (MODE ? HW : 0) + h * HD;
#pragma unroll
    for (int r = 0; r < 16; ++r) {
        bf16* rowp = Ow + (size_t)crow(r, hi) * D + r32;
        rowp[0] = (bf16)f2bf(o[0][r] * rli[r]); rowp[32] = (bf16)f2bf(o[1][r] * rli[r]);
    }
}
}

template <int MODE> __device__ __forceinline__ void p3_attn_fast(Frame& F) {
    for (int i = 3; i >= 0; --i) { const int id = (int)blockIdx.x + F.G * i; if (id < 1024) att::attn_unit<MODE>(F, id & 31, id >> 5); }
}

struct Args { const float* in[18]; float* out; unsigned char* ws; int ph_lo, ph_hi; };
__global__ void __launch_bounds__(NTHR, 2) mk_fwd(Args args) {
    extern __shared__ __attribute__((aligned(16))) unsigned char lds[];
    Frame F;
    F.lds = (LAS unsigned char*)lds; F.MISC = (volatile LAS unsigned*)(F.lds + MISC_OFF);
    F.tid = threadIdx.x; F.lane = F.tid & 63; F.wave = __builtin_amdgcn_readfirstlane(F.tid >> 6);
    F.G = gridDim.x; { const int bx = blockIdx.x; F.vcu = (F.G % 8 == 0) ? (bx % 8) * (F.G / 8) + bx / 8 : bx; }
    unsigned char* ws = args.ws;
    F.ctl = (gu32*)(ws + WS_CTL);
    F.x = args.in[0]; F.p = args.in[1]; F.w_in = args.in[2]; F.b_forget = args.in[3]; F.w_out = args.in[4]; F.ln1g = args.in[5]; F.ln1b = args.in[6]; F.w_group = args.in[7]; F.b_group = args.in[8];
    F.w_router = args.in[9]; F.b_router = args.in[10]; F.w_gate = args.in[11]; F.w_up = args.in[12]; F.w_down = args.in[13]; F.w_ple = args.in[14]; F.w_pg = args.in[15]; F.ln2g = args.in[16]; F.ln2b = args.in[17];
    F.out = args.out;
    F.Win_t = (bf16*)(ws + WS_WIN); F.Wout_t = (bf16*)(ws + WS_WOUT); F.Wple_t = (bf16*)(ws + WS_WPLE); F.Wpg_t = (bf16*)(ws + WS_WPG); F.Wgu_t = (bf16*)(ws + WS_WGU); F.Wd_t = (bf16*)(ws + WS_WD);
    F.pple = (bf16*)(ws + WS_PPLE); F.qkv = (bf16*)(ws + WS_R1); F.xs = (bf16*)(ws + WS_R1); F.y = (bf16*)(ws + WS_R1);
    F.xb = (bf16*)(ws + WS_R2); F.mixed = (bf16*)(ws + WS_R2); F.hb = (bf16*)(ws + WS_R2); F.pb = (bf16*)(ws + WS_R3); F.hdn = (bf16*)(ws + WS_R3);
    F.ls = (float*)(ws + WS_LS); F.cfl = (float*)(ws + WS_CFL); F.ctot = (float*)(ws + WS_CTOT); F.knt = (float*)(ws + WS_KNT); F.gatev = (float*)(ws + WS_GATE); F.gslot = (float*)(ws + WS_GSLOT);
    F.eid = (int*)(ws + WS_EID); F.rank = (int*)(ws + WS_RANK); F.slot = (int*)(ws + WS_SLOT);
    for (int u = F.tid; u < (LDS_BYTES - LDSCTL_OFF) / 4; u += NTHR) ((LAS unsigned*)(F.lds + LDSCTL_OFF))[u] = 0u;
    __syncthreads();
    XcdBarrier bar = xcd_barrier_post((unsigned*)(F.ctl + CW_BAR), F.MISC + 8);
    const int lo = args.ph_lo, hi = args.ph_hi;
#ifndef PH_MASK
#define PH_MASK 0x3ff
#endif
#define IN(k) (((PH_MASK >> (k)) & 1) && lo <= (k) && (k) < hi)
#ifndef PROBE_PH
#define PROBE_PH -1
#endif
    unsigned long long pt0_ = (PROBE_PH == 0) ? rt() : 0ull, pt1_ = 0ull;
#define SEAM(k) do { if (IN(k) && IN((k) + 1)) xcd_barrier(bar); if ((k) == PROBE_PH) pt1_ = rt(); if ((k) + 1 == PROBE_PH) pt0_ = rt(); } while (0)

#ifndef REPEAT_PH
#define REPEAT_PH -1
#endif
#define REP(k) _Pragma("unroll") for (int rep_ = 0; rep_ < ((k) == REPEAT_PH ? 2 : 1); ++rep_)
    REP(100) { if (IN(0)) { p0_prologue<0>(F); } }
    REP(101) { if (IN(0)) { p0_prologue<1>(F); } }
    REP(102) { if (IN(0)) { p0_prologue<2>(F); } }
    SEAM(0);

    if (IN(1)) {
        { pg8::Gemm g{F.xb, F.Win_t, M, NPROJ, D}; pg8::StaticOrder S; S.init(M, NPROJ, F.G, (int)blockIdx.x);
          pg8::EpiBf16<0> E{F.qkv, HW, nullptr, HW, (size_t)M * HW, 1.f};
          pg8::gemm_phase<pg8::EpiBf16<0>, pg8::StaticOrder, true, true>(F.lds + RING_OFF, g, S, E); }
        { pg8::Gemm g{F.pb, F.Wple_t, M, D, PLED}; pg8::StaticOrder S; S.init(M, D, F.G, (int)blockIdx.x);
          pg8::EpiBf16<0> E{F.pple, D, nullptr, 0, 0, 1.f};
          pg8::gemm_phase<pg8::EpiBf16<0>, pg8::StaticOrder, true, true>(F.lds + RING_OFF, g, S, E); }
    } SEAM(1);

    if (IN(2)) { p2_scan(F); } SEAM(2);

#if ATT_FAST
    REP(31) { if (IN(3)) { p3_attn_fast<1>(F); } }
    REP(32) { if (IN(3)) { p3_attn_fast<0>(F); } }
    SEAM(3);
#else
    if (IN(3)) { p3_attn_simple(F); } SEAM(3);
#endif

    if (IN(4)) {
        pg8::Gemm g{F.mixed, F.Wout_t, M, D, D}; pg8::StaticOrder S; S.init(M, D, F.G, (int)blockIdx.x);
        pg8::EpiPre E{F.x, F.out};
        pg8::gemm_phase<pg8::EpiPre, pg8::StaticOrder, true, true>(F.lds + RING_OFF, g, S, E);
    } SEAM(4);

    if (IN(5)) { p5_ln_route(F); } SEAM(5);

    if (IN(6)) {
        p6_slots_gather(F);
        { pg8::Gemm g{F.hb, F.Wpg_t, M, D, D}; pg8::StaticOrder S; S.init(M, D, F.G, (int)blockIdx.x);
          pg8::EpiPle E{F.pple};
          pg8::gemm_phase<pg8::EpiPle, pg8::StaticOrder, true, true>(F.lds + RING_OFF, g, S, E); }
    } SEAM(6);

    if (IN(7)) {
        build_pstart(F);
        const LAS int* pst = (const LAS int*)(F.lds + PST_OFF);
        pg8::Gemm g{F.xs, F.Wgu_t, SPAD, NE * 1024, D}; MoeOrder S{pst, (pst[NE] >> 8) * 4, F.G, (int)blockIdx.x};
        pg8::EpiSwiglu E{F.hdn, F.gslot};
        pg8::gemm_phase<pg8::EpiSwiglu, MoeOrder, true, true>(F.lds + RING_OFF, g, S, E);
    } SEAM(7);

    if (IN(8)) {
        build_pstart(F);
        const LAS int* pst = (const LAS int*)(F.lds + PST_OFF);
        pg8::Gemm g{F.hdn, F.Wd_t, SPAD, NE * 1024, DF}; MoeOrder S{pst, (pst[NE] >> 8) * 4, F.G, (int)blockIdx.x};
        pg8::EpiBf16<0> E{F.y, D, nullptr, 1024, 0, 1.f};
        pg8::gemm_phase<pg8::EpiBf16<0>, MoeOrder, true, true>(F.lds + RING_OFF, g, S, E);
    } SEAM(8);

    if (IN(9)) {
        const bool poison = __hip_atomic_load((gu32*)((unsigned*)(F.ctl + CW_BAR) + XB_TMO), RLX_AGENT) != 0u || F.G != 256;
        p9_final(F, poison);
    }
    if (PROBE_PH >= 0 && blockIdx.x == 0) {
        const unsigned long long now = rt(); if (PROBE_PH == NPH - 1) pt1_ = now;
        const unsigned long long dur = pt1_ - pt0_;
        if (F.tid == 0) while (rt() - now < 4ull * dur) __builtin_amdgcn_s_sleep(8);
        __syncthreads();
    }
#undef IN
#undef SEAM
}

#ifndef MK_CUTS
#define MK_CUTS 0
#endif
extern "C" void kernel_launch(void* const* d_in, const int* in_sizes, int n_in, void* d_out, int out_size, void* d_ws, size_t ws_size, hipStream_t stream) {
    static int grid = 0;
    if (grid == 0) {
        if (n_in != 18 || in_sizes[0] != M * D || out_size != M * D || ws_size < WS_END) { fprintf(stderr, "kernel_launch: shape/workspace mismatch (n_in %d, in0 %d, out %d, ws %zu)\n", n_in, n_in > 0 ? in_sizes[0] : -1, out_size, ws_size); grid = -1; return; }
        int dev = 0, cus = 0, per_cu = 0;
        if (hipGetDevice(&dev) != hipSuccess || hipDeviceGetAttribute(&cus, hipDeviceAttributeMultiprocessorCount, dev) != hipSuccess) { grid = -1; return; }
        if (hipFuncSetAttribute((const void*)mk_fwd, hipFuncAttributeMaxDynamicSharedMemorySize, LDS_BYTES) != hipSuccess) { fprintf(stderr, "kernel_launch: hipFuncSetAttribute failed\n"); grid = -1; return; }
        if (hipOccupancyMaxActiveBlocksPerMultiprocessor(&per_cu, (const void*)mk_fwd, NTHR, LDS_BYTES) != hipSuccess || per_cu < 1) fprintf(stderr, "kernel_launch: occupancy query reports %d\n", per_cu);
        (void)hipGetLastError();
        grid = cus;
        if (grid != 256) fprintf(stderr, "kernel_launch: %d CUs; this kernel is built for 256\n", grid);
    }
    if (grid < 0) return;
    if (hipMemsetAsync((char*)d_ws + WS_CTL, 0, CTL_ZERO_BYTES, stream) != hipSuccess) return;
    Args a{};
    for (int i = 0; i < 18; ++i) a.in[i] = (const float*)d_in[i];
    a.out = (float*)d_out; a.ws = (unsigned char*)d_ws;
#if MK_CUTS
    for (int ph = 0; ph < NPH; ++ph) { a.ph_lo = ph; a.ph_hi = ph + 1; hipLaunchKernelGGL(mk_fwd, dim3(grid), dim3(NTHR), LDS_BYTES, stream, a); }
#else
    a.ph_lo = 0; a.ph_hi = NPH;
    hipLaunchKernelGGL(mk_fwd, dim3(grid), dim3(NTHR), LDS_BYTES, stream, a);
#endif
}
```

```cpp
#include <hip/hip_runtime.h>
#include <hip/hip_bf16.h>
#include <cstdio>
#include <cstdint>
#include <cmath>
namespace pg8 {
#define PG8_LAS __attribute__((address_space(3)))
typedef unsigned short bf16_t;
typedef short bf16x8 __attribute__((ext_vector_type(8)));
typedef float f32x4 __attribute__((ext_vector_type(4)));
typedef unsigned u32x4 __attribute__((ext_vector_type(4)));
constexpr int BM = 256, BK = 64, HALF = 128, HTB = HALF * BK * 2  , STAGE_BYTES = 8 * HTB, NXCD = 8, WGM = 8;

__host__ __device__ __forceinline__ int lds_byte(int r, int c) { const int st = (r >> 4) * 2 + (c >> 5), rr = r & 15, cc = c & 31, ob = rr * 64 + cc * 2; return st * 1024 + (ob ^ (((ob >> 9) & 1) << 5)); }
__host__ __device__ __forceinline__ void stage_rc(int b, int& R, int& C) { const int st = b / 1024, sb = b % 1024, swz = sb ^ (((sb >> 9) & 1) << 5); R = (st >> 1) * 16 + swz / 64; C = (st & 1) * 32 + (swz % 64) / 2; }
__host__ __device__ __forceinline__ int perm32(int rho) { const int n = rho >> 4, i = rho & 15; return 8 * (i >> 2) + 4 * n + (i & 3); }

struct Unit { int pm, pn; };
struct Gemm { const bf16_t* A; const bf16_t* Bt; int M, N, K; };

struct StaticOrder {
    int nM, nN, nwg, G, c;
    __host__ __device__ void init(int M, int N, int G_, int c_) { nM = M / BM; nN = N / BM; nwg = nM * nN; G = G_; c = c_; }
    __host__ __device__ bool next(int i, Unit& u) const {
        const long L = (long)i * G + c; if (L >= nwg) return false;
        int wgid = (int)L; { const int q = nwg / NXCD, r = nwg % NXCD, xcd = wgid % NXCD, off = wgid / NXCD; wgid = (xcd < r ? xcd * (q + 1) : r * (q + 1) + (xcd - r) * q) + off; }
        const int nig = WGM * nN, gid = wgid / nig, fm = gid * WGM, gsz = (nM - fm) < WGM ? (nM - fm) : WGM;
        u.pm = fm + ((wgid % nig) % gsz); u.pn = (wgid % nig) / gsz; return true;
    }
    __device__ __forceinline__ void a_ready(const Unit&) const {}
    __device__ __forceinline__ void done(const Unit&) const {}
};

__device__ __forceinline__ unsigned cvt_pk_bf16(float lo, float hi) { unsigned r; asm volatile("v_cvt_pk_bf16_f32 %0, %1, %2" : "=v"(r) : "v"(lo), "v"(hi)); return r; }
typedef float f32x2 __attribute__((ext_vector_type(2)));
__device__ __forceinline__ f32x2 gelu_pk(f32x2 v) {
    const f32x2 av = __builtin_elementwise_abs(v), d = av * 0.2316418882f + 1.0f;
    f32x2 t; t.x = __builtin_amdgcn_rcpf(d.x); t.y = __builtin_amdgcn_rcpf(d.y);
    f32x2 q = t * 0.5307027145f + (-0.7265760135f); q = q * t + 0.7107068705f; q = q * t + (-0.142248368f); q = q * t + 0.127414796f; q = q * t;
    const f32x2 s = (v * v) * (-0.72134752044f);
    f32x2 e; e.x = __builtin_amdgcn_exp2f(s.x); e.y = __builtin_amdgcn_exp2f(s.y);
    const f32x2 m = v * (q * e), r = v - m;
    f32x2 o; o.x = v.x < 0.f ? m.x : r.x; o.y = v.y < 0.f ? m.y : r.y; return o;
}

template <int ACT  > struct EpiBf16 {
    static constexpr bool PERM = true, AFTER_DRAIN = false; static_assert(ACT == 0 || ACT == 1, "EpiBf16: ACT is 0 (none) or 1 (gelu_pk)");
    bf16_t* O; int ldc; const float* bias; int split_cols; size_t split_stride; float scale0;
    __device__ __forceinline__ void operator()(const f32x4 (&acc)[2][2][4][2], const Unit& u, int wr, int wc, int fr, int fq) const {
        const int row0 = u.pm * BM + wr * 64 + fr; int colt = u.pn * BM; bf16_t* base = O;
        float sc = 1.f; if (split_cols) { const int t = colt / split_cols; base += (size_t)t * split_stride; colt -= t * split_cols; if (t == 0) sc = scale0; }
        const int col0 = colt + wc * 32 + 8 * fq, bcol0 = u.pn * BM + wc * 32 + 8 * fq;
        f32x4 bv[2][2];
#pragma unroll
        for (int bj = 0; bj < 2; ++bj)
#pragma unroll
            for (int n = 0; n < 2; ++n) bv[bj][n] = bias ? *(const f32x4*)(bias + bcol0 + bj * HALF + 4 * n) : (f32x4){0.f, 0.f, 0.f, 0.f};
#pragma unroll
        for (int ai = 0; ai < 2; ++ai)
#pragma unroll
            for (int m = 0; m < 4; ++m) { bf16_t* rowp = base + (size_t)(row0 + ai * HALF + m * 16) * ldc + col0;
#pragma unroll
                for (int bj = 0; bj < 2; ++bj) { f32x4 v0 = acc[ai][bj][m][0] + bv[bj][0], v1 = acc[ai][bj][m][1] + bv[bj][1];
                    if (ACT == 1) { f32x2 a = gelu_pk((f32x2){v0[0], v0[1]}), b = gelu_pk((f32x2){v0[2], v0[3]}), c = gelu_pk((f32x2){v1[0], v1[1]}), d = gelu_pk((f32x2){v1[2], v1[3]});
                        v0 = (f32x4){a.x, a.y, b.x, b.y}; v1 = (f32x4){c.x, c.y, d.x, d.y}; }
                    v0 = v0 * sc; v1 = v1 * sc; u32x4 w; w.x = cvt_pk_bf16(v0[0], v0[1]); w.y = cvt_pk_bf16(v0[2], v0[3]); w.z = cvt_pk_bf16(v1[0], v1[1]); w.w = cvt_pk_bf16(v1[2], v1[3]);
                    *(u32x4*)(rowp + bj * HALF) = w; } }
    }
};

struct PanelStats {
    unsigned* xbuf;
    unsigned* cnt;
    unsigned* tmo;
    int ntn; float eps;
    unsigned code;
    __device__ __forceinline__ bool run(const f32x4 (&v)[2][2][4][2], const Unit& u, int wr, int wc, int fr, int fq, PG8_LAS unsigned char* lds, int wid, int lane) const {
        typedef float f32x2v __attribute__((ext_vector_type(2)));
        PG8_LAS f32x2v* P = (PG8_LAS f32x2v*)lds;
        PG8_LAS f32x2v* S = (PG8_LAS f32x2v*)(lds + 8192);
        PG8_LAS unsigned* flag = (PG8_LAS unsigned*)(lds + 8192 + 2048);
#pragma unroll
        for (int ai = 0; ai < 2; ++ai)
#pragma unroll
            for (int m = 0; m < 4; ++m) {
                float s = 0.f;
#pragma unroll
                for (int bj = 0; bj < 2; ++bj)
#pragma unroll
                    for (int n = 0; n < 2; ++n) { const f32x4 x = v[ai][bj][m][n]; s += (x[0] + x[1]) + (x[2] + x[3]); }
                s += __shfl_xor(s, 16); s += __shfl_xor(s, 32);
                const float mw = s * (1.0f / 64.0f); float q = 0.f;
#pragma unroll
                for (int bj = 0; bj < 2; ++bj)
#pragma unroll
                    for (int n = 0; n < 2; ++n) { const f32x4 d = v[ai][bj][m][n] - mw; q += (d[0] * d[0] + d[1] * d[1]) + (d[2] * d[2] + d[3] * d[3]); }
                q += __shfl_xor(q, 16); q += __shfl_xor(q, 32);
                if (fq == 0) P[(ai * HALF + wr * 64 + m * 16 + fr) * 4 + wc] = (f32x2v){mw, q};
            }
        asm volatile("s_waitcnt lgkmcnt(0)" ::: "memory"); __builtin_amdgcn_s_barrier(); asm volatile("" ::: "memory");
#if defined(BROKEN_EXCHANGE_NO_WAIT)
#warning BROKEN CONTROL BUILD: the row-statistics exchange does not wait; results are wrong by design
        if (blockIdx.x >= 64) { const long long t0_ = clock64(); while (clock64() - t0_ < 60000) __builtin_amdgcn_s_sleep(8); }
#endif
        const int row = wid * 32 + (lane & 31);
        if (lane < 32) {
            const f32x2v a = P[row * 4 + 0], b = P[row * 4 + 1], c = P[row * 4 + 2], d = P[row * 4 + 3];
            const float mt = (a.x + b.x + c.x + d.x) * 0.25f;
            const float da = a.x - mt, db = b.x - mt, dc = c.x - mt, dd = d.x - mt;
            const float m2 = (a.y + b.y) + (c.y + d.y) + 64.0f * ((da * da + db * db) + (dc * dc + dd * dd));
            unsigned long long* slot = (unsigned long long*)xbuf + ((size_t)(u.pm * BM + row) * 4 + u.pn);
            __hip_atomic_store(slot, ((unsigned long long)__float_as_uint(m2) << 32) | __float_as_uint(mt), __ATOMIC_RELAXED, __HIP_MEMORY_SCOPE_AGENT);
        }
        asm volatile("s_waitcnt vmcnt(0)" ::: "memory");
        if (lane == 0) __hip_atomic_fetch_add(cnt + 64 * u.pm, 1u, __ATOMIC_RELAXED, __HIP_MEMORY_SCOPE_AGENT);
        if (wid == 0) {
            bool dead = false; const unsigned long long t0 = __builtin_amdgcn_s_memrealtime(); const unsigned want = 8u * (unsigned)ntn;
            for (;;) {
#if defined(BROKEN_EXCHANGE_NO_WAIT)
                break;
#endif
                if ((unsigned)__builtin_amdgcn_readfirstlane(__hip_atomic_load(cnt + 64 * u.pm, __ATOMIC_RELAXED, __HIP_MEMORY_SCOPE_AGENT)) >= want) break;
                if (__builtin_amdgcn_s_memrealtime() - t0 > 2000000ull) {
                    if (lane == 0) { unsigned expect = 0u; __hip_atomic_compare_exchange_strong(tmo + 1, &expect, code | (unsigned)(u.pm & 0xff), __ATOMIC_RELAXED, __ATOMIC_RELAXED, __HIP_MEMORY_SCOPE_AGENT);
                                     __hip_atomic_store(tmo, 1u, __ATOMIC_RELAXED, __HIP_MEMORY_SCOPE_AGENT); }
                    dead = true; break; }
                __builtin_amdgcn_s_sleep(2);
            }
            __builtin_amdgcn_fence(__ATOMIC_ACQUIRE, "agent");
            if (lane == 0) flag[0] = dead ? 1u : 0u;
        }
        asm volatile("s_waitcnt vmcnt(0) lgkmcnt(0)" ::: "memory"); __builtin_amdgcn_s_barrier(); asm volatile("" ::: "memory");
        const bool bad = flag[0] != 0u;
        if (lane < 32) {
            const unsigned long long* slot = (const unsigned long long*)xbuf + (size_t)(u.pm * BM + row) * 4; float mt[4], m2[4]; float ms = 0.f;
#pragma unroll
            for (int t = 0; t < 4; ++t) { if (t < ntn) { const unsigned long long w = __hip_atomic_load(slot + t, __ATOMIC_RELAXED, __HIP_MEMORY_SCOPE_AGENT); mt[t] = __uint_as_float((unsigned)w); m2[t] = __uint_as_float((unsigned)(w >> 32)); } else { mt[t] = 0.f; m2[t] = 0.f; } ms += mt[t]; }
            const float mean = ms / (float)ntn; float q = 0.f;
#pragma unroll
            for (int t = 0; t < 4; ++t) if (t < ntn) { const float dm = mt[t] - mean; q += m2[t] + 256.0f * dm * dm; }
            S[row] = (f32x2v){mean, 1.0f / sqrtf(q / (256.0f * (float)ntn) + eps)};
        }
        asm volatile("s_waitcnt lgkmcnt(0)" ::: "memory"); __builtin_amdgcn_s_barrier(); asm volatile("" ::: "memory");
        return bad;
    }
};
struct EpiLnRes {
    static constexpr bool PERM = false, AFTER_DRAIN = true;
    const float* base; float* out; int ldc; const float* bias; PanelStats st; unsigned poison;
    __device__ __forceinline__ void fused(f32x4 (&acc)[2][2][4][2], const Unit& u, int wr, int wc, int fr, int fq, PG8_LAS unsigned char* lds, int wid, int lane) const {
        typedef float f32x2v __attribute__((ext_vector_type(2)));
        const PG8_LAS f32x2v* S = (const PG8_LAS f32x2v*)(lds + 8192);
        const int col0 = u.pn * BM + wc * 32 + 4 * fq;
#pragma unroll
        for (int bj = 0; bj < 2; ++bj)
#pragma unroll
            for (int n = 0; n < 2; ++n) { const f32x4 bv = bias ? *(const f32x4*)(bias + col0 + bj * HALF + n * 16) : (f32x4){0.f, 0.f, 0.f, 0.f};
#pragma unroll
                for (int ai = 0; ai < 2; ++ai)
#pragma unroll
                    for (int m = 0; m < 4; ++m) acc[ai][bj][m][n] += bv; }
        f32x4 pre[4][2][2];
#pragma unroll
        for (int m = 0; m < 4; ++m) { const size_t off = (size_t)(u.pm * BM + wr * 64 + m * 16 + fr) * ldc + col0;
#pragma unroll
            for (int bj = 0; bj < 2; ++bj)
#pragma unroll
                for (int n = 0; n < 2; ++n) pre[m][bj][n] = *(const f32x4*)(base + off + bj * HALF + n * 16); }
        const bool bad = st.run(acc, u, wr, wc, fr, fq, lds, wid, lane) || poison != 0u;
        const float qnan = __builtin_nanf("");
#pragma unroll
        for (int ai = 0; ai < 2; ++ai)
#pragma unroll
            for (int m = 0; m < 4; ++m) { const int r = ai * HALF + wr * 64 + m * 16 + fr; const f32x2v sr = S[r]; const size_t off = (size_t)(u.pm * BM + r) * ldc + col0;
#pragma unroll
                for (int bj = 0; bj < 2; ++bj)
#pragma unroll
                    for (int n = 0; n < 2; ++n) { const f32x4 bs = ai == 0 ? pre[m][bj][n] : *(const f32x4*)(base + off + bj * HALF + n * 16); f32x4 o = bs + (acc[ai][bj][m][n] - sr.x) * sr.y;
                        if (bad) o = (f32x4){qnan, qnan, qnan, qnan}; *(f32x4*)(out + off + bj * HALF + n * 16) = o; }
                if (m & 1) asm volatile("" ::: "memory"); }
    }
};
struct EpiLnResLn {
    static constexpr bool PERM = false, AFTER_DRAIN = true;
    const float* base; float* out; bf16_t* xn; int ldc; const float* bias; PanelStats st1, st2; unsigned poison;
    __device__ __forceinline__ void fused(f32x4 (&acc)[2][2][4][2], const Unit& u, int wr, int wc, int fr, int fq, PG8_LAS unsigned char* lds, int wid, int lane) const {
        typedef float f32x2v __attribute__((ext_vector_type(2))); typedef unsigned u32x2v __attribute__((ext_vector_type(2)));
        const PG8_LAS f32x2v* S = (const PG8_LAS f32x2v*)(lds + 8192);
        const int col0 = u.pn * BM + wc * 32 + 4 * fq;
#pragma unroll
        for (int bj = 0; bj < 2; ++bj)
#pragma unroll
            for (int n = 0; n < 2; ++n) { const f32x4 bv = bias ? *(const f32x4*)(bias + col0 + bj * HALF + n * 16) : (f32x4){0.f, 0.f, 0.f, 0.f};
#pragma unroll
                for (int ai = 0; ai < 2; ++ai)
#pragma unroll
                    for (int m = 0; m < 4; ++m) acc[ai][bj][m][n] += bv; }
        bool bad = st1.run(acc, u, wr, wc, fr, fq, lds, wid, lane) || poison != 0u;
        const float qnan = __builtin_nanf("");
#pragma unroll
        for (int ai = 0; ai < 2; ++ai)
#pragma unroll
            for (int m = 0; m < 4; ++m) { const int r = ai * HALF + wr * 64 + m * 16 + fr; const f32x2v sr = S[r]; const size_t off = (size_t)(u.pm * BM + r) * ldc + col0;
#pragma unroll
                for (int bj = 0; bj < 2; ++bj)
#pragma unroll
                    for (int n = 0; n < 2; ++n) { const f32x4 bs = *(const f32x4*)(base + off + bj * HALF + n * 16); acc[ai][bj][m][n] = bs + (acc[ai][bj][m][n] - sr.x) * sr.y; }
                asm volatile("" : "+v"(acc[ai][0][m][0]), "+v"(acc[ai][0][m][1]), "+v"(acc[ai][1][m][0]), "+v"(acc[ai][1][m][1]));
                if (m & 1) asm volatile("" ::: "memory"); }
        const bool bad1 = bad;
        bad = st2.run(acc, u, wr, wc, fr, fq, lds, wid, lane) || bad;
#pragma unroll
        for (int ai = 0; ai < 2; ++ai)
#pragma unroll
            for (int m = 0; m < 4; ++m) { const int r = ai * HALF + wr * 64 + m * 16 + fr; const f32x2v sr = S[r]; const size_t off = (size_t)(u.pm * BM + r) * ldc + col0;
#pragma unroll
                for (int bj = 0; bj < 2; ++bj)
#pragma unroll
                    for (int n = 0; n < 2; ++n) { const f32x4 x1 = acc[ai][bj][m][n]; *(f32x4*)(out + off + bj * HALF + n * 16) = bad1 ? (f32x4){qnan, qnan, qnan, qnan} : x1;
                        const f32x4 o = (x1 - sr.x) * sr.y; u32x2v w; w.x = cvt_pk_bf16(o[0], o[1]); w.y = cvt_pk_bf16(o[2], o[3]);
                        if (bad) { w.x = 0x7fc07fc0u; w.y = 0x7fc07fc0u; } *(u32x2v*)(xn + off + bj * HALF + n * 16) = w; }
                asm volatile("" ::: "memory"); }
    }
};

template <class Epi, class Sched, bool ALIGN_EPI = false, bool SP2 = false>
__device__ __forceinline__ void gemm_phase(PG8_LAS unsigned char* lds, const Gemm g, const Sched& S, const Epi& E) {
    const int tid = threadIdx.x, wid = __builtin_amdgcn_readfirstlane(tid >> 6), lane = tid & 63, wr = wid >> 2, wc = wid & 3, fr = lane & 15, fq = lane >> 4;
    const int K = g.K, nt = K / BK;
    unsigned voffA[2], voffB[2];
#pragma unroll
    for (int i = 0; i < 2; ++i) { int R, C; stage_rc(tid * 16 + i * 8192, R, C); const int Rb = Epi::PERM ? ((R & ~31) + perm32(R & 31)) : R;
        voffA[i] = (unsigned)(R * K + C) * 2u; voffB[i] = (unsigned)(Rb * K + C) * 2u; }
    const size_t kstep = (size_t)(BK * 2);
    const size_t hstep = (size_t)HALF * K * 2;
    const size_t tstep = 2 * hstep;
    const unsigned ldsw = (unsigned)wid * 1024u;
    const int aoff = lds_byte(wr * 64 + fr, fq * 8), boff = lds_byte(wc * 32 + fr, fq * 8);
#define PG8_SA(b, h) (((b) * 2 + (h)) * HTB)
#define PG8_SB(b, h) ((4 + (b) * 2 + (h)) * HTB)
#define PG8_STAGE(bufoff, gbase, voff) do { _Pragma("unroll") for (int _i = 0; _i < 2; ++_i) \
        __builtin_amdgcn_global_load_lds((const unsigned*)((const char*)(gbase) + (voff)[_i]), (PG8_LAS unsigned*)(lds + (bufoff) + ldsw + _i * 8192), 16, 0, 0); } while (0)
#define PG8_LDA(dst, b, h) do { _Pragma("unroll") for (int m = 0; m < 4; ++m) _Pragma("unroll") for (int k = 0; k < 2; ++k) dst[m][k] = *(const PG8_LAS bf16x8*)(lds + PG8_SA(b, h) + aoff + m * 2048 + k * 1024); } while (0)
#define PG8_LDB(dst, b, h) do { _Pragma("unroll") for (int n = 0; n < 2; ++n) _Pragma("unroll") for (int k = 0; k < 2; ++k) dst[n][k] = *(const PG8_LAS bf16x8*)(lds + PG8_SB(b, h) + boff + n * 2048 + k * 1024); } while (0)
#define PG8_MMA(ai, bj, At, Bt) do { __builtin_amdgcn_s_setprio(1); _Pragma("unroll") for (int m = 0; m < 4; ++m) _Pragma("unroll") for (int n = 0; n < 2; ++n) _Pragma("unroll") for (int k = 0; k < 2; ++k) \
        acc[ai][bj][m][n] = __builtin_amdgcn_mfma_f32_16x16x32_bf16(Bt[n][k], At[m][k], acc[ai][bj][m][n], 0, 0, 0); __builtin_amdgcn_s_setprio(0); } while (0)
#define PG8_WAIT_V(n) asm volatile("s_waitcnt vmcnt(" #n ")" ::: "memory")
#define PG8_WAIT_L(n) asm volatile("s_waitcnt lgkmcnt(" #n ")" ::: "memory")
#define PG8_BAR __builtin_amdgcn_s_barrier()
#define PG8_SCHED __builtin_amdgcn_sched_barrier(0)
    Unit cur, nxt; int ui = 0;
    if (!S.next(0, cur)) return;
    f32x4 acc[2][2][4][2];
#pragma unroll
    for (int a = 0; a < 2; ++a)
#pragma unroll
        for (int b = 0; b < 2; ++b)
#pragma unroll
            for (int m = 0; m < 4; ++m)
#pragma unroll
                for (int n = 0; n < 2; ++n) acc[a][b][m][n] = (f32x4){0.f, 0.f, 0.f, 0.f};
    bf16x8 At[4][2], B0[2][2], B1[2][2];
    const char* cA = (const char*)g.A + (size_t)cur.pm * tstep; const char* cB = (const char*)g.Bt + (size_t)cur.pn * tstep;
    S.a_ready(cur);
    if constexpr (SP2) {
        PG8_STAGE(PG8_SB(0, 0), cB, voffB); PG8_STAGE(PG8_SB(0, 1), cB + hstep, voffB); PG8_STAGE(PG8_SA(0, 0), cA, voffA); PG8_STAGE(PG8_SA(0, 1), cA + hstep, voffA);
        if (wr == 1) PG8_BAR;
        PG8_WAIT_V(2); PG8_BAR;
        PG8_STAGE(PG8_SB(1, 0), cB + kstep, voffB); PG8_STAGE(PG8_SA(1, 0), cA + kstep, voffA); PG8_STAGE(PG8_SB(1, 1), cB + hstep + kstep, voffB);
        PG8_WAIT_V(6); PG8_BAR;
    } else {
        PG8_STAGE(PG8_SB(0, 0), cB, voffB); PG8_STAGE(PG8_SA(0, 0), cA, voffA); PG8_STAGE(PG8_SB(0, 1), cB + hstep, voffB); PG8_STAGE(PG8_SA(0, 1), cA + hstep, voffA);
        if (wr == 1) PG8_BAR;
        PG8_WAIT_V(4); PG8_BAR;
        PG8_STAGE(PG8_SB(1, 0), cB + kstep, voffB); PG8_STAGE(PG8_SA(1, 0), cA + kstep, voffA); PG8_STAGE(PG8_SB(1, 1), cB + hstep + kstep, voffB);
        PG8_WAIT_V(6); PG8_BAR;
    }
    for (;;) {
        const bool has_next = S.next(ui + 1, nxt);
        const char* nA = has_next ? (const char*)g.A + (size_t)nxt.pm * tstep : cA; const char* nB = has_next ? (const char*)g.Bt + (size_t)nxt.pn * tstep : cB;
        for (int t = 0; t < nt; t += 2) {
            const bool last = (t == nt - 2);
            const char* a1 = cA + (size_t)(t + 1) * kstep;
            const char* a2 = last ? nA : cA + (size_t)(t + 2) * kstep; const char* b2 = last ? nB : cB + (size_t)(t + 2) * kstep;
            const char* a3 = a2 + kstep; const char* b3 = b2 + kstep;
            if (last && has_next) S.a_ready(nxt);
            if constexpr (SP2) {
            PG8_LDB(B0, 0, 0); PG8_LDB(B1, 0, 1); PG8_SCHED; PG8_LDA(At, 0, 0); PG8_STAGE(PG8_SA(1, 1), a1 + hstep, voffA);
            PG8_WAIT_V(8); PG8_WAIT_L(0); PG8_BAR; PG8_MMA(0, 0, At, B0); PG8_MMA(0, 1, At, B1); PG8_BAR; PG8_SCHED;
            PG8_LDA(At, 0, 1); PG8_STAGE(PG8_SB(0, 0), b2, voffB); PG8_STAGE(PG8_SB(0, 1), b2 + hstep, voffB); PG8_STAGE(PG8_SA(0, 0), a2, voffA);
            PG8_WAIT_V(8); PG8_WAIT_L(0); PG8_BAR; PG8_MMA(1, 0, At, B0); PG8_MMA(1, 1, At, B1); PG8_BAR; PG8_SCHED;
            PG8_LDB(B0, 1, 0); PG8_LDB(B1, 1, 1); PG8_SCHED; PG8_LDA(At, 1, 0); PG8_STAGE(PG8_SA(0, 1), a2 + hstep, voffA);
            PG8_WAIT_V(8); PG8_WAIT_L(0); PG8_BAR; PG8_MMA(0, 0, At, B0); PG8_MMA(0, 1, At, B1); PG8_BAR; PG8_SCHED;
            PG8_LDA(At, 1, 1); PG8_STAGE(PG8_SB(1, 0), b3, voffB); PG8_STAGE(PG8_SB(1, 1), b3 + hstep, voffB); PG8_STAGE(PG8_SA(1, 0), a3, voffA);
            PG8_WAIT_V(8); PG8_WAIT_L(0); PG8_BAR; PG8_MMA(1, 0, At, B0); PG8_MMA(1, 1, At, B1); PG8_BAR; PG8_SCHED;
            } else {
            PG8_LDB(B0, 0, 0); PG8_SCHED; PG8_LDA(At, 0, 0); PG8_STAGE(PG8_SA(1, 1), a1 + hstep, voffA);
            PG8_WAIT_L(8); PG8_BAR; PG8_WAIT_L(0); PG8_MMA(0, 0, At, B0); PG8_BAR; PG8_SCHED;
            PG8_LDB(B1, 0, 1); PG8_STAGE(PG8_SB(0, 0), b2, voffB);
            PG8_BAR; PG8_WAIT_L(0); PG8_MMA(0, 1, At, B1); PG8_BAR;
            PG8_LDA(At, 0, 1); PG8_STAGE(PG8_SA(0, 0), a2, voffA);
            PG8_BAR; PG8_WAIT_L(0); PG8_MMA(1, 0, At, B0); PG8_BAR; PG8_SCHED;
            PG8_STAGE(PG8_SB(0, 1), b2 + hstep, voffB);
            PG8_WAIT_V(6); PG8_BAR; PG8_MMA(1, 1, At, B1); PG8_BAR;
            PG8_LDB(B0, 1, 0); PG8_SCHED; PG8_LDA(At, 1, 0); PG8_STAGE(PG8_SA(0, 1), a2 + hstep, voffA);
            PG8_WAIT_L(8); PG8_BAR; PG8_WAIT_L(0); PG8_MMA(0, 0, At, B0); PG8_BAR; PG8_SCHED;
            PG8_LDB(B1, 1, 1); PG8_STAGE(PG8_SB(1, 0), b3, voffB);
            PG8_BAR; PG8_WAIT_L(0); PG8_MMA(0, 1, At, B1); PG8_BAR;
            PG8_LDA(At, 1, 1); PG8_STAGE(PG8_SA(1, 0), a3, voffA);
            PG8_BAR; PG8_WAIT_L(0); PG8_MMA(1, 0, At, B0); PG8_BAR; PG8_SCHED;
            PG8_STAGE(PG8_SB(1, 1), b3 + hstep, voffB);
            PG8_WAIT_V(6); PG8_BAR; PG8_MMA(1, 1, At, B1); PG8_BAR;
            }
        }
        if constexpr (ALIGN_EPI) { if (wr == 0) PG8_BAR; }
        if constexpr (!Epi::AFTER_DRAIN) { E(acc, cur, wr, wc, fr, fq); S.done(cur); }
        if (!has_next) break;
#pragma unroll
        for (int a = 0; a < 2; ++a)
#pragma unroll
            for (int b = 0; b < 2; ++b)
#pragma unroll
                for (int m = 0; m < 4; ++m)
#pragma unroll
                    for (int n = 0; n < 2; ++n) acc[a][b][m][n] = (f32x4){0.f, 0.f, 0.f, 0.f};
        cur = nxt; cA = nA; cB = nB; ++ui;
        if constexpr (ALIGN_EPI) { if (wr == 1) PG8_BAR; }
    }
    PG8_WAIT_V(0);
    if constexpr (!ALIGN_EPI) { if (wr == 0) PG8_BAR; }
    PG8_BAR;
    if constexpr (Epi::AFTER_DRAIN) { E.fused(acc, cur, wr, wc, fr, fq, lds, wid, lane); S.done(cur); }
#undef PG8_SA
#undef PG8_SB
#undef PG8_STAGE
#undef PG8_LDA
#undef PG8_LDB
#undef PG8_MMA
#undef PG8_WAIT_V
#undef PG8_WAIT_L
#undef PG8_BAR
#undef PG8_SCHED
}
}
namespace pg8 {
template <class F> struct EpiScalar {
    static constexpr bool PERM = true, AFTER_DRAIN = false; F f;
    __device__ __forceinline__ void operator()(const f32x4 (&acc)[2][2][4][2], const Unit& u, int wr, int wc, int fr, int fq) const {
        const int row0 = u.pm * BM + wr * 64 + fr, col0 = u.pn * BM + wc * 32 + 8 * fq;
#pragma unroll
        for (int ai = 0; ai < 2; ++ai)
#pragma unroll
            for (int m = 0; m < 4; ++m) {
#pragma unroll
                for (int bj = 0; bj < 2; ++bj)
#pragma unroll
                    for (int n = 0; n < 2; ++n)
#pragma unroll
                        for (int e = 0; e < 4; ++e) f(row0 + ai * HALF + m * 16, col0 + bj * HALF + 4 * n + e, acc[ai][bj][m][n][e]);
                asm volatile("" ::: "memory"); }
    }
};
template <class F> struct EpiScalarPair {
    static constexpr bool PERM = true, AFTER_DRAIN = false; F f;
    __device__ __forceinline__ void operator()(const f32x4 (&acc)[2][2][4][2], const Unit& u, int wr, int wc, int fr, int fq) const {
        const int row0 = u.pm * BM + wr * 64 + fr, cl0 = wc * 32 + 8 * fq;
#pragma unroll
        for (int ai = 0; ai < 2; ++ai)
#pragma unroll
            for (int m = 0; m < 4; ++m) {
#pragma unroll
                for (int n = 0; n < 2; ++n)
#pragma unroll
                    for (int e = 0; e < 4; ++e) f(row0 + ai * HALF + m * 16, u.pn, cl0 + 4 * n + e, acc[ai][0][m][n][e], acc[ai][1][m][n][e]);
                asm volatile("" ::: "memory"); }
    }
};
}
#define GAS __attribute__((address_space(1)))
#define LAS __attribute__((address_space(3)))
typedef unsigned short bf16;
typedef unsigned v4u __attribute__((ext_vector_type(4)));
typedef float f32x4 __attribute__((ext_vector_type(4)));
typedef short bf16x8 __attribute__((ext_vector_type(8)));
typedef GAS unsigned gu32;
typedef GAS unsigned long long gu64;
#define RLX_AGENT __ATOMIC_RELAXED, __HIP_MEMORY_SCOPE_AGENT
#define LDS_WAIT() asm volatile("s_waitcnt lgkmcnt(0)" ::: "memory")
#define VM_WAIT() asm volatile("s_waitcnt vmcnt(0)" ::: "memory")
__device__ __forceinline__ unsigned long long rt() { return __builtin_amdgcn_s_memrealtime(); }
__device__ __forceinline__ unsigned f2bf(float f) { unsigned u = __builtin_bit_cast(unsigned, f); return (u + 0x7fffu + ((u >> 16) & 1u)) >> 16; }
__device__ __forceinline__ unsigned pk2(float lo, float hi) { return f2bf(lo) | (f2bf(hi) << 16); }

#define XB_TMO      128
#define XB_XCNT(j)  (256  + 64 * (j))
#define XB_XSUB(j)  (1280 + 64 * (j))
#define XB_XGEN(j)  (2304 + 64 * (j))
#define XB_TOP      3328
#define XB_TOPGEN   3392
#define XCD_BAR_WORDS 3456
#define XB_SPIN_CAP (1u << 18)

__device__ __forceinline__ unsigned xb_ld(unsigned* p)              { return __hip_atomic_load(p, __ATOMIC_RELAXED, __HIP_MEMORY_SCOPE_AGENT); }
__device__ __forceinline__ unsigned xb_add(unsigned* p, unsigned v) { return __hip_atomic_fetch_add(p, v, __ATOMIC_RELAXED, __HIP_MEMORY_SCOPE_AGENT); }
__device__ __forceinline__ unsigned xb_xcc_id() { return (unsigned)__builtin_amdgcn_s_getreg((3 << 11) | 20) & 0xFu; }
#define XB_SPIN(cond, bar) do { unsigned _sp = 0; while (cond) { __builtin_amdgcn_s_sleep(1); \
    if ((++_sp & 255u) == 0u) { if (xb_ld(&(bar)[XB_TMO])) break; if (_sp > XB_SPIN_CAP) { atomicAdd(&(bar)[XB_TMO], 1u); break; } } } } while (0)

struct XcdBarrier {
    unsigned* bar; unsigned x;
    volatile LAS unsigned* st;
};

__device__ __forceinline__ XcdBarrier xcd_barrier_post(unsigned* bar, volatile LAS unsigned* st) {
    XcdBarrier b; b.bar = bar; b.x = xb_xcc_id(); b.st = st;
    if (threadIdx.x == 0) (void)xb_add(&bar[XB_XCNT(b.x)], 1u);
    return b;
}
__device__ __forceinline__ void xcd_barrier_complete(unsigned* bar, unsigned x, unsigned& nloc, unsigned& nx) {
    const unsigned G = gridDim.x * gridDim.y * gridDim.z;
    unsigned sum, cnt, mine, sp = 0u;
    for (;;) {
        sum = 0u; cnt = 0u; mine = 0u;
#pragma unroll
        for (unsigned j = 0; j < 16; ++j) { const unsigned c = xb_ld(&bar[XB_XCNT(j)]); sum += c; cnt += (c > 0u) ? 1u : 0u; mine = (j == x) ? c : mine; }
        if (sum == G) break;
        __builtin_amdgcn_s_sleep(1);
        if ((++sp & 255u) == 0u) { if (xb_ld(&bar[XB_TMO])) break; if (sp > XB_SPIN_CAP) { atomicAdd(&bar[XB_TMO], 1u); break; } }
    }
    nloc = mine > 0u ? mine : 1u; nx = cnt > 0u ? cnt : 1u;
}

__device__ __forceinline__ void xcd_barrier(const XcdBarrier& b) {
    asm volatile("s_waitcnt vmcnt(0)" ::: "memory");
    __syncthreads();
    if (threadIdx.x == 0) {
        unsigned* bar = b.bar;
        __builtin_amdgcn_s_waitcnt(0);
        unsigned nloc = b.st[0], nx = b.st[1];
        if (nloc == 0u) { xcd_barrier_complete(bar, b.x, nloc, nx); b.st[0] = nloc; b.st[1] = nx; }
        const unsigned old = xb_add(&bar[XB_XSUB(b.x)], 1u);
        const unsigned gen = old / nloc;
        if (old + 1u == (gen + 1u) * nloc) {
            __builtin_amdgcn_fence(__ATOMIC_RELEASE, "agent");
            asm volatile("s_waitcnt vmcnt(0)" ::: "memory");
            const unsigned og = xb_add(&bar[XB_TOP], 1u);
            const unsigned tg = og / nx;
            if (og + 1u == (tg + 1u) * nx) xb_add(&bar[XB_TOPGEN], 1u);
            else XB_SPIN(xb_ld(&bar[XB_TOPGEN]) == tg, bar);
            __builtin_amdgcn_fence(__ATOMIC_ACQUIRE, "agent");
            xb_add(&bar[XB_XGEN(b.x)], 1u);
            asm volatile("s_waitcnt vmcnt(0)" ::: "memory");
        } else {
            XB_SPIN(xb_ld(&bar[XB_XGEN(b.x)]) == gen, bar);
            __builtin_amdgcn_fence(__ATOMIC_ACQUIRE, "agent");
            asm volatile("s_waitcnt vmcnt(0)" ::: "memory");
        }
    }
    __syncthreads();
}
#ifndef ATT_FAST
#define ATT_FAST 1
#endif

constexpr int NWAVES = 8, NTHR = NWAVES * 64;
constexpr int BATCH = 4, SEQ = 8192, D = 1024, M = BATCH * SEQ;
constexpr int NHG = 8, HD = 64, HW = NHG * HD;
constexpr int INCOLS = 3080, NPROJ = 3072;
constexpr int NE = 32, NGRP = 4, EPG = 8, DF = 512, PLED = 256;
constexpr int SPAD = 2 * M + NE * 256;
constexpr float ALPHA = 1.189207115002721f, LN_EPS = 1e-5f, LOG2E = 1.4426950408889634f;
constexpr int NPH = 10;

constexpr size_t MiB = 1u << 20;
constexpr size_t WS_CTL = 0, CTL_ZERO_BYTES = 256 * 1024;
constexpr size_t WS_LS = 1 * MiB, WS_CFL = 2 * MiB, WS_CTOT = 3 * MiB, WS_KNT = 3 * MiB + 4096, WS_EID = 3 * MiB + 256 * 1024, WS_GATE = 3 * MiB + 512 * 1024, WS_RANK = 3 * MiB + 768 * 1024,
                 WS_SLOT = 4 * MiB, WS_GSLOT = 4 * MiB + 256 * 1024;
constexpr size_t WS_WIN = 5 * MiB, WS_WOUT = 11 * MiB, WS_WPLE = 13 * MiB, WS_WPG = 14 * MiB, WS_WGU = 16 * MiB, WS_WD = 80 * MiB, WS_PPLE = 112 * MiB;
constexpr size_t WS_R1 = 176 * MiB;
constexpr size_t WS_R2 = 368 * MiB;
constexpr size_t WS_R3 = 432 * MiB;
constexpr size_t WS_END = 504 * MiB;
static_assert(WS_GSLOT + (size_t)SPAD * 4 <= WS_WIN && WS_R1 + (size_t)SPAD * 2048 <= WS_R2 && WS_R3 + (size_t)SPAD * 1024 <= WS_END, "ws map");
constexpr int CW_TMO = 0, CW_BAR = 4096, CW_CNT = 8192;

constexpr int RING_OFF = 0, RING_BYTES = 131072;
constexpr int WGRP_OFF = RING_BYTES;
constexpr int LDSCTL_OFF = RING_BYTES + 16384, MISC_OFF = LDSCTL_OFF + 320, PST_OFF = LDSCTL_OFF + 1024, HIST_OFF = LDSCTL_OFF + 1280, BASE_OFF = LDSCTL_OFF + 1408, ROWL_OFF = LDSCTL_OFF + 2048;
constexpr int LDS_BYTES = 163840;

#define BFLO(w) __builtin_bit_cast(float, (w) << 16)
#define BFHI(w) __builtin_bit_cast(float, (w) & 0xffff0000u)
__device__ __forceinline__ float bf2f(unsigned short v) { return __builtin_bit_cast(float, (unsigned)v << 16); }
__device__ __forceinline__ float wave_sum(float v) {
#pragma unroll
    for (int o = 1; o < 64; o <<= 1) v += __shfl_xor(v, o);
    return v;
}
__device__ __forceinline__ float wave_max(float v) {
#pragma unroll
    for (int o = 1; o < 64; o <<= 1) v = fmaxf(v, __shfl_xor(v, o));
    return v;
}

struct Frame {
    LAS unsigned char* lds; volatile LAS unsigned* MISC; gu32* ctl;
    int tid, lane, wave, vcu, G;
    const float *x, *p, *w_in, *b_forget, *w_out, *ln1g, *ln1b, *w_group, *b_group, *w_router, *b_router, *w_gate, *w_up, *w_down, *w_ple, *w_pg, *ln2g, *ln2b;
    float* out;
    bf16 *Win_t, *Wout_t, *Wple_t, *Wpg_t, *Wgu_t, *Wd_t, *pple, *qkv, *xs, *y, *xb, *mixed, *hb, *pb, *hdn, *mixp;
    float *ls, *cfl, *ctot, *knt, *gatev, *gslot; int *eid, *rank, *slot;
};

struct TileRef { const float* src; bf16* dst; int ldw, ldt; float sc; };
__device__ __forceinline__ void tile_load(f32x4 (&r)[8], const TileRef& t, int lane) {
    const GAS float* p = (const GAS float*)t.src + (size_t)(lane >> 4) * t.ldw + 4 * (lane & 15);
#pragma unroll
    for (int i = 0; i < 8; ++i) r[i] = *(const GAS f32x4*)(p + (size_t)(4 * i) * t.ldw);
}
__device__ __forceinline__ void tile_store(const f32x4 (&r)[8], const TileRef& t, LAS float* scr, int lane) {
#pragma unroll
    for (int i = 0; i < 8; ++i) { LAS float* s = scr + (4 * i + (lane >> 4)) * 65 + 4 * (lane & 15); s[0] = r[i].x * t.sc; s[1] = r[i].y * t.sc; s[2] = r[i].z * t.sc; s[3] = r[i].w * t.sc; }
    LDS_WAIT(); asm volatile("" ::: "memory");
    const int c = lane & 3;
#pragma unroll
    for (int j = 0; j < 4; ++j) { const int n = 16 * j + (lane >> 2); const LAS float* s = scr + (8 * c) * 65 + n;
        v4u o; o.x = pk2(s[0 * 65], s[1 * 65]); o.y = pk2(s[2 * 65], s[3 * 65]); o.z = pk2(s[4 * 65], s[5 * 65]); o.w = pk2(s[6 * 65], s[7 * 65]);
        *(GAS v4u*)(t.dst + (size_t)n * t.ldt + 8 * c) = o; }
    LDS_WAIT(); asm volatile("" ::: "memory");
}
__device__ __forceinline__ float log_sigmoid_f(float v) { return fminf(v, 0.f) - log1pf(expf(-fabsf(v))); }
constexpr int I_IN = 16 * 48, I_OUT = 16 * 16, I_PLE = 4 * 16, I_PG = 16 * 16, I_GU = NE * 2 * 16 * 8, I_DN = NE * 8 * 16;
constexpr int P0_ITEMS = I_IN + I_OUT + I_PLE + I_PG + I_GU + I_DN;
__device__ __forceinline__ TileRef p0_item(Frame& F, int it, int sub) {
    int r = it; TileRef t; t.sc = 1.f;
    if (r < I_IN) { const int kb = 2 * (r / 48) + sub, nb = r % 48, s = nb >> 3;
        t.src = F.w_in + (size_t)kb * 32 * INCOLS + nb * 64; t.ldw = INCOLS; t.dst = F.Win_t + (size_t)nb * 64 * D + kb * 32; t.ldt = D; t.sc = (s == 0 || s == 3) ? 0.125f * LOG2E : 1.f; return t; } r -= I_IN;
    if (r < I_OUT) { const int kb = 2 * (r / 16) + sub, nb = r % 16; t.src = F.w_out + (size_t)kb * 32 * D + nb * 64; t.ldw = D; t.dst = F.Wout_t + (size_t)nb * 64 * D + kb * 32; t.ldt = D; return t; } r -= I_OUT;
    if (r < I_PLE) { const int kb = 2 * (r / 16) + sub, nb = r % 16; t.src = F.w_ple + (size_t)kb * 32 * D + nb * 64; t.ldw = D; t.dst = F.Wple_t + (size_t)nb * 64 * PLED + kb * 32; t.ldt = PLED; return t; } r -= I_PLE;
    if (r < I_PG) { const int kb = 2 * (r / 16) + sub, nb = r % 16; t.src = F.w_pg + (size_t)kb * 32 * D + nb * 64; t.ldw = D; t.dst = F.Wpg_t + (size_t)nb * 64 * D + kb * 32; t.ldt = D; return t; } r -= I_PG;
    if (r < I_GU) { const int e = r / 256, gu = (r >> 7) & 1, kb = 2 * ((r >> 3) & 15) + sub, nb = r & 7;
        t.src = (gu ? F.w_up : F.w_gate) + (size_t)e * D * DF + (size_t)kb * 32 * DF + nb * 64; t.ldw = DF;
        const int row = e * 1024 + (nb >> 1) * 256 + gu * 128 + (nb & 1) * 64;
        t.dst = F.Wgu_t + (size_t)row * D + kb * 32; t.ldt = D; return t; } r -= I_GU;
    { const int e = r / 128, kb = 2 * ((r >> 4) & 7) + sub, nb = r & 15;
        t.src = F.w_down + (size_t)e * DF * D + (size_t)kb * 32 * D + nb * 64; t.ldw = D; t.dst = F.Wd_t + (size_t)(e * 1024 + nb * 64) * DF + kb * 32; t.ldt = DF; return t; }
}
template <int PART> __device__ __forceinline__ void p0_prologue(Frame& F) {
    LAS float* scr = (LAS float*)(F.lds + RING_OFF + F.wave * 16384);
    const int gw = F.vcu * NWAVES + F.wave, NGW = F.G * NWAVES;
    if (PART == 0) {
        f32x4 ra[8], rb[8]; int it = gw;
        TileRef ta = p0_item(F, it < P0_ITEMS ? it : 0, 0), tb = p0_item(F, it < P0_ITEMS ? it : 0, 1);
        if (it < P0_ITEMS) { tile_load(ra, ta, F.lane); tile_load(rb, tb, F.lane); }
        while (it < P0_ITEMS) {
            const int i2 = it + NGW;
            tile_store(ra, ta, scr, F.lane);
            if (i2 < P0_ITEMS) { ta = p0_item(F, i2, 0); tile_load(ra, ta, F.lane); }
            tile_store(rb, tb, scr, F.lane);
            if (i2 < P0_ITEMS) { tb = p0_item(F, i2, 1); tile_load(rb, tb, F.lane); }
            it = i2;
        }
    }
    __syncthreads();
    if (PART == 1) {
    __syncthreads();
    LAS float* wf = (LAS float*)(F.lds + RING_OFF);
    for (int i = F.tid; i < 2048; i += NTHR) { const int c = i >> 1, j0 = (i & 1) * 4; const f32x4 w = *(const GAS f32x4*)(F.w_in + (size_t)c * INCOLS + NPROJ + j0);
        wf[(j0 + 0) * 1024 + c] = w.x; wf[(j0 + 1) * 1024 + c] = w.y; wf[(j0 + 2) * 1024 + c] = w.z; wf[(j0 + 3) * 1024 + c] = w.w; }
    __syncthreads();
    {
        f32x4 v[4], vn[4]; int m = gw;
        if (m < M) { const GAS f32x4* xr = (const GAS f32x4*)(F.x + (size_t)m * D) + F.lane;
#pragma unroll
            for (int j = 0; j < 4; ++j) v[j] = xr[64 * j]; }
        const float bfg = (F.lane < 8) ? F.b_forget[F.lane] : 0.f;
        for (; m < M; m += NGW) {
            const int mn = m + NGW;
            if (mn < M) { const GAS f32x4* xr = (const GAS f32x4*)(F.x + (size_t)mn * D) + F.lane;
#pragma unroll
                for (int j = 0; j < 4; ++j) vn[j] = xr[64 * j]; }
            GAS unsigned long long* o8 = (GAS unsigned long long*)(F.xb + (size_t)m * D) + F.lane;
#pragma unroll
            for (int j = 0; j < 4; ++j) o8[64 * j] = (unsigned long long)pk2(v[j].x, v[j].y) | ((unsigned long long)pk2(v[j].z, v[j].w) << 32);
            float mine = 0.f;
#pragma unroll
            for (int g = 0; g < 8; ++g) { float a = 0.f;
#pragma unroll
                for (int j = 0; j < 4; ++j) { const f32x4 w = *(const LAS f32x4*)(wf + g * 1024 + 4 * F.lane + 256 * j); a += (v[j].x * w.x + v[j].y * w.y) + (v[j].z * w.z + v[j].w * w.w); }
                a = wave_sum(a); if (F.lane == g) mine = a; }
            if (F.lane < 8) F.ls[(size_t)m * 8 + F.lane] = log_sigmoid_f(mine + bfg);
#pragma unroll
            for (int j = 0; j < 4; ++j) v[j] = vn[j];
        }
    }
    __syncthreads(); }
    if (PART == 2) { const int gtid = blockIdx.x * NTHR + F.tid, NT = F.G * NTHR;
      for (int i = gtid; i < M * PLED / 8; i += NT) { const GAS f32x4* s = (const GAS f32x4*)(F.p) + 2 * (size_t)i; const f32x4 a = s[0], b = s[1];
          v4u o; o.x = pk2(a.x, a.y); o.y = pk2(a.z, a.w); o.z = pk2(b.x, b.y); o.w = pk2(b.z, b.w); ((GAS v4u*)F.pb)[i] = o; } }
}

__device__ __forceinline__ void p2_scan(Frame& F) {
    LAS float* wt = (LAS float*)(F.lds + RING_OFF);
    for (int it = blockIdx.x; it < 256; it += F.G) {
        const int bh = it >> 3, chunk = it & 7, b = bh >> 3, h = bh & 7, t = chunk * 1024 + 2 * F.tid;
        const float a0 = F.ls[(size_t)(b * SEQ + t) * 8 + h] * LOG2E, a1 = F.ls[(size_t)(b * SEQ + t + 1) * 8 + h] * LOG2E;
        float s = a0 + a1;
#pragma unroll
        for (int o = 1; o < 64; o <<= 1) { const float u = __shfl_up(s, o); if (F.lane >= o) s += u; }
        __syncthreads();
        if (F.lane == 63) wt[F.wave] = s;
        __syncthreads();
        float off = 0.f, tot = 0.f;
#pragma unroll
        for (int w = 0; w < 8; ++w) { const float u = wt[w]; if (w < F.wave) off += u; tot += u; }
        const float i1 = off + s, i0 = i1 - a1;
        F.cfl[(size_t)bh * SEQ + t] = i0; F.cfl[(size_t)bh * SEQ + t + 1] = i1;
        if (F.tid == 0) F.ctot[bh * 8 + chunk] = tot;
        const bf16* kf = F.qkv + (size_t)4 * M * HW;
        float nmax = 0.f;
#pragma unroll
        for (int rr = 0; rr < 2; ++rr) { const GAS v4u* kp = (const GAS v4u*)(kf + (size_t)(b * SEQ + t + rr) * HW + h * HD); float n2 = 0.f;
#pragma unroll
            for (int c = 0; c < 8; ++c) { const v4u w = kp[c];
#pragma unroll
                for (int e = 0; e < 4; ++e) { const float lo = __builtin_bit_cast(float, w[e] << 16), hi = __builtin_bit_cast(float, w[e] & 0xffff0000u); n2 += lo * lo + hi * hi; } }
            nmax = fmaxf(nmax, n2); }
#pragma unroll
        for (int o = 1; o < 32; o <<= 1) nmax = fmaxf(nmax, __shfl_xor(nmax, o));
        if ((F.lane & 31) == 0) F.knt[bh * 128 + chunk * 16 + F.wave * 2 + (F.lane >> 5)] = sqrtf(nmax);
    }
}

#if !defined(ATT_FAST) || !ATT_FAST
__device__ __forceinline__ void ld64(float (&d)[64], const bf16* p) {
    const GAS v4u* s = (const GAS v4u*)p;
#pragma unroll
    for (int c = 0; c < 8; ++c) { const v4u w = s[c];
#pragma unroll
        for (int e = 0; e < 4; ++e) { d[c * 8 + 2 * e] = BFLO(w[e]); d[c * 8 + 2 * e + 1] = BFHI(w[e]); } }
}
__device__ __forceinline__ float dot64(const float (&q)[64], const bf16* p) {
    const GAS v4u* s = (const GAS v4u*)p; float z = 0.f;
#pragma unroll
    for (int c = 0; c < 8; ++c) { const v4u w = s[c];
#pragma unroll
        for (int e = 0; e < 4; ++e) { z += q[c * 8 + 2 * e] * BFLO(w[e]); z += q[c * 8 + 2 * e + 1] * BFHI(w[e]); } }
    return z;
}
__device__ __forceinline__ void axpy64(float (&o)[64], float a, const bf16* p) {
    const GAS v4u* s = (const GAS v4u*)p;
#pragma unroll
    for (int c = 0; c < 8; ++c) { const v4u w = s[c];
#pragma unroll
        for (int e = 0; e < 4; ++e) { o[c * 8 + 2 * e] += a * BFLO(w[e]); o[c * 8 + 2 * e + 1] += a * BFHI(w[e]); } }
}
__device__ __forceinline__ void st64(bf16* p, const float (&d)[64], float sc) {
    GAS v4u* s = (GAS v4u*)p;
#pragma unroll
    for (int c = 0; c < 8; ++c) { v4u w;
#pragma unroll
        for (int e = 0; e < 4; ++e) w[e] = pk2(d[c * 8 + 2 * e] * sc, d[c * 8 + 2 * e + 1] * sc);
        s[c] = w; }
}
__device__ __forceinline__ void p3_attn_simple(Frame& F) {
    const int gtid = blockIdx.x * NTHR + F.tid, NT = F.G * NTHR;
    const bf16 *Qs = F.qkv, *Ks = F.qkv + (size_t)1 * M * HW, *Vs = F.qkv + (size_t)2 * M * HW, *Qf = F.qkv + (size_t)3 * M * HW, *Kf = F.qkv + (size_t)4 * M * HW, *Vf = F.qkv + (size_t)5 * M * HW;
    for (int idx = gtid; idx < M * NHG; idx += NT) {
        const int h = idx >> 15, m = idx & (M - 1), b = m >> 13, t = m & (SEQ - 1);
        float q[64], o[64];
        ld64(q, Qs + (size_t)m * HW + h * HD);
#pragma unroll
        for (int d = 0; d < 64; ++d) o[d] = 0.f;
        float C2 = 0.f;
        for (int s = t - 1; s >= 0; --s) {
            const float z = dot64(q, Ks + (size_t)(b * SEQ + s) * HW + h * HD);
            const float L2 = -(fmaxf(z, 0.f) * LOG2E + log2f(1.f + exp2f(-fabsf(z) * LOG2E)));
            const float w = exp2f(z * LOG2E + L2 + C2);
            axpy64(o, w, Vs + (size_t)(b * SEQ + s) * HW + h * HD);
            C2 += L2;
            if (C2 < -160.f) break;
        }
        st64(F.mixed + (size_t)m * D + h * HD, o, 1.f);
    }
    for (int idx = gtid; idx < M * NHG; idx += NT) {
        const int h = idx >> 15, m = idx & (M - 1), b = m >> 13, t = m & (SEQ - 1), bh = b * 8 + h;
        float q[64], o[64];
        ld64(q, Qf + (size_t)m * HW + h * HD);
#pragma unroll
        for (int d = 0; d < 64; ++d) o[d] = 0.f;
        float cq = F.cfl[(size_t)bh * SEQ + t];
        for (int c = 0; c < (t >> 10); ++c) cq += F.ctot[bh * 8 + c];
        float carry = 0.f, mr = -1e30f, l = 0.f;
        for (int s = 0; s <= t; ++s) {
            if ((s & 1023) == 0 && s > 0) carry += F.ctot[bh * 8 + (s >> 10) - 1];
            const float z = dot64(q, Kf + (size_t)(b * SEQ + s) * HW + h * HD);
            const float s2 = z * LOG2E + (cq - (F.cfl[(size_t)bh * SEQ + s] + carry));
            if (s2 > mr) { const float f = exp2f(mr - s2); l *= f;
#pragma unroll
                for (int d = 0; d < 64; ++d) o[d] *= f;
                mr = s2; }
            const float pw = exp2f(s2 - mr); l += pw;
            axpy64(o, pw, Vf + (size_t)(b * SEQ + s) * HW + h * HD);
        }
        st64(F.mixed + (size_t)m * D + HW + h * HD, o, 1.f / l);
    }
}

#endif
struct FProj { bf16* qkv; __device__ __forceinline__ void operator()(int row, int col, float v) const { const int t = col >> 9, cc = col & 511; const float sc = (t == 0 || t == 3) ? 0.125f : 1.f;
    qkv[(size_t)t * M * HW + (size_t)row * HW + cc] = (bf16)f2bf(v * sc); } };
struct FBf16 { bf16* O; int ldc; int cmask; __device__ __forceinline__ void operator()(int row, int col, float v) const { O[(size_t)row * ldc + (col & cmask)] = (bf16)f2bf(v); } };
struct FPre { const float* x; float* out; __device__ __forceinline__ void operator()(int row, int col, float v) const { const size_t i = (size_t)row * D + col; out[i] = ALPHA * x[i] + v; } };
struct FSwiglu { bf16* hdn; const float* gslot; __device__ __forceinline__ void operator()(int row, int pn, int cl, float g, float u) const {
    const int f = (pn & 3) * 128 + cl; const float s = g / (1.f + __expf(-g)); hdn[(size_t)row * DF + f] = (bf16)f2bf(s * u * gslot[row]); } };
struct FComb { float* out; const bf16* pple; const bf16* y; const int* slot; __device__ __forceinline__ void operator()(int row, int col, float v) const {
    const size_t i = (size_t)row * D + col; const int s0 = slot[row * 2], s1 = slot[row * 2 + 1]; const float sig = 1.f / (1.f + __expf(-v));
    out[i] = ALPHA * out[i] + bf2f(pple[i]) * sig + bf2f(y[(size_t)s0 * D + col]) + bf2f(y[(size_t)s1 * D + col]); } };

#ifndef PROBE_TWICE
#define PROBE_TWICE -1
#endif
template <class S> struct Rep2T : S {
    __device__ __forceinline__ bool next(int i, pg8::Unit& u) const { return S::next(i >> 1, u); }
};
template <class S, bool ON> struct Rep2Sel { typedef S type; };
template <class S> struct Rep2Sel<S, true> { typedef Rep2T<S> type; };
#define Rep2(S, ON) typename Rep2Sel<S, ON>::type

namespace pg8 {
struct EpiPre {
    static constexpr bool PERM = true, AFTER_DRAIN = false; const float* x; float* out;
    __device__ __forceinline__ void operator()(const f32x4 (&acc)[2][2][4][2], const Unit& u, int wr, int wc, int fr, int fq) const {
        const int row0 = u.pm * BM + wr * 64 + fr, col0 = u.pn * BM + wc * 32 + 8 * fq;
#pragma unroll
        for (int ai = 0; ai < 2; ++ai)
#pragma unroll
            for (int m = 0; m < 4; ++m) { const size_t off = (size_t)(row0 + ai * HALF + m * 16) * D + col0;
#pragma unroll
                for (int bj = 0; bj < 2; ++bj) { const f32x4 x0 = *(const f32x4*)(x + off + bj * HALF), x1 = *(const f32x4*)(x + off + bj * HALF + 4);
                    *(f32x4*)(out + off + bj * HALF) = x0 * ALPHA + acc[ai][bj][m][0]; *(f32x4*)(out + off + bj * HALF + 4) = x1 * ALPHA + acc[ai][bj][m][1]; }
                asm volatile("" ::: "memory"); }
    }
};
struct EpiSwiglu {
    static constexpr bool PERM = true, AFTER_DRAIN = false; bf16_t* hdn; const float* gslot;
    __device__ __forceinline__ void operator()(const f32x4 (&acc)[2][2][4][2], const Unit& u, int wr, int wc, int fr, int fq) const {
        const int row0 = u.pm * BM + wr * 64 + fr, f0 = (u.pn & 3) * 128 + wc * 32 + 8 * fq;
#pragma unroll
        for (int ai = 0; ai < 2; ++ai)
#pragma unroll
            for (int m = 0; m < 4; ++m) { const int r = row0 + ai * HALF + m * 16; const float gs = gslot[r]; float v[8];
#pragma unroll
                for (int n = 0; n < 2; ++n)
#pragma unroll
                    for (int e = 0; e < 4; ++e) { const float g = acc[ai][0][m][n][e], up = acc[ai][1][m][n][e]; v[4 * n + e] = g * __builtin_amdgcn_rcpf(1.f + __expf(-g)) * up * gs; }
                u32x4 w; w.x = cvt_pk_bf16(v[0], v[1]); w.y = cvt_pk_bf16(v[2], v[3]); w.z = cvt_pk_bf16(v[4], v[5]); w.w = cvt_pk_bf16(v[6], v[7]);
                *(u32x4*)(hdn + (size_t)r * DF + f0) = w; }
    }
};
struct EpiPle {
    static constexpr bool PERM = true, AFTER_DRAIN = false; bf16_t* pple;
    __device__ __forceinline__ void operator()(const f32x4 (&acc)[2][2][4][2], const Unit& u, int wr, int wc, int fr, int fq) const {
        const int row0 = u.pm * BM + wr * 64 + fr, col0 = u.pn * BM + wc * 32 + 8 * fq;
#pragma unroll
        for (int ai = 0; ai < 2; ++ai)
#pragma unroll
            for (int m = 0; m < 4; ++m) { const size_t off = (size_t)(row0 + ai * HALF + m * 16) * D + col0;
#pragma unroll
                for (int bj = 0; bj < 2; ++bj) { const u32x4 pp = *(const u32x4*)(pple + off + bj * HALF); float v[8];
#pragma unroll
                    for (int e = 0; e < 8; ++e) { const float g = acc[ai][bj][m][e >> 2][e & 3]; const unsigned pw = pp[e >> 1];
                        const float pv = (e & 1) ? __builtin_bit_cast(float, pw & 0xffff0000u) : __builtin_bit_cast(float, pw << 16);
                        v[e] = pv * __builtin_amdgcn_rcpf(1.f + __expf(-g)); }
                    u32x4 w; w.x = cvt_pk_bf16(v[0], v[1]); w.y = cvt_pk_bf16(v[2], v[3]); w.z = cvt_pk_bf16(v[4], v[5]); w.w = cvt_pk_bf16(v[6], v[7]);
                    *(u32x4*)(pple + off + bj * HALF) = w; }
                asm volatile("" ::: "memory"); }
    }
};
}

struct MoeOrder {
    const LAS int* pst; int nunits, G, c;
    __device__ __forceinline__ bool next(int i, pg8::Unit& u) const {
        const int L = i * G + c; if (L >= nunits) return false;
        const int pm = L >> 2, r0 = pm * 256; int e = 0;
        for (int k = 0; k < NE - 1; ++k) if (r0 >= pst[k + 1]) e = k + 1;
        u.pm = pm; u.pn = e * 4 + (L & 3); return true;
    }
    __device__ __forceinline__ void a_ready(const pg8::Unit&) const {}
    __device__ __forceinline__ void done(const pg8::Unit&) const {}
};
__device__ __forceinline__ void build_pstart(Frame& F) {
    LAS int* pst = (LAS int*)(F.lds + PST_OFF);
    if (F.tid == 0) { int acc = 0; for (int e = 0; e < NE; ++e) { const int c = (int)__hip_atomic_load(F.ctl + CW_CNT + 64 * e, RLX_AGENT); pst[e] = acc; acc += (c + 255) & ~255; } pst[NE] = acc; }
    __syncthreads();
}

constexpr int RB = 2;
__device__ __forceinline__ unsigned long long pk4(const f32x4 v) { return (unsigned long long)pk2(v.x, v.y) | ((unsigned long long)pk2(v.z, v.w) << 32); }
__device__ __forceinline__ float rdl(float v, int l) { return __builtin_bit_cast(float, __builtin_amdgcn_readlane(__builtin_bit_cast(int, v), l)); }
template <int H, int K> __device__ __forceinline__ void rs_step(float* a, int lane) {
    const bool up = (lane >> K) & 1;
#pragma unroll
    for (int i = 0; i < H; ++i) { const float keep = up ? a[H + i] : a[i], send = up ? a[i] : a[H + i]; a[i] = keep + __shfl_xor(send, 1 << K); }
}
__device__ __forceinline__ void p5_ln_route(Frame& F) {
    LAS unsigned* hist = (LAS unsigned*)(F.lds + HIST_OFF); LAS unsigned* base = (LAS unsigned*)(F.lds + BASE_OFF);
    LAS int* eidL = (LAS int*)(F.lds + ROWL_OFF); LAS int* rankL = eidL + 256;
    LAS f32x4* wr = (LAS f32x4*)(F.lds + RING_OFF); LAS f32x4* wg = (LAS f32x4*)(F.lds + WGRP_OFF);
    for (int i = F.tid; i < 8192; i += NTHR) { const int c = i >> 3, pc = i & 7, g = pc >> 1, half = pc & 1, ln = (c & 255) >> 2, j = c >> 8, e = c & 3;
        wr[((((g * 4 + j) * 4 + e) * 2 + half) << 6) + ln] = *(const GAS f32x4*)(F.w_router + (size_t)c * NE + pc * 4); }
    for (int c = F.tid; c < 1024; c += NTHR) { const int ln = (c & 255) >> 2, j = c >> 8, e = c & 3; wg[((j * 4 + e) << 6) + ln] = *(const GAS f32x4*)(F.w_group + (size_t)c * 4); }
    if (F.tid < NE) hist[F.tid] = 0u;
    __syncthreads();
    f32x4 gv[4], bv[4];
#pragma unroll
    for (int j = 0; j < 4; ++j) { gv[j] = *(const GAS f32x4*)(F.ln1g + 4 * F.lane + 256 * j); bv[j] = *(const GAS f32x4*)(F.ln1b + 4 * F.lane + 256 * j); }
    for (int r0 = F.wave * 2; r0 < 128; r0 += NWAVES * 2) {
        f32x4 v[2][4]; float st[4];
#pragma unroll
        for (int rr = 0; rr < 2; ++rr) { const size_t ro = (size_t)(blockIdx.x * 128 + r0 + rr) * D;
            const GAS f32x4* pr = (const GAS f32x4*)(F.x + ro) + F.lane; const GAS unsigned long long* pm = (const GAS unsigned long long*)(F.mixp + ro) + F.lane;
#pragma unroll
            for (int j = 0; j < 4; ++j) { const f32x4 xv = pr[64 * j]; const unsigned long long mw = pm[64 * j]; const unsigned m0 = (unsigned)mw, m1 = (unsigned)(mw >> 32);
                v[rr][j] = (f32x4){xv.x * ALPHA + BFLO(m0), xv.y * ALPHA + BFHI(m0), xv.z * ALPHA + BFLO(m1), xv.w * ALPHA + BFHI(m1)}; } }
#pragma unroll
        for (int rr = 0; rr < 2; ++rr) { float s = 0.f, q = 0.f;
#pragma unroll
            for (int j = 0; j < 4; ++j) { s += (v[rr][j].x + v[rr][j].y) + (v[rr][j].z + v[rr][j].w); q += (v[rr][j].x * v[rr][j].x + v[rr][j].y * v[rr][j].y) + (v[rr][j].z * v[rr][j].z + v[rr][j].w * v[rr][j].w); }
            st[2 * rr] = s; st[2 * rr + 1] = q; }
        rs_step<2, 5>(st, F.lane); rs_step<1, 4>(st, F.lane);
#pragma unroll
        for (int o = 1; o < 16; o <<= 1) st[0] += __shfl_xor(st[0], o);
        float gl[8];
#pragma unroll
        for (int i = 0; i < 8; ++i) gl[i] = 0.f;
#pragma unroll
        for (int rr = 0; rr < 2; ++rr) { const int m = blockIdx.x * 128 + r0 + rr;
            const float sum = rdl(st[0], 32 * rr), sq = rdl(st[0], 32 * rr + 16);
            const float mean = sum * (1.f / D), rstd = 1.f / sqrtf(fmaxf(sq * (1.f / D) - mean * mean, 0.f) + LN_EPS);
            GAS f32x4* pr = (GAS f32x4*)(F.out + (size_t)m * D) + F.lane; GAS unsigned long long* o8 = (GAS unsigned long long*)(F.hb + (size_t)m * D) + F.lane;
#pragma unroll
            for (int j = 0; j < 4; ++j) { v[rr][j] = (v[rr][j] - mean) * rstd * gv[j] + bv[j]; pr[64 * j] = v[rr][j]; o8[64 * j] = pk4(v[rr][j]); } }
#pragma unroll
        for (int j = 0; j < 4; ++j)
#pragma unroll
            for (int e = 0; e < 4; ++e) { const f32x4 w = wg[((j * 4 + e) << 6) + F.lane];
#pragma unroll
                for (int rr = 0; rr < 2; ++rr) { const float hv = v[rr][j][e]; gl[4 * rr] += hv * w.x; gl[4 * rr + 1] += hv * w.y; gl[4 * rr + 2] += hv * w.z; gl[4 * rr + 3] += hv * w.w; } }
        rs_step<4, 5>(gl, F.lane); rs_step<2, 4>(gl, F.lane); rs_step<1, 3>(gl, F.lane);
#pragma unroll
        for (int o = 1; o < 8; o <<= 1) gl[0] += __shfl_xor(gl[0], o);
        int gs[2]; float gprob[2]; float el[16];
#pragma unroll
        for (int rr = 0; rr < 2; ++rr) { float t[4];
#pragma unroll
            for (int i = 0; i < 4; ++i) t[i] = rdl(gl[0], 8 * (4 * rr + i)) + F.b_group[i];
            int g = 0; float gm = t[0];
#pragma unroll
            for (int i = 1; i < 4; ++i) if (t[i] > gm) { gm = t[i]; g = i; }
            gs[rr] = g; float gden = 0.f;
#pragma unroll
            for (int i = 0; i < 4; ++i) gden += expf(t[i] - gm);
            gprob[rr] = 1.f / gden; }
#pragma unroll
        for (int i = 0; i < 16; ++i) el[i] = 0.f;
#pragma unroll
        for (int j = 0; j < 4; ++j)
#pragma unroll
            for (int e = 0; e < 4; ++e)
#pragma unroll
                for (int rr = 0; rr < 2; ++rr) { const LAS f32x4* wp = wr + ((((gs[rr] * 4 + j) * 4 + e) * 2) << 6) + F.lane; const f32x4 w0 = wp[0], w1 = wp[64]; const float hv = v[rr][j][e];
                    el[8 * rr + 0] += hv * w0.x; el[8 * rr + 1] += hv * w0.y; el[8 * rr + 2] += hv * w0.z; el[8 * rr + 3] += hv * w0.w;
                    el[8 * rr + 4] += hv * w1.x; el[8 * rr + 5] += hv * w1.y; el[8 * rr + 6] += hv * w1.z; el[8 * rr + 7] += hv * w1.w; }
        rs_step<8, 5>(el, F.lane); rs_step<4, 4>(el, F.lane); rs_step<2, 3>(el, F.lane); rs_step<1, 2>(el, F.lane);
#pragma unroll
        for (int o = 1; o < 4; o <<= 1) el[0] += __shfl_xor(el[0], o);
#pragma unroll
        for (int rr = 0; rr < 2; ++rr) { const int r = r0 + rr, m = blockIdx.x * 128 + r; float t[8];
#pragma unroll
            for (int i = 0; i < 8; ++i) t[i] = rdl(el[0], 4 * (8 * rr + i)) + F.b_router[gs[rr] * EPG + i];
            int i1 = 0; float v1 = t[0];
#pragma unroll
            for (int i = 1; i < 8; ++i) if (t[i] > v1) { v1 = t[i]; i1 = i; }
            int i2 = (i1 == 0) ? 1 : 0; float v2 = (i1 == 0) ? t[1] : t[0];
#pragma unroll
            for (int i = 1; i < 8; ++i) if (i != i1 && t[i] > v2) { v2 = t[i]; i2 = i; }
            const float e2 = expf(v2 - v1), g1 = 1.f / (1.f + e2), g2 = e2 * g1;
            if (F.lane == 0) {
                const int ea = gs[rr] * EPG + i1, eb = gs[rr] * EPG + i2;
                const unsigned ra = __hip_atomic_fetch_add(hist + ea, 1u, __ATOMIC_RELAXED, __HIP_MEMORY_SCOPE_WORKGROUP);
                const unsigned rb = __hip_atomic_fetch_add(hist + eb, 1u, __ATOMIC_RELAXED, __HIP_MEMORY_SCOPE_WORKGROUP);
                eidL[r * 2] = ea; eidL[r * 2 + 1] = eb; rankL[r * 2] = (int)ra; rankL[r * 2 + 1] = (int)rb;
                F.eid[m * 2] = ea; F.eid[m * 2 + 1] = eb; F.gatev[m * 2] = g1 * gprob[rr]; F.gatev[m * 2 + 1] = g2 * gprob[rr];
            } }
    }
    __syncthreads();
    if (F.tid < NE) base[F.tid] = __hip_atomic_fetch_add(F.ctl + CW_CNT + 64 * F.tid, hist[F.tid], RLX_AGENT);
    __syncthreads();
    if (F.tid < 256) F.rank[blockIdx.x * 256 + F.tid] = rankL[F.tid] + (int)base[eidL[F.tid]];
}
__device__ __forceinline__ void p6_slots_gather(Frame& F) {
    build_pstart(F);
    const LAS int* pst = (const LAS int*)(F.lds + PST_OFF);
    for (int r0 = F.wave * 4; r0 < 128; r0 += NWAVES * 4) {
        v4u a[4], b[4]; int s0[4], s1[4];
#pragma unroll
        for (int rr = 0; rr < 4; ++rr) { const int m = blockIdx.x * 128 + r0 + rr; int s = 0;
            if (F.lane < 2) { const int e = F.eid[m * 2 + F.lane]; s = pst[e] + F.rank[m * 2 + F.lane]; F.slot[m * 2 + F.lane] = s; F.gslot[s] = F.gatev[m * 2 + F.lane]; }
            s0[rr] = __shfl(s, 0); s1[rr] = __shfl(s, 1);
            const GAS v4u* src = (const GAS v4u*)(F.hb + (size_t)m * D); a[rr] = src[F.lane]; b[rr] = src[F.lane + 64]; }
#pragma unroll
        for (int rr = 0; rr < 4; ++rr) { GAS v4u* d0 = (GAS v4u*)(F.xs + (size_t)s0[rr] * D); GAS v4u* d1 = (GAS v4u*)(F.xs + (size_t)s1[rr] * D);
            d0[F.lane] = a[rr]; d0[F.lane + 64] = b[rr]; d1[F.lane] = a[rr]; d1[F.lane + 64] = b[rr]; }
    }
}
__device__ __forceinline__ void p9_final(Frame& F, bool poison) {
    f32x4 gv[4], bv[4];
#pragma unroll
    for (int j = 0; j < 4; ++j) { gv[j] = *(const GAS f32x4*)(F.ln2g + 4 * F.lane + 256 * j); bv[j] = *(const GAS f32x4*)(F.ln2b + 4 * F.lane + 256 * j); }
    const int gw = blockIdx.x * NWAVES + F.wave, NGW = F.G * NWAVES; const float qn = __builtin_nanf("");
    for (int m0 = gw * RB; m0 < M; m0 += NGW * RB) {
        f32x4 v[RB][4]; float mean[RB], rstd[RB];
#pragma unroll
        for (int rr = 0; rr < RB; ++rr) { const int m = m0 + rr; const int s0 = F.slot[2 * m], s1 = F.slot[2 * m + 1];
            const GAS f32x4* pr = (const GAS f32x4*)(F.out + (size_t)m * D) + F.lane;
            const GAS unsigned long long* pp = (const GAS unsigned long long*)(F.pple + (size_t)m * D) + F.lane;
            const GAS unsigned long long* y0 = (const GAS unsigned long long*)(F.y + (size_t)s0 * D) + F.lane; const GAS unsigned long long* y1 = (const GAS unsigned long long*)(F.y + (size_t)s1 * D) + F.lane;
#pragma unroll
            for (int j = 0; j < 4; ++j) { const f32x4 h = pr[64 * j]; const unsigned long long pw = pp[64 * j], aw = y0[64 * j], bw = y1[64 * j];
                const unsigned p0 = (unsigned)pw, p1 = (unsigned)(pw >> 32), a0 = (unsigned)aw, a1 = (unsigned)(aw >> 32), b0 = (unsigned)bw, b1 = (unsigned)(bw >> 32);
                f32x4 t;
                t.x = h.x * ALPHA + BFLO(p0) + (BFLO(a0) + BFLO(b0)); t.y = h.y * ALPHA + BFHI(p0) + (BFHI(a0) + BFHI(b0));
                t.z = h.z * ALPHA + BFLO(p1) + (BFLO(a1) + BFLO(b1)); t.w = h.w * ALPHA + BFHI(p1) + (BFHI(a1) + BFHI(b1));
                v[rr][j] = t; } }
#pragma unroll
        for (int rr = 0; rr < RB; ++rr) { float s = 0.f;
#pragma unroll
            for (int j = 0; j < 4; ++j) s += (v[rr][j].x + v[rr][j].y) + (v[rr][j].z + v[rr][j].w);
            mean[rr] = s; }
#pragma unroll
        for (int o = 1; o < 64; o <<= 1)
#pragma unroll
            for (int rr = 0; rr < RB; ++rr) mean[rr] += __shfl_xor(mean[rr], o);
#pragma unroll
        for (int rr = 0; rr < RB; ++rr) { mean[rr] *= (1.f / D); float s2 = 0.f;
#pragma unroll
            for (int j = 0; j < 4; ++j) { v[rr][j] = v[rr][j] - mean[rr]; s2 += (v[rr][j].x * v[rr][j].x + v[rr][j].y * v[rr][j].y) + (v[rr][j].z * v[rr][j].z + v[rr][j].w * v[rr][j].w); }
            rstd[rr] = s2; }
#pragma unroll
        for (int o = 1; o < 64; o <<= 1)
#pragma unroll
            for (int rr = 0; rr < RB; ++rr) rstd[rr] += __shfl_xor(rstd[rr], o);
#pragma unroll
        for (int rr = 0; rr < RB; ++rr) { const float rs = 1.f / sqrtf(rstd[rr] * (1.f / D) + LN_EPS); GAS f32x4* pr = (GAS f32x4*)(F.out + (size_t)(m0 + rr) * D) + F.lane;
#pragma unroll
            for (int j = 0; j < 4; ++j) { f32x4 o = v[rr][j] * rs * gv[j] + bv[j]; if (poison) o = (f32x4){qn, qn, qn, qn}; pr[64 * j] = o; } }
    }
}


namespace att {
typedef float f32x16 __attribute__((ext_vector_type(16)));
typedef short s16x4 __attribute__((ext_vector_type(4)));
typedef short v4i16_t __attribute__((ext_vector_type(4)));
constexpr int BUFB = 16384 + 512, A_WS = 2 * BUFB, A_FLAG = A_WS + 2048, A_CAR = A_FLAG + 64, A_END = A_CAR + 64;
constexpr float STOP2 = -48.f;
__device__ __forceinline__ int crow(int r, int hi) { return (r & 3) + 8 * (r >> 2) + 4 * hi; }
__device__ __forceinline__ unsigned cvtpk(float lo, float hi) { typedef float f2 __attribute__((ext_vector_type(2))); typedef __bf16 b2 __attribute__((ext_vector_type(2))); f2 v = {lo, hi}; b2 b = __builtin_convertvector(v, b2); return __builtin_bit_cast(unsigned, b); }

template <int MODE> __device__ __forceinline__ void attn_unit(Frame& F, int bh, int qb) {
    const int tid = F.tid, lane = F.lane, r32 = lane & 31, hi = lane >> 5, wid = F.wave;
    const int b = bh >> 3, h = bh & 7;
    const bf16* Qg = F.qkv + (size_t)(MODE ? 3 : 0) * M * HW; const bf16* Kg = F.qkv + (size_t)(MODE ? 4 : 1) * M * HW; const bf16* Vg = F.qkv + (size_t)(MODE ? 5 : 2) * M * HW;
    const size_t rowbase = (size_t)b * SEQ; const int q0 = qb * 256;
    const bf16* Qw = Qg + (rowbase + q0 + wid * 32) * HW + h * HD;
    const bf16* Kh = Kg + rowbase * HW + h * HD; const bf16* Vh = Vg + rowbase * HW + h * HD;
    LAS unsigned char* L = F.lds + RING_OFF;
    LAS float* wsf = (LAS float*)(L + A_WS) + wid * 64;
    LAS unsigned* flg = (LAS unsigned*)(L + A_FLAG);
    LAS float* car = (LAS float*)(L + A_CAR);
    const int jt = (q0 >> 6) + 3, jw = (q0 >> 6) + (wid >> 1);
    const bf16* ksrc = Kh + (size_t)lane * HW + wid * 8;
    const bf16* vsrc = Vh + (size_t)(16 * (wid & 3) + (lane >> 2)) * HW + (wid >> 2) * 32 + (lane & 3) * 8;
    const int kdst = wid * 1024 + lane * 16, vdst = 8192 + wid * 1024 + lane * 16;
    const float* cfsrc = F.cfl + (size_t)bh * SEQ + tid * 4;
    float KNu = 0.f;
    if (MODE) {
        if (tid < 8) { float c = 0.f; for (int k = 0; k < tid; ++k) c += F.ctot[bh * 8 + k]; car[tid] = c; }
        float kn = (lane <= jt) ? F.knt[bh * 128 + lane] : 0.f; if (lane + 64 <= jt) kn = fmaxf(kn, F.knt[bh * 128 + lane + 64]);
        KNu = wave_max(kn);
    }
    bf16x8 qr[4];
#pragma unroll
    for (int d0 = 0; d0 < 4; ++d0) qr[d0] = *(const GAS bf16x8*)(Qw + (size_t)r32 * HW + d0 * 16 + hi * 8);
    __syncthreads();
    v4u kreg = *(const GAS v4u*)(ksrc + (size_t)jt * 64 * HW), vreg = *(const GAS v4u*)(vsrc + (size_t)jt * 64 * HW); f32x4 cfreg = {0.f, 0.f, 0.f, 0.f};
    if (MODE && tid < 16) { cfreg = *(const GAS f32x4*)(cfsrc + jt * 64); const float c = car[jt >> 4]; cfreg = -(cfreg + c); }
    *(LAS v4u*)(L + kdst) = kreg; *(LAS v4u*)(L + vdst) = vreg; if (MODE && tid < 16) *(LAS f32x4*)(L + 16384 + tid * 16) = cfreg;
    float qnb = 0.f;
    if (MODE) {
        float n2 = 0.f;
#pragma unroll
        for (int d0 = 0; d0 < 4; ++d0)
#pragma unroll
            for (int e = 0; e < 8; ++e) { const float qv = __builtin_bit_cast(float, (unsigned)(unsigned short)qr[d0][e] << 16); n2 += qv * qv; }
        n2 += __shfl_xor(n2, 32);
        qnb = sqrtf(n2) * KNu * 1.01f;
    }
    __syncthreads();
    f32x16 o[2]; o[0] = f32x16{}; o[1] = f32x16{};
    float C2 = 0.f, mhat = -1e30f, lsum = 0.f;
    bool wdone = false; int cur = 0;
    const LAS unsigned char* vb0 = L + 8192 + ((lane >> 4) & 1) * 32 + (lane & 3) * 8 + (4 * hi + ((lane & 15) >> 2)) * 64;
    for (int j = jt;; --j) {
        const bool more = j > 0;
        if (more) { kreg = *(const GAS v4u*)(ksrc + (size_t)(j - 1) * 64 * HW); vreg = *(const GAS v4u*)(vsrc + (size_t)(j - 1) * 64 * HW);
            if (MODE && tid < 16) cfreg = *(const GAS f32x4*)(cfsrc + (j - 1) * 64); }
        if (!wdone && j <= jw) {
            const LAS unsigned char* Kb = L + cur * BUFB;
            f32x16 p0 = f32x16{}, p1 = f32x16{};
            if (MODE) {
                const LAS float* cfp = (const LAS float*)(Kb + 16384);
#pragma unroll
                for (int g = 0; g < 4; ++g) { const f32x4 c0 = *(const LAS f32x4*)(cfp + 8 * g + 4 * hi), c1 = *(const LAS f32x4*)(cfp + 32 + 8 * g + 4 * hi);
#pragma unroll
                    for (int e = 0; e < 4; ++e) { p0[4 * g + e] = c0[e]; p1[4 * g + e] = c1[e]; } }
            }
            { const LAS unsigned char* kb = Kb + hi * 1024 + r32 * 16;
#pragma unroll
              for (int d0 = 0; d0 < 4; ++d0) { const bf16x8 b0 = *(const LAS bf16x8*)(kb + d0 * 2048), b1 = *(const LAS bf16x8*)(kb + d0 * 2048 + 512);
                  p0 = __builtin_amdgcn_mfma_f32_32x32x16_bf16(b0, qr[d0], p0, 0, 0, 0); p1 = __builtin_amdgcn_mfma_f32_32x32x16_bf16(b1, qr[d0], p1, 0, 0, 0); } }
            const bool diag = (j == jw); const int qrel = 32 * (wid & 1) + r32;
            if (MODE == 0) {
                float Lg[32];
#pragma unroll
                for (int r = 0; r < 16; ++r) {
                    const float z0 = p0[r], z1 = p1[r];
                    float l0 = -(fmaxf(z0, 0.f) + __builtin_amdgcn_logf(1.f + __builtin_amdgcn_exp2f(-fabsf(z0))));
                    float l1 = -(fmaxf(z1, 0.f) + __builtin_amdgcn_logf(1.f + __builtin_amdgcn_exp2f(-fabsf(z1))));
                    if (diag) { if (crow(r, hi) >= qrel) l0 = 0.f; if (crow(r, hi) + 32 >= qrel) l1 = 0.f; }
                    Lg[r] = l0; Lg[16 + r] = l1;
                }
                float Os[8], Ps[8];
#pragma unroll
                for (int i = 0; i < 8; ++i) { Os[i] = (Lg[4 * i] + Lg[4 * i + 1]) + (Lg[4 * i + 2] + Lg[4 * i + 3]); Ps[i] = __shfl_xor(Os[i], 32); }
                float T = 0.f;
#pragma unroll
                for (int i = 7; i >= 0; --i) {
                    float s = T + (hi ? 0.f : Ps[i]) + C2;
#pragma unroll
                    for (int e = 3; e >= 0; --e) { s += Lg[4 * i + e]; const int r = (4 * i + e) & 15; const float zz = (i < 4) ? p0[r] : p1[r];
                        float w = __builtin_amdgcn_exp2f(zz + s);
                        if (diag) { const int kk = crow(r, hi) + (i < 4 ? 0 : 32); if (kk >= qrel) w = 0.f; }
                        if (i < 4) p0[r] = w; else p1[r] = w; }
                    T += Os[i] + Ps[i];
                }
                C2 += T;
                wdone = __all(C2 < STOP2);
            } else {
                const LAS float* cfp = (const LAS float*)(Kb + 16384);
                float rm = -INFINITY;
#pragma unroll
                for (int r = 0; r < 16; ++r) {
                    if (diag) { if (crow(r, hi) > qrel) p0[r] = -INFINITY; if (crow(r, hi) + 32 > qrel) p1[r] = -INFINITY; }
                    rm = fmaxf(rm, fmaxf(p0[r], p1[r])); }
                rm = fmaxf(rm, __shfl_xor(rm, 32));
                const float mnew = fmaxf(mhat, rm);
                if (__any(mnew > mhat)) {
                    const float f = __builtin_amdgcn_exp2f(mhat - mnew); lsum *= f;
                    if (hi == 0) wsf[r32] = f;
                    asm volatile("s_waitcnt lgkmcnt(0)" ::: "memory");
#pragma unroll
                    for (int r = 0; r < 16; ++r) { const float fr = wsf[crow(r, hi)]; o[0][r] *= fr; o[1][r] *= fr; }
                    mhat = mnew;
                }
                float sacc = 0.f;
#pragma unroll
                for (int r = 0; r < 16; ++r) { p0[r] = __builtin_amdgcn_exp2f(p0[r] - mhat); p1[r] = __builtin_amdgcn_exp2f(p1[r] - mhat); sacc += p0[r] + p1[r]; }
                lsum += sacc;
                const float n00 = cfp[0];
                wdone = __all(qnb + n00 - mhat < STOP2);
            }
            v4u pw0, pw1, pw2, pw3;
#pragma unroll
            for (int e = 0; e < 4; ++e) { pw0[e] = cvtpk(p0[2 * e], p0[2 * e + 1]); pw1[e] = cvtpk(p0[8 + 2 * e], p0[8 + 2 * e + 1]); pw2[e] = cvtpk(p1[2 * e], p1[2 * e + 1]); pw3[e] = cvtpk(p1[8 + 2 * e], p1[8 + 2 * e + 1]); }
            const LAS unsigned char* vb = vb0 + cur * BUFB;
#pragma unroll
            for (int d0 = 0; d0 < 2; ++d0) { s16x4 lo[4], hh[4];
#pragma unroll
                for (int ks = 0; ks < 4; ++ks) {
                    lo[ks] = __builtin_bit_cast(s16x4, __builtin_amdgcn_ds_read_tr16_b64_v4i16((LAS v4i16_t*)(vb + d0 * 4096 + ks * 1024)));
                    hh[ks] = __builtin_bit_cast(s16x4, __builtin_amdgcn_ds_read_tr16_b64_v4i16((LAS v4i16_t*)(vb + d0 * 4096 + ks * 1024 + 512))); }
#define ATT_PK(k) (bf16x8){lo[k][0], lo[k][1], lo[k][2], lo[k][3], hh[k][0], hh[k][1], hh[k][2], hh[k][3]}
                o[d0] = __builtin_amdgcn_mfma_f32_32x32x16_bf16(__builtin_bit_cast(bf16x8, pw0), ATT_PK(0), o[d0], 0, 0, 0);
                o[d0] = __builtin_amdgcn_mfma_f32_32x32x16_bf16(__builtin_bit_cast(bf16x8, pw1), ATT_PK(1), o[d0], 0, 0, 0);
                o[d0] = __builtin_amdgcn_mfma_f32_32x32x16_bf16(__builtin_bit_cast(bf16x8, pw2), ATT_PK(2), o[d0], 0, 0, 0);
                o[d0] = __builtin_amdgcn_mfma_f32_32x32x16_bf16(__builtin_bit_cast(bf16x8, pw3), ATT_PK(3), o[d0], 0, 0, 0);
#undef ATT_PK
            }
        }
        if (more) { const int nb = (cur ^ 1) * BUFB;
            if (MODE && tid < 16) { const float c = car[(j - 1) >> 4]; cfreg = -(cfreg + c); *(LAS f32x4*)(L + nb + 16384 + tid * 16) = cfreg; }
            *(LAS v4u*)(L + nb + kdst) = kreg; *(LAS v4u*)(L + nb + vdst) = vreg; }
        if (lane == 0) flg[cur * 8 + wid] = wdone ? 1u : 0u;
        __syncthreads();
        if (!more) break;
        unsigned alld = 1u;
#pragma unroll
        for (int w = 0; w < 8; ++w) alld &= flg[cur * 8 + w];
        if (alld) break;
        cur ^= 1;
    }
    float rli[16];
    if (MODE) {
        lsum += __shfl_xor(lsum, 32);
        if (hi == 0) wsf[r32] = lsum;
        asm volatile("s_waitcnt lgkmcnt(0)" ::: "memory");
#pragma unroll
        for (int r = 0; r < 16; ++r) rli[r] = 1.f / wsf[crow(r, hi)];
    } else {
#pragma unroll
        for (int r = 0; r < 16; ++r) rli[r] = 1.f;
    }
    bf16* Ow = F.mixed + (rowbase + q0 + wid * 32) * D + (MODE ? HW : 0) + h * HD;
#pragma unroll
    for (int r = 0; r < 16; ++r) {
        bf16* rowp = Ow + (size_t)crow(r, hi) * D + r32;
        rowp[0] = (bf16)f2bf(o[0][r] * rli[r]); rowp[32] = (bf16)f2bf(o[1][r] * rli[r]);
    }
}
}

template <int MODE> __device__ __forceinline__ void p3_attn_fast(Frame& F) {
    for (int i = 3; i >= 0; --i) { const int id = (int)blockIdx.x + F.G * i; if (id < 1024) att::attn_unit<MODE>(F, id & 31, id >> 5); }
}

struct Args { const float* in[18]; float* out; unsigned char* ws; int ph_lo, ph_hi; };
__global__ void __launch_bounds__(NTHR, 2) mk_fwd(Args args) {
    extern __shared__ __attribute__((aligned(16))) unsigned char lds[];
    Frame F;
    F.lds = (LAS unsigned char*)lds; F.MISC = (volatile LAS unsigned*)(F.lds + MISC_OFF);
    F.tid = threadIdx.x; F.lane = F.tid & 63; F.wave = __builtin_amdgcn_readfirstlane(F.tid >> 6);
    F.G = gridDim.x; { const int bx = blockIdx.x; F.vcu = (F.G % 8 == 0) ? (bx % 8) * (F.G / 8) + bx / 8 : bx; }
    unsigned char* ws = args.ws;
    F.ctl = (gu32*)(ws + WS_CTL);
    F.x = args.in[0]; F.p = args.in[1]; F.w_in = args.in[2]; F.b_forget = args.in[3]; F.w_out = args.in[4]; F.ln1g = args.in[5]; F.ln1b = args.in[6]; F.w_group = args.in[7]; F.b_group = args.in[8];
    F.w_router = args.in[9]; F.b_router = args.in[10]; F.w_gate = args.in[11]; F.w_up = args.in[12]; F.w_down = args.in[13]; F.w_ple = args.in[14]; F.w_pg = args.in[15]; F.ln2g = args.in[16]; F.ln2b = args.in[17];
    F.out = args.out;
    F.Win_t = (bf16*)(ws + WS_WIN); F.Wout_t = (bf16*)(ws + WS_WOUT); F.Wple_t = (bf16*)(ws + WS_WPLE); F.Wpg_t = (bf16*)(ws + WS_WPG); F.Wgu_t = (bf16*)(ws + WS_WGU); F.Wd_t = (bf16*)(ws + WS_WD);
    F.pple = (bf16*)(ws + WS_PPLE); F.qkv = (bf16*)(ws + WS_R1); F.xs = (bf16*)(ws + WS_R1); F.y = (bf16*)(ws + WS_R1);
    F.xb = (bf16*)(ws + WS_R2); F.mixed = (bf16*)(ws + WS_R2); F.hb = (bf16*)(ws + WS_R2); F.pb = (bf16*)(ws + WS_R3); F.hdn = (bf16*)(ws + WS_R3); F.mixp = (bf16*)(ws + WS_R3);
    F.ls = (float*)(ws + WS_LS); F.cfl = (float*)(ws + WS_CFL); F.ctot = (float*)(ws + WS_CTOT); F.knt = (float*)(ws + WS_KNT); F.gatev = (float*)(ws + WS_GATE); F.gslot = (float*)(ws + WS_GSLOT);
    F.eid = (int*)(ws + WS_EID); F.rank = (int*)(ws + WS_RANK); F.slot = (int*)(ws + WS_SLOT);
    for (int u = F.tid; u < (LDS_BYTES - LDSCTL_OFF) / 4; u += NTHR) ((LAS unsigned*)(F.lds + LDSCTL_OFF))[u] = 0u;
    __syncthreads();
    XcdBarrier bar = xcd_barrier_post((unsigned*)(F.ctl + CW_BAR), F.MISC + 8);
    const int lo = args.ph_lo, hi = args.ph_hi;
#ifndef PH_MASK
#define PH_MASK 0x3ff
#endif
#define IN(k) (((PH_MASK >> (k)) & 1) && lo <= (k) && (k) < hi)
#ifndef PROBE_PH
#define PROBE_PH -1
#endif
    unsigned long long pt0_ = (PROBE_PH == 0) ? rt() : 0ull, pt1_ = 0ull;
#define SEAM(k) do { if (IN(k) && IN((k) + 1)) xcd_barrier(bar); if ((k) == PROBE_PH) pt1_ = rt(); if ((k) + 1 == PROBE_PH) pt0_ = rt(); } while (0)

#ifndef REPEAT_PH
#define REPEAT_PH -1
#endif
#define REP(k) _Pragma("unroll") for (int rep_ = 0; rep_ < ((k) == REPEAT_PH ? 2 : 1); ++rep_)
#define PSTAMP(id, body) do { if (PROBE_PH == (id)) { __syncthreads(); pt0_ = rt(); } body; if (PROBE_PH == (id)) { __syncthreads(); pt1_ = rt(); } } while (0)
    if (IN(0)) { PSTAMP(100, p0_prologue<0>(F)); PSTAMP(101, p0_prologue<1>(F)); PSTAMP(102, p0_prologue<2>(F)); }
    SEAM(0);

    if (IN(1)) {
        { pg8::Gemm g{F.xb, F.Win_t, M, NPROJ, D}; pg8::StaticOrder S; S.init(M, NPROJ, F.G, (int)blockIdx.x);
          pg8::EpiBf16<0> E{F.qkv, HW, nullptr, HW, (size_t)M * HW, 1.f};
          pg8::gemm_phase<pg8::EpiBf16<0>, pg8::StaticOrder, true, true>(F.lds + RING_OFF, g, S, E); }
        { pg8::Gemm g{F.pb, F.Wple_t, M, D, PLED}; pg8::StaticOrder S; S.init(M, D, F.G, (int)blockIdx.x);
          pg8::EpiBf16<0> E{F.pple, D, nullptr, 0, 0, 1.f};
          pg8::gemm_phase<pg8::EpiBf16<0>, pg8::StaticOrder, true, true>(F.lds + RING_OFF, g, S, E); }
    } SEAM(1);

    if (IN(2)) { p2_scan(F); } SEAM(2);

#if ATT_FAST
    if (IN(3)) { PSTAMP(131, p3_attn_fast<1>(F)); PSTAMP(132, p3_attn_fast<0>(F)); }
    SEAM(3);
#else
    if (IN(3)) { p3_attn_simple(F); } SEAM(3);
#endif

    if (IN(4)) {
        pg8::Gemm g{F.mixed, F.Wout_t, M, D, D}; pg8::StaticOrder S; S.init(M, D, F.G, (int)blockIdx.x);
        pg8::EpiBf16<0> E{F.mixp, D, nullptr, 0, 0, 1.f};
        pg8::gemm_phase<pg8::EpiBf16<0>, pg8::StaticOrder, true, true>(F.lds + RING_OFF, g, S, E);
    } SEAM(4);

    if (IN(5)) { p5_ln_route(F); } SEAM(5);

    if (IN(6)) {
        p6_slots_gather(F);
        { pg8::Gemm g{F.hb, F.Wpg_t, M, D, D}; pg8::StaticOrder S; S.init(M, D, F.G, (int)blockIdx.x);
          pg8::EpiPle E{F.pple};
          pg8::gemm_phase<pg8::EpiPle, pg8::StaticOrder, true, true>(F.lds + RING_OFF, g, S, E); }
    } SEAM(6);

    if (IN(7)) {
        build_pstart(F);
        const LAS int* pst = (const LAS int*)(F.lds + PST_OFF);
        pg8::Gemm g{F.xs, F.Wgu_t, SPAD, NE * 1024, D}; MoeOrder S{pst, (pst[NE] >> 8) * 4, F.G, (int)blockIdx.x};
        pg8::EpiSwiglu E{F.hdn, F.gslot};
        pg8::gemm_phase<pg8::EpiSwiglu, MoeOrder, true, true>(F.lds + RING_OFF, g, S, E);
    } SEAM(7);

    if (IN(8)) {
        build_pstart(F);
        const LAS int* pst = (const LAS int*)(F.lds + PST_OFF);
        pg8::Gemm g{F.hdn, F.Wd_t, SPAD, NE * 1024, DF}; MoeOrder S{pst, (pst[NE] >> 8) * 4, F.G, (int)blockIdx.x};
        pg8::EpiBf16<0> E{F.y, D, nullptr, 1024, 0, 1.f};
        pg8::gemm_phase<pg8::EpiBf16<0>, MoeOrder, true, true>(F.lds + RING_OFF, g, S, E);
    } SEAM(8);

    if (IN(9)) {
        const bool poison = __hip_atomic_load((gu32*)((unsigned*)(F.ctl + CW_BAR) + XB_TMO), RLX_AGENT) != 0u || F.G != 256;
        p9_final(F, poison);
    }
    if (PROBE_PH >= 0 && blockIdx.x == 0) {
        const unsigned long long now = rt(); if (PROBE_PH == NPH - 1) pt1_ = now;
        const unsigned long long dur = pt1_ - pt0_;
        if (F.tid == 0) while (rt() - now < 4ull * dur) __builtin_amdgcn_s_sleep(8);
        __syncthreads();
    }
#undef IN
#undef SEAM
}

#ifndef MK_CUTS
#define MK_CUTS 0
#endif
extern "C" void kernel_launch(void* const* d_in, const int* in_sizes, int n_in, void* d_out, int out_size, void* d_ws, size_t ws_size, hipStream_t stream) {
    static int grid = 0;
    if (grid == 0) {
        if (n_in != 18 || in_sizes[0] != M * D || out_size != M * D || ws_size < WS_END) { fprintf(stderr, "kernel_launch: shape/workspace mismatch (n_in %d, in0 %d, out %d, ws %zu)\n", n_in, n_in > 0 ? in_sizes[0] : -1, out_size, ws_size); grid = -1; return; }
        int dev = 0, cus = 0, per_cu = 0;
        if (hipGetDevice(&dev) != hipSuccess || hipDeviceGetAttribute(&cus, hipDeviceAttributeMultiprocessorCount, dev) != hipSuccess) { grid = -1; return; }
        if (hipFuncSetAttribute((const void*)mk_fwd, hipFuncAttributeMaxDynamicSharedMemorySize, LDS_BYTES) != hipSuccess) { fprintf(stderr, "kernel_launch: hipFuncSetAttribute failed\n"); grid = -1; return; }
        if (hipOccupancyMaxActiveBlocksPerMultiprocessor(&per_cu, (const void*)mk_fwd, NTHR, LDS_BYTES) != hipSuccess || per_cu < 1) fprintf(stderr, "kernel_launch: occupancy query reports %d\n", per_cu);
        (void)hipGetLastError();
        grid = cus;
        if (grid != 256) fprintf(stderr, "kernel_launch: %d CUs; this kernel is built for 256\n", grid);
    }
    if (grid < 0) return;
    if (hipMemsetAsync((char*)d_ws + WS_CTL, 0, CTL_ZERO_BYTES, stream) != hipSuccess) return;
    Args a{};
    for (int i = 0; i < 18; ++i) a.in[i] = (const float*)d_in[i];
    a.out = (float*)d_out; a.ws = (unsigned char*)d_ws;
#if MK_CUTS
    for (int ph = 0; ph < NPH; ++ph) { a.ph_lo = ph; a.ph_hi = ph + 1; hipLaunchKernelGGL(mk_fwd, dim3(grid), dim3(NTHR), LDS_BYTES, stream, a); }
#else
    a.ph_lo = 0; a.ph_hi = NPH;
    hipLaunchKernelGGL(mk_fwd, dim3(grid), dim3(NTHR), LDS_BYTES, stream, a);
#endif
}
```

```cpp
#include <hip/hip_runtime.h>
#include <hip/hip_bf16.h>
#include <cstdio>
#include <cstdint>
#include <cmath>
namespace pg8 {
#define PG8_LAS __attribute__((address_space(3)))
typedef unsigned short bf16_t;
typedef short bf16x8 __attribute__((ext_vector_type(8)));
typedef float f32x4 __attribute__((ext_vector_type(4)));
typedef unsigned u32x4 __attribute__((ext_vector_type(4)));
constexpr int BM = 256, BK = 64, HALF = 128, HTB = HALF * BK * 2  , STAGE_BYTES = 8 * HTB, NXCD = 8, WGM = 8;

__host__ __device__ __forceinline__ int lds_byte(int r, int c) { const int st = (r >> 4) * 2 + (c >> 5), rr = r & 15, cc = c & 31, ob = rr * 64 + cc * 2; return st * 1024 + (ob ^ (((ob >> 9) & 1) << 5)); }
__host__ __device__ __forceinline__ void stage_rc(int b, int& R, int& C) { const int st = b / 1024, sb = b % 1024, swz = sb ^ (((sb >> 9) & 1) << 5); R = (st >> 1) * 16 + swz / 64; C = (st & 1) * 32 + (swz % 64) / 2; }
__host__ __device__ __forceinline__ int perm32(int rho) { const int n = rho >> 4, i = rho & 15; return 8 * (i >> 2) + 4 * n + (i & 3); }

struct Unit { int pm, pn; };
struct Gemm { const bf16_t* A; const bf16_t* Bt; int M, N, K; };

struct StaticOrder {
    int nM, nN, nwg, G, c;
    __host__ __device__ void init(int M, int N, int G_, int c_) { nM = M / BM; nN = N / BM; nwg = nM * nN; G = G_; c = c_; }
    __host__ __device__ bool next(int i, Unit& u) const {
        const long L = (long)i * G + c; if (L >= nwg) return false;
        int wgid = (int)L; { const int q = nwg / NXCD, r = nwg % NXCD, xcd = wgid % NXCD, off = wgid / NXCD; wgid = (xcd < r ? xcd * (q + 1) : r * (q + 1) + (xcd - r) * q) + off; }
        const int nig = WGM * nN, gid = wgid / nig, fm = gid * WGM, gsz = (nM - fm) < WGM ? (nM - fm) : WGM;
        u.pm = fm + ((wgid % nig) % gsz); u.pn = (wgid % nig) / gsz; return true;
    }
    __device__ __forceinline__ void a_ready(const Unit&) const {}
    __device__ __forceinline__ void done(const Unit&) const {}
};

__device__ __forceinline__ unsigned cvt_pk_bf16(float lo, float hi) { unsigned r; asm volatile("v_cvt_pk_bf16_f32 %0, %1, %2" : "=v"(r) : "v"(lo), "v"(hi)); return r; }
typedef float f32x2 __attribute__((ext_vector_type(2)));
__device__ __forceinline__ f32x2 gelu_pk(f32x2 v) {
    const f32x2 av = __builtin_elementwise_abs(v), d = av * 0.2316418882f + 1.0f;
    f32x2 t; t.x = __builtin_amdgcn_rcpf(d.x); t.y = __builtin_amdgcn_rcpf(d.y);
    f32x2 q = t * 0.5307027145f + (-0.7265760135f); q = q * t + 0.7107068705f; q = q * t + (-0.142248368f); q = q * t + 0.127414796f; q = q * t;
    const f32x2 s = (v * v) * (-0.72134752044f);
    f32x2 e; e.x = __builtin_amdgcn_exp2f(s.x); e.y = __builtin_amdgcn_exp2f(s.y);
    const f32x2 m = v * (q * e), r = v - m;
    f32x2 o; o.x = v.x < 0.f ? m.x : r.x; o.y = v.y < 0.f ? m.y : r.y; return o;
}

template <int ACT  > struct EpiBf16 {
    static constexpr bool PERM = true, AFTER_DRAIN = false; static_assert(ACT == 0 || ACT == 1, "EpiBf16: ACT is 0 (none) or 1 (gelu_pk)");
    bf16_t* O; int ldc; const float* bias; int split_cols; size_t split_stride; float scale0;
    __device__ __forceinline__ void operator()(const f32x4 (&acc)[2][2][4][2], const Unit& u, int wr, int wc, int fr, int fq) const {
        const int row0 = u.pm * BM + wr * 64 + fr; int colt = u.pn * BM; bf16_t* base = O;
        float sc = 1.f; if (split_cols) { const int t = colt / split_cols; base += (size_t)t * split_stride; colt -= t * split_cols; if (t == 0) sc = scale0; }
        const int col0 = colt + wc * 32 + 8 * fq, bcol0 = u.pn * BM + wc * 32 + 8 * fq;
        f32x4 bv[2][2];
#pragma unroll
        for (int bj = 0; bj < 2; ++bj)
#pragma unroll
            for (int n = 0; n < 2; ++n) bv[bj][n] = bias ? *(const f32x4*)(bias + bcol0 + bj * HALF + 4 * n) : (f32x4){0.f, 0.f, 0.f, 0.f};
#pragma unroll
        for (int ai = 0; ai < 2; ++ai)
#pragma unroll
            for (int m = 0; m < 4; ++m) { bf16_t* rowp = base + (size_t)(row0 + ai * HALF + m * 16) * ldc + col0;
#pragma unroll
                for (int bj = 0; bj < 2; ++bj) { f32x4 v0 = acc[ai][bj][m][0] + bv[bj][0], v1 = acc[ai][bj][m][1] + bv[bj][1];
                    if (ACT == 1) { f32x2 a = gelu_pk((f32x2){v0[0], v0[1]}), b = gelu_pk((f32x2){v0[2], v0[3]}), c = gelu_pk((f32x2){v1[0], v1[1]}), d = gelu_pk((f32x2){v1[2], v1[3]});
                        v0 = (f32x4){a.x, a.y, b.x, b.y}; v1 = (f32x4){c.x, c.y, d.x, d.y}; }
                    v0 = v0 * sc; v1 = v1 * sc; u32x4 w; w.x = cvt_pk_bf16(v0[0], v0[1]); w.y = cvt_pk_bf16(v0[2], v0[3]); w.z = cvt_pk_bf16(v1[0], v1[1]); w.w = cvt_pk_bf16(v1[2], v1[3]);
                    *(u32x4*)(rowp + bj * HALF) = w; } }
    }
};

struct PanelStats {
    unsigned* xbuf;
    unsigned* cnt;
    unsigned* tmo;
    int ntn; float eps;
    unsigned code;
    __device__ __forceinline__ bool run(const f32x4 (&v)[2][2][4][2], const Unit& u, int wr, int wc, int fr, int fq, PG8_LAS unsigned char* lds, int wid, int lane) const {
        typedef float f32x2v __attribute__((ext_vector_type(2)));
        PG8_LAS f32x2v* P = (PG8_LAS f32x2v*)lds;
        PG8_LAS f32x2v* S = (PG8_LAS f32x2v*)(lds + 8192);
        PG8_LAS unsigned* flag = (PG8_LAS unsigned*)(lds + 8192 + 2048);
#pragma unroll
        for (int ai = 0; ai < 2; ++ai)
#pragma unroll
            for (int m = 0; m < 4; ++m) {
                float s = 0.f;
#pragma unroll
                for (int bj = 0; bj < 2; ++bj)
#pragma unroll
                    for (int n = 0; n < 2; ++n) { const f32x4 x = v[ai][bj][m][n]; s += (x[0] + x[1]) + (x[2] + x[3]); }
                s += __shfl_xor(s, 16); s += __shfl_xor(s, 32);
                const float mw = s * (1.0f / 64.0f); float q = 0.f;
#pragma unroll
                for (int bj = 0; bj < 2; ++bj)
#pragma unroll
                    for (int n = 0; n < 2; ++n) { const f32x4 d = v[ai][bj][m][n] - mw; q += (d[0] * d[0] + d[1] * d[1]) + (d[2] * d[2] + d[3] * d[3]); }
                q += __shfl_xor(q, 16); q += __shfl_xor(q, 32);
                if (fq == 0) P[(ai * HALF + wr * 64 + m * 16 + fr) * 4 + wc] = (f32x2v){mw, q};
            }
        asm volatile("s_waitcnt lgkmcnt(0)" ::: "memory"); __builtin_amdgcn_s_barrier(); asm volatile("" ::: "memory");
#if defined(BROKEN_EXCHANGE_NO_WAIT)
#warning BROKEN CONTROL BUILD: the row-statistics exchange does not wait; results are wrong by design
        if (blockIdx.x >= 64) { const long long t0_ = clock64(); while (clock64() - t0_ < 60000) __builtin_amdgcn_s_sleep(8); }
#endif
        const int row = wid * 32 + (lane & 31);
        if (lane < 32) {
            const f32x2v a = P[row * 4 + 0], b = P[row * 4 + 1], c = P[row * 4 + 2], d = P[row * 4 + 3];
            const float mt = (a.x + b.x + c.x + d.x) * 0.25f;
            const float da = a.x - mt, db = b.x - mt, dc = c.x - mt, dd = d.x - mt;
            const float m2 = (a.y + b.y) + (c.y + d.y) + 64.0f * ((da * da + db * db) + (dc * dc + dd * dd));
            unsigned long long* slot = (unsigned long long*)xbuf + ((size_t)(u.pm * BM + row) * 4 + u.pn);
            __hip_atomic_store(slot, ((unsigned long long)__float_as_uint(m2) << 32) | __float_as_uint(mt), __ATOMIC_RELAXED, __HIP_MEMORY_SCOPE_AGENT);
        }
        asm volatile("s_waitcnt vmcnt(0)" ::: "memory");
        if (lane == 0) __hip_atomic_fetch_add(cnt + 64 * u.pm, 1u, __ATOMIC_RELAXED, __HIP_MEMORY_SCOPE_AGENT);
        if (wid == 0) {
            bool dead = false; const unsigned long long t0 = __builtin_amdgcn_s_memrealtime(); const unsigned want = 8u * (unsigned)ntn;
            for (;;) {
#if defined(BROKEN_EXCHANGE_NO_WAIT)
                break;
#endif
                if ((unsigned)__builtin_amdgcn_readfirstlane(__hip_atomic_load(cnt + 64 * u.pm, __ATOMIC_RELAXED, __HIP_MEMORY_SCOPE_AGENT)) >= want) break;
                if (__builtin_amdgcn_s_memrealtime() - t0 > 2000000ull) {
                    if (lane == 0) { unsigned expect = 0u; __hip_atomic_compare_exchange_strong(tmo + 1, &expect, code | (unsigned)(u.pm & 0xff), __ATOMIC_RELAXED, __ATOMIC_RELAXED, __HIP_MEMORY_SCOPE_AGENT);
                                     __hip_atomic_store(tmo, 1u, __ATOMIC_RELAXED, __HIP_MEMORY_SCOPE_AGENT); }
                    dead = true; break; }
                __builtin_amdgcn_s_sleep(2);
            }
            __builtin_amdgcn_fence(__ATOMIC_ACQUIRE, "agent");
            if (lane == 0) flag[0] = dead ? 1u : 0u;
        }
        asm volatile("s_waitcnt vmcnt(0) lgkmcnt(0)" ::: "memory"); __builtin_amdgcn_s_barrier(); asm volatile("" ::: "memory");
        const bool bad = flag[0] != 0u;
        if (lane < 32) {
            const unsigned long long* slot = (const unsigned long long*)xbuf + (size_t)(u.pm * BM + row) * 4; float mt[4], m2[4]; float ms = 0.f;
#pragma unroll
            for (int t = 0; t < 4; ++t) { if (t < ntn) { const unsigned long long w = __hip_atomic_load(slot + t, __ATOMIC_RELAXED, __HIP_MEMORY_SCOPE_AGENT); mt[t] = __uint_as_float((unsigned)w); m2[t] = __uint_as_float((unsigned)(w >> 32)); } else { mt[t] = 0.f; m2[t] = 0.f; } ms += mt[t]; }
            const float mean = ms / (float)ntn; float q = 0.f;
#pragma unroll
            for (int t = 0; t < 4; ++t) if (t < ntn) { const float dm = mt[t] - mean; q += m2[t] + 256.0f * dm * dm; }
            S[row] = (f32x2v){mean, 1.0f / sqrtf(q / (256.0f * (float)ntn) + eps)};
        }
        asm volatile("s_waitcnt lgkmcnt(0)" ::: "memory"); __builtin_amdgcn_s_barrier(); asm volatile("" ::: "memory");
        return bad;
    }
};
struct EpiLnRes {
    static constexpr bool PERM = false, AFTER_DRAIN = true;
    const float* base; float* out; int ldc; const float* bias; PanelStats st; unsigned poison;
    __device__ __forceinline__ void fused(f32x4 (&acc)[2][2][4][2], const Unit& u, int wr, int wc, int fr, int fq, PG8_LAS unsigned char* lds, int wid, int lane) const {
        typedef float f32x2v __attribute__((ext_vector_type(2)));
        const PG8_LAS f32x2v* S = (const PG8_LAS f32x2v*)(lds + 8192);
        const int col0 = u.pn * BM + wc * 32 + 4 * fq;
#pragma unroll
        for (int bj = 0; bj < 2; ++bj)
#pragma unroll
            for (int n = 0; n < 2; ++n) { const f32x4 bv = bias ? *(const f32x4*)(bias + col0 + bj * HALF + n * 16) : (f32x4){0.f, 0.f, 0.f, 0.f};
#pragma unroll
                for (int ai = 0; ai < 2; ++ai)
#pragma unroll
                    for (int m = 0; m < 4; ++m) acc[ai][bj][m][n] += bv; }
        f32x4 pre[4][2][2];
#pragma unroll
        for (int m = 0; m < 4; ++m) { const size_t off = (size_t)(u.pm * BM + wr * 64 + m * 16 + fr) * ldc + col0;
#pragma unroll
            for (int bj = 0; bj < 2; ++bj)
#pragma unroll
                for (int n = 0; n < 2; ++n) pre[m][bj][n] = *(const f32x4*)(base + off + bj * HALF + n * 16); }
        const bool bad = st.run(acc, u, wr, wc, fr, fq, lds, wid, lane) || poison != 0u;
        const float qnan = __builtin_nanf("");
#pragma unroll
        for (int ai = 0; ai < 2; ++ai)
#pragma unroll
            for (int m = 0; m < 4; ++m) { const int r = ai * HALF + wr * 64 + m * 16 + fr; const f32x2v sr = S[r]; const size_t off = (size_t)(u.pm * BM + r) * ldc + col0;
#pragma unroll
                for (int bj = 0; bj < 2; ++bj)
#pragma unroll
                    for (int n = 0; n < 2; ++n) { const f32x4 bs = ai == 0 ? pre[m][bj][n] : *(const f32x4*)(base + off + bj * HALF + n * 16); f32x4 o = bs + (acc[ai][bj][m][n] - sr.x) * sr.y;
                        if (bad) o = (f32x4){qnan, qnan, qnan, qnan}; *(f32x4*)(out + off + bj * HALF + n * 16) = o; }
                if (m & 1) asm volatile("" ::: "memory"); }
    }
};
struct EpiLnResLn {
    static constexpr bool PERM = false, AFTER_DRAIN = true;
    const float* base; float* out; bf16_t* xn; int ldc; const float* bias; PanelStats st1, st2; unsigned poison;
    __device__ __forceinline__ void fused(f32x4 (&acc)[2][2][4][2], const Unit& u, int wr, int wc, int fr, int fq, PG8_LAS unsigned char* lds, int wid, int lane) const {
        typedef float f32x2v __attribute__((ext_vector_type(2))); typedef unsigned u32x2v __attribute__((ext_vector_type(2)));
        const PG8_LAS f32x2v* S = (const PG8_LAS f32x2v*)(lds + 8192);
        const int col0 = u.pn * BM + wc * 32 + 4 * fq;
#pragma unroll
        for (int bj = 0; bj < 2; ++bj)
#pragma unroll
            for (int n = 0; n < 2; ++n) { const f32x4 bv = bias ? *(const f32x4*)(bias + col0 + bj * HALF + n * 16) : (f32x4){0.f, 0.f, 0.f, 0.f};
#pragma unroll
                for (int ai = 0; ai < 2; ++ai)
#pragma unroll
                    for (int m = 0; m < 4; ++m) acc[ai][bj][m][n] += bv; }
        bool bad = st1.run(acc, u, wr, wc, fr, fq, lds, wid, lane) || poison != 0u;
        const float qnan = __builtin_nanf("");
#pragma unroll
        for (int ai = 0; ai < 2; ++ai)
#pragma unroll
            for (int m = 0; m < 4; ++m) { const int r = ai * HALF + wr * 64 + m * 16 + fr; const f32x2v sr = S[r]; const size_t off = (size_t)(u.pm * BM + r) * ldc + col0;
#pragma unroll
                for (int bj = 0; bj < 2; ++bj)
#pragma unroll
                    for (int n = 0; n < 2; ++n) { const f32x4 bs = *(const f32x4*)(base + off + bj * HALF + n * 16); acc[ai][bj][m][n] = bs + (acc[ai][bj][m][n] - sr.x) * sr.y; }
                asm volatile("" : "+v"(acc[ai][0][m][0]), "+v"(acc[ai][0][m][1]), "+v"(acc[ai][1][m][0]), "+v"(acc[ai][1][m][1]));
                if (m & 1) asm volatile("" ::: "memory"); }
        const bool bad1 = bad;
        bad = st2.run(acc, u, wr, wc, fr, fq, lds, wid, lane) || bad;
#pragma unroll
        for (int ai = 0; ai < 2; ++ai)
#pragma unroll
            for (int m = 0; m < 4; ++m) { const int r = ai * HALF + wr * 64 + m * 16 + fr; const f32x2v sr = S[r]; const size_t off = (size_t)(u.pm * BM + r) * ldc + col0;
#pragma unroll
                for (int bj = 0; bj < 2; ++bj)
#pragma unroll
                    for (int n = 0; n < 2; ++n) { const f32x4 x1 = acc[ai][bj][m][n]; *(f32x4*)(out + off + bj * HALF + n * 16) = bad1 ? (f32x4){qnan, qnan, qnan, qnan} : x1;
                        const f32x4 o = (x1 - sr.x) * sr.y; u32x2v w; w.x = cvt_pk_bf16(o[0], o[1]); w.y = cvt_pk_bf16(o[2], o[3]);
                        if (bad) { w.x = 0x7fc07fc0u; w.y = 0x7fc07fc0u; } *(u32x2v*)(xn + off + bj * HALF + n * 16) = w; }
                asm volatile("" ::: "memory"); }
    }
};

template <class Epi, class Sched, bool ALIGN_EPI = false, bool SP2 = false>
__device__ __forceinline__ void gemm_phase(PG8_LAS unsigned char* lds, const Gemm g, const Sched& S, const Epi& E) {
    const int tid = threadIdx.x, wid = __builtin_amdgcn_readfirstlane(tid >> 6), lane = tid & 63, wr = wid >> 2, wc = wid & 3, fr = lane & 15, fq = lane >> 4;
    const int K = g.K, nt = K / BK;
    unsigned voffA[2], voffB[2];
#pragma unroll
    for (int i = 0; i < 2; ++i) { int R, C; stage_rc(tid * 16 + i * 8192, R, C); const int Rb = Epi::PERM ? ((R & ~31) + perm32(R & 31)) : R;
        voffA[i] = (unsigned)(R * K + C) * 2u; voffB[i] = (unsigned)(Rb * K + C) * 2u; }
    const size_t kstep = (size_t)(BK * 2);
    const size_t hstep = (size_t)HALF * K * 2;
    const size_t tstep = 2 * hstep;
    const unsigned ldsw = (unsigned)wid * 1024u;
    const int aoff = lds_byte(wr * 64 + fr, fq * 8), boff = lds_byte(wc * 32 + fr, fq * 8);
#define PG8_SA(b, h) (((b) * 2 + (h)) * HTB)
#define PG8_SB(b, h) ((4 + (b) * 2 + (h)) * HTB)
#define PG8_STAGE(bufoff, gbase, voff) do { _Pragma("unroll") for (int _i = 0; _i < 2; ++_i) \
        __builtin_amdgcn_global_load_lds((const unsigned*)((const char*)(gbase) + (voff)[_i]), (PG8_LAS unsigned*)(lds + (bufoff) + ldsw + _i * 8192), 16, 0, 0); } while (0)
#define PG8_LDA(dst, b, h) do { _Pragma("unroll") for (int m = 0; m < 4; ++m) _Pragma("unroll") for (int k = 0; k < 2; ++k) dst[m][k] = *(const PG8_LAS bf16x8*)(lds + PG8_SA(b, h) + aoff + m * 2048 + k * 1024); } while (0)
#define PG8_LDB(dst, b, h) do { _Pragma("unroll") for (int n = 0; n < 2; ++n) _Pragma("unroll") for (int k = 0; k < 2; ++k) dst[n][k] = *(const PG8_LAS bf16x8*)(lds + PG8_SB(b, h) + boff + n * 2048 + k * 1024); } while (0)
#define PG8_MMA(ai, bj, At, Bt) do { __builtin_amdgcn_s_setprio(1); _Pragma("unroll") for (int m = 0; m < 4; ++m) _Pragma("unroll") for (int n = 0; n < 2; ++n) _Pragma("unroll") for (int k = 0; k < 2; ++k) \
        acc[ai][bj][m][n] = __builtin_amdgcn_mfma_f32_16x16x32_bf16(Bt[n][k], At[m][k], acc[ai][bj][m][n], 0, 0, 0); __builtin_amdgcn_s_setprio(0); } while (0)
#define PG8_WAIT_V(n) asm volatile("s_waitcnt vmcnt(" #n ")" ::: "memory")
#define PG8_WAIT_L(n) asm volatile("s_waitcnt lgkmcnt(" #n ")" ::: "memory")
#define PG8_BAR __builtin_amdgcn_s_barrier()
#define PG8_SCHED __builtin_amdgcn_sched_barrier(0)
    Unit cur, nxt; int ui = 0;
    if (!S.next(0, cur)) return;
    f32x4 acc[2][2][4][2];
#pragma unroll
    for (int a = 0; a < 2; ++a)
#pragma unroll
        for (int b = 0; b < 2; ++b)
#pragma unroll
            for (int m = 0; m < 4; ++m)
#pragma unroll
                for (int n = 0; n < 2; ++n) acc[a][b][m][n] = (f32x4){0.f, 0.f, 0.f, 0.f};
    bf16x8 At[4][2], B0[2][2], B1[2][2];
    const char* cA = (const char*)g.A + (size_t)cur.pm * tstep; const char* cB = (const char*)g.Bt + (size_t)cur.pn * tstep;
    S.a_ready(cur);
    if constexpr (SP2) {
        PG8_STAGE(PG8_SB(0, 0), cB, voffB); PG8_STAGE(PG8_SB(0, 1), cB + hstep, voffB); PG8_STAGE(PG8_SA(0, 0), cA, voffA); PG8_STAGE(PG8_SA(0, 1), cA + hstep, voffA);
        if (wr == 1) PG8_BAR;
        PG8_WAIT_V(2); PG8_BAR;
        PG8_STAGE(PG8_SB(1, 0), cB + kstep, voffB); PG8_STAGE(PG8_SA(1, 0), cA + kstep, voffA); PG8_STAGE(PG8_SB(1, 1), cB + hstep + kstep, voffB);
        PG8_WAIT_V(6); PG8_BAR;
    } else {
        PG8_STAGE(PG8_SB(0, 0), cB, voffB); PG8_STAGE(PG8_SA(0, 0), cA, voffA); PG8_STAGE(PG8_SB(0, 1), cB + hstep, voffB); PG8_STAGE(PG8_SA(0, 1), cA + hstep, voffA);
        if (wr == 1) PG8_BAR;
        PG8_WAIT_V(4); PG8_BAR;
        PG8_STAGE(PG8_SB(1, 0), cB + kstep, voffB); PG8_STAGE(PG8_SA(1, 0), cA + kstep, voffA); PG8_STAGE(PG8_SB(1, 1), cB + hstep + kstep, voffB);
        PG8_WAIT_V(6); PG8_BAR;
    }
    for (;;) {
        const bool has_next = S.next(ui + 1, nxt);
        const char* nA = has_next ? (const char*)g.A + (size_t)nxt.pm * tstep : cA; const char* nB = has_next ? (const char*)g.Bt + (size_t)nxt.pn * tstep : cB;
        for (int t = 0; t < nt; t += 2) {
            const bool last = (t == nt - 2);
            const char* a1 = cA + (size_t)(t + 1) * kstep;
            const char* a2 = last ? nA : cA + (size_t)(t + 2) * kstep; const char* b2 = last ? nB : cB + (size_t)(t + 2) * kstep;
            const char* a3 = a2 + kstep; const char* b3 = b2 + kstep;
            if (last && has_next) S.a_ready(nxt);
            if constexpr (SP2) {
            PG8_LDB(B0, 0, 0); PG8_LDB(B1, 0, 1); PG8_SCHED; PG8_LDA(At, 0, 0); PG8_STAGE(PG8_SA(1, 1), a1 + hstep, voffA);
            PG8_WAIT_V(8); PG8_WAIT_L(0); PG8_BAR; PG8_MMA(0, 0, At, B0); PG8_MMA(0, 1, At, B1); PG8_BAR; PG8_SCHED;
            PG8_LDA(At, 0, 1); PG8_STAGE(PG8_SB(0, 0), b2, voffB); PG8_STAGE(PG8_SB(0, 1), b2 + hstep, voffB); PG8_STAGE(PG8_SA(0, 0), a2, voffA);
            PG8_WAIT_V(8); PG8_WAIT_L(0); PG8_BAR; PG8_MMA(1, 0, At, B0); PG8_MMA(1, 1, At, B1); PG8_BAR; PG8_SCHED;
            PG8_LDB(B0, 1, 0); PG8_LDB(B1, 1, 1); PG8_SCHED; PG8_LDA(At, 1, 0); PG8_STAGE(PG8_SA(0, 1), a2 + hstep, voffA);
            PG8_WAIT_V(8); PG8_WAIT_L(0); PG8_BAR; PG8_MMA(0, 0, At, B0); PG8_MMA(0, 1, At, B1); PG8_BAR; PG8_SCHED;
            PG8_LDA(At, 1, 1); PG8_STAGE(PG8_SB(1, 0), b3, voffB); PG8_STAGE(PG8_SB(1, 1), b3 + hstep, voffB); PG8_STAGE(PG8_SA(1, 0), a3, voffA);
            PG8_WAIT_V(8); PG8_WAIT_L(0); PG8_BAR; PG8_MMA(1, 0, At, B0); PG8_MMA(1, 1, At, B1); PG8_BAR; PG8_SCHED;
            } else {
            PG8_LDB(B0, 0, 0); PG8_SCHED; PG8_LDA(At, 0, 0); PG8_STAGE(PG8_SA(1, 1), a1 + hstep, voffA);
            PG8_WAIT_L(8); PG8_BAR; PG8_WAIT_L(0); PG8_MMA(0, 0, At, B0); PG8_BAR; PG8_SCHED;
            PG8_LDB(B1, 0, 1); PG8_STAGE(PG8_SB(0, 0), b2, voffB);
            PG8_BAR; PG8_WAIT_L(0); PG8_MMA(0, 1, At, B1); PG8_BAR;
            PG8_LDA(At, 0, 1); PG8_STAGE(PG8_SA(0, 0), a2, voffA);
            PG8_BAR; PG8_WAIT_L(0); PG8_MMA(1, 0, At, B0); PG8_BAR; PG8_SCHED;
            PG8_STAGE(PG8_SB(0, 1), b2 + hstep, voffB);
            PG8_WAIT_V(6); PG8_BAR; PG8_MMA(1, 1, At, B1); PG8_BAR;
            PG8_LDB(B0, 1, 0); PG8_SCHED; PG8_LDA(At, 1, 0); PG8_STAGE(PG8_SA(0, 1), a2 + hstep, voffA);
            PG8_WAIT_L(8); PG8_BAR; PG8_WAIT_L(0); PG8_MMA(0, 0, At, B0); PG8_BAR; PG8_SCHED;
            PG8_LDB(B1, 1, 1); PG8_STAGE(PG8_SB(1, 0), b3, voffB);
            PG8_BAR; PG8_WAIT_L(0); PG8_MMA(0, 1, At, B1); PG8_BAR;
            PG8_LDA(At, 1, 1); PG8_STAGE(PG8_SA(1, 0), a3, voffA);
            PG8_BAR; PG8_WAIT_L(0); PG8_MMA(1, 0, At, B0); PG8_BAR; PG8_SCHED;
            PG8_STAGE(PG8_SB(1, 1), b3 + hstep, voffB);
            PG8_WAIT_V(6); PG8_BAR; PG8_MMA(1, 1, At, B1); PG8_BAR;
            }
        }
        if constexpr (ALIGN_EPI) { if (wr == 0) PG8_BAR; }
        if constexpr (!Epi::AFTER_DRAIN) { E(acc, cur, wr, wc, fr, fq); S.done(cur); }
        if (!has_next) break;
#pragma unroll
        for (int a = 0; a < 2; ++a)
#pragma unroll
            for (int b = 0; b < 2; ++b)
#pragma unroll
                for (int m = 0; m < 4; ++m)
#pragma unroll
                    for (int n = 0; n < 2; ++n) acc[a][b][m][n] = (f32x4){0.f, 0.f, 0.f, 0.f};
        cur = nxt; cA = nA; cB = nB; ++ui;
        if constexpr (ALIGN_EPI) { if (wr == 1) PG8_BAR; }
    }
    PG8_WAIT_V(0);
    if constexpr (!ALIGN_EPI) { if (wr == 0) PG8_BAR; }
    PG8_BAR;
    if constexpr (Epi::AFTER_DRAIN) { E.fused(acc, cur, wr, wc, fr, fq, lds, wid, lane); S.done(cur); }
#undef PG8_SA
#undef PG8_SB
#undef PG8_STAGE
#undef PG8_LDA
#undef PG8_LDB
#undef PG8_MMA
#undef PG8_WAIT_V
#undef PG8_WAIT_L
#undef PG8_BAR
#undef PG8_SCHED
}
}
namespace pg8 {
template <class F> struct EpiScalar {
    static constexpr bool PERM = true, AFTER_DRAIN = false; F f;
    __device__ __forceinline__ void operator()(const f32x4 (&acc)[2][2][4][2], const Unit& u, int wr, int wc, int fr, int fq) const {
        const int row0 = u.pm * BM + wr * 64 + fr, col0 = u.pn * BM + wc * 32 + 8 * fq;
#pragma unroll
        for (int ai = 0; ai < 2; ++ai)
#pragma unroll
            for (int m = 0; m < 4; ++m) {
#pragma unroll
                for (int bj = 0; bj < 2; ++bj)
#pragma unroll
                    for (int n = 0; n < 2; ++n)
#pragma unroll
                        for (int e = 0; e < 4; ++e) f(row0 + ai * HALF + m * 16, col0 + bj * HALF + 4 * n + e, acc[ai][bj][m][n][e]);
                asm volatile("" ::: "memory"); }
    }
};
template <class F> struct EpiScalarPair {
    static constexpr bool PERM = true, AFTER_DRAIN = false; F f;
    __device__ __forceinline__ void operator()(const f32x4 (&acc)[2][2][4][2], const Unit& u, int wr, int wc, int fr, int fq) const {
        const int row0 = u.pm * BM + wr * 64 + fr, cl0 = wc * 32 + 8 * fq;
#pragma unroll
        for (int ai = 0; ai < 2; ++ai)
#pragma unroll
            for (int m = 0; m < 4; ++m) {
#pragma unroll
                for (int n = 0; n < 2; ++n)
#pragma unroll
                    for (int e = 0; e < 4; ++e) f(row0 + ai * HALF + m * 16, u.pn, cl0 + 4 * n + e, acc[ai][0][m][n][e], acc[ai][1][m][n][e]);
                asm volatile("" ::: "memory"); }
    }
};
}
#define GAS __attribute__((address_space(1)))
#define LAS __attribute__((address_space(3)))
typedef unsigned short bf16;
typedef unsigned v4u __attribute__((ext_vector_type(4)));
typedef float f32x4 __attribute__((ext_vector_type(4)));
typedef short bf16x8 __attribute__((ext_vector_type(8)));
typedef GAS unsigned gu32;
typedef GAS unsigned long long gu64;
#define RLX_AGENT __ATOMIC_RELAXED, __HIP_MEMORY_SCOPE_AGENT
#define LDS_WAIT() asm volatile("s_waitcnt lgkmcnt(0)" ::: "memory")
#define VM_WAIT() asm volatile("s_waitcnt vmcnt(0)" ::: "memory")
__device__ __forceinline__ unsigned long long rt() { return __builtin_amdgcn_s_memrealtime(); }
__device__ __forceinline__ unsigned f2bf(float f) { unsigned u = __builtin_bit_cast(unsigned, f); return (u + 0x7fffu + ((u >> 16) & 1u)) >> 16; }
__device__ __forceinline__ unsigned pk2(float lo, float hi) { return f2bf(lo) | (f2bf(hi) << 16); }

#define XB_TMO      128
#define XB_XCNT(j)  (256  + 64 * (j))
#define XB_XSUB(j)  (1280 + 64 * (j))
#define XB_XGEN(j)  (2304 + 64 * (j))
#define XB_TOP      3328
#define XB_TOPGEN   3392
#define XCD_BAR_WORDS 3456
#define XB_SPIN_CAP (1u << 18)

__device__ __forceinline__ unsigned xb_ld(unsigned* p)              { return __hip_atomic_load(p, __ATOMIC_RELAXED, __HIP_MEMORY_SCOPE_AGENT); }
__device__ __forceinline__ unsigned xb_add(unsigned* p, unsigned v) { return __hip_atomic_fetch_add(p, v, __ATOMIC_RELAXED, __HIP_MEMORY_SCOPE_AGENT); }
__device__ __forceinline__ unsigned xb_xcc_id() { return (unsigned)__builtin_amdgcn_s_getreg((3 << 11) | 20) & 0xFu; }
#define XB_SPIN(cond, bar) do { unsigned _sp = 0; while (cond) { __builtin_amdgcn_s_sleep(1); \
    if ((++_sp & 255u) == 0u) { if (xb_ld(&(bar)[XB_TMO])) break; if (_sp > XB_SPIN_CAP) { atomicAdd(&(bar)[XB_TMO], 1u); break; } } } } while (0)

struct XcdBarrier {
    unsigned* bar; unsigned x;
    volatile LAS unsigned* st;
};

__device__ __forceinline__ XcdBarrier xcd_barrier_post(unsigned* bar, volatile LAS unsigned* st) {
    XcdBarrier b; b.bar = bar; b.x = xb_xcc_id(); b.st = st;
    if (threadIdx.x == 0) (void)xb_add(&bar[XB_XCNT(b.x)], 1u);
    return b;
}
__device__ __forceinline__ void xcd_barrier_complete(unsigned* bar, unsigned x, unsigned& nloc, unsigned& nx) {
    const unsigned G = gridDim.x * gridDim.y * gridDim.z;
    unsigned sum, cnt, mine, sp = 0u;
    for (;;) {
        sum = 0u; cnt = 0u; mine = 0u;
#pragma unroll
        for (unsigned j = 0; j < 16; ++j) { const unsigned c = xb_ld(&bar[XB_XCNT(j)]); sum += c; cnt += (c > 0u) ? 1u : 0u; mine = (j == x) ? c : mine; }
        if (sum == G) break;
        __builtin_amdgcn_s_sleep(1);
        if ((++sp & 255u) == 0u) { if (xb_ld(&bar[XB_TMO])) break; if (sp > XB_SPIN_CAP) { atomicAdd(&bar[XB_TMO], 1u); break; } }
    }
    nloc = mine > 0u ? mine : 1u; nx = cnt > 0u ? cnt : 1u;
}

__device__ __forceinline__ void xcd_barrier(const XcdBarrier& b) {
    asm volatile("s_waitcnt vmcnt(0)" ::: "memory");
    __syncthreads();
    if (threadIdx.x == 0) {
        unsigned* bar = b.bar;
        __builtin_amdgcn_s_waitcnt(0);
        unsigned nloc = b.st[0], nx = b.st[1];
        if (nloc == 0u) { xcd_barrier_complete(bar, b.x, nloc, nx); b.st[0] = nloc; b.st[1] = nx; }
        const unsigned old = xb_add(&bar[XB_XSUB(b.x)], 1u);
        const unsigned gen = old / nloc;
        if (old + 1u == (gen + 1u) * nloc) {
            __builtin_amdgcn_fence(__ATOMIC_RELEASE, "agent");
            asm volatile("s_waitcnt vmcnt(0)" ::: "memory");
            const unsigned og = xb_add(&bar[XB_TOP], 1u);
            const unsigned tg = og / nx;
            if (og + 1u == (tg + 1u) * nx) xb_add(&bar[XB_TOPGEN], 1u);
            else XB_SPIN(xb_ld(&bar[XB_TOPGEN]) == tg, bar);
            __builtin_amdgcn_fence(__ATOMIC_ACQUIRE, "agent");
            xb_add(&bar[XB_XGEN(b.x)], 1u);
            asm volatile("s_waitcnt vmcnt(0)" ::: "memory");
        } else {
            XB_SPIN(xb_ld(&bar[XB_XGEN(b.x)]) == gen, bar);
            __builtin_amdgcn_fence(__ATOMIC_ACQUIRE, "agent");
            asm volatile("s_waitcnt vmcnt(0)" ::: "memory");
        }
    }
    __syncthreads();
}
#ifndef ATT_FAST
#define ATT_FAST 1
#endif

constexpr int NWAVES = 8, NTHR = NWAVES * 64;
constexpr int BATCH = 4, SEQ = 8192, D = 1024, M = BATCH * SEQ;
constexpr int NHG = 8, HD = 64, HW = NHG * HD;
constexpr int INCOLS = 3080, NPROJ = 3072;
constexpr int NE = 32, NGRP = 4, EPG = 8, DF = 512, PLED = 256;
constexpr int SPAD = 2 * M + NE * 256;
constexpr float ALPHA = 1.189207115002721f, LN_EPS = 1e-5f, LOG2E = 1.4426950408889634f;
constexpr int NPH = 10;

constexpr size_t MiB = 1u << 20;
constexpr size_t WS_CTL = 0, CTL_ZERO_BYTES = 256 * 1024;
constexpr size_t WS_LS = 1 * MiB, WS_CFL = 2 * MiB, WS_CTOT = 3 * MiB, WS_KNT = 3 * MiB + 4096, WS_EID = 3 * MiB + 256 * 1024, WS_GATE = 3 * MiB + 512 * 1024, WS_RANK = 3 * MiB + 768 * 1024,
                 WS_SLOT = 4 * MiB, WS_GSLOT = 4 * MiB + 256 * 1024;
constexpr size_t WS_WIN = 5 * MiB, WS_WOUT = 11 * MiB, WS_WPLE = 13 * MiB, WS_WPG = 14 * MiB, WS_WGU = 16 * MiB, WS_WD = 80 * MiB, WS_PPLE = 112 * MiB;
constexpr size_t WS_R1 = 176 * MiB;
constexpr size_t WS_R2 = 368 * MiB;
constexpr size_t WS_R3 = 432 * MiB;
constexpr size_t WS_END = 504 * MiB;
static_assert(WS_GSLOT + (size_t)SPAD * 4 <= WS_WIN && WS_R1 + (size_t)SPAD * 2048 <= WS_R2 && WS_R3 + (size_t)SPAD * 1024 <= WS_END, "ws map");
constexpr int CW_TMO = 0, CW_BAR = 4096, CW_CNT = 8192;

constexpr int RING_OFF = 0, RING_BYTES = 131072;
constexpr int WGRP_OFF = RING_BYTES;
constexpr int LDSCTL_OFF = RING_BYTES + 16384, MISC_OFF = LDSCTL_OFF + 320, PST_OFF = LDSCTL_OFF + 1024, HIST_OFF = LDSCTL_OFF + 1280, BASE_OFF = LDSCTL_OFF + 1408, ROWL_OFF = LDSCTL_OFF + 2048;
constexpr int LDS_BYTES = 163840;

#define BFLO(w) __builtin_bit_cast(float, (w) << 16)
#define BFHI(w) __builtin_bit_cast(float, (w) & 0xffff0000u)
__device__ __forceinline__ float bf2f(unsigned short v) { return __builtin_bit_cast(float, (unsigned)v << 16); }
__device__ __forceinline__ float wave_sum(float v) {
#pragma unroll
    for (int o = 1; o < 64; o <<= 1) v += __shfl_xor(v, o);
    return v;
}
__device__ __forceinline__ float wave_max(float v) {
#pragma unroll
    for (int o = 1; o < 64; o <<= 1) v = fmaxf(v, __shfl_xor(v, o));
    return v;
}

struct Frame {
    LAS unsigned char* lds; volatile LAS unsigned* MISC; gu32* ctl;
    int tid, lane, wave, vcu, G;
    const float *x, *p, *w_in, *b_forget, *w_out, *ln1g, *ln1b, *w_group, *b_group, *w_router, *b_router, *w_gate, *w_up, *w_down, *w_ple, *w_pg, *ln2g, *ln2b;
    float* out;
    bf16 *Win_t, *Wout_t, *Wple_t, *Wpg_t, *Wgu_t, *Wd_t, *pple, *qkv, *xs, *y, *xb, *mixed, *hb, *pb, *hdn, *mixp;
    float *ls, *cfl, *ctot, *knt, *gatev, *gslot; int *eid, *rank, *slot;
};

struct TileRef { const float* src; bf16* dst; int ldw, ldt; float sc; };
__device__ __forceinline__ void tile_load(f32x4 (&r)[8], const TileRef& t, int lane) {
    const GAS float* p = (const GAS float*)t.src + (size_t)(lane >> 4) * t.ldw + 4 * (lane & 15);
#pragma unroll
    for (int i = 0; i < 8; ++i) r[i] = *(const GAS f32x4*)(p + (size_t)(4 * i) * t.ldw);
}
__device__ __forceinline__ void tile_store(const f32x4 (&r)[8], const TileRef& t, LAS float* scr, int lane) {
#pragma unroll
    for (int i = 0; i < 8; ++i) { LAS float* s = scr + (4 * i + (lane >> 4)) * 65 + 4 * (lane & 15); s[0] = r[i].x * t.sc; s[1] = r[i].y * t.sc; s[2] = r[i].z * t.sc; s[3] = r[i].w * t.sc; }
    LDS_WAIT(); asm volatile("" ::: "memory");
    const int c = lane & 3;
#pragma unroll
    for (int j = 0; j < 4; ++j) { const int n = 16 * j + (lane >> 2); const LAS float* s = scr + (8 * c) * 65 + n;
        v4u o; o.x = pk2(s[0 * 65], s[1 * 65]); o.y = pk2(s[2 * 65], s[3 * 65]); o.z = pk2(s[4 * 65], s[5 * 65]); o.w = pk2(s[6 * 65], s[7 * 65]);
        *(GAS v4u*)(t.dst + (size_t)n * t.ldt + 8 * c) = o; }
    LDS_WAIT(); asm volatile("" ::: "memory");
}
__device__ __forceinline__ float log_sigmoid_f(float v) { return fminf(v, 0.f) - log1pf(expf(-fabsf(v))); }
constexpr int I_IN = 16 * 48, I_OUT = 16 * 16, I_PLE = 4 * 16, I_PG = 16 * 16, I_GU = NE * 2 * 16 * 8, I_DN = NE * 8 * 16;
constexpr int P0_ITEMS = I_IN + I_OUT + I_PLE + I_PG + I_GU + I_DN;
__device__ __forceinline__ TileRef p0_item(Frame& F, int it, int sub) {
    int r = it; TileRef t; t.sc = 1.f;
    if (r < I_IN) { const int kb = 2 * (r / 48) + sub, nb = r % 48, s = nb >> 3;
        t.src = F.w_in + (size_t)kb * 32 * INCOLS + nb * 64; t.ldw = INCOLS; t.dst = F.Win_t + (size_t)nb * 64 * D + kb * 32; t.ldt = D; t.sc = (s == 0 || s == 3) ? 0.125f * LOG2E : 1.f; return t; } r -= I_IN;
    if (r < I_OUT) { const int kb = 2 * (r / 16) + sub, nb = r % 16; t.src = F.w_out + (size_t)kb * 32 * D + nb * 64; t.ldw = D; t.dst = F.Wout_t + (size_t)nb * 64 * D + kb * 32; t.ldt = D; return t; } r -= I_OUT;
    if (r < I_PLE) { const int kb = 2 * (r / 16) + sub, nb = r % 16; t.src = F.w_ple + (size_t)kb * 32 * D + nb * 64; t.ldw = D; t.dst = F.Wple_t + (size_t)nb * 64 * PLED + kb * 32; t.ldt = PLED; return t; } r -= I_PLE;
    if (r < I_PG) { const int kb = 2 * (r / 16) + sub, nb = r % 16; t.src = F.w_pg + (size_t)kb * 32 * D + nb * 64; t.ldw = D; t.dst = F.Wpg_t + (size_t)nb * 64 * D + kb * 32; t.ldt = D; return t; } r -= I_PG;
    if (r < I_GU) { const int e = r / 256, gu = (r >> 7) & 1, kb = 2 * ((r >> 3) & 15) + sub, nb = r & 7;
        t.src = (gu ? F.w_up : F.w_gate) + (size_t)e * D * DF + (size_t)kb * 32 * DF + nb * 64; t.ldw = DF;
        const int row = e * 1024 + (nb >> 1) * 256 + gu * 128 + (nb & 1) * 64;
        t.dst = F.Wgu_t + (size_t)row * D + kb * 32; t.ldt = D; return t; } r -= I_GU;
    { const int e = r / 128, kb = 2 * ((r >> 4) & 7) + sub, nb = r & 15;
        t.src = F.w_down + (size_t)e * DF * D + (size_t)kb * 32 * D + nb * 64; t.ldw = D; t.dst = F.Wd_t + (size_t)(e * 1024 + nb * 64) * DF + kb * 32; t.ldt = DF; return t; }
}
template <int PART> __device__ __forceinline__ void p0_prologue(Frame& F) {
    LAS float* scr = (LAS float*)(F.lds + RING_OFF + F.wave * 16384);
    const int gw = F.vcu * NWAVES + F.wave, NGW = F.G * NWAVES;
    if (PART == 0) {
        f32x4 ra[8], rb[8]; int it = gw;
        TileRef ta = p0_item(F, it < P0_ITEMS ? it : 0, 0), tb = p0_item(F, it < P0_ITEMS ? it : 0, 1);
        if (it < P0_ITEMS) { tile_load(ra, ta, F.lane); tile_load(rb, tb, F.lane); }
        while (it < P0_ITEMS) {
            const int i2 = it + NGW;
            tile_store(ra, ta, scr, F.lane);
            if (i2 < P0_ITEMS) { ta = p0_item(F, i2, 0); tile_load(ra, ta, F.lane); }
            tile_store(rb, tb, scr, F.lane);
            if (i2 < P0_ITEMS) { tb = p0_item(F, i2, 1); tile_load(rb, tb, F.lane); }
            it = i2;
        }
    }
    __syncthreads();
    if (PART == 1) {
    __syncthreads();
    LAS float* wf = (LAS float*)(F.lds + RING_OFF);
    for (int i = F.tid; i < 2048; i += NTHR) { const int c = i >> 1, j0 = (i & 1) * 4; const f32x4 w = *(const GAS f32x4*)(F.w_in + (size_t)c * INCOLS + NPROJ + j0);
        wf[(j0 + 0) * 1024 + c] = w.x; wf[(j0 + 1) * 1024 + c] = w.y; wf[(j0 + 2) * 1024 + c] = w.z; wf[(j0 + 3) * 1024 + c] = w.w; }
    __syncthreads();
    {
        f32x4 v[4], vn[4]; int m = gw;
        if (m < M) { const GAS f32x4* xr = (const GAS f32x4*)(F.x + (size_t)m * D) + F.lane;
#pragma unroll
            for (int j = 0; j < 4; ++j) v[j] = xr[64 * j]; }
        const float bfg = (F.lane < 8) ? F.b_forget[F.lane] : 0.f;
        for (; m < M; m += NGW) {
            const int mn = m + NGW;
            if (mn < M) { const GAS f32x4* xr = (const GAS f32x4*)(F.x + (size_t)mn * D) + F.lane;
#pragma unroll
                for (int j = 0; j < 4; ++j) vn[j] = xr[64 * j]; }
            GAS unsigned long long* o8 = (GAS unsigned long long*)(F.xb + (size_t)m * D) + F.lane;
#pragma unroll
            for (int j = 0; j < 4; ++j) o8[64 * j] = (unsigned long long)pk2(v[j].x, v[j].y) | ((unsigned long long)pk2(v[j].z, v[j].w) << 32);
            float mine = 0.f;
#pragma unroll
            for (int g = 0; g < 8; ++g) { float a = 0.f;
#pragma unroll
                for (int j = 0; j < 4; ++j) { const f32x4 w = *(const LAS f32x4*)(wf + g * 1024 + 4 * F.lane + 256 * j); a += (v[j].x * w.x + v[j].y * w.y) + (v[j].z * w.z + v[j].w * w.w); }
                a = wave_sum(a); if (F.lane == g) mine = a; }
            if (F.lane < 8) F.ls[(size_t)m * 8 + F.lane] = log_sigmoid_f(mine + bfg);
#pragma unroll
            for (int j = 0; j < 4; ++j) v[j] = vn[j];
        }
    }
    __syncthreads(); }
    if (PART == 2) { const int gtid = blockIdx.x * NTHR + F.tid, NT = F.G * NTHR;
      for (int i = gtid; i < M * PLED / 8; i += NT) { const GAS f32x4* s = (const GAS f32x4*)(F.p) + 2 * (size_t)i; const f32x4 a = s[0], b = s[1];
          v4u o; o.x = pk2(a.x, a.y); o.y = pk2(a.z, a.w); o.z = pk2(b.x, b.y); o.w = pk2(b.z, b.w); ((GAS v4u*)F.pb)[i] = o; } }
}

__device__ __forceinline__ void p2_scan(Frame& F) {
    LAS float* wt = (LAS float*)(F.lds + RING_OFF);
    for (int it = blockIdx.x; it < 256; it += F.G) {
        const int bh = it >> 3, chunk = it & 7, b = bh >> 3, h = bh & 7, t = chunk * 1024 + 2 * F.tid;
        const float a0 = F.ls[(size_t)(b * SEQ + t) * 8 + h] * LOG2E, a1 = F.ls[(size_t)(b * SEQ + t + 1) * 8 + h] * LOG2E;
        float s = a0 + a1;
#pragma unroll
        for (int o = 1; o < 64; o <<= 1) { const float u = __shfl_up(s, o); if (F.lane >= o) s += u; }
        __syncthreads();
        if (F.lane == 63) wt[F.wave] = s;
        __syncthreads();
        float off = 0.f, tot = 0.f;
#pragma unroll
        for (int w = 0; w < 8; ++w) { const float u = wt[w]; if (w < F.wave) off += u; tot += u; }
        const float i1 = off + s, i0 = i1 - a1;
        F.cfl[(size_t)bh * SEQ + t] = i0; F.cfl[(size_t)bh * SEQ + t + 1] = i1;
        if (F.tid == 0) F.ctot[bh * 8 + chunk] = tot;
        const bf16* kf = F.qkv + (size_t)4 * M * HW;
        float nmax = 0.f;
#pragma unroll
        for (int rr = 0; rr < 2; ++rr) { const GAS v4u* kp = (const GAS v4u*)(kf + (size_t)(b * SEQ + t + rr) * HW + h * HD); float n2 = 0.f;
#pragma unroll
            for (int c = 0; c < 8; ++c) { const v4u w = kp[c];
#pragma unroll
                for (int e = 0; e < 4; ++e) { const float lo = __builtin_bit_cast(float, w[e] << 16), hi = __builtin_bit_cast(float, w[e] & 0xffff0000u); n2 += lo * lo + hi * hi; } }
            nmax = fmaxf(nmax, n2); }
#pragma unroll
        for (int o = 1; o < 32; o <<= 1) nmax = fmaxf(nmax, __shfl_xor(nmax, o));
        if ((F.lane & 31) == 0) F.knt[bh * 128 + chunk * 16 + F.wave * 2 + (F.lane >> 5)] = sqrtf(nmax);
    }
}

#if !defined(ATT_FAST) || !ATT_FAST
__device__ __forceinline__ void ld64(float (&d)[64], const bf16* p) {
    const GAS v4u* s = (const GAS v4u*)p;
#pragma unroll
    for (int c = 0; c < 8; ++c) { const v4u w = s[c];
#pragma unroll
        for (int e = 0; e < 4; ++e) { d[c * 8 + 2 * e] = BFLO(w[e]); d[c * 8 + 2 * e + 1] = BFHI(w[e]); } }
}
__device__ __forceinline__ float dot64(const float (&q)[64], const bf16* p) {
    const GAS v4u* s = (const GAS v4u*)p; float z = 0.f;
#pragma unroll
    for (int c = 0; c < 8; ++c) { const v4u w = s[c];
#pragma unroll
        for (int e = 0; e < 4; ++e) { z += q[c * 8 + 2 * e] * BFLO(w[e]); z += q[c * 8 + 2 * e + 1] * BFHI(w[e]); } }
    return z;
}
__device__ __forceinline__ void axpy64(float (&o)[64], float a, const bf16* p) {
    const GAS v4u* s = (const GAS v4u*)p;
#pragma unroll
    for (int c = 0; c < 8; ++c) { const v4u w = s[c];
#pragma unroll
        for (int e = 0; e < 4; ++e) { o[c * 8 + 2 * e] += a * BFLO(w[e]); o[c * 8 + 2 * e + 1] += a * BFHI(w[e]); } }
}
__device__ __forceinline__ void st64(bf16* p, const float (&d)[64], float sc) {
    GAS v4u* s = (GAS v4u*)p;
#pragma unroll
    for (int c = 0; c < 8; ++c) { v4u w;
#pragma unroll
        for (int e = 0; e < 4; ++e) w[e] = pk2(d[c * 8 + 2 * e] * sc, d[c * 8 + 2 * e + 1] * sc);
        s[c] = w; }
}
__device__ __forceinline__ void p3_attn_simple(Frame& F) {
    const int gtid = blockIdx.x * NTHR + F.tid, NT = F.G * NTHR;
    const bf16 *Qs = F.qkv, *Ks = F.qkv + (size_t)1 * M * HW, *Vs = F.qkv + (size_t)2 * M * HW, *Qf = F.qkv + (size_t)3 * M * HW, *Kf = F.qkv + (size_t)4 * M * HW, *Vf = F.qkv + (size_t)5 * M * HW;
    for (int idx = gtid; idx < M * NHG; idx += NT) {
        const int h = idx >> 15, m = idx & (M - 1), b = m >> 13, t = m & (SEQ - 1);
        float q[64], o[64];
        ld64(q, Qs + (size_t)m * HW + h * HD);
#pragma unroll
        for (int d = 0; d < 64; ++d) o[d] = 0.f;
        float C2 = 0.f;
        for (int s = t - 1; s >= 0; --s) {
            const float z = dot64(q, Ks + (size_t)(b * SEQ + s) * HW + h * HD);
            const float L2 = -(fmaxf(z, 0.f) * LOG2E + log2f(1.f + exp2f(-fabsf(z) * LOG2E)));
            const float w = exp2f(z * LOG2E + L2 + C2);
            axpy64(o, w, Vs + (size_t)(b * SEQ + s) * HW + h * HD);
            C2 += L2;
            if (C2 < -160.f) break;
        }
        st64(F.mixed + (size_t)m * D + h * HD, o, 1.f);
    }
    for (int idx = gtid; idx < M * NHG; idx += NT) {
        const int h = idx >> 15, m = idx & (M - 1), b = m >> 13, t = m & (SEQ - 1), bh = b * 8 + h;
        float q[64], o[64];
        ld64(q, Qf + (size_t)m * HW + h * HD);
#pragma unroll
        for (int d = 0; d < 64; ++d) o[d] = 0.f;
        float cq = F.cfl[(size_t)bh * SEQ + t];
        for (int c = 0; c < (t >> 10); ++c) cq += F.ctot[bh * 8 + c];
        float carry = 0.f, mr = -1e30f, l = 0.f;
        for (int s = 0; s <= t; ++s) {
            if ((s & 1023) == 0 && s > 0) carry += F.ctot[bh * 8 + (s >> 10) - 1];
            const float z = dot64(q, Kf + (size_t)(b * SEQ + s) * HW + h * HD);
            const float s2 = z * LOG2E + (cq - (F.cfl[(size_t)bh * SEQ + s] + carry));
            if (s2 > mr) { const float f = exp2f(mr - s2); l *= f;
#pragma unroll
                for (int d = 0; d < 64; ++d) o[d] *= f;
                mr = s2; }
            const float pw = exp2f(s2 - mr); l += pw;
            axpy64(o, pw, Vf + (size_t)(b * SEQ + s) * HW + h * HD);
        }
        st64(F.mixed + (size_t)m * D + HW + h * HD, o, 1.f / l);
    }
}

#endif
struct FProj { bf16* qkv; __device__ __forceinline__ void operator()(int row, int col, float v) const { const int t = col >> 9, cc = col & 511; const float sc = (t == 0 || t == 3) ? 0.125f : 1.f;
    qkv[(size_t)t * M * HW + (size_t)row * HW + cc] = (bf16)f2bf(v * sc); } };
struct FBf16 { bf16* O; int ldc; int cmask; __device__ __forceinline__ void operator()(int row, int col, float v) const { O[(size_t)row * ldc + (col & cmask)] = (bf16)f2bf(v); } };
struct FPre { const float* x; float* out; __device__ __forceinline__ void operator()(int row, int col, float v) const { const size_t i = (size_t)row * D + col; out[i] = ALPHA * x[i] + v; } };
struct FSwiglu { bf16* hdn; const float* gslot; __device__ __forceinline__ void operator()(int row, int pn, int cl, float g, float u) const {
    const int f = (pn & 3) * 128 + cl; const float s = g / (1.f + __expf(-g)); hdn[(size_t)row * DF + f] = (bf16)f2bf(s * u * gslot[row]); } };
struct FComb { float* out; const bf16* pple; const bf16* y; const int* slot; __device__ __forceinline__ void operator()(int row, int col, float v) const {
    const size_t i = (size_t)row * D + col; const int s0 = slot[row * 2], s1 = slot[row * 2 + 1]; const float sig = 1.f / (1.f + __expf(-v));
    out[i] = ALPHA * out[i] + bf2f(pple[i]) * sig + bf2f(y[(size_t)s0 * D + col]) + bf2f(y[(size_t)s1 * D + col]); } };

#ifndef PROBE_TWICE
#define PROBE_TWICE -1
#endif
template <class S> struct Rep2T : S {
    __device__ __forceinline__ bool next(int i, pg8::Unit& u) const { return S::next(i >> 1, u); }
};
template <class S, bool ON> struct Rep2Sel { typedef S type; };
template <class S> struct Rep2Sel<S, true> { typedef Rep2T<S> type; };
#define Rep2(S, ON) typename Rep2Sel<S, ON>::type

namespace pg8 {
struct EpiPre {
    static constexpr bool PERM = true, AFTER_DRAIN = false; const float* x; float* out;
    __device__ __forceinline__ void operator()(const f32x4 (&acc)[2][2][4][2], const Unit& u, int wr, int wc, int fr, int fq) const {
        const int row0 = u.pm * BM + wr * 64 + fr, col0 = u.pn * BM + wc * 32 + 8 * fq;
#pragma unroll
        for (int ai = 0; ai < 2; ++ai)
#pragma unroll
            for (int m = 0; m < 4; ++m) { const size_t off = (size_t)(row0 + ai * HALF + m * 16) * D + col0;
#pragma unroll
                for (int bj = 0; bj < 2; ++bj) { const f32x4 x0 = *(const f32x4*)(x + off + bj * HALF), x1 = *(const f32x4*)(x + off + bj * HALF + 4);
                    *(f32x4*)(out + off + bj * HALF) = x0 * ALPHA + acc[ai][bj][m][0]; *(f32x4*)(out + off + bj * HALF + 4) = x1 * ALPHA + acc[ai][bj][m][1]; }
                asm volatile("" ::: "memory"); }
    }
};
struct EpiSwiglu {
    static constexpr bool PERM = true, AFTER_DRAIN = false; bf16_t* hdn; const float* gslot;
    __device__ __forceinline__ void operator()(const f32x4 (&acc)[2][2][4][2], const Unit& u, int wr, int wc, int fr, int fq) const {
        const int row0 = u.pm * BM + wr * 64 + fr, f0 = (u.pn & 3) * 128 + wc * 32 + 8 * fq;
#pragma unroll
        for (int ai = 0; ai < 2; ++ai)
#pragma unroll
            for (int m = 0; m < 4; ++m) { const int r = row0 + ai * HALF + m * 16; const float gs = gslot[r]; float v[8];
#pragma unroll
                for (int n = 0; n < 2; ++n)
#pragma unroll
                    for (int e = 0; e < 4; ++e) { const float g = acc[ai][0][m][n][e], up = acc[ai][1][m][n][e]; v[4 * n + e] = g * __builtin_amdgcn_rcpf(1.f + __expf(-g)) * up * gs; }
                u32x4 w; w.x = cvt_pk_bf16(v[0], v[1]); w.y = cvt_pk_bf16(v[2], v[3]); w.z = cvt_pk_bf16(v[4], v[5]); w.w = cvt_pk_bf16(v[6], v[7]);
                *(u32x4*)(hdn + (size_t)r * DF + f0) = w; }
    }
};
struct EpiPle {
    static constexpr bool PERM = true, AFTER_DRAIN = false; bf16_t* pple;
    __device__ __forceinline__ void operator()(const f32x4 (&acc)[2][2][4][2], const Unit& u, int wr, int wc, int fr, int fq) const {
        const int row0 = u.pm * BM + wr * 64 + fr, col0 = u.pn * BM + wc * 32 + 8 * fq;
#pragma unroll
        for (int ai = 0; ai < 2; ++ai)
#pragma unroll
            for (int m = 0; m < 4; ++m) { const size_t off = (size_t)(row0 + ai * HALF + m * 16) * D + col0;
#pragma unroll
                for (int bj = 0; bj < 2; ++bj) { const u32x4 pp = *(const u32x4*)(pple + off + bj * HALF); float v[8];
#pragma unroll
                    for (int e = 0; e < 8; ++e) { const float g = acc[ai][bj][m][e >> 2][e & 3]; const unsigned pw = pp[e >> 1];
                        const float pv = (e & 1) ? __builtin_bit_cast(float, pw & 0xffff0000u) : __builtin_bit_cast(float, pw << 16);
                        v[e] = pv * __builtin_amdgcn_rcpf(1.f + __expf(-g)); }
                    u32x4 w; w.x = cvt_pk_bf16(v[0], v[1]); w.y = cvt_pk_bf16(v[2], v[3]); w.z = cvt_pk_bf16(v[4], v[5]); w.w = cvt_pk_bf16(v[6], v[7]);
                    *(u32x4*)(pple + off + bj * HALF) = w; }
                asm volatile("" ::: "memory"); }
    }
};
}

struct MoeOrder {
    const LAS int* pst; int nunits, G, c;
    __device__ __forceinline__ bool next(int i, pg8::Unit& u) const {
        const int L = i * G + c; if (L >= nunits) return false;
        const int pm = L >> 2, r0 = pm * 256; int e = 0;
        for (int k = 0; k < NE - 1; ++k) if (r0 >= pst[k + 1]) e = k + 1;
        u.pm = pm; u.pn = e * 4 + (L & 3); return true;
    }
    __device__ __forceinline__ void a_ready(const pg8::Unit&) const {}
    __device__ __forceinline__ void done(const pg8::Unit&) const {}
};
__device__ __forceinline__ void build_pstart(Frame& F) {
    LAS int* pst = (LAS int*)(F.lds + PST_OFF);
    if (F.tid == 0) { int acc = 0; for (int e = 0; e < NE; ++e) { const int c = (int)__hip_atomic_load(F.ctl + CW_CNT + 64 * e, RLX_AGENT); pst[e] = acc; acc += (c + 255) & ~255; } pst[NE] = acc; }
    __syncthreads();
}

constexpr int RB = 2;
__device__ __forceinline__ unsigned long long pk4(const f32x4 v) { return (unsigned long long)pk2(v.x, v.y) | ((unsigned long long)pk2(v.z, v.w) << 32); }
__device__ __forceinline__ float rdl(float v, int l) { return __builtin_bit_cast(float, __builtin_amdgcn_readlane(__builtin_bit_cast(int, v), l)); }
template <int H, int K> __device__ __forceinline__ void rs_step(float* a, int lane) {
    const bool up = (lane >> K) & 1;
#pragma unroll
    for (int i = 0; i < H; ++i) { const float keep = up ? a[H + i] : a[i], send = up ? a[i] : a[H + i]; a[i] = keep + __shfl_xor(send, 1 << K); }
}
__device__ __forceinline__ void p5_ln_route(Frame& F) {
    LAS unsigned* hist = (LAS unsigned*)(F.lds + HIST_OFF); LAS unsigned* base = (LAS unsigned*)(F.lds + BASE_OFF);
    LAS int* eidL = (LAS int*)(F.lds + ROWL_OFF); LAS int* rankL = eidL + 256;
    LAS f32x4* wr = (LAS f32x4*)(F.lds + RING_OFF); LAS f32x4* wg = (LAS f32x4*)(F.lds + WGRP_OFF);
    for (int i = F.tid; i < 8192; i += NTHR) { const int c = i >> 3, pc = i & 7, g = pc >> 1, half = pc & 1, ln = (c & 255) >> 2, j = c >> 8, e = c & 3;
        wr[((((g * 4 + j) * 4 + e) * 2 + half) << 6) + ln] = *(const GAS f32x4*)(F.w_router + (size_t)c * NE + pc * 4); }
    for (int c = F.tid; c < 1024; c += NTHR) { const int ln = (c & 255) >> 2, j = c >> 8, e = c & 3; wg[((j * 4 + e) << 6) + ln] = *(const GAS f32x4*)(F.w_group + (size_t)c * 4); }
    if (F.tid < NE) hist[F.tid] = 0u;
    __syncthreads();
    f32x4 gv[4], bv[4];
#pragma unroll
    for (int j = 0; j < 4; ++j) { gv[j] = *(const GAS f32x4*)(F.ln1g + 4 * F.lane + 256 * j); bv[j] = *(const GAS f32x4*)(F.ln1b + 4 * F.lane + 256 * j); }
    for (int r0 = F.wave * 2; r0 < 128; r0 += NWAVES * 2) {
        f32x4 v[2][4]; float st[4];
#pragma unroll
        for (int rr = 0; rr < 2; ++rr) { const size_t ro = (size_t)(blockIdx.x * 128 + r0 + rr) * D;
            const GAS f32x4* pr = (const GAS f32x4*)(F.x + ro) + F.lane; const GAS unsigned long long* pm = (const GAS unsigned long long*)(F.mixp + ro) + F.lane;
#pragma unroll
            for (int j = 0; j < 4; ++j) { const f32x4 xv = pr[64 * j]; const unsigned long long mw = pm[64 * j]; const unsigned m0 = (unsigned)mw, m1 = (unsigned)(mw >> 32);
                v[rr][j] = (f32x4){xv.x * ALPHA + BFLO(m0), xv.y * ALPHA + BFHI(m0), xv.z * ALPHA + BFLO(m1), xv.w * ALPHA + BFHI(m1)}; } }
#pragma unroll
        for (int rr = 0; rr < 2; ++rr) { float s = 0.f, q = 0.f;
#pragma unroll
            for (int j = 0; j < 4; ++j) { s += (v[rr][j].x + v[rr][j].y) + (v[rr][j].z + v[rr][j].w); q += (v[rr][j].x * v[rr][j].x + v[rr][j].y * v[rr][j].y) + (v[rr][j].z * v[rr][j].z + v[rr][j].w * v[rr][j].w); }
            st[2 * rr] = s; st[2 * rr + 1] = q; }
        rs_step<2, 5>(st, F.lane); rs_step<1, 4>(st, F.lane);
#pragma unroll
        for (int o = 1; o < 16; o <<= 1) st[0] += __shfl_xor(st[0], o);
        float gl[8];
#pragma unroll
        for (int i = 0; i < 8; ++i) gl[i] = 0.f;
#pragma unroll
        for (int rr = 0; rr < 2; ++rr) { const int m = blockIdx.x * 128 + r0 + rr;
            const float sum = rdl(st[0], 32 * rr), sq = rdl(st[0], 32 * rr + 16);
            const float mean = sum * (1.f / D), rstd = 1.f / sqrtf(fmaxf(sq * (1.f / D) - mean * mean, 0.f) + LN_EPS);
            GAS f32x4* pr = (GAS f32x4*)(F.out + (size_t)m * D) + F.lane; GAS unsigned long long* o8 = (GAS unsigned long long*)(F.hb + (size_t)m * D) + F.lane;
#pragma unroll
            for (int j = 0; j < 4; ++j) { v[rr][j] = (v[rr][j] - mean) * rstd * gv[j] + bv[j]; pr[64 * j] = v[rr][j]; o8[64 * j] = pk4(v[rr][j]); } }
#pragma unroll
        for (int j = 0; j < 4; ++j)
#pragma unroll
            for (int e = 0; e < 4; ++e) { const f32x4 w = wg[((j * 4 + e) << 6) + F.lane];
#pragma unroll
                for (int rr = 0; rr < 2; ++rr) { const float hv = v[rr][j][e]; gl[4 * rr] += hv * w.x; gl[4 * rr + 1] += hv * w.y; gl[4 * rr + 2] += hv * w.z; gl[4 * rr + 3] += hv * w.w; } }
        rs_step<4, 5>(gl, F.lane); rs_step<2, 4>(gl, F.lane); rs_step<1, 3>(gl, F.lane);
#pragma unroll
        for (int o = 1; o < 8; o <<= 1) gl[0] += __shfl_xor(gl[0], o);
        int gs[2]; float gprob[2]; float el[16];
#pragma unroll
        for (int rr = 0; rr < 2; ++rr) { float t[4];
#pragma unroll
            for (int i = 0; i < 4; ++i) t[i] = rdl(gl[0], 8 * (4 * rr + i)) + F.b_group[i];
            int g = 0; float gm = t[0];
#pragma unroll
            for (int i = 1; i < 4; ++i) if (t[i] > gm) { gm = t[i]; g = i; }
            gs[rr] = g; float gden = 0.f;
#pragma unroll
            for (int i = 0; i < 4; ++i) gden += expf(t[i] - gm);
            gprob[rr] = 1.f / gden; }
#pragma unroll
        for (int i = 0; i < 16; ++i) el[i] = 0.f;
#pragma unroll
        for (int j = 0; j < 4; ++j)
#pragma unroll
            for (int e = 0; e < 4; ++e)
#pragma unroll
                for (int rr = 0; rr < 2; ++rr) { const LAS f32x4* wp = wr + ((((gs[rr] * 4 + j) * 4 + e) * 2) << 6) + F.lane; const f32x4 w0 = wp[0], w1 = wp[64]; const float hv = v[rr][j][e];
                    el[8 * rr + 0] += hv * w0.x; el[8 * rr + 1] += hv * w0.y; el[8 * rr + 2] += hv * w0.z; el[8 * rr + 3] += hv * w0.w;
                    el[8 * rr + 4] += hv * w1.x; el[8 * rr + 5] += hv * w1.y; el[8 * rr + 6] += hv * w1.z; el[8 * rr + 7] += hv * w1.w; }
        rs_step<8, 5>(el, F.lane); rs_step<4, 4>(el, F.lane); rs_step<2, 3>(el, F.lane); rs_step<1, 2>(el, F.lane);
#pragma unroll
        for (int o = 1; o < 4; o <<= 1) el[0] += __shfl_xor(el[0], o);
#pragma unroll
        for (int rr = 0; rr < 2; ++rr) { const int r = r0 + rr, m = blockIdx.x * 128 + r; float t[8];
#pragma unroll
            for (int i = 0; i < 8; ++i) t[i] = rdl(el[0], 4 * (8 * rr + i)) + F.b_router[gs[rr] * EPG + i];
            int i1 = 0; float v1 = t[0];
#pragma unroll
            for (int i = 1; i < 8; ++i) if (t[i] > v1) { v1 = t[i]; i1 = i; }
            int i2 = (i1 == 0) ? 1 : 0; float v2 = (i1 == 0) ? t[1] : t[0];
#pragma unroll
            for (int i = 1; i < 8; ++i) if (i != i1 && t[i] > v2) { v2 = t[i]; i2 = i; }
            const float e2 = expf(v2 - v1), g1 = 1.f / (1.f + e2), g2 = e2 * g1;
            if (F.lane == 0) {
                const int ea = gs[rr] * EPG + i1, eb = gs[rr] * EPG + i2;
                const unsigned ra = __hip_atomic_fetch_add(hist + ea, 1u, __ATOMIC_RELAXED, __HIP_MEMORY_SCOPE_WORKGROUP);
                const unsigned rb = __hip_atomic_fetch_add(hist + eb, 1u, __ATOMIC_RELAXED, __HIP_MEMORY_SCOPE_WORKGROUP);
                eidL[r * 2] = ea; eidL[r * 2 + 1] = eb; rankL[r * 2] = (int)ra; rankL[r * 2 + 1] = (int)rb;
                F.eid[m * 2] = ea; F.eid[m * 2 + 1] = eb; F.gatev[m * 2] = g1 * gprob[rr]; F.gatev[m * 2 + 1] = g2 * gprob[rr];
            } }
    }
    __syncthreads();
    if (F.tid < NE) base[F.tid] = __hip_atomic_fetch_add(F.ctl + CW_CNT + 64 * F.tid, hist[F.tid], RLX_AGENT);
    __syncthreads();
    if (F.tid < 256) F.rank[blockIdx.x * 256 + F.tid] = rankL[F.tid] + (int)base[eidL[F.tid]];
}
__device__ __forceinline__ void p6_slots_gather(Frame& F) {
    build_pstart(F);
    const LAS int* pst = (const LAS int*)(F.lds + PST_OFF);
    for (int r0 = F.wave * 4; r0 < 128; r0 += NWAVES * 4) {
        v4u a[4], b[4]; int s0[4], s1[4];
#pragma unroll
        for (int rr = 0; rr < 4; ++rr) { const int m = blockIdx.x * 128 + r0 + rr; int s = 0;
            if (F.lane < 2) { const int e = F.eid[m * 2 + F.lane]; s = pst[e] + F.rank[m * 2 + F.lane]; F.slot[m * 2 + F.lane] = s; F.gslot[s] = F.gatev[m * 2 + F.lane]; }
            s0[rr] = __shfl(s, 0); s1[rr] = __shfl(s, 1);
            const GAS v4u* src = (const GAS v4u*)(F.hb + (size_t)m * D); a[rr] = src[F.lane]; b[rr] = src[F.lane + 64]; }
#pragma unroll
        for (int rr = 0; rr < 4; ++rr) { GAS v4u* d0 = (GAS v4u*)(F.xs + (size_t)s0[rr] * D); GAS v4u* d1 = (GAS v4u*)(F.xs + (size_t)s1[rr] * D);
            d0[F.lane] = a[rr]; d0[F.lane + 64] = b[rr]; d1[F.lane] = a[rr]; d1[F.lane + 64] = b[rr]; }
    }
}
__device__ __forceinline__ void p9_final(Frame& F, bool poison) {
    f32x4 gv[4], bv[4];
#pragma unroll
    for (int j = 0; j < 4; ++j) { gv[j] = *(const GAS f32x4*)(F.ln2g + 4 * F.lane + 256 * j); bv[j] = *(const GAS f32x4*)(F.ln2b + 4 * F.lane + 256 * j); }
    const int gw = blockIdx.x * NWAVES + F.wave, NGW = F.G * NWAVES; const float qn = __builtin_nanf("");
    for (int m0 = gw * RB; m0 < M; m0 += NGW * RB) {
        f32x4 v[RB][4]; float mean[RB], rstd[RB];
#pragma unroll
        for (int rr = 0; rr < RB; ++rr) { const int m = m0 + rr; const int s0 = F.slot[2 * m], s1 = F.slot[2 * m + 1];
            const GAS f32x4* pr = (const GAS f32x4*)(F.out + (size_t)m * D) + F.lane;
            const GAS unsigned long long* pp = (const GAS unsigned long long*)(F.pple + (size_t)m * D) + F.lane;
            const GAS unsigned long long* y0 = (const GAS unsigned long long*)(F.y + (size_t)s0 * D) + F.lane; const GAS unsigned long long* y1 = (const GAS unsigned long long*)(F.y + (size_t)s1 * D) + F.lane;
#pragma unroll
            for (int j = 0; j < 4; ++j) { const f32x4 h = pr[64 * j]; const unsigned long long pw = pp[64 * j], aw = y0[64 * j], bw = y1[64 * j];
                const unsigned p0 = (unsigned)pw, p1 = (unsigned)(pw >> 32), a0 = (unsigned)aw, a1 = (unsigned)(aw >> 32), b0 = (unsigned)bw, b1 = (unsigned)(bw >> 32);
                f32x4 t;
                t.x = h.x * ALPHA + BFLO(p0) + (BFLO(a0) + BFLO(b0)); t.y = h.y * ALPHA + BFHI(p0) + (BFHI(a0) + BFHI(b0));
                t.z = h.z * ALPHA + BFLO(p1) + (BFLO(a1) + BFLO(b1)); t.w = h.w * ALPHA + BFHI(p1) + (BFHI(a1) + BFHI(b1));
                v[rr][j] = t; } }
#pragma unroll
        for (int rr = 0; rr < RB; ++rr) { float s = 0.f;
#pragma unroll
            for (int j = 0; j < 4; ++j) s += (v[rr][j].x + v[rr][j].y) + (v[rr][j].z + v[rr][j].w);
            mean[rr] = s; }
#pragma unroll
        for (int o = 1; o < 64; o <<= 1)
#pragma unroll
            for (int rr = 0; rr < RB; ++rr) mean[rr] += __shfl_xor(mean[rr], o);
#pragma unroll
        for (int rr = 0; rr < RB; ++rr) { mean[rr] *= (1.f / D); float s2 = 0.f;
#pragma unroll
            for (int j = 0; j < 4; ++j) { v[rr][j] = v[rr][j] - mean[rr]; s2 += (v[rr][j].x * v[rr][j].x + v[rr][j].y * v[rr][j].y) + (v[rr][j].z * v[rr][j].z + v[rr][j].w * v[rr][j].w); }
            rstd[rr] = s2; }
#pragma unroll
        for (int o = 1; o < 64; o <<= 1)
#pragma unroll
            for (int rr = 0; rr < RB; ++rr) rstd[rr] += __shfl_xor(rstd[rr], o);
#pragma unroll
        for (int rr = 0; rr < RB; ++rr) { const float rs = 1.f / sqrtf(rstd[rr] * (1.f / D) + LN_EPS); GAS f32x4* pr = (GAS f32x4*)(F.out + (size_t)(m0 + rr) * D) + F.lane;
#pragma unroll
            for (int j = 0; j < 4; ++j) { f32x4 o = v[rr][j] * rs * gv[j] + bv[j]; if (poison) o = (f32x4){qn, qn, qn, qn}; pr[64 * j] = o; } }
    }
}


namespace att {
typedef float f32x16 __attribute__((ext_vector_type(16)));
typedef short s16x4 __attribute__((ext_vector_type(4)));
typedef short v4i16_t __attribute__((ext_vector_type(4)));
constexpr int NSLOT = 5, BUFB = 16384 + 512, A_WS = NSLOT * BUFB, A_FLAG = A_WS + 2048, A_CAR = A_FLAG + 64, A_END = A_CAR + 64;
constexpr float STOP2 = -48.f;
__device__ __forceinline__ int crow(int r, int hi) { return (r & 3) + 8 * (r >> 2) + 4 * hi; }
__device__ __forceinline__ unsigned cvtpk(float lo, float hi) { typedef float f2 __attribute__((ext_vector_type(2))); typedef __bf16 b2 __attribute__((ext_vector_type(2))); f2 v = {lo, hi}; b2 b = __builtin_convertvector(v, b2); return __builtin_bit_cast(unsigned, b); }

template <int MODE> __device__ __forceinline__ void attn_unit(Frame& F, int bh, int qb) {
    const int tid = F.tid, lane = F.lane, r32 = lane & 31, hi = lane >> 5, wid = F.wave;
    const int b = bh >> 3, h = bh & 7;
    const bf16* Qg = F.qkv + (size_t)(MODE ? 3 : 0) * M * HW; const bf16* Kg = F.qkv + (size_t)(MODE ? 4 : 1) * M * HW; const bf16* Vg = F.qkv + (size_t)(MODE ? 5 : 2) * M * HW;
    const size_t rowbase = (size_t)b * SEQ; const int q0 = qb * 256;
    const bf16* Qw = Qg + (rowbase + q0 + wid * 32) * HW + h * HD;
    const bf16* Kh = Kg + rowbase * HW + h * HD; const bf16* Vh = Vg + rowbase * HW + h * HD;
    LAS unsigned char* L = F.lds + RING_OFF;
    LAS float* wsf = (LAS float*)(L + A_WS) + wid * 64;
    LAS unsigned* flg = (LAS unsigned*)(L + A_FLAG);
    LAS float* car = (LAS float*)(L + A_CAR);
    const int jt = (q0 >> 6) + 3, jw = (q0 >> 6) + (wid >> 1);
    const bf16* ksrc = Kh + (size_t)lane * HW + wid * 8;
    const bf16* vsrc = Vh + (size_t)(16 * (wid & 3) + (lane >> 2)) * HW + (wid >> 2) * 32 + (lane & 3) * 8;
    const int kdst = wid * 1024 + lane * 16, vdst = 8192 + wid * 1024 + lane * 16;
    const float* cfsrc = F.cfl + (size_t)bh * SEQ + tid * 4;
    float KNu = 0.f;
    if (MODE) {
        if (tid < 8) { float c = 0.f; for (int k = 0; k < tid; ++k) c += F.ctot[bh * 8 + k]; car[tid] = c; }
        float kn = (lane <= jt) ? F.knt[bh * 128 + lane] : 0.f; if (lane + 64 <= jt) kn = fmaxf(kn, F.knt[bh * 128 + lane + 64]);
        KNu = wave_max(kn);
    }
    bf16x8 qr[4];
#pragma unroll
    for (int d0 = 0; d0 < 4; ++d0) qr[d0] = *(const GAS bf16x8*)(Qw + (size_t)r32 * HW + d0 * 16 + hi * 8);
    __syncthreads();
    v4u kreg[2], vreg[2]; f32x4 cfreg[2]; cfreg[0] = (f32x4){0.f, 0.f, 0.f, 0.f}; cfreg[1] = cfreg[0];
#pragma unroll
    for (int k = 0; k < 4; ++k) { const int t = jt - k, so = (t % NSLOT) * BUFB;
        const v4u kk = *(const GAS v4u*)(ksrc + (size_t)t * 64 * HW), vv = *(const GAS v4u*)(vsrc + (size_t)t * 64 * HW);
        *(LAS v4u*)(L + so + kdst) = kk; *(LAS v4u*)(L + so + vdst) = vv;
        if (MODE && tid < 16) { f32x4 cc = *(const GAS f32x4*)(cfsrc + t * 64); const float c = car[t >> 4]; cc = -(cc + c); *(LAS f32x4*)(L + so + 16384 + tid * 16) = cc; } }
    if (jt >= 4) { kreg[1] = *(const GAS v4u*)(ksrc + (size_t)(jt - 4) * 64 * HW); vreg[1] = *(const GAS v4u*)(vsrc + (size_t)(jt - 4) * 64 * HW);
        if (MODE && tid < 16) cfreg[1] = *(const GAS f32x4*)(cfsrc + (jt - 4) * 64); }
    float qnb = 0.f;
    if (MODE) {
        float n2 = 0.f;
#pragma unroll
        for (int d0 = 0; d0 < 4; ++d0)
#pragma unroll
            for (int e = 0; e < 8; ++e) { const float qv = __builtin_bit_cast(float, (unsigned)(unsigned short)qr[d0][e] << 16); n2 += qv * qv; }
        n2 += __shfl_xor(n2, 32);
        qnb = sqrtf(n2) * KNu * 1.01f;
    }
    __syncthreads();
    f32x16 o[2]; o[0] = f32x16{}; o[1] = f32x16{};
    float C2 = 0.f, mhat = -1e30f, lsum = 0.f;
    bool wdone = false;
    const LAS unsigned char* vb0 = L + 8192 + ((lane >> 4) & 1) * 32 + (lane & 3) * 8 + (4 * hi + ((lane & 15) >> 2)) * 64;
    int i = 0, sw = (jw % NSLOT) * BUFB;
    for (;;) {
#pragma unroll
    for (int ph = 0; ph < 2; ++ph) {
        const int j = jw - i;
        { const int tl = jt - 5 - i;
          if (tl >= 0) { kreg[ph] = *(const GAS v4u*)(ksrc + (size_t)tl * 64 * HW); vreg[ph] = *(const GAS v4u*)(vsrc + (size_t)tl * 64 * HW);
              if (MODE && tid < 16) cfreg[ph] = *(const GAS f32x4*)(cfsrc + tl * 64); } }
        if (!wdone && j >= 0) {
            const LAS unsigned char* Kb = L + sw;
            f32x16 p0 = f32x16{}, p1 = f32x16{};
            if (MODE) {
                const LAS float* cfp = (const LAS float*)(Kb + 16384);
#pragma unroll
                for (int g = 0; g < 4; ++g) { const f32x4 c0 = *(const LAS f32x4*)(cfp + 8 * g + 4 * hi), c1 = *(const LAS f32x4*)(cfp + 32 + 8 * g + 4 * hi);
#pragma unroll
                    for (int e = 0; e < 4; ++e) { p0[4 * g + e] = c0[e]; p1[4 * g + e] = c1[e]; } }
            }
            { const LAS unsigned char* kb = Kb + hi * 1024 + r32 * 16;
#pragma unroll
              for (int d0 = 0; d0 < 4; ++d0) { const bf16x8 b0 = *(const LAS bf16x8*)(kb + d0 * 2048), b1 = *(const LAS bf16x8*)(kb + d0 * 2048 + 512);
                  p0 = __builtin_amdgcn_mfma_f32_32x32x16_bf16(b0, qr[d0], p0, 0, 0, 0); p1 = __builtin_amdgcn_mfma_f32_32x32x16_bf16(b1, qr[d0], p1, 0, 0, 0); } }
            const bool diag = (i == 0); const int qrel = 32 * (wid & 1) + r32;
            if (MODE == 0) {
                float Lg[32];
#pragma unroll
                for (int r = 0; r < 16; ++r) {
                    const float z0 = p0[r], z1 = p1[r];
                    Lg[r] = -(fmaxf(z0, 0.f) + __builtin_amdgcn_logf(1.f + __builtin_amdgcn_exp2f(-fabsf(z0))));
                    Lg[16 + r] = -(fmaxf(z1, 0.f) + __builtin_amdgcn_logf(1.f + __builtin_amdgcn_exp2f(-fabsf(z1))));
                }
                if (diag) {
                    asm volatile("" ::: "memory");
#pragma unroll
                    for (int r = 0; r < 16; ++r) { Lg[r] = (crow(r, hi) >= qrel) ? 0.f : Lg[r]; Lg[16 + r] = (crow(r, hi) + 32 >= qrel) ? 0.f : Lg[16 + r]; } }
                float Os[8], Ps[8];
#pragma unroll
                for (int i = 0; i < 8; ++i) { Os[i] = (Lg[4 * i] + Lg[4 * i + 1]) + (Lg[4 * i + 2] + Lg[4 * i + 3]); Ps[i] = __shfl_xor(Os[i], 32); }
                float T = 0.f;
#pragma unroll
                for (int i = 7; i >= 0; --i) {
                    float s = T + (hi ? 0.f : Ps[i]) + C2;
#pragma unroll
                    for (int e = 3; e >= 0; --e) { s += Lg[4 * i + e]; const int r = (4 * i + e) & 15; const float zz = (i < 4) ? p0[r] : p1[r];
                        const float w = __builtin_amdgcn_exp2f(zz + s);
                        if (i < 4) p0[r] = w; else p1[r] = w; }
                    T += Os[i] + Ps[i];
                }
                if (diag) {
                    asm volatile("" ::: "memory");
#pragma unroll
                    for (int r = 0; r < 16; ++r) { p0[r] = (crow(r, hi) >= qrel) ? 0.f : p0[r]; p1[r] = (crow(r, hi) + 32 >= qrel) ? 0.f : p1[r]; } }
                C2 += T;
                wdone = __all(C2 < STOP2);
            } else {
                const LAS float* cfp = (const LAS float*)(Kb + 16384);
                if (diag) {
                    asm volatile("" ::: "memory");
#pragma unroll
                    for (int r = 0; r < 16; ++r) { p0[r] = (crow(r, hi) > qrel) ? -INFINITY : p0[r]; p1[r] = (crow(r, hi) + 32 > qrel) ? -INFINITY : p1[r]; } }
#define ATT_MX3(a, b, c) __builtin_fmaxf(__builtin_fmaxf((a), (b)), (c))
                float ra = ATT_MX3(p0[0], p0[1], p1[0]), rb = ATT_MX3(p0[2], p0[3], p1[1]); ra = ATT_MX3(ra, p1[2], p1[3]);
#pragma unroll
                for (int r = 4; r < 16; r += 4) { ra = ATT_MX3(ra, p0[r], p0[r + 1]); rb = ATT_MX3(rb, p0[r + 2], p0[r + 3]); ra = ATT_MX3(ra, p1[r], p1[r + 1]); rb = ATT_MX3(rb, p1[r + 2], p1[r + 3]); }
#undef ATT_MX3
                float rm = fmaxf(ra, rb); rm = fmaxf(rm, __shfl_xor(rm, 32));
                const float mnew = fmaxf(mhat, rm);
                if (__any(mnew > mhat)) {
                    const float f = __builtin_amdgcn_exp2f(mhat - mnew); lsum *= f;
                    if (hi == 0) wsf[r32] = f;
                    asm volatile("s_waitcnt lgkmcnt(0)" ::: "memory");
#pragma unroll
                    for (int r = 0; r < 16; ++r) { const float fr = wsf[crow(r, hi)]; o[0][r] *= fr; o[1][r] *= fr; }
                    mhat = mnew;
                }
                typedef float f32x2 __attribute__((ext_vector_type(2)));
                const f32x2 nm2 = {-mhat, -mhat}; f32x2 sa = {0.f, 0.f}, sb = {0.f, 0.f};
#pragma unroll
                for (int r = 0; r < 16; r += 2) { f32x2 t0 = (f32x2){p0[r], p0[r + 1]} + nm2, t1 = (f32x2){p1[r], p1[r + 1]} + nm2;
                    t0.x = __builtin_amdgcn_exp2f(t0.x); t0.y = __builtin_amdgcn_exp2f(t0.y); t1.x = __builtin_amdgcn_exp2f(t1.x); t1.y = __builtin_amdgcn_exp2f(t1.y);
                    sa += t0; sb += t1; p0[r] = t0.x; p0[r + 1] = t0.y; p1[r] = t1.x; p1[r + 1] = t1.y; }
                sa += sb; lsum += sa.x + sa.y;
                const float n00 = cfp[0];
                wdone = __all(qnb + n00 - mhat < STOP2);
            }
            v4u pw0, pw1, pw2, pw3;
#pragma unroll
            for (int e = 0; e < 4; ++e) { pw0[e] = cvtpk(p0[2 * e], p0[2 * e + 1]); pw1[e] = cvtpk(p0[8 + 2 * e], p0[8 + 2 * e + 1]); pw2[e] = cvtpk(p1[2 * e], p1[2 * e + 1]); pw3[e] = cvtpk(p1[8 + 2 * e], p1[8 + 2 * e + 1]); }
            const LAS unsigned char* vb = vb0 + sw;
#pragma unroll
            for (int d0 = 0; d0 < 2; ++d0) { s16x4 lo[4], hh[4];
#pragma unroll
                for (int ks = 0; ks < 4; ++ks) {
                    lo[ks] = __builtin_bit_cast(s16x4, __builtin_amdgcn_ds_read_tr16_b64_v4i16((LAS v4i16_t*)(vb + d0 * 4096 + ks * 1024)));
                    hh[ks] = __builtin_bit_cast(s16x4, __builtin_amdgcn_ds_read_tr16_b64_v4i16((LAS v4i16_t*)(vb + d0 * 4096 + ks * 1024 + 512))); }
#define ATT_PK(k) (bf16x8){lo[k][0], lo[k][1], lo[k][2], lo[k][3], hh[k][0], hh[k][1], hh[k][2], hh[k][3]}
                o[d0] = __builtin_amdgcn_mfma_f32_32x32x16_bf16(__builtin_bit_cast(bf16x8, pw0), ATT_PK(0), o[d0], 0, 0, 0);
                o[d0] = __builtin_amdgcn_mfma_f32_32x32x16_bf16(__builtin_bit_cast(bf16x8, pw1), ATT_PK(1), o[d0], 0, 0, 0);
                o[d0] = __builtin_amdgcn_mfma_f32_32x32x16_bf16(__builtin_bit_cast(bf16x8, pw2), ATT_PK(2), o[d0], 0, 0, 0);
                o[d0] = __builtin_amdgcn_mfma_f32_32x32x16_bf16(__builtin_bit_cast(bf16x8, pw3), ATT_PK(3), o[d0], 0, 0, 0);
#undef ATT_PK
            }
        }
        { const int ts = jt - 4 - i;
          if (ts >= 0) { const int nb = (ts % NSLOT) * BUFB;
              if (MODE && tid < 16) { const float c = car[ts >> 4]; cfreg[ph ^ 1] = -(cfreg[ph ^ 1] + c); *(LAS f32x4*)(L + nb + 16384 + tid * 16) = cfreg[ph ^ 1]; }
              *(LAS v4u*)(L + nb + kdst) = kreg[ph ^ 1]; *(LAS v4u*)(L + nb + vdst) = vreg[ph ^ 1]; } }
        if (lane == 0) flg[ph * 8 + wid] = (wdone || j <= 0) ? 1u : 0u;
        __syncthreads();
        { unsigned alld = 1u;
#pragma unroll
          for (int w = 0; w < 8; ++w) alld &= flg[ph * 8 + w];
          if (alld) goto att_done; }
        ++i; sw = (sw == 0) ? (NSLOT - 1) * BUFB : sw - BUFB;
    }
    }
att_done:
    float rli[16];
    if (MODE) {
        lsum += __shfl_xor(lsum, 32);
        if (hi == 0) wsf[r32] = lsum;
        asm volatile("s_waitcnt lgkmcnt(0)" ::: "memory");
#pragma unroll
        for (int r = 0; r < 16; ++r) rli[r] = 1.f / wsf[crow(r, hi)];
    } else {
#pragma unroll
        for (int r = 0; r < 16; ++r) rli[r] = 1.f;
    }
    bf16* Ow = F.mixed + (rowbase + q0 + wid * 32) * D + (MODE ? HW : 0) + h * HD;
#pragma unroll
    for (int r = 0; r < 16; ++r) {
        bf16* rowp = Ow + (size_t)crow(r, hi) * D + r32;
        rowp[0] = (bf16)f2bf(o[0][r] * rli[r]); rowp[32] = (bf16)f2bf(o[1][r] * rli[r]);
    }
}
}

template <int MODE> __device__ __forceinline__ void p3_attn_fast(Frame& F) {
    for (int i = 3; i >= 0; --i) { const int id = (int)blockIdx.x + F.G * i; if (id < 1024) att::attn_unit<MODE>(F, id & 31, id >> 5); }
}

struct Args { const float* in[18]; float* out; unsigned char* ws; int ph_lo, ph_hi; };
__global__ void __launch_bounds__(NTHR, 2) mk_fwd(Args args) {
    extern __shared__ __attribute__((aligned(16))) unsigned char lds[];
    Frame F;
    F.lds = (LAS unsigned char*)lds; F.MISC = (volatile LAS unsigned*)(F.lds + MISC_OFF);
    F.tid = threadIdx.x; F.lane = F.tid & 63; F.wave = __builtin_amdgcn_readfirstlane(F.tid >> 6);
    F.G = gridDim.x; { const int bx = blockIdx.x; F.vcu = (F.G % 8 == 0) ? (bx % 8) * (F.G / 8) + bx / 8 : bx; }
    unsigned char* ws = args.ws;
    F.ctl = (gu32*)(ws + WS_CTL);
    F.x = args.in[0]; F.p = args.in[1]; F.w_in = args.in[2]; F.b_forget = args.in[3]; F.w_out = args.in[4]; F.ln1g = args.in[5]; F.ln1b = args.in[6]; F.w_group = args.in[7]; F.b_group = args.in[8];
    F.w_router = args.in[9]; F.b_router = args.in[10]; F.w_gate = args.in[11]; F.w_up = args.in[12]; F.w_down = args.in[13]; F.w_ple = args.in[14]; F.w_pg = args.in[15]; F.ln2g = args.in[16]; F.ln2b = args.in[17];
    F.out = args.out;
    F.Win_t = (bf16*)(ws + WS_WIN); F.Wout_t = (bf16*)(ws + WS_WOUT); F.Wple_t = (bf16*)(ws + WS_WPLE); F.Wpg_t = (bf16*)(ws + WS_WPG); F.Wgu_t = (bf16*)(ws + WS_WGU); F.Wd_t = (bf16*)(ws + WS_WD);
    F.pple = (bf16*)(ws + WS_PPLE); F.qkv = (bf16*)(ws + WS_R1); F.xs = (bf16*)(ws + WS_R1); F.y = (bf16*)(ws + WS_R1);
    F.xb = (bf16*)(ws + WS_R2); F.mixed = (bf16*)(ws + WS_R2); F.hb = (bf16*)(ws + WS_R2); F.pb = (bf16*)(ws + WS_R3); F.hdn = (bf16*)(ws + WS_R3); F.mixp = (bf16*)(ws + WS_R3);
    F.ls = (float*)(ws + WS_LS); F.cfl = (float*)(ws + WS_CFL); F.ctot = (float*)(ws + WS_CTOT); F.knt = (float*)(ws + WS_KNT); F.gatev = (float*)(ws + WS_GATE); F.gslot = (float*)(ws + WS_GSLOT);
    F.eid = (int*)(ws + WS_EID); F.rank = (int*)(ws + WS_RANK); F.slot = (int*)(ws + WS_SLOT);
    for (int u = F.tid; u < (LDS_BYTES - LDSCTL_OFF) / 4; u += NTHR) ((LAS unsigned*)(F.lds + LDSCTL_OFF))[u] = 0u;
    __syncthreads();
    XcdBarrier bar = xcd_barrier_post((unsigned*)(F.ctl + CW_BAR), F.MISC + 8);
    const int lo = args.ph_lo, hi = args.ph_hi;
#ifndef PH_MASK
#define PH_MASK 0x3ff
#endif
#define IN(k) (((PH_MASK >> (k)) & 1) && lo <= (k) && (k) < hi)
#ifndef PROBE_PH
#define PROBE_PH -1
#endif
    unsigned long long pt0_ = (PROBE_PH == 0) ? rt() : 0ull, pt1_ = 0ull;
#define SEAM(k) do { if (IN(k) && IN((k) + 1)) xcd_barrier(bar); if ((k) == PROBE_PH) pt1_ = rt(); if ((k) + 1 == PROBE_PH) pt0_ = rt(); } while (0)

#ifndef REPEAT_PH
#define REPEAT_PH -1
#endif
#define REP(k) _Pragma("unroll") for (int rep_ = 0; rep_ < ((k) == REPEAT_PH ? 2 : 1); ++rep_)
#define PSTAMP(id, body) do { if (PROBE_PH == (id)) { __syncthreads(); pt0_ = rt(); } body; if (PROBE_PH == (id)) { __syncthreads(); pt1_ = rt(); } } while (0)
    if (IN(0)) { PSTAMP(100, p0_prologue<0>(F)); PSTAMP(101, p0_prologue<1>(F)); PSTAMP(102, p0_prologue<2>(F)); }
    SEAM(0);

    if (IN(1)) {
        { pg8::Gemm g{F.xb, F.Win_t, M, NPROJ, D}; pg8::StaticOrder S; S.init(M, NPROJ, F.G, (int)blockIdx.x);
          pg8::EpiBf16<0> E{F.qkv, HW, nullptr, HW, (size_t)M * HW, 1.f};
          pg8::gemm_phase<pg8::EpiBf16<0>, pg8::StaticOrder, true, true>(F.lds + RING_OFF, g, S, E); }
        { pg8::Gemm g{F.pb, F.Wple_t, M, D, PLED}; pg8::StaticOrder S; S.init(M, D, F.G, (int)blockIdx.x);
          pg8::EpiBf16<0> E{F.pple, D, nullptr, 0, 0, 1.f};
          pg8::gemm_phase<pg8::EpiBf16<0>, pg8::StaticOrder, true, true>(F.lds + RING_OFF, g, S, E); }
    } SEAM(1);

    if (IN(2)) { p2_scan(F); } SEAM(2);

#if ATT_FAST
#ifndef ATT_ONLY
#define ATT_ONLY 3
#endif
    if (IN(3)) { if (ATT_ONLY & 1) PSTAMP(131, p3_attn_fast<1>(F)); if (ATT_ONLY & 2) PSTAMP(132, p3_attn_fast<0>(F)); }
    SEAM(3);
#else
    if (IN(3)) { p3_attn_simple(F); } SEAM(3);
#endif

    if (IN(4)) {
        pg8::Gemm g{F.mixed, F.Wout_t, M, D, D}; pg8::StaticOrder S; S.init(M, D, F.G, (int)blockIdx.x);
        pg8::EpiBf16<0> E{F.mixp, D, nullptr, 0, 0, 1.f};
        pg8::gemm_phase<pg8::EpiBf16<0>, pg8::StaticOrder, true, true>(F.lds + RING_OFF, g, S, E);
    } SEAM(4);

    if (IN(5)) { p5_ln_route(F); } SEAM(5);

    if (IN(6)) {
        p6_slots_gather(F);
        { pg8::Gemm g{F.hb, F.Wpg_t, M, D, D}; pg8::StaticOrder S; S.init(M, D, F.G, (int)blockIdx.x);
          pg8::EpiPle E{F.pple};
          pg8::gemm_phase<pg8::EpiPle, pg8::StaticOrder, true, true>(F.lds + RING_OFF, g, S, E); }
    } SEAM(6);

    if (IN(7)) {
        build_pstart(F);
        const LAS int* pst = (const LAS int*)(F.lds + PST_OFF);
        pg8::Gemm g{F.xs, F.Wgu_t, SPAD, NE * 1024, D}; MoeOrder S{pst, (pst[NE] >> 8) * 4, F.G, (int)blockIdx.x};
        pg8::EpiSwiglu E{F.hdn, F.gslot};
        pg8::gemm_phase<pg8::EpiSwiglu, MoeOrder, true, true>(F.lds + RING_OFF, g, S, E);
    } SEAM(7);

    if (IN(8)) {
        build_pstart(F);
        const LAS int* pst = (const LAS int*)(F.lds + PST_OFF);
        pg8::Gemm g{F.hdn, F.Wd_t, SPAD, NE * 1024, DF}; MoeOrder S{pst, (pst[NE] >> 8) * 4, F.G, (int)blockIdx.x};
        pg8::EpiBf16<0> E{F.y, D, nullptr, 1024, 0, 1.f};
        pg8::gemm_phase<pg8::EpiBf16<0>, MoeOrder, true, true>(F.lds + RING_OFF, g, S, E);
    } SEAM(8);

    if (IN(9)) {
        const bool poison = __hip_atomic_load((gu32*)((unsigned*)(F.ctl + CW_BAR) + XB_TMO), RLX_AGENT) != 0u || F.G != 256;
        p9_final(F, poison);
    }
    if (PROBE_PH >= 0 && blockIdx.x == 0) {
        const unsigned long long now = rt(); if (PROBE_PH == NPH - 1) pt1_ = now;
        const unsigned long long dur = pt1_ - pt0_;
        if (F.tid == 0) while (rt() - now < 4ull * dur) __builtin_amdgcn_s_sleep(8);
        __syncthreads();
    }
#undef IN
#undef SEAM
}

#ifndef MK_CUTS
#define MK_CUTS 0
#endif
extern "C" void kernel_launch(void* const* d_in, const int* in_sizes, int n_in, void* d_out, int out_size, void* d_ws, size_t ws_size, hipStream_t stream) {
    static int grid = 0;
    if (grid == 0) {
        if (n_in != 18 || in_sizes[0] != M * D || out_size != M * D || ws_size < WS_END) { fprintf(stderr, "kernel_launch: shape/workspace mismatch (n_in %d, in0 %d, out %d, ws %zu)\n", n_in, n_in > 0 ? in_sizes[0] : -1, out_size, ws_size); grid = -1; return; }
        int dev = 0, cus = 0, per_cu = 0;
        if (hipGetDevice(&dev) != hipSuccess || hipDeviceGetAttribute(&cus, hipDeviceAttributeMultiprocessorCount, dev) != hipSuccess) { grid = -1; return; }
        if (hipFuncSetAttribute((const void*)mk_fwd, hipFuncAttributeMaxDynamicSharedMemorySize, LDS_BYTES) != hipSuccess) { fprintf(stderr, "kernel_launch: hipFuncSetAttribute failed\n"); grid = -1; return; }
        if (hipOccupancyMaxActiveBlocksPerMultiprocessor(&per_cu, (const void*)mk_fwd, NTHR, LDS_BYTES) != hipSuccess || per_cu < 1) fprintf(stderr, "kernel_launch: occupancy query reports %d\n", per_cu);
        (void)hipGetLastError();
        grid = cus;
        if (grid != 256) fprintf(stderr, "kernel_launch: %d CUs; this kernel is built for 256\n", grid);
    }
    if (grid < 0) return;
    if (hipMemsetAsync((char*)d_ws + WS_CTL, 0, CTL_ZERO_BYTES, stream) != hipSuccess) return;
    Args a{};
    for (int i = 0; i < 18; ++i) a.in[i] = (const float*)d_in[i];
    a.out = (float*)d_out; a.ws = (unsigned char*)d_ws;
#if MK_CUTS
    for (int ph = 0; ph < NPH; ++ph) { a.ph_lo = ph; a.ph_hi = ph + 1; hipLaunchKernelGGL(mk_fwd, dim3(grid), dim3(NTHR), LDS_BYTES, stream, a); }
#else
    a.ph_lo = 0; a.ph_hi = NPH;
    hipLaunchKernelGGL(mk_fwd, dim3(grid), dim3(NTHR), LDS_BYTES, stream, a);
#endif
}
```

```cpp
#include <hip/hip_runtime.h>
#include <hip/hip_bf16.h>
#include <cstdio>
#include <cstdint>
#include <cmath>
namespace pg8 {
#define PG8_LAS __attribute__((address_space(3)))
typedef unsigned short bf16_t;
typedef short bf16x8 __attribute__((ext_vector_type(8)));
typedef float f32x4 __attribute__((ext_vector_type(4)));
typedef unsigned u32x4 __attribute__((ext_vector_type(4)));
constexpr int BM = 256, BK = 64, HALF = 128, HTB = HALF * BK * 2  , STAGE_BYTES = 8 * HTB, NXCD = 8, WGM = 8;

__host__ __device__ __forceinline__ int lds_byte(int r, int c) { const int st = (r >> 4) * 2 + (c >> 5), rr = r & 15, cc = c & 31, ob = rr * 64 + cc * 2; return st * 1024 + (ob ^ (((ob >> 9) & 1) << 5)); }
__host__ __device__ __forceinline__ void stage_rc(int b, int& R, int& C) { const int st = b / 1024, sb = b % 1024, swz = sb ^ (((sb >> 9) & 1) << 5); R = (st >> 1) * 16 + swz / 64; C = (st & 1) * 32 + (swz % 64) / 2; }
__host__ __device__ __forceinline__ int perm32(int rho) { const int n = rho >> 4, i = rho & 15; return 8 * (i >> 2) + 4 * n + (i & 3); }

struct Unit { int pm, pn; };
struct Gemm { const bf16_t* A; const bf16_t* Bt; int M, N, K; };

struct StaticOrder {
    int nM, nN, nwg, G, c;
    __host__ __device__ void init(int M, int N, int G_, int c_) { nM = M / BM; nN = N / BM; nwg = nM * nN; G = G_; c = c_; }
    __host__ __device__ bool next(int i, Unit& u) const {
        const long L = (long)i * G + c; if (L >= nwg) return false;
        int wgid = (int)L; { const int q = nwg / NXCD, r = nwg % NXCD, xcd = wgid % NXCD, off = wgid / NXCD; wgid = (xcd < r ? xcd * (q + 1) : r * (q + 1) + (xcd - r) * q) + off; }
        const int nig = WGM * nN, gid = wgid / nig, fm = gid * WGM, gsz = (nM - fm) < WGM ? (nM - fm) : WGM;
        u.pm = fm + ((wgid % nig) % gsz); u.pn = (wgid % nig) / gsz; return true;
    }
    __device__ __forceinline__ void a_ready(const Unit&) const {}
    __device__ __forceinline__ void done(const Unit&) const {}
};

__device__ __forceinline__ unsigned cvt_pk_bf16(float lo, float hi) { unsigned r; asm volatile("v_cvt_pk_bf16_f32 %0, %1, %2" : "=v"(r) : "v"(lo), "v"(hi)); return r; }
typedef float f32x2 __attribute__((ext_vector_type(2)));
__device__ __forceinline__ f32x2 gelu_pk(f32x2 v) {
    const f32x2 av = __builtin_elementwise_abs(v), d = av * 0.2316418882f + 1.0f;
    f32x2 t; t.x = __builtin_amdgcn_rcpf(d.x); t.y = __builtin_amdgcn_rcpf(d.y);
    f32x2 q = t * 0.5307027145f + (-0.7265760135f); q = q * t + 0.7107068705f; q = q * t + (-0.142248368f); q = q * t + 0.127414796f; q = q * t;
    const f32x2 s = (v * v) * (-0.72134752044f);
    f32x2 e; e.x = __builtin_amdgcn_exp2f(s.x); e.y = __builtin_amdgcn_exp2f(s.y);
    const f32x2 m = v * (q * e), r = v - m;
    f32x2 o; o.x = v.x < 0.f ? m.x : r.x; o.y = v.y < 0.f ? m.y : r.y; return o;
}

template <int ACT  > struct EpiBf16 {
    static constexpr bool PERM = true, AFTER_DRAIN = false; static_assert(ACT == 0 || ACT == 1, "EpiBf16: ACT is 0 (none) or 1 (gelu_pk)");
    bf16_t* O; int ldc; const float* bias; int split_cols; size_t split_stride; float scale0;
    __device__ __forceinline__ void operator()(const f32x4 (&acc)[2][2][4][2], const Unit& u, int wr, int wc, int fr, int fq) const {
        const int row0 = u.pm * BM + wr * 64 + fr; int colt = u.pn * BM; bf16_t* base = O;
        float sc = 1.f; if (split_cols) { const int t = colt / split_cols; base += (size_t)t * split_stride; colt -= t * split_cols; if (t == 0) sc = scale0; }
        const int col0 = colt + wc * 32 + 8 * fq, bcol0 = u.pn * BM + wc * 32 + 8 * fq;
        f32x4 bv[2][2];
#pragma unroll
        for (int bj = 0; bj < 2; ++bj)
#pragma unroll
            for (int n = 0; n < 2; ++n) bv[bj][n] = bias ? *(const f32x4*)(bias + bcol0 + bj * HALF + 4 * n) : (f32x4){0.f, 0.f, 0.f, 0.f};
#pragma unroll
        for (int ai = 0; ai < 2; ++ai)
#pragma unroll
            for (int m = 0; m < 4; ++m) { bf16_t* rowp = base + (size_t)(row0 + ai * HALF + m * 16) * ldc + col0;
#pragma unroll
                for (int bj = 0; bj < 2; ++bj) { f32x4 v0 = acc[ai][bj][m][0] + bv[bj][0], v1 = acc[ai][bj][m][1] + bv[bj][1];
                    if (ACT == 1) { f32x2 a = gelu_pk((f32x2){v0[0], v0[1]}), b = gelu_pk((f32x2){v0[2], v0[3]}), c = gelu_pk((f32x2){v1[0], v1[1]}), d = gelu_pk((f32x2){v1[2], v1[3]});
                        v0 = (f32x4){a.x, a.y, b.x, b.y}; v1 = (f32x4){c.x, c.y, d.x, d.y}; }
                    v0 = v0 * sc; v1 = v1 * sc; u32x4 w; w.x = cvt_pk_bf16(v0[0], v0[1]); w.y = cvt_pk_bf16(v0[2], v0[3]); w.z = cvt_pk_bf16(v1[0], v1[1]); w.w = cvt_pk_bf16(v1[2], v1[3]);
                    *(u32x4*)(rowp + bj * HALF) = w; } }
    }
};

struct PanelStats {
    unsigned* xbuf;
    unsigned* cnt;
    unsigned* tmo;
    int ntn; float eps;
    unsigned code;
    __device__ __forceinline__ bool run(const f32x4 (&v)[2][2][4][2], const Unit& u, int wr, int wc, int fr, int fq, PG8_LAS unsigned char* lds, int wid, int lane) const {
        typedef float f32x2v __attribute__((ext_vector_type(2)));
        PG8_LAS f32x2v* P = (PG8_LAS f32x2v*)lds;
        PG8_LAS f32x2v* S = (PG8_LAS f32x2v*)(lds + 8192);
        PG8_LAS unsigned* flag = (PG8_LAS unsigned*)(lds + 8192 + 2048);
#pragma unroll
        for (int ai = 0; ai < 2; ++ai)
#pragma unroll
            for (int m = 0; m < 4; ++m) {
                float s = 0.f;
#pragma unroll
                for (int bj = 0; bj < 2; ++bj)
#pragma unroll
                    for (int n = 0; n < 2; ++n) { const f32x4 x = v[ai][bj][m][n]; s += (x[0] + x[1]) + (x[2] + x[3]); }
                s += __shfl_xor(s, 16); s += __shfl_xor(s, 32);
                const float mw = s * (1.0f / 64.0f); float q = 0.f;
#pragma unroll
                for (int bj = 0; bj < 2; ++bj)
#pragma unroll
                    for (int n = 0; n < 2; ++n) { const f32x4 d = v[ai][bj][m][n] - mw; q += (d[0] * d[0] + d[1] * d[1]) + (d[2] * d[2] + d[3] * d[3]); }
                q += __shfl_xor(q, 16); q += __shfl_xor(q, 32);
                if (fq == 0) P[(ai * HALF + wr * 64 + m * 16 + fr) * 4 + wc] = (f32x2v){mw, q};
            }
        asm volatile("s_waitcnt lgkmcnt(0)" ::: "memory"); __builtin_amdgcn_s_barrier(); asm volatile("" ::: "memory");
#if defined(BROKEN_EXCHANGE_NO_WAIT)
#warning BROKEN CONTROL BUILD: the row-statistics exchange does not wait; results are wrong by design
        if (blockIdx.x >= 64) { const long long t0_ = clock64(); while (clock64() - t0_ < 60000) __builtin_amdgcn_s_sleep(8); }
#endif
        const int row = wid * 32 + (lane & 31);
        if (lane < 32) {
            const f32x2v a = P[row * 4 + 0], b = P[row * 4 + 1], c = P[row * 4 + 2], d = P[row * 4 + 3];
            const float mt = (a.x + b.x + c.x + d.x) * 0.25f;
            const float da = a.x - mt, db = b.x - mt, dc = c.x - mt, dd = d.x - mt;
            const float m2 = (a.y + b.y) + (c.y + d.y) + 64.0f * ((da * da + db * db) + (dc * dc + dd * dd));
            unsigned long long* slot = (unsigned long long*)xbuf + ((size_t)(u.pm * BM + row) * 4 + u.pn);
            __hip_atomic_store(slot, ((unsigned long long)__float_as_uint(m2) << 32) | __float_as_uint(mt), __ATOMIC_RELAXED, __HIP_MEMORY_SCOPE_AGENT);
        }
        asm volatile("s_waitcnt vmcnt(0)" ::: "memory");
        if (lane == 0) __hip_atomic_fetch_add(cnt + 64 * u.pm, 1u, __ATOMIC_RELAXED, __HIP_MEMORY_SCOPE_AGENT);
        if (wid == 0) {
            bool dead = false; const unsigned long long t0 = __builtin_amdgcn_s_memrealtime(); const unsigned want = 8u * (unsigned)ntn;
            for (;;) {
#if defined(BROKEN_EXCHANGE_NO_WAIT)
                break;
#endif
                if ((unsigned)__builtin_amdgcn_readfirstlane(__hip_atomic_load(cnt + 64 * u.pm, __ATOMIC_RELAXED, __HIP_MEMORY_SCOPE_AGENT)) >= want) break;
                if (__builtin_amdgcn_s_memrealtime() - t0 > 2000000ull) {
                    if (lane == 0) { unsigned expect = 0u; __hip_atomic_compare_exchange_strong(tmo + 1, &expect, code | (unsigned)(u.pm & 0xff), __ATOMIC_RELAXED, __ATOMIC_RELAXED, __HIP_MEMORY_SCOPE_AGENT);
                                     __hip_atomic_store(tmo, 1u, __ATOMIC_RELAXED, __HIP_MEMORY_SCOPE_AGENT); }
                    dead = true; break; }
                __builtin_amdgcn_s_sleep(2);
            }
            __builtin_amdgcn_fence(__ATOMIC_ACQUIRE, "agent");
            if (lane == 0) flag[0] = dead ? 1u : 0u;
        }
        asm volatile("s_waitcnt vmcnt(0) lgkmcnt(0)" ::: "memory"); __builtin_amdgcn_s_barrier(); asm volatile("" ::: "memory");
        const bool bad = flag[0] != 0u;
        if (lane < 32) {
            const unsigned long long* slot = (const unsigned long long*)xbuf + (size_t)(u.pm * BM + row) * 4; float mt[4], m2[4]; float ms = 0.f;
#pragma unroll
            for (int t = 0; t < 4; ++t) { if (t < ntn) { const unsigned long long w = __hip_atomic_load(slot + t, __ATOMIC_RELAXED, __HIP_MEMORY_SCOPE_AGENT); mt[t] = __uint_as_float((unsigned)w); m2[t] = __uint_as_float((unsigned)(w >> 32)); } else { mt[t] = 0.f; m2[t] = 0.f; } ms += mt[t]; }
            const float mean = ms / (float)ntn; float q = 0.f;
#pragma unroll
            for (int t = 0; t < 4; ++t) if (t < ntn) { const float dm = mt[t] - mean; q += m2[t] + 256.0f * dm * dm; }
            S[row] = (f32x2v){mean, 1.0f / sqrtf(q / (256.0f * (float)ntn) + eps)};
        }
        asm volatile("s_waitcnt lgkmcnt(0)" ::: "memory"); __builtin_amdgcn_s_barrier(); asm volatile("" ::: "memory");
        return bad;
    }
};
struct EpiLnRes {
    static constexpr bool PERM = false, AFTER_DRAIN = true;
    const float* base; float* out; int ldc; const float* bias; PanelStats st; unsigned poison;
    __device__ __forceinline__ void fused(f32x4 (&acc)[2][2][4][2], const Unit& u, int wr, int wc, int fr, int fq, PG8_LAS unsigned char* lds, int wid, int lane) const {
        typedef float f32x2v __attribute__((ext_vector_type(2)));
        const PG8_LAS f32x2v* S = (const PG8_LAS f32x2v*)(lds + 8192);
        const int col0 = u.pn * BM + wc * 32 + 4 * fq;
#pragma unroll
        for (int bj = 0; bj < 2; ++bj)
#pragma unroll
            for (int n = 0; n < 2; ++n) { const f32x4 bv = bias ? *(const f32x4*)(bias + col0 + bj * HALF + n * 16) : (f32x4){0.f, 0.f, 0.f, 0.f};
#pragma unroll
                for (int ai = 0; ai < 2; ++ai)
#pragma unroll
                    for (int m = 0; m < 4; ++m) acc[ai][bj][m][n] += bv; }
        f32x4 pre[4][2][2];
#pragma unroll
        for (int m = 0; m < 4; ++m) { const size_t off = (size_t)(u.pm * BM + wr * 64 + m * 16 + fr) * ldc + col0;
#pragma unroll
            for (int bj = 0; bj < 2; ++bj)
#pragma unroll
                for (int n = 0; n < 2; ++n) pre[m][bj][n] = *(const f32x4*)(base + off + bj * HALF + n * 16); }
        const bool bad = st.run(acc, u, wr, wc, fr, fq, lds, wid, lane) || poison != 0u;
        const float qnan = __builtin_nanf("");
#pragma unroll
        for (int ai = 0; ai < 2; ++ai)
#pragma unroll
            for (int m = 0; m < 4; ++m) { const int r = ai * HALF + wr * 64 + m * 16 + fr; const f32x2v sr = S[r]; const size_t off = (size_t)(u.pm * BM + r) * ldc + col0;
#pragma unroll
                for (int bj = 0; bj < 2; ++bj)
#pragma unroll
                    for (int n = 0; n < 2; ++n) { const f32x4 bs = ai == 0 ? pre[m][bj][n] : *(const f32x4*)(base + off + bj * HALF + n * 16); f32x4 o = bs + (acc[ai][bj][m][n] - sr.x) * sr.y;
                        if (bad) o = (f32x4){qnan, qnan, qnan, qnan}; *(f32x4*)(out + off + bj * HALF + n * 16) = o; }
                if (m & 1) asm volatile("" ::: "memory"); }
    }
};
struct EpiLnResLn {
    static constexpr bool PERM = false, AFTER_DRAIN = true;
    const float* base; float* out; bf16_t* xn; int ldc; const float* bias; PanelStats st1, st2; unsigned poison;
    __device__ __forceinline__ void fused(f32x4 (&acc)[2][2][4][2], const Unit& u, int wr, int wc, int fr, int fq, PG8_LAS unsigned char* lds, int wid, int lane) const {
        typedef float f32x2v __attribute__((ext_vector_type(2))); typedef unsigned u32x2v __attribute__((ext_vector_type(2)));
        const PG8_LAS f32x2v* S = (const PG8_LAS f32x2v*)(lds + 8192);
        const int col0 = u.pn * BM + wc * 32 + 4 * fq;
#pragma unroll
        for (int bj = 0; bj < 2; ++bj)
#pragma unroll
            for (int n = 0; n < 2; ++n) { const f32x4 bv = bias ? *(const f32x4*)(bias + col0 + bj * HALF + n * 16) : (f32x4){0.f, 0.f, 0.f, 0.f};
#pragma unroll
                for (int ai = 0; ai < 2; ++ai)
#pragma unroll
                    for (int m = 0; m < 4; ++m) acc[ai][bj][m][n] += bv; }
        bool bad = st1.run(acc, u, wr, wc, fr, fq, lds, wid, lane) || poison != 0u;
        const float qnan = __builtin_nanf("");
#pragma unroll
        for (int ai = 0; ai < 2; ++ai)
#pragma unroll
            for (int m = 0; m < 4; ++m) { const int r = ai * HALF + wr * 64 + m * 16 + fr; const f32x2v sr = S[r]; const size_t off = (size_t)(u.pm * BM + r) * ldc + col0;
#pragma unroll
                for (int bj = 0; bj < 2; ++bj)
#pragma unroll
                    for (int n = 0; n < 2; ++n) { const f32x4 bs = *(const f32x4*)(base + off + bj * HALF + n * 16); acc[ai][bj][m][n] = bs + (acc[ai][bj][m][n] - sr.x) * sr.y; }
                asm volatile("" : "+v"(acc[ai][0][m][0]), "+v"(acc[ai][0][m][1]), "+v"(acc[ai][1][m][0]), "+v"(acc[ai][1][m][1]));
                if (m & 1) asm volatile("" ::: "memory"); }
        const bool bad1 = bad;
        bad = st2.run(acc, u, wr, wc, fr, fq, lds, wid, lane) || bad;
#pragma unroll
        for (int ai = 0; ai < 2; ++ai)
#pragma unroll
            for (int m = 0; m < 4; ++m) { const int r = ai * HALF + wr * 64 + m * 16 + fr; const f32x2v sr = S[r]; const size_t off = (size_t)(u.pm * BM + r) * ldc + col0;
#pragma unroll
                for (int bj = 0; bj < 2; ++bj)
#pragma unroll
                    for (int n = 0; n < 2; ++n) { const f32x4 x1 = acc[ai][bj][m][n]; *(f32x4*)(out + off + bj * HALF + n * 16) = bad1 ? (f32x4){qnan, qnan, qnan, qnan} : x1;
                        const f32x4 o = (x1 - sr.x) * sr.y; u32x2v w; w.x = cvt_pk_bf16(o[0], o[1]); w.y = cvt_pk_bf16(o[2], o[3]);
                        if (bad) { w.x = 0x7fc07fc0u; w.y = 0x7fc07fc0u; } *(u32x2v*)(xn + off + bj * HALF + n * 16) = w; }
                asm volatile("" ::: "memory"); }
    }
};

template <class Epi, class Sched, bool ALIGN_EPI = false, bool SP2 = false>
__device__ __forceinline__ void gemm_phase(PG8_LAS unsigned char* lds, const Gemm g, const Sched& S, const Epi& E) {
    const int tid = threadIdx.x, wid = __builtin_amdgcn_readfirstlane(tid >> 6), lane = tid & 63, wr = wid >> 2, wc = wid & 3, fr = lane & 15, fq = lane >> 4;
    const int K = g.K, nt = K / BK;
    unsigned voffA[2], voffB[2];
#pragma unroll
    for (int i = 0; i < 2; ++i) { int R, C; stage_rc(tid * 16 + i * 8192, R, C); const int Rb = Epi::PERM ? ((R & ~31) + perm32(R & 31)) : R;
        voffA[i] = (unsigned)(R * K + C) * 2u; voffB[i] = (unsigned)(Rb * K + C) * 2u; }
    const size_t kstep = (size_t)(BK * 2);
    const size_t hstep = (size_t)HALF * K * 2;
    const size_t tstep = 2 * hstep;
    const unsigned ldsw = (unsigned)wid * 1024u;
    const int aoff = lds_byte(wr * 64 + fr, fq * 8), boff = lds_byte(wc * 32 + fr, fq * 8);
#define PG8_SA(b, h) (((b) * 2 + (h)) * HTB)
#define PG8_SB(b, h) ((4 + (b) * 2 + (h)) * HTB)
#define PG8_STAGE(bufoff, gbase, voff) do { _Pragma("unroll") for (int _i = 0; _i < 2; ++_i) \
        __builtin_amdgcn_global_load_lds((const unsigned*)((const char*)(gbase) + (voff)[_i]), (PG8_LAS unsigned*)(lds + (bufoff) + ldsw + _i * 8192), 16, 0, 0); } while (0)
#define PG8_LDA(dst, b, h) do { _Pragma("unroll") for (int m = 0; m < 4; ++m) _Pragma("unroll") for (int k = 0; k < 2; ++k) dst[m][k] = *(const PG8_LAS bf16x8*)(lds + PG8_SA(b, h) + aoff + m * 2048 + k * 1024); } while (0)
#define PG8_LDB(dst, b, h) do { _Pragma("unroll") for (int n = 0; n < 2; ++n) _Pragma("unroll") for (int k = 0; k < 2; ++k) dst[n][k] = *(const PG8_LAS bf16x8*)(lds + PG8_SB(b, h) + boff + n * 2048 + k * 1024); } while (0)
#define PG8_MMA(ai, bj, At, Bt) do { __builtin_amdgcn_s_setprio(1); _Pragma("unroll") for (int m = 0; m < 4; ++m) _Pragma("unroll") for (int n = 0; n < 2; ++n) _Pragma("unroll") for (int k = 0; k < 2; ++k) \
        acc[ai][bj][m][n] = __builtin_amdgcn_mfma_f32_16x16x32_bf16(Bt[n][k], At[m][k], acc[ai][bj][m][n], 0, 0, 0); __builtin_amdgcn_s_setprio(0); } while (0)
#define PG8_WAIT_V(n) asm volatile("s_waitcnt vmcnt(" #n ")" ::: "memory")
#define PG8_WAIT_L(n) asm volatile("s_waitcnt lgkmcnt(" #n ")" ::: "memory")
#define PG8_BAR __builtin_amdgcn_s_barrier()
#define PG8_SCHED __builtin_amdgcn_sched_barrier(0)
    Unit cur, nxt; int ui = 0;
    if (!S.next(0, cur)) return;
    f32x4 acc[2][2][4][2];
#pragma unroll
    for (int a = 0; a < 2; ++a)
#pragma unroll
        for (int b = 0; b < 2; ++b)
#pragma unroll
            for (int m = 0; m < 4; ++m)
#pragma unroll
                for (int n = 0; n < 2; ++n) acc[a][b][m][n] = (f32x4){0.f, 0.f, 0.f, 0.f};
    bf16x8 At[4][2], B0[2][2], B1[2][2];
    const char* cA = (const char*)g.A + (size_t)cur.pm * tstep; const char* cB = (const char*)g.Bt + (size_t)cur.pn * tstep;
    S.a_ready(cur);
    if constexpr (SP2) {
        PG8_STAGE(PG8_SB(0, 0), cB, voffB); PG8_STAGE(PG8_SB(0, 1), cB + hstep, voffB); PG8_STAGE(PG8_SA(0, 0), cA, voffA); PG8_STAGE(PG8_SA(0, 1), cA + hstep, voffA);
        if (wr == 1) PG8_BAR;
        PG8_WAIT_V(2); PG8_BAR;
        PG8_STAGE(PG8_SB(1, 0), cB + kstep, voffB); PG8_STAGE(PG8_SA(1, 0), cA + kstep, voffA); PG8_STAGE(PG8_SB(1, 1), cB + hstep + kstep, voffB);
        PG8_WAIT_V(6); PG8_BAR;
    } else {
        PG8_STAGE(PG8_SB(0, 0), cB, voffB); PG8_STAGE(PG8_SA(0, 0), cA, voffA); PG8_STAGE(PG8_SB(0, 1), cB + hstep, voffB); PG8_STAGE(PG8_SA(0, 1), cA + hstep, voffA);
        if (wr == 1) PG8_BAR;
        PG8_WAIT_V(4); PG8_BAR;
        PG8_STAGE(PG8_SB(1, 0), cB + kstep, voffB); PG8_STAGE(PG8_SA(1, 0), cA + kstep, voffA); PG8_STAGE(PG8_SB(1, 1), cB + hstep + kstep, voffB);
        PG8_WAIT_V(6); PG8_BAR;
    }
    for (;;) {
        const bool has_next = S.next(ui + 1, nxt);
        const char* nA = has_next ? (const char*)g.A + (size_t)nxt.pm * tstep : cA; const char* nB = has_next ? (const char*)g.Bt + (size_t)nxt.pn * tstep : cB;
        for (int t = 0; t < nt; t += 2) {
            const bool last = (t == nt - 2);
            const char* a1 = cA + (size_t)(t + 1) * kstep;
            const char* a2 = last ? nA : cA + (size_t)(t + 2) * kstep; const char* b2 = last ? nB : cB + (size_t)(t + 2) * kstep;
            const char* a3 = a2 + kstep; const char* b3 = b2 + kstep;
            if (last && has_next) S.a_ready(nxt);
            if constexpr (SP2) {
            PG8_LDB(B0, 0, 0); PG8_LDB(B1, 0, 1); PG8_SCHED; PG8_LDA(At, 0, 0); PG8_STAGE(PG8_SA(1, 1), a1 + hstep, voffA);
            PG8_WAIT_V(8); PG8_WAIT_L(0); PG8_BAR; PG8_MMA(0, 0, At, B0); PG8_MMA(0, 1, At, B1); PG8_BAR; PG8_SCHED;
            PG8_LDA(At, 0, 1); PG8_STAGE(PG8_SB(0, 0), b2, voffB); PG8_STAGE(PG8_SB(0, 1), b2 + hstep, voffB); PG8_STAGE(PG8_SA(0, 0), a2, voffA);
            PG8_WAIT_V(8); PG8_WAIT_L(0); PG8_BAR; PG8_MMA(1, 0, At, B0); PG8_MMA(1, 1, At, B1); PG8_BAR; PG8_SCHED;
            PG8_LDB(B0, 1, 0); PG8_LDB(B1, 1, 1); PG8_SCHED; PG8_LDA(At, 1, 0); PG8_STAGE(PG8_SA(0, 1), a2 + hstep, voffA);
            PG8_WAIT_V(8); PG8_WAIT_L(0); PG8_BAR; PG8_MMA(0, 0, At, B0); PG8_MMA(0, 1, At, B1); PG8_BAR; PG8_SCHED;
            PG8_LDA(At, 1, 1); PG8_STAGE(PG8_SB(1, 0), b3, voffB); PG8_STAGE(PG8_SB(1, 1), b3 + hstep, voffB); PG8_STAGE(PG8_SA(1, 0), a3, voffA);
            PG8_WAIT_V(8); PG8_WAIT_L(0); PG8_BAR; PG8_MMA(1, 0, At, B0); PG8_MMA(1, 1, At, B1); PG8_BAR; PG8_SCHED;
            } else {
            PG8_LDB(B0, 0, 0); PG8_SCHED; PG8_LDA(At, 0, 0); PG8_STAGE(PG8_SA(1, 1), a1 + hstep, voffA);
            PG8_WAIT_L(8); PG8_BAR; PG8_WAIT_L(0); PG8_MMA(0, 0, At, B0); PG8_BAR; PG8_SCHED;
            PG8_LDB(B1, 0, 1); PG8_STAGE(PG8_SB(0, 0), b2, voffB);
            PG8_BAR; PG8_WAIT_L(0); PG8_MMA(0, 1, At, B1); PG8_BAR;
            PG8_LDA(At, 0, 1); PG8_STAGE(PG8_SA(0, 0), a2, voffA);
            PG8_BAR; PG8_WAIT_L(0); PG8_MMA(1, 0, At, B0); PG8_BAR; PG8_SCHED;
            PG8_STAGE(PG8_SB(0, 1), b2 + hstep, voffB);
            PG8_WAIT_V(6); PG8_BAR; PG8_MMA(1, 1, At, B1); PG8_BAR;
            PG8_LDB(B0, 1, 0); PG8_SCHED; PG8_LDA(At, 1, 0); PG8_STAGE(PG8_SA(0, 1), a2 + hstep, voffA);
            PG8_WAIT_L(8); PG8_BAR; PG8_WAIT_L(0); PG8_MMA(0, 0, At, B0); PG8_BAR; PG8_SCHED;
            PG8_LDB(B1, 1, 1); PG8_STAGE(PG8_SB(1, 0), b3, voffB);
            PG8_BAR; PG8_WAIT_L(0); PG8_MMA(0, 1, At, B1); PG8_BAR;
            PG8_LDA(At, 1, 1); PG8_STAGE(PG8_SA(1, 0), a3, voffA);
            PG8_BAR; PG8_WAIT_L(0); PG8_MMA(1, 0, At, B0); PG8_BAR; PG8_SCHED;
            PG8_STAGE(PG8_SB(1, 1), b3 + hstep, voffB);
            PG8_WAIT_V(6); PG8_BAR; PG8_MMA(1, 1, At, B1); PG8_BAR;
            }
        }
        if constexpr (ALIGN_EPI) { if (wr == 0) PG8_BAR; }
        if constexpr (!Epi::AFTER_DRAIN) { E(acc, cur, wr, wc, fr, fq); S.done(cur); }
        if (!has_next) break;
#pragma unroll
        for (int a = 0; a < 2; ++a)
#pragma unroll
            for (int b = 0; b < 2; ++b)
#pragma unroll
                for (int m = 0; m < 4; ++m)
#pragma unroll
                    for (int n = 0; n < 2; ++n) acc[a][b][m][n] = (f32x4){0.f, 0.f, 0.f, 0.f};
        cur = nxt; cA = nA; cB = nB; ++ui;
        if constexpr (ALIGN_EPI) { if (wr == 1) PG8_BAR; }
    }
    PG8_WAIT_V(0);
    if constexpr (!ALIGN_EPI) { if (wr == 0) PG8_BAR; }
    PG8_BAR;
    if constexpr (Epi::AFTER_DRAIN) { E.fused(acc, cur, wr, wc, fr, fq, lds, wid, lane); S.done(cur); }
#undef PG8_SA
#undef PG8_SB
#undef PG8_STAGE
#undef PG8_LDA
#undef PG8_LDB
#undef PG8_MMA
#undef PG8_WAIT_V
#undef PG8_WAIT_L
#undef PG8_BAR
#undef PG8_SCHED
}
}
namespace pg8 {
template <class F> struct EpiScalar {
    static constexpr bool PERM = true, AFTER_DRAIN = false; F f;
    __device__ __forceinline__ void operator()(const f32x4 (&acc)[2][2][4][2], const Unit& u, int wr, int wc, int fr, int fq) const {
        const int row0 = u.pm * BM + wr * 64 + fr, col0 = u.pn * BM + wc * 32 + 8 * fq;
#pragma unroll
        for (int ai = 0; ai < 2; ++ai)
#pragma unroll
            for (int m = 0; m < 4; ++m) {
#pragma unroll
                for (int bj = 0; bj < 2; ++bj)
#pragma unroll
                    for (int n = 0; n < 2; ++n)
#pragma unroll
                        for (int e = 0; e < 4; ++e) f(row0 + ai * HALF + m * 16, col0 + bj * HALF + 4 * n + e, acc[ai][bj][m][n][e]);
                asm volatile("" ::: "memory"); }
    }
};
template <class F> struct EpiScalarPair {
    static constexpr bool PERM = true, AFTER_DRAIN = false; F f;
    __device__ __forceinline__ void operator()(const f32x4 (&acc)[2][2][4][2], const Unit& u, int wr, int wc, int fr, int fq) const {
        const int row0 = u.pm * BM + wr * 64 + fr, cl0 = wc * 32 + 8 * fq;
#pragma unroll
        for (int ai = 0; ai < 2; ++ai)
#pragma unroll
            for (int m = 0; m < 4; ++m) {
#pragma unroll
                for (int n = 0; n < 2; ++n)
#pragma unroll
                    for (int e = 0; e < 4; ++e) f(row0 + ai * HALF + m * 16, u.pn, cl0 + 4 * n + e, acc[ai][0][m][n][e], acc[ai][1][m][n][e]);
                asm volatile("" ::: "memory"); }
    }
};
}
#define GAS __attribute__((address_space(1)))
#define LAS __attribute__((address_space(3)))
typedef unsigned short bf16;
typedef unsigned v4u __attribute__((ext_vector_type(4)));
typedef float f32x4 __attribute__((ext_vector_type(4)));
typedef short bf16x8 __attribute__((ext_vector_type(8)));
typedef GAS unsigned gu32;
typedef GAS unsigned long long gu64;
#define RLX_AGENT __ATOMIC_RELAXED, __HIP_MEMORY_SCOPE_AGENT
#define LDS_WAIT() asm volatile("s_waitcnt lgkmcnt(0)" ::: "memory")
#define VM_WAIT() asm volatile("s_waitcnt vmcnt(0)" ::: "memory")
__device__ __forceinline__ unsigned long long rt() { return __builtin_amdgcn_s_memrealtime(); }
__device__ __forceinline__ unsigned f2bf(float f) { unsigned u = __builtin_bit_cast(unsigned, f); return (u + 0x7fffu + ((u >> 16) & 1u)) >> 16; }
__device__ __forceinline__ unsigned pk2(float lo, float hi) { return f2bf(lo) | (f2bf(hi) << 16); }

#define XB_TMO      128
#define XB_XCNT(j)  (256  + 64 * (j))
#define XB_XSUB(j)  (1280 + 64 * (j))
#define XB_XGEN(j)  (2304 + 64 * (j))
#define XB_TOP      3328
#define XB_TOPGEN   3392
#define XCD_BAR_WORDS 3456
#define XB_SPIN_CAP (1u << 18)

__device__ __forceinline__ unsigned xb_ld(unsigned* p)              { return __hip_atomic_load(p, __ATOMIC_RELAXED, __HIP_MEMORY_SCOPE_AGENT); }
__device__ __forceinline__ unsigned xb_add(unsigned* p, unsigned v) { return __hip_atomic_fetch_add(p, v, __ATOMIC_RELAXED, __HIP_MEMORY_SCOPE_AGENT); }
__device__ __forceinline__ unsigned xb_xcc_id() { return (unsigned)__builtin_amdgcn_s_getreg((3 << 11) | 20) & 0xFu; }
#define XB_SPIN(cond, bar) do { unsigned _sp = 0; while (cond) { __builtin_amdgcn_s_sleep(1); \
    if ((++_sp & 255u) == 0u) { if (xb_ld(&(bar)[XB_TMO])) break; if (_sp > XB_SPIN_CAP) { atomicAdd(&(bar)[XB_TMO], 1u); break; } } } } while (0)

struct XcdBarrier {
    unsigned* bar; unsigned x;
    volatile LAS unsigned* st;
};

__device__ __forceinline__ XcdBarrier xcd_barrier_post(unsigned* bar, volatile LAS unsigned* st) {
    XcdBarrier b; b.bar = bar; b.x = xb_xcc_id(); b.st = st;
    if (threadIdx.x == 0) (void)xb_add(&bar[XB_XCNT(b.x)], 1u);
    return b;
}
__device__ __forceinline__ void xcd_barrier_complete(unsigned* bar, unsigned x, unsigned& nloc, unsigned& nx) {
    const unsigned G = gridDim.x * gridDim.y * gridDim.z;
    unsigned sum, cnt, mine, sp = 0u;
    for (;;) {
        sum = 0u; cnt = 0u; mine = 0u;
#pragma unroll
        for (unsigned j = 0; j < 16; ++j) { const unsigned c = xb_ld(&bar[XB_XCNT(j)]); sum += c; cnt += (c > 0u) ? 1u : 0u; mine = (j == x) ? c : mine; }
        if (sum == G) break;
        __builtin_amdgcn_s_sleep(1);
        if ((++sp & 255u) == 0u) { if (xb_ld(&bar[XB_TMO])) break; if (sp > XB_SPIN_CAP) { atomicAdd(&bar[XB_TMO], 1u); break; } }
    }
    nloc = mine > 0u ? mine : 1u; nx = cnt > 0u ? cnt : 1u;
}

__device__ __forceinline__ void xcd_barrier(const XcdBarrier& b) {
    asm volatile("s_waitcnt vmcnt(0)" ::: "memory");
    __syncthreads();
    if (threadIdx.x == 0) {
        unsigned* bar = b.bar;
        __builtin_amdgcn_s_waitcnt(0);
        unsigned nloc = b.st[0], nx = b.st[1];
        if (nloc == 0u) { xcd_barrier_complete(bar, b.x, nloc, nx); b.st[0] = nloc; b.st[1] = nx; }
        const unsigned old = xb_add(&bar[XB_XSUB(b.x)], 1u);
        const unsigned gen = old / nloc;
        if (old + 1u == (gen + 1u) * nloc) {
            __builtin_amdgcn_fence(__ATOMIC_RELEASE, "agent");
            asm volatile("s_waitcnt vmcnt(0)" ::: "memory");
            const unsigned og = xb_add(&bar[XB_TOP], 1u);
            const unsigned tg = og / nx;
            if (og + 1u == (tg + 1u) * nx) xb_add(&bar[XB_TOPGEN], 1u);
            else XB_SPIN(xb_ld(&bar[XB_TOPGEN]) == tg, bar);
            __builtin_amdgcn_fence(__ATOMIC_ACQUIRE, "agent");
            xb_add(&bar[XB_XGEN(b.x)], 1u);
            asm volatile("s_waitcnt vmcnt(0)" ::: "memory");
        } else {
            XB_SPIN(xb_ld(&bar[XB_XGEN(b.x)]) == gen, bar);
            __builtin_amdgcn_fence(__ATOMIC_ACQUIRE, "agent");
            asm volatile("s_waitcnt vmcnt(0)" ::: "memory");
        }
    }
    __syncthreads();
}
#ifndef ATT_FAST
#define ATT_FAST 1
#endif

constexpr int NWAVES = 8, NTHR = NWAVES * 64;
constexpr int BATCH = 4, SEQ = 8192, D = 1024, M = BATCH * SEQ;
constexpr int NHG = 8, HD = 64, HW = NHG * HD;
constexpr int INCOLS = 3080, NPROJ = 3072;
constexpr int NE = 32, NGRP = 4, EPG = 8, DF = 512, PLED = 256;
constexpr int SPAD = 2 * M + NE * 256;
constexpr float ALPHA = 1.189207115002721f, LN_EPS = 1e-5f, LOG2E = 1.4426950408889634f;
constexpr int NPH = 10;

constexpr size_t MiB = 1u << 20;
constexpr size_t WS_CTL = 0, CTL_ZERO_BYTES = 256 * 1024;
constexpr size_t WS_LS = 1 * MiB, WS_CFL = 2 * MiB, WS_CTOT = 3 * MiB, WS_KNT = 3 * MiB + 4096, WS_EID = 3 * MiB + 256 * 1024, WS_GATE = 3 * MiB + 512 * 1024, WS_RANK = 3 * MiB + 768 * 1024,
                 WS_SLOT = 4 * MiB, WS_GSLOT = 4 * MiB + 256 * 1024;
constexpr size_t WS_WIN = 5 * MiB, WS_WOUT = 11 * MiB, WS_WPLE = 13 * MiB, WS_WPG = 14 * MiB, WS_WGU = 16 * MiB, WS_WD = 80 * MiB, WS_PPLE = 112 * MiB;
constexpr size_t WS_R1 = 176 * MiB;
constexpr size_t WS_R2 = 368 * MiB;
constexpr size_t WS_R3 = 432 * MiB;
constexpr size_t WS_END = 504 * MiB;
static_assert(WS_GSLOT + (size_t)SPAD * 4 <= WS_WIN && WS_R1 + (size_t)SPAD * 2048 <= WS_R2 && WS_R3 + (size_t)SPAD * 1024 <= WS_END, "ws map");
constexpr int CW_TMO = 0, CW_BAR = 4096, CW_CNT = 8192;

constexpr int RING_OFF = 0, RING_BYTES = 131072;
constexpr int WGRP_OFF = RING_BYTES;
constexpr int LDSCTL_OFF = RING_BYTES + 16384, MISC_OFF = LDSCTL_OFF + 320, PST_OFF = LDSCTL_OFF + 1024, HIST_OFF = LDSCTL_OFF + 1280, BASE_OFF = LDSCTL_OFF + 1408, ROWL_OFF = LDSCTL_OFF + 2048;
constexpr int LDS_BYTES = 163840;

#define BFLO(w) __builtin_bit_cast(float, (w) << 16)
#define BFHI(w) __builtin_bit_cast(float, (w) & 0xffff0000u)
__device__ __forceinline__ float bf2f(unsigned short v) { return __builtin_bit_cast(float, (unsigned)v << 16); }
__device__ __forceinline__ float wave_sum(float v) {
#pragma unroll
    for (int o = 1; o < 64; o <<= 1) v += __shfl_xor(v, o);
    return v;
}
__device__ __forceinline__ float wave_max(float v) {
#pragma unroll
    for (int o = 1; o < 64; o <<= 1) v = fmaxf(v, __shfl_xor(v, o));
    return v;
}

struct Frame {
    LAS unsigned char* lds; volatile LAS unsigned* MISC; gu32* ctl;
    int tid, lane, wave, vcu, G;
    const float *x, *p, *w_in, *b_forget, *w_out, *ln1g, *ln1b, *w_group, *b_group, *w_router, *b_router, *w_gate, *w_up, *w_down, *w_ple, *w_pg, *ln2g, *ln2b;
    float* out;
    bf16 *Win_t, *Wout_t, *Wple_t, *Wpg_t, *Wgu_t, *Wd_t, *pple, *qkv, *xs, *y, *xb, *mixed, *hb, *pb, *hdn, *mixp;
    float *ls, *cfl, *ctot, *knt, *gatev, *gslot; int *eid, *rank, *slot;
};

struct TileRef { const float* src; bf16* dst; int ldw, ldt; float sc; };
__device__ __forceinline__ void tile_load(f32x4 (&r)[8], const TileRef& t, int lane) {
    const GAS float* p = (const GAS float*)t.src + (size_t)(lane >> 4) * t.ldw + 4 * (lane & 15);
#pragma unroll
    for (int i = 0; i < 8; ++i) r[i] = *(const GAS f32x4*)(p + (size_t)(4 * i) * t.ldw);
}
__device__ __forceinline__ void tile_store(const f32x4 (&r)[8], const TileRef& t, LAS float* scr, int lane) {
#pragma unroll
    for (int i = 0; i < 8; ++i) { LAS float* s = scr + (4 * i + (lane >> 4)) * 65 + 4 * (lane & 15); s[0] = r[i].x * t.sc; s[1] = r[i].y * t.sc; s[2] = r[i].z * t.sc; s[3] = r[i].w * t.sc; }
    LDS_WAIT(); asm volatile("" ::: "memory");
    const int c = lane & 3;
#pragma unroll
    for (int j = 0; j < 4; ++j) { const int n = 16 * j + (lane >> 2); const LAS float* s = scr + (8 * c) * 65 + n;
        v4u o; o.x = pk2(s[0 * 65], s[1 * 65]); o.y = pk2(s[2 * 65], s[3 * 65]); o.z = pk2(s[4 * 65], s[5 * 65]); o.w = pk2(s[6 * 65], s[7 * 65]);
        *(GAS v4u*)(t.dst + (size_t)n * t.ldt + 8 * c) = o; }
    LDS_WAIT(); asm volatile("" ::: "memory");
}
__device__ __forceinline__ float log_sigmoid_f(float v) { return fminf(v, 0.f) - log1pf(expf(-fabsf(v))); }
constexpr int I_IN = 16 * 48, I_OUT = 16 * 16, I_PLE = 4 * 16, I_PG = 16 * 16, I_GU = NE * 2 * 16 * 8, I_DN = NE * 8 * 16;
constexpr int P0_ITEMS = I_IN + I_OUT + I_PLE + I_PG + I_GU + I_DN;
__device__ __forceinline__ TileRef p0_item(Frame& F, int it, int sub) {
    int r = it; TileRef t; t.sc = 1.f;
    if (r < I_IN) { const int kb = 2 * (r / 48) + sub, nb = r % 48, s = nb >> 3;
        t.src = F.w_in + (size_t)kb * 32 * INCOLS + nb * 64; t.ldw = INCOLS; t.dst = F.Win_t + (size_t)nb * 64 * D + kb * 32; t.ldt = D; t.sc = (s == 0 || s == 3) ? 0.125f * LOG2E : 1.f; return t; } r -= I_IN;
    if (r < I_OUT) { const int kb = 2 * (r / 16) + sub, nb = r % 16; t.src = F.w_out + (size_t)kb * 32 * D + nb * 64; t.ldw = D; t.dst = F.Wout_t + (size_t)nb * 64 * D + kb * 32; t.ldt = D; return t; } r -= I_OUT;
    if (r < I_PLE) { const int kb = 2 * (r / 16) + sub, nb = r % 16; t.src = F.w_ple + (size_t)kb * 32 * D + nb * 64; t.ldw = D; t.dst = F.Wple_t + (size_t)nb * 64 * PLED + kb * 32; t.ldt = PLED; return t; } r -= I_PLE;
    if (r < I_PG) { const int kb = 2 * (r / 16) + sub, nb = r % 16; t.src = F.w_pg + (size_t)kb * 32 * D + nb * 64; t.ldw = D; t.dst = F.Wpg_t + (size_t)nb * 64 * D + kb * 32; t.ldt = D; return t; } r -= I_PG;
    if (r < I_GU) { const int e = r / 256, gu = (r >> 7) & 1, kb = 2 * ((r >> 3) & 15) + sub, nb = r & 7;
        t.src = (gu ? F.w_up : F.w_gate) + (size_t)e * D * DF + (size_t)kb * 32 * DF + nb * 64; t.ldw = DF;
        const int row = e * 1024 + (nb >> 1) * 256 + gu * 128 + (nb & 1) * 64;
        t.dst = F.Wgu_t + (size_t)row * D + kb * 32; t.ldt = D; return t; } r -= I_GU;
    { const int e = r / 128, kb = 2 * ((r >> 4) & 7) + sub, nb = r & 15;
        t.src = F.w_down + (size_t)e * DF * D + (size_t)kb * 32 * D + nb * 64; t.ldw = D; t.dst = F.Wd_t + (size_t)(e * 1024 + nb * 64) * DF + kb * 32; t.ldt = DF; return t; }
}
template <int PART> __device__ __forceinline__ void p0_prologue(Frame& F) {
    LAS float* scr = (LAS float*)(F.lds + RING_OFF + F.wave * 16384);
    const int gw = F.vcu * NWAVES + F.wave, NGW = F.G * NWAVES;
    if (PART == 0) {
        f32x4 ra[8], rb[8]; int it = gw;
        TileRef ta = p0_item(F, it < P0_ITEMS ? it : 0, 0), tb = p0_item(F, it < P0_ITEMS ? it : 0, 1);
        if (it < P0_ITEMS) { tile_load(ra, ta, F.lane); tile_load(rb, tb, F.lane); }
        while (it < P0_ITEMS) {
            const int i2 = it + NGW;
            tile_store(ra, ta, scr, F.lane);
            if (i2 < P0_ITEMS) { ta = p0_item(F, i2, 0); tile_load(ra, ta, F.lane); }
            tile_store(rb, tb, scr, F.lane);
            if (i2 < P0_ITEMS) { tb = p0_item(F, i2, 1); tile_load(rb, tb, F.lane); }
            it = i2;
        }
    }
    __syncthreads();
    if (PART == 1) {
    __syncthreads();
    LAS float* wf = (LAS float*)(F.lds + RING_OFF);
    for (int i = F.tid; i < 2048; i += NTHR) { const int c = i >> 1, j0 = (i & 1) * 4; const f32x4 w = *(const GAS f32x4*)(F.w_in + (size_t)c * INCOLS + NPROJ + j0);
        wf[(j0 + 0) * 1024 + c] = w.x; wf[(j0 + 1) * 1024 + c] = w.y; wf[(j0 + 2) * 1024 + c] = w.z; wf[(j0 + 3) * 1024 + c] = w.w; }
    __syncthreads();
    {
        f32x4 v[4], vn[4]; int m = gw;
        if (m < M) { const GAS f32x4* xr = (const GAS f32x4*)(F.x + (size_t)m * D) + F.lane;
#pragma unroll
            for (int j = 0; j < 4; ++j) v[j] = xr[64 * j]; }
        const float bfg = (F.lane < 8) ? F.b_forget[F.lane] : 0.f;
        for (; m < M; m += NGW) {
            const int mn = m + NGW;
            if (mn < M) { const GAS f32x4* xr = (const GAS f32x4*)(F.x + (size_t)mn * D) + F.lane;
#pragma unroll
                for (int j = 0; j < 4; ++j) vn[j] = xr[64 * j]; }
            GAS unsigned long long* o8 = (GAS unsigned long long*)(F.xb + (size_t)m * D) + F.lane;
#pragma unroll
            for (int j = 0; j < 4; ++j) o8[64 * j] = (unsigned long long)pk2(v[j].x, v[j].y) | ((unsigned long long)pk2(v[j].z, v[j].w) << 32);
            float mine = 0.f;
#pragma unroll
            for (int g = 0; g < 8; ++g) { float a = 0.f;
#pragma unroll
                for (int j = 0; j < 4; ++j) { const f32x4 w = *(const LAS f32x4*)(wf + g * 1024 + 4 * F.lane + 256 * j); a += (v[j].x * w.x + v[j].y * w.y) + (v[j].z * w.z + v[j].w * w.w); }
                a = wave_sum(a); if (F.lane == g) mine = a; }
            if (F.lane < 8) F.ls[(size_t)m * 8 + F.lane] = log_sigmoid_f(mine + bfg);
#pragma unroll
            for (int j = 0; j < 4; ++j) v[j] = vn[j];
        }
    }
    __syncthreads(); }
    if (PART == 2) { const int gtid = blockIdx.x * NTHR + F.tid, NT = F.G * NTHR;
      for (int i = gtid; i < M * PLED / 8; i += NT) { const GAS f32x4* s = (const GAS f32x4*)(F.p) + 2 * (size_t)i; const f32x4 a = s[0], b = s[1];
          v4u o; o.x = pk2(a.x, a.y); o.y = pk2(a.z, a.w); o.z = pk2(b.x, b.y); o.w = pk2(b.z, b.w); ((GAS v4u*)F.pb)[i] = o; } }
}

__device__ __forceinline__ void p2_scan(Frame& F) {
    LAS float* wt = (LAS float*)(F.lds + RING_OFF);
    for (int it = blockIdx.x; it < 256; it += F.G) {
        const int bh = it >> 3, chunk = it & 7, b = bh >> 3, h = bh & 7, t = chunk * 1024 + 2 * F.tid;
        const float a0 = F.ls[(size_t)(b * SEQ + t) * 8 + h] * LOG2E, a1 = F.ls[(size_t)(b * SEQ + t + 1) * 8 + h] * LOG2E;
        float s = a0 + a1;
#pragma unroll
        for (int o = 1; o < 64; o <<= 1) { const float u = __shfl_up(s, o); if (F.lane >= o) s += u; }
        __syncthreads();
        if (F.lane == 63) wt[F.wave] = s;
        __syncthreads();
        float off = 0.f, tot = 0.f;
#pragma unroll
        for (int w = 0; w < 8; ++w) { const float u = wt[w]; if (w < F.wave) off += u; tot += u; }
        const float i1 = off + s, i0 = i1 - a1;
        F.cfl[(size_t)bh * SEQ + t] = i0; F.cfl[(size_t)bh * SEQ + t + 1] = i1;
        if (F.tid == 0) F.ctot[bh * 8 + chunk] = tot;
        const bf16* kf = F.qkv + (size_t)4 * M * HW;
        float nmax = 0.f;
#pragma unroll
        for (int rr = 0; rr < 2; ++rr) { const GAS v4u* kp = (const GAS v4u*)(kf + (size_t)(b * SEQ + t + rr) * HW + h * HD); float n2 = 0.f;
#pragma unroll
            for (int c = 0; c < 8; ++c) { const v4u w = kp[c];
#pragma unroll
                for (int e = 0; e < 4; ++e) { const float lo = __builtin_bit_cast(float, w[e] << 16), hi = __builtin_bit_cast(float, w[e] & 0xffff0000u); n2 += lo * lo + hi * hi; } }
            nmax = fmaxf(nmax, n2); }
#pragma unroll
        for (int o = 1; o < 32; o <<= 1) nmax = fmaxf(nmax, __shfl_xor(nmax, o));
        if ((F.lane & 31) == 0) F.knt[bh * 128 + chunk * 16 + F.wave * 2 + (F.lane >> 5)] = sqrtf(nmax);
    }
}

#if !defined(ATT_FAST) || !ATT_FAST
__device__ __forceinline__ void ld64(float (&d)[64], const bf16* p) {
    const GAS v4u* s = (const GAS v4u*)p;
#pragma unroll
    for (int c = 0; c < 8; ++c) { const v4u w = s[c];
#pragma unroll
        for (int e = 0; e < 4; ++e) { d[c * 8 + 2 * e] = BFLO(w[e]); d[c * 8 + 2 * e + 1] = BFHI(w[e]); } }
}
__device__ __forceinline__ float dot64(const float (&q)[64], const bf16* p) {
    const GAS v4u* s = (const GAS v4u*)p; float z = 0.f;
#pragma unroll
    for (int c = 0; c < 8; ++c) { const v4u w = s[c];
#pragma unroll
        for (int e = 0; e < 4; ++e) { z += q[c * 8 + 2 * e] * BFLO(w[e]); z += q[c * 8 + 2 * e + 1] * BFHI(w[e]); } }
    return z;
}
__device__ __forceinline__ void axpy64(float (&o)[64], float a, const bf16* p) {
    const GAS v4u* s = (const GAS v4u*)p;
#pragma unroll
    for (int c = 0; c < 8; ++c) { const v4u w = s[c];
#pragma unroll
        for (int e = 0; e < 4; ++e) { o[c * 8 + 2 * e] += a * BFLO(w[e]); o[c * 8 + 2 * e + 1] += a * BFHI(w[e]); } }
}
__device__ __forceinline__ void st64(bf16* p, const float (&d)[64], float sc) {
    GAS v4u* s = (GAS v4u*)p;
#pragma unroll
    for (int c = 0; c < 8; ++c) { v4u w;
#pragma unroll
        for (int e = 0; e < 4; ++e) w[e] = pk2(d[c * 8 + 2 * e] * sc, d[c * 8 + 2 * e + 1] * sc);
        s[c] = w; }
}
__device__ __forceinline__ void p3_attn_simple(Frame& F) {
    const int gtid = blockIdx.x * NTHR + F.tid, NT = F.G * NTHR;
    const bf16 *Qs = F.qkv, *Ks = F.qkv + (size_t)1 * M * HW, *Vs = F.qkv + (size_t)2 * M * HW, *Qf = F.qkv + (size_t)3 * M * HW, *Kf = F.qkv + (size_t)4 * M * HW, *Vf = F.qkv + (size_t)5 * M * HW;
    for (int idx = gtid; idx < M * NHG; idx += NT) {
        const int h = idx >> 15, m = idx & (M - 1), b = m >> 13, t = m & (SEQ - 1);
        float q[64], o[64];
        ld64(q, Qs + (size_t)m * HW + h * HD);
#pragma unroll
        for (int d = 0; d < 64; ++d) o[d] = 0.f;
        float C2 = 0.f;
        for (int s = t - 1; s >= 0; --s) {
            const float z = dot64(q, Ks + (size_t)(b * SEQ + s) * HW + h * HD);
            const float L2 = -(fmaxf(z, 0.f) * LOG2E + log2f(1.f + exp2f(-fabsf(z) * LOG2E)));
            const float w = exp2f(z * LOG2E + L2 + C2);
            axpy64(o, w, Vs + (size_t)(b * SEQ + s) * HW + h * HD);
            C2 += L2;
            if (C2 < -160.f) break;
        }
        st64(F.mixed + (size_t)m * D + h * HD, o, 1.f);
    }
    for (int idx = gtid; idx < M * NHG; idx += NT) {
        const int h = idx >> 15, m = idx & (M - 1), b = m >> 13, t = m & (SEQ - 1), bh = b * 8 + h;
        float q[64], o[64];
        ld64(q, Qf + (size_t)m * HW + h * HD);
#pragma unroll
        for (int d = 0; d < 64; ++d) o[d] = 0.f;
        float cq = F.cfl[(size_t)bh * SEQ + t];
        for (int c = 0; c < (t >> 10); ++c) cq += F.ctot[bh * 8 + c];
        float carry = 0.f, mr = -1e30f, l = 0.f;
        for (int s = 0; s <= t; ++s) {
            if ((s & 1023) == 0 && s > 0) carry += F.ctot[bh * 8 + (s >> 10) - 1];
            const float z = dot64(q, Kf + (size_t)(b * SEQ + s) * HW + h * HD);
            const float s2 = z * LOG2E + (cq - (F.cfl[(size_t)bh * SEQ + s] + carry));
            if (s2 > mr) { const float f = exp2f(mr - s2); l *= f;
#pragma unroll
                for (int d = 0; d < 64; ++d) o[d] *= f;
                mr = s2; }
            const float pw = exp2f(s2 - mr); l += pw;
            axpy64(o, pw, Vf + (size_t)(b * SEQ + s) * HW + h * HD);
        }
        st64(F.mixed + (size_t)m * D + HW + h * HD, o, 1.f / l);
    }
}

#endif
struct FProj { bf16* qkv; __device__ __forceinline__ void operator()(int row, int col, float v) const { const int t = col >> 9, cc = col & 511; const float sc = (t == 0 || t == 3) ? 0.125f : 1.f;
    qkv[(size_t)t * M * HW + (size_t)row * HW + cc] = (bf16)f2bf(v * sc); } };
struct FBf16 { bf16* O; int ldc; int cmask; __device__ __forceinline__ void operator()(int row, int col, float v) const { O[(size_t)row * ldc + (col & cmask)] = (bf16)f2bf(v); } };
struct FPre { const float* x; float* out; __device__ __forceinline__ void operator()(int row, int col, float v) const { const size_t i = (size_t)row * D + col; out[i] = ALPHA * x[i] + v; } };
struct FSwiglu { bf16* hdn; const float* gslot; __device__ __forceinline__ void operator()(int row, int pn, int cl, float g, float u) const {
    const int f = (pn & 3) * 128 + cl; const float s = g / (1.f + __expf(-g)); hdn[(size_t)row * DF + f] = (bf16)f2bf(s * u * gslot[row]); } };
struct FComb { float* out; const bf16* pple; const bf16* y; const int* slot; __device__ __forceinline__ void operator()(int row, int col, float v) const {
    const size_t i = (size_t)row * D + col; const int s0 = slot[row * 2], s1 = slot[row * 2 + 1]; const float sig = 1.f / (1.f + __expf(-v));
    out[i] = ALPHA * out[i] + bf2f(pple[i]) * sig + bf2f(y[(size_t)s0 * D + col]) + bf2f(y[(size_t)s1 * D + col]); } };

#ifndef PROBE_TWICE
#define PROBE_TWICE -1
#endif
template <class S> struct Rep2T : S {
    __device__ __forceinline__ bool next(int i, pg8::Unit& u) const { return S::next(i >> 1, u); }
};
template <class S, bool ON> struct Rep2Sel { typedef S type; };
template <class S> struct Rep2Sel<S, true> { typedef Rep2T<S> type; };
#define Rep2(S, ON) typename Rep2Sel<S, ON>::type

namespace pg8 {
struct EpiPre {
    static constexpr bool PERM = true, AFTER_DRAIN = false; const float* x; float* out;
    __device__ __forceinline__ void operator()(const f32x4 (&acc)[2][2][4][2], const Unit& u, int wr, int wc, int fr, int fq) const {
        const int row0 = u.pm * BM + wr * 64 + fr, col0 = u.pn * BM + wc * 32 + 8 * fq;
#pragma unroll
        for (int ai = 0; ai < 2; ++ai)
#pragma unroll
            for (int m = 0; m < 4; ++m) { const size_t off = (size_t)(row0 + ai * HALF + m * 16) * D + col0;
#pragma unroll
                for (int bj = 0; bj < 2; ++bj) { const f32x4 x0 = *(const f32x4*)(x + off + bj * HALF), x1 = *(const f32x4*)(x + off + bj * HALF + 4);
                    *(f32x4*)(out + off + bj * HALF) = x0 * ALPHA + acc[ai][bj][m][0]; *(f32x4*)(out + off + bj * HALF + 4) = x1 * ALPHA + acc[ai][bj][m][1]; }
                asm volatile("" ::: "memory"); }
    }
};
struct EpiSwiglu {
    static constexpr bool PERM = true, AFTER_DRAIN = false; bf16_t* hdn; const float* gslot;
    __device__ __forceinline__ void operator()(const f32x4 (&acc)[2][2][4][2], const Unit& u, int wr, int wc, int fr, int fq) const {
        const int row0 = u.pm * BM + wr * 64 + fr, f0 = (u.pn & 3) * 128 + wc * 32 + 8 * fq;
#pragma unroll
        for (int ai = 0; ai < 2; ++ai)
#pragma unroll
            for (int m = 0; m < 4; ++m) { const int r = row0 + ai * HALF + m * 16; const float gs = gslot[r]; float v[8];
#pragma unroll
                for (int n = 0; n < 2; ++n)
#pragma unroll
                    for (int e = 0; e < 4; ++e) { const float g = acc[ai][0][m][n][e], up = acc[ai][1][m][n][e]; v[4 * n + e] = g * __builtin_amdgcn_rcpf(1.f + __expf(-g)) * up * gs; }
                u32x4 w; w.x = cvt_pk_bf16(v[0], v[1]); w.y = cvt_pk_bf16(v[2], v[3]); w.z = cvt_pk_bf16(v[4], v[5]); w.w = cvt_pk_bf16(v[6], v[7]);
                *(u32x4*)(hdn + (size_t)r * DF + f0) = w; }
    }
};
struct EpiPle {
    static constexpr bool PERM = true, AFTER_DRAIN = false; bf16_t* pple;
    const bf16_t* hb; bf16_t* xs; const int* eid; const int* rank; const float* gatev; int* slot; float* gslot; const PG8_LAS int* pst;
    __device__ __forceinline__ void operator()(const f32x4 (&acc)[2][2][4][2], const Unit& u, int wr, int wc, int fr, int fq) const {
        const int row0 = u.pm * BM + wr * 64 + fr, col0 = u.pn * BM + wc * 32 + 8 * fq;
#pragma unroll
        for (int ai = 0; ai < 2; ++ai)
#pragma unroll
            for (int m = 0; m < 4; ++m) { const size_t off = (size_t)(row0 + ai * HALF + m * 16) * D + col0;
#pragma unroll
                for (int bj = 0; bj < 2; ++bj) { const u32x4 pp = *(const u32x4*)(pple + off + bj * HALF); float v[8];
#pragma unroll
                    for (int e = 0; e < 8; ++e) { const float g = acc[ai][bj][m][e >> 2][e & 3]; const unsigned pw = pp[e >> 1];
                        const float pv = (e & 1) ? __builtin_bit_cast(float, pw & 0xffff0000u) : __builtin_bit_cast(float, pw << 16);
                        v[e] = pv * __builtin_amdgcn_rcpf(1.f + __expf(-g)); }
                    u32x4 w; w.x = cvt_pk_bf16(v[0], v[1]); w.y = cvt_pk_bf16(v[2], v[3]); w.z = cvt_pk_bf16(v[4], v[5]); w.w = cvt_pk_bf16(v[6], v[7]);
                    *(u32x4*)(pple + off + bj * HALF) = w; }
                asm volatile("" ::: "memory"); }
        const int lane = fq * 16 + fr, rb = u.pm * BM + (u.pn & 3) * 64 + (wr * 4 + wc) * 8;
        u32x4 ra[8], rbv[8]; int s0[8], s1[8];
#pragma unroll
        for (int k = 0; k < 8; ++k) { const int mrow = rb + k; int s = 0;
            if (lane < 2) { const int e = eid[mrow * 2 + lane]; s = pst[e] + rank[mrow * 2 + lane]; slot[mrow * 2 + lane] = s; gslot[s] = gatev[mrow * 2 + lane]; }
            s0[k] = __shfl(s, 0); s1[k] = __shfl(s, 1);
            const u32x4* src = (const u32x4*)(hb + (size_t)mrow * D); ra[k] = src[lane]; rbv[k] = src[lane + 64]; }
#pragma unroll
        for (int k = 0; k < 8; ++k) { u32x4* d0 = (u32x4*)(xs + (size_t)s0[k] * D); u32x4* d1 = (u32x4*)(xs + (size_t)s1[k] * D);
            d0[lane] = ra[k]; d0[lane + 64] = rbv[k]; d1[lane] = ra[k]; d1[lane + 64] = rbv[k]; }
    }
};
}

struct MoeOrder {
    const LAS int* pst; int nunits, G, c;
    __device__ __forceinline__ bool next(int i, pg8::Unit& u) const {
        const int L = i * G + c; if (L >= nunits) return false;
        const int pm = L >> 2, r0 = pm * 256; int e = 0;
        for (int k = 0; k < NE - 1; ++k) if (r0 >= pst[k + 1]) e = k + 1;
        u.pm = pm; u.pn = e * 4 + (L & 3); return true;
    }
    __device__ __forceinline__ void a_ready(const pg8::Unit&) const {}
    __device__ __forceinline__ void done(const pg8::Unit&) const {}
};
__device__ __forceinline__ void build_pstart(Frame& F) {
    LAS int* pst = (LAS int*)(F.lds + PST_OFF);
    if (F.tid == 0) { int acc = 0; for (int e = 0; e < NE; ++e) { const int c = (int)__hip_atomic_load(F.ctl + CW_CNT + 64 * e, RLX_AGENT); pst[e] = acc; acc += (c + 255) & ~255; } pst[NE] = acc; }
    __syncthreads();
}

constexpr int RB = 2;
__device__ __forceinline__ unsigned long long pk4(const f32x4 v) { return (unsigned long long)pk2(v.x, v.y) | ((unsigned long long)pk2(v.z, v.w) << 32); }
__device__ __forceinline__ float rdl(float v, int l) { return __builtin_bit_cast(float, __builtin_amdgcn_readlane(__builtin_bit_cast(int, v), l)); }
template <int H, int K> __device__ __forceinline__ void rs_step(float* a, int lane) {
    const bool up = (lane >> K) & 1;
#pragma unroll
    for (int i = 0; i < H; ++i) { const float keep = up ? a[H + i] : a[i], send = up ? a[i] : a[H + i]; a[i] = keep + __shfl_xor(send, 1 << K); }
}
__device__ __forceinline__ void p5_ln_route(Frame& F) {
    LAS unsigned* hist = (LAS unsigned*)(F.lds + HIST_OFF); LAS unsigned* base = (LAS unsigned*)(F.lds + BASE_OFF);
    LAS int* eidL = (LAS int*)(F.lds + ROWL_OFF); LAS int* rankL = eidL + 256;
    LAS f32x4* wr = (LAS f32x4*)(F.lds + RING_OFF); LAS f32x4* wg = (LAS f32x4*)(F.lds + WGRP_OFF);
    for (int it = F.wave; it < 128; it += NWAVES) { const int j = it >> 5, e = (it >> 3) & 3, ln = (it & 7) * 8 + (F.lane & 7), pc = F.lane >> 3, g = pc >> 1, half = pc & 1, c = 256 * j + 4 * ln + e;
        wr[((((g * 4 + j) * 4 + e) * 2 + half) << 6) + ln] = *(const GAS f32x4*)(F.w_router + (size_t)c * NE + pc * 4); }
    for (int c = F.tid; c < 1024; c += NTHR) { const int ln = (c & 255) >> 2, j = c >> 8, e = c & 3; wg[((j * 4 + e) << 6) + ln] = *(const GAS f32x4*)(F.w_group + (size_t)c * 4); }
    if (F.tid < NE) hist[F.tid] = 0u;
    __syncthreads();
    f32x4 gv[4], bv[4];
#pragma unroll
    for (int j = 0; j < 4; ++j) { gv[j] = *(const GAS f32x4*)(F.ln1g + 4 * F.lane + 256 * j); bv[j] = *(const GAS f32x4*)(F.ln1b + 4 * F.lane + 256 * j); }
    constexpr int R4 = 4;
    for (int r0 = F.wave * R4; r0 < 128; r0 += NWAVES * R4) {
        f32x4 v[R4][4]; float st[2 * R4];
#pragma unroll
        for (int rr = 0; rr < R4; ++rr) { const size_t ro = (size_t)(blockIdx.x * 128 + r0 + rr) * D;
            const GAS f32x4* pr = (const GAS f32x4*)(F.x + ro) + F.lane; const GAS unsigned long long* pm = (const GAS unsigned long long*)(F.mixp + ro) + F.lane;
#pragma unroll
            for (int j = 0; j < 4; ++j) { const f32x4 xv = pr[64 * j]; const unsigned long long mw = pm[64 * j]; const unsigned m0 = (unsigned)mw, m1 = (unsigned)(mw >> 32);
                v[rr][j] = (f32x4){xv.x * ALPHA + BFLO(m0), xv.y * ALPHA + BFHI(m0), xv.z * ALPHA + BFLO(m1), xv.w * ALPHA + BFHI(m1)}; } }
#pragma unroll
        for (int rr = 0; rr < R4; ++rr) { float s = 0.f, q = 0.f;
#pragma unroll
            for (int j = 0; j < 4; ++j) { s += (v[rr][j].x + v[rr][j].y) + (v[rr][j].z + v[rr][j].w); q += (v[rr][j].x * v[rr][j].x + v[rr][j].y * v[rr][j].y) + (v[rr][j].z * v[rr][j].z + v[rr][j].w * v[rr][j].w); }
            st[2 * rr] = s; st[2 * rr + 1] = q; }
        rs_step<4, 5>(st, F.lane); rs_step<2, 4>(st, F.lane); rs_step<1, 3>(st, F.lane);
#pragma unroll
        for (int o = 1; o < 8; o <<= 1) st[0] += __shfl_xor(st[0], o);
        float gl[4 * R4];
#pragma unroll
        for (int i = 0; i < 4 * R4; ++i) gl[i] = 0.f;
#pragma unroll
        for (int rr = 0; rr < R4; ++rr) { const int m = blockIdx.x * 128 + r0 + rr;
            const float sum = rdl(st[0], 16 * rr), sq = rdl(st[0], 16 * rr + 8);
            const float mean = sum * (1.f / D), rstd = 1.f / sqrtf(fmaxf(sq * (1.f / D) - mean * mean, 0.f) + LN_EPS);
            GAS unsigned long long* o8 = (GAS unsigned long long*)(F.hb + (size_t)m * D) + F.lane;
#pragma unroll
            for (int j = 0; j < 4; ++j) { v[rr][j] = (v[rr][j] - mean) * rstd * gv[j] + bv[j]; o8[64 * j] = pk4(v[rr][j]); } }
#pragma unroll
        for (int j = 0; j < 4; ++j)
#pragma unroll
            for (int e = 0; e < 4; ++e) { const f32x4 w = wg[((j * 4 + e) << 6) + F.lane];
#pragma unroll
                for (int rr = 0; rr < R4; ++rr) { const float hv = v[rr][j][e]; gl[4 * rr] += hv * w.x; gl[4 * rr + 1] += hv * w.y; gl[4 * rr + 2] += hv * w.z; gl[4 * rr + 3] += hv * w.w; } }
        rs_step<8, 5>(gl, F.lane); rs_step<4, 4>(gl, F.lane); rs_step<2, 3>(gl, F.lane); rs_step<1, 2>(gl, F.lane);
#pragma unroll
        for (int o = 1; o < 4; o <<= 1) gl[0] += __shfl_xor(gl[0], o);
        int gs[R4]; float gprob[R4]; float el[8 * R4];
#pragma unroll
        for (int rr = 0; rr < R4; ++rr) { float t[4];
#pragma unroll
            for (int i = 0; i < 4; ++i) t[i] = rdl(gl[0], 4 * (4 * rr + i)) + F.b_group[i];
            int g = 0; float gm = t[0];
#pragma unroll
            for (int i = 1; i < 4; ++i) if (t[i] > gm) { gm = t[i]; g = i; }
            gs[rr] = g; float gden = 0.f;
#pragma unroll
            for (int i = 0; i < 4; ++i) gden += expf(t[i] - gm);
            gprob[rr] = 1.f / gden; }
#pragma unroll
        for (int i = 0; i < 8 * R4; ++i) el[i] = 0.f;
#pragma unroll
        for (int j = 0; j < 4; ++j)
#pragma unroll
            for (int e = 0; e < 4; ++e)
#pragma unroll
                for (int rr = 0; rr < R4; ++rr) { const LAS f32x4* wp = wr + ((((gs[rr] * 4 + j) * 4 + e) * 2) << 6) + F.lane; const f32x4 w0 = wp[0], w1 = wp[64]; const float hv = v[rr][j][e];
                    el[8 * rr + 0] += hv * w0.x; el[8 * rr + 1] += hv * w0.y; el[8 * rr + 2] += hv * w0.z; el[8 * rr + 3] += hv * w0.w;
                    el[8 * rr + 4] += hv * w1.x; el[8 * rr + 5] += hv * w1.y; el[8 * rr + 6] += hv * w1.z; el[8 * rr + 7] += hv * w1.w; }
        rs_step<16, 5>(el, F.lane); rs_step<8, 4>(el, F.lane); rs_step<4, 3>(el, F.lane); rs_step<2, 2>(el, F.lane); rs_step<1, 1>(el, F.lane);
        el[0] += __shfl_xor(el[0], 1);
#pragma unroll
        for (int rr = 0; rr < R4; ++rr) { const int r = r0 + rr, m = blockIdx.x * 128 + r; float t[8];
#pragma unroll
            for (int i = 0; i < 8; ++i) t[i] = rdl(el[0], 2 * (8 * rr + i)) + F.b_router[gs[rr] * EPG + i];
            int i1 = 0; float v1 = t[0];
#pragma unroll
            for (int i = 1; i < 8; ++i) if (t[i] > v1) { v1 = t[i]; i1 = i; }
            int i2 = (i1 == 0) ? 1 : 0; float v2 = (i1 == 0) ? t[1] : t[0];
#pragma unroll
            for (int i = 1; i < 8; ++i) if (i != i1 && t[i] > v2) { v2 = t[i]; i2 = i; }
            const float e2 = expf(v2 - v1), g1 = 1.f / (1.f + e2), g2 = e2 * g1;
            if (F.lane == 0) {
                const int ea = gs[rr] * EPG + i1, eb = gs[rr] * EPG + i2;
                const unsigned ra = __hip_atomic_fetch_add(hist + ea, 1u, __ATOMIC_RELAXED, __HIP_MEMORY_SCOPE_WORKGROUP);
                const unsigned rb = __hip_atomic_fetch_add(hist + eb, 1u, __ATOMIC_RELAXED, __HIP_MEMORY_SCOPE_WORKGROUP);
                eidL[r * 2] = ea; eidL[r * 2 + 1] = eb; rankL[r * 2] = (int)ra; rankL[r * 2 + 1] = (int)rb;
                F.eid[m * 2] = ea; F.eid[m * 2 + 1] = eb; F.gatev[m * 2] = g1 * gprob[rr]; F.gatev[m * 2 + 1] = g2 * gprob[rr];
            } }
    }
    __syncthreads();
    if (F.tid < NE) base[F.tid] = __hip_atomic_fetch_add(F.ctl + CW_CNT + 64 * F.tid, hist[F.tid], RLX_AGENT);
    __syncthreads();
    if (F.tid < 256) F.rank[blockIdx.x * 256 + F.tid] = rankL[F.tid] + (int)base[eidL[F.tid]];
}
__device__ __forceinline__ void p6_slots_gather(Frame& F) {
    build_pstart(F);
    const LAS int* pst = (const LAS int*)(F.lds + PST_OFF);
    for (int r0 = F.wave * 4; r0 < 128; r0 += NWAVES * 4) {
        v4u a[4], b[4]; int s0[4], s1[4];
#pragma unroll
        for (int rr = 0; rr < 4; ++rr) { const int m = blockIdx.x * 128 + r0 + rr; int s = 0;
            if (F.lane < 2) { const int e = F.eid[m * 2 + F.lane]; s = pst[e] + F.rank[m * 2 + F.lane]; F.slot[m * 2 + F.lane] = s; F.gslot[s] = F.gatev[m * 2 + F.lane]; }
            s0[rr] = __shfl(s, 0); s1[rr] = __shfl(s, 1);
            const GAS v4u* src = (const GAS v4u*)(F.hb + (size_t)m * D); a[rr] = src[F.lane]; b[rr] = src[F.lane + 64]; }
#pragma unroll
        for (int rr = 0; rr < 4; ++rr) { GAS v4u* d0 = (GAS v4u*)(F.xs + (size_t)s0[rr] * D); GAS v4u* d1 = (GAS v4u*)(F.xs + (size_t)s1[rr] * D);
            d0[F.lane] = a[rr]; d0[F.lane + 64] = b[rr]; d1[F.lane] = a[rr]; d1[F.lane + 64] = b[rr]; }
    }
}
__device__ __forceinline__ void p9_final(Frame& F, bool poison) {
    f32x4 gv[4], bv[4];
#pragma unroll
    for (int j = 0; j < 4; ++j) { gv[j] = *(const GAS f32x4*)(F.ln2g + 4 * F.lane + 256 * j); bv[j] = *(const GAS f32x4*)(F.ln2b + 4 * F.lane + 256 * j); }
    const int gw = blockIdx.x * NWAVES + F.wave, NGW = F.G * NWAVES; const float qn = __builtin_nanf("");
    for (int m0 = gw * RB; m0 < M; m0 += NGW * RB) {
        f32x4 v[RB][4]; float mean[RB], rstd[RB];
#pragma unroll
        for (int rr = 0; rr < RB; ++rr) { const int m = m0 + rr; const int s0 = F.slot[2 * m], s1 = F.slot[2 * m + 1];
            const GAS unsigned long long* ph = (const GAS unsigned long long*)(F.hb + (size_t)m * D) + F.lane;
            const GAS unsigned long long* pp = (const GAS unsigned long long*)(F.pple + (size_t)m * D) + F.lane;
            const GAS unsigned long long* y0 = (const GAS unsigned long long*)(F.y + (size_t)s0 * D) + F.lane; const GAS unsigned long long* y1 = (const GAS unsigned long long*)(F.y + (size_t)s1 * D) + F.lane;
#pragma unroll
            for (int j = 0; j < 4; ++j) { const unsigned long long hw = ph[64 * j], pw = pp[64 * j], aw = y0[64 * j], bw = y1[64 * j];
                const unsigned h0 = (unsigned)hw, h1 = (unsigned)(hw >> 32), p0 = (unsigned)pw, p1 = (unsigned)(pw >> 32), a0 = (unsigned)aw, a1 = (unsigned)(aw >> 32), b0 = (unsigned)bw, b1 = (unsigned)(bw >> 32);
                f32x4 t;
                t.x = BFLO(h0) * ALPHA + BFLO(p0) + (BFLO(a0) + BFLO(b0)); t.y = BFHI(h0) * ALPHA + BFHI(p0) + (BFHI(a0) + BFHI(b0));
                t.z = BFLO(h1) * ALPHA + BFLO(p1) + (BFLO(a1) + BFLO(b1)); t.w = BFHI(h1) * ALPHA + BFHI(p1) + (BFHI(a1) + BFHI(b1));
                v[rr][j] = t; } }
#pragma unroll
        for (int rr = 0; rr < RB; ++rr) { float s = 0.f;
#pragma unroll
            for (int j = 0; j < 4; ++j) s += (v[rr][j].x + v[rr][j].y) + (v[rr][j].z + v[rr][j].w);
            mean[rr] = s; }
#pragma unroll
        for (int o = 1; o < 64; o <<= 1)
#pragma unroll
            for (int rr = 0; rr < RB; ++rr) mean[rr] += __shfl_xor(mean[rr], o);
#pragma unroll
        for (int rr = 0; rr < RB; ++rr) { mean[rr] *= (1.f / D); float s2 = 0.f;
#pragma unroll
            for (int j = 0; j < 4; ++j) { v[rr][j] = v[rr][j] - mean[rr]; s2 += (v[rr][j].x * v[rr][j].x + v[rr][j].y * v[rr][j].y) + (v[rr][j].z * v[rr][j].z + v[rr][j].w * v[rr][j].w); }
            rstd[rr] = s2; }
#pragma unroll
        for (int o = 1; o < 64; o <<= 1)
#pragma unroll
            for (int rr = 0; rr < RB; ++rr) rstd[rr] += __shfl_xor(rstd[rr], o);
#pragma unroll
        for (int rr = 0; rr < RB; ++rr) { const float rs = 1.f / sqrtf(rstd[rr] * (1.f / D) + LN_EPS); GAS f32x4* pr = (GAS f32x4*)(F.out + (size_t)(m0 + rr) * D) + F.lane;
#pragma unroll
            for (int j = 0; j < 4; ++j) { f32x4 o = v[rr][j] * rs * gv[j] + bv[j]; if (poison) o = (f32x4){qn, qn, qn, qn}; pr[64 * j] = o; } }
    }
}


namespace att {
typedef float f32x16 __attribute__((ext_vector_type(16)));
typedef short s16x4 __attribute__((ext_vector_type(4)));
typedef short v4i16_t __attribute__((ext_vector_type(4)));
constexpr int NSLOT = 5, BUFB = 16384 + 512, A_WS = NSLOT * BUFB, A_FLAG = A_WS + 2048, A_CAR = A_FLAG + 64, A_END = A_CAR + 64;
constexpr float STOP2 = -40.f;
__device__ __forceinline__ int crow(int r, int hi) { return (r & 3) + 8 * (r >> 2) + 4 * hi; }
__device__ __forceinline__ unsigned cvtpk(float lo, float hi) { typedef float f2 __attribute__((ext_vector_type(2))); typedef __bf16 b2 __attribute__((ext_vector_type(2))); f2 v = {lo, hi}; b2 b = __builtin_convertvector(v, b2); return __builtin_bit_cast(unsigned, b); }

template <int MODE> __device__ __forceinline__ void attn_unit(Frame& F, int bh, int qb) {
    const int tid = F.tid, lane = F.lane, r32 = lane & 31, hi = lane >> 5, wid = F.wave;
    const int b = bh >> 3, h = bh & 7;
    const bf16* Qg = F.qkv + (size_t)(MODE ? 3 : 0) * M * HW; const bf16* Kg = F.qkv + (size_t)(MODE ? 4 : 1) * M * HW; const bf16* Vg = F.qkv + (size_t)(MODE ? 5 : 2) * M * HW;
    const size_t rowbase = (size_t)b * SEQ; const int q0 = qb * 256;
    const bf16* Qw = Qg + (rowbase + q0 + wid * 32) * HW + h * HD;
    const bf16* Kh = Kg + rowbase * HW + h * HD; const bf16* Vh = Vg + rowbase * HW + h * HD;
    LAS unsigned char* L = F.lds + RING_OFF;
    LAS float* wsf = (LAS float*)(L + A_WS) + wid * 64;
    LAS unsigned* flg = (LAS unsigned*)(L + A_FLAG);
    LAS float* car = (LAS float*)(L + A_CAR);
    const int jt = (q0 >> 6) + 3, jw = (q0 >> 6) + (wid >> 1);
    const bf16* ksrc = Kh + (size_t)lane * HW + wid * 8;
    const bf16* vsrc = Vh + (size_t)(16 * (wid & 3) + (lane >> 2)) * HW + (wid >> 2) * 32 + (lane & 3) * 8;
    const int kdst = wid * 1024 + lane * 16, vdst = 8192 + wid * 1024 + lane * 16;
    const float* cfsrc = F.cfl + (size_t)bh * SEQ + tid * 4;
    float KNu = 0.f;
    if (MODE) {
        if (tid < 8) { float c = 0.f; for (int k = 0; k < tid; ++k) c += F.ctot[bh * 8 + k]; car[tid] = c; }
        float kn = (lane <= jt) ? F.knt[bh * 128 + lane] : 0.f; if (lane + 64 <= jt) kn = fmaxf(kn, F.knt[bh * 128 + lane + 64]);
        KNu = wave_max(kn);
    }
    bf16x8 qr[4];
#pragma unroll
    for (int d0 = 0; d0 < 4; ++d0) qr[d0] = *(const GAS bf16x8*)(Qw + (size_t)r32 * HW + d0 * 16 + hi * 8);
    __syncthreads();
    v4u kreg[2], vreg[2]; f32x4 cfreg[2]; cfreg[0] = (f32x4){0.f, 0.f, 0.f, 0.f}; cfreg[1] = cfreg[0];
#pragma unroll
    for (int k = 0; k < 4; ++k) { const int t = jt - k, so = (t % NSLOT) * BUFB;
        const v4u kk = *(const GAS v4u*)(ksrc + (size_t)t * 64 * HW), vv = *(const GAS v4u*)(vsrc + (size_t)t * 64 * HW);
        *(LAS v4u*)(L + so + kdst) = kk; *(LAS v4u*)(L + so + vdst) = vv;
        if (MODE && tid < 16) { f32x4 cc = *(const GAS f32x4*)(cfsrc + t * 64); const float c = car[t >> 4]; cc = -(cc + c); *(LAS f32x4*)(L + so + 16384 + tid * 16) = cc; } }
    if (jt >= 4) { kreg[1] = *(const GAS v4u*)(ksrc + (size_t)(jt - 4) * 64 * HW); vreg[1] = *(const GAS v4u*)(vsrc + (size_t)(jt - 4) * 64 * HW);
        if (MODE && tid < 16) cfreg[1] = *(const GAS f32x4*)(cfsrc + (jt - 4) * 64); }
    float qnb = 0.f;
    if (MODE) {
        float n2 = 0.f;
#pragma unroll
        for (int d0 = 0; d0 < 4; ++d0)
#pragma unroll
            for (int e = 0; e < 8; ++e) { const float qv = __builtin_bit_cast(float, (unsigned)(unsigned short)qr[d0][e] << 16); n2 += qv * qv; }
        n2 += __shfl_xor(n2, 32);
        qnb = sqrtf(n2) * KNu * 1.01f;
    }
    __syncthreads();
    f32x16 o[2]; o[0] = f32x16{}; o[1] = f32x16{};
    float C2 = 0.f, mhat = -1e30f, lsum = 0.f;
    bool wdone = false;
    const LAS unsigned char* vb0 = L + 8192 + ((lane >> 4) & 1) * 32 + (lane & 3) * 8 + (4 * hi + ((lane & 15) >> 2)) * 64;
    int i = 0, sw = (jw % NSLOT) * BUFB;
    for (;;) {
#pragma unroll
    for (int ph = 0; ph < 2; ++ph) {
        const int j = jw - i;
        { const int tl = jt - 5 - i;
          if (tl >= 0) { kreg[ph] = *(const GAS v4u*)(ksrc + (size_t)tl * 64 * HW); vreg[ph] = *(const GAS v4u*)(vsrc + (size_t)tl * 64 * HW);
              if (MODE && tid < 16) cfreg[ph] = *(const GAS f32x4*)(cfsrc + tl * 64); } }
        if (!wdone && j >= 0) {
            const LAS unsigned char* Kb = L + sw;
            f32x16 p0 = f32x16{}, p1 = f32x16{};
            if (MODE) {
                const LAS float* cfp = (const LAS float*)(Kb + 16384);
#pragma unroll
                for (int g = 0; g < 4; ++g) { const f32x4 c0 = *(const LAS f32x4*)(cfp + 8 * g + 4 * hi), c1 = *(const LAS f32x4*)(cfp + 32 + 8 * g + 4 * hi);
#pragma unroll
                    for (int e = 0; e < 4; ++e) { p0[4 * g + e] = c0[e]; p1[4 * g + e] = c1[e]; } }
            }
            { const LAS unsigned char* kb = Kb + hi * 1024 + r32 * 16;
#pragma unroll
              for (int d0 = 0; d0 < 4; ++d0) { const bf16x8 b0 = *(const LAS bf16x8*)(kb + d0 * 2048), b1 = *(const LAS bf16x8*)(kb + d0 * 2048 + 512);
                  p0 = __builtin_amdgcn_mfma_f32_32x32x16_bf16(b0, qr[d0], p0, 0, 0, 0); p1 = __builtin_amdgcn_mfma_f32_32x32x16_bf16(b1, qr[d0], p1, 0, 0, 0); } }
            const bool diag = (i == 0); const int qrel = 32 * (wid & 1) + r32;
            if (MODE == 0) {
                float Lg[32];
#pragma unroll
                for (int r = 0; r < 16; ++r) {
                    const float z0 = p0[r], z1 = p1[r];
                    Lg[r] = -(fmaxf(z0, 0.f) + __builtin_amdgcn_logf(1.f + __builtin_amdgcn_exp2f(-fabsf(z0))));
                    Lg[16 + r] = -(fmaxf(z1, 0.f) + __builtin_amdgcn_logf(1.f + __builtin_amdgcn_exp2f(-fabsf(z1))));
                }
                if (diag) {
                    asm volatile("" ::: "memory");
#pragma unroll
                    for (int r = 0; r < 16; ++r) { Lg[r] = (crow(r, hi) >= qrel) ? 0.f : Lg[r]; Lg[16 + r] = (crow(r, hi) + 32 >= qrel) ? 0.f : Lg[16 + r]; } }
                float Os[8], Ps[8];
#pragma unroll
                for (int i = 0; i < 8; ++i) { Os[i] = (Lg[4 * i] + Lg[4 * i + 1]) + (Lg[4 * i + 2] + Lg[4 * i + 3]); Ps[i] = __shfl_xor(Os[i], 32); }
                float T = 0.f;
#pragma unroll
                for (int i = 7; i >= 0; --i) {
                    float s = T + (hi ? 0.f : Ps[i]) + C2;
#pragma unroll
                    for (int e = 3; e >= 0; --e) { s += Lg[4 * i + e]; const int r = (4 * i + e) & 15; const float zz = (i < 4) ? p0[r] : p1[r];
                        const float w = __builtin_amdgcn_exp2f(zz + s);
                        if (i < 4) p0[r] = w; else p1[r] = w; }
                    T += Os[i] + Ps[i];
                }
                if (diag) {
                    asm volatile("" ::: "memory");
#pragma unroll
                    for (int r = 0; r < 16; ++r) { p0[r] = (crow(r, hi) >= qrel) ? 0.f : p0[r]; p1[r] = (crow(r, hi) + 32 >= qrel) ? 0.f : p1[r]; } }
                C2 += T;
                wdone = __all(C2 < STOP2);
            } else {
                const LAS float* cfp = (const LAS float*)(Kb + 16384);
                if (diag) {
                    asm volatile("" ::: "memory");
#pragma unroll
                    for (int r = 0; r < 16; ++r) { p0[r] = (crow(r, hi) > qrel) ? -INFINITY : p0[r]; p1[r] = (crow(r, hi) + 32 > qrel) ? -INFINITY : p1[r]; } }
#define ATT_MX3(a, b, c) __builtin_fmaxf(__builtin_fmaxf((a), (b)), (c))
                float ra = ATT_MX3(p0[0], p0[1], p1[0]), rb = ATT_MX3(p0[2], p0[3], p1[1]); ra = ATT_MX3(ra, p1[2], p1[3]);
#pragma unroll
                for (int r = 4; r < 16; r += 4) { ra = ATT_MX3(ra, p0[r], p0[r + 1]); rb = ATT_MX3(rb, p0[r + 2], p0[r + 3]); ra = ATT_MX3(ra, p1[r], p1[r + 1]); rb = ATT_MX3(rb, p1[r + 2], p1[r + 3]); }
#undef ATT_MX3
                float rm = fmaxf(ra, rb); rm = fmaxf(rm, __shfl_xor(rm, 32));
                const float mnew = fmaxf(mhat, rm);
                if (__any(mnew > mhat)) {
                    const float f = __builtin_amdgcn_exp2f(mhat - mnew); lsum *= f;
                    if (hi == 0) wsf[r32] = f;
                    asm volatile("s_waitcnt lgkmcnt(0)" ::: "memory");
#pragma unroll
                    for (int r = 0; r < 16; ++r) { const float fr = wsf[crow(r, hi)]; o[0][r] *= fr; o[1][r] *= fr; }
                    mhat = mnew;
                }
                typedef float f32x2 __attribute__((ext_vector_type(2)));
                const f32x2 nm2 = {-mhat, -mhat}; f32x2 sa = {0.f, 0.f}, sb = {0.f, 0.f};
#pragma unroll
                for (int r = 0; r < 16; r += 2) { f32x2 t0 = (f32x2){p0[r], p0[r + 1]} + nm2, t1 = (f32x2){p1[r], p1[r + 1]} + nm2;
                    t0.x = __builtin_amdgcn_exp2f(t0.x); t0.y = __builtin_amdgcn_exp2f(t0.y); t1.x = __builtin_amdgcn_exp2f(t1.x); t1.y = __builtin_amdgcn_exp2f(t1.y);
                    sa += t0; sb += t1; p0[r] = t0.x; p0[r + 1] = t0.y; p1[r] = t1.x; p1[r + 1] = t1.y; }
                sa += sb; lsum += sa.x + sa.y;
                const float n00 = cfp[0];
                wdone = __all(qnb + n00 - mhat < STOP2);
            }
            v4u pw0, pw1, pw2, pw3;
#pragma unroll
            for (int e = 0; e < 4; ++e) { pw0[e] = cvtpk(p0[2 * e], p0[2 * e + 1]); pw1[e] = cvtpk(p0[8 + 2 * e], p0[8 + 2 * e + 1]); pw2[e] = cvtpk(p1[2 * e], p1[2 * e + 1]); pw3[e] = cvtpk(p1[8 + 2 * e], p1[8 + 2 * e + 1]); }
            const LAS unsigned char* vb = vb0 + sw;
#pragma unroll
            for (int d0 = 0; d0 < 2; ++d0) { s16x4 lo[4], hh[4];
#pragma unroll
                for (int ks = 0; ks < 4; ++ks) {
                    lo[ks] = __builtin_bit_cast(s16x4, __builtin_amdgcn_ds_read_tr16_b64_v4i16((LAS v4i16_t*)(vb + d0 * 4096 + ks * 1024)));
                    hh[ks] = __builtin_bit_cast(s16x4, __builtin_amdgcn_ds_read_tr16_b64_v4i16((LAS v4i16_t*)(vb + d0 * 4096 + ks * 1024 + 512))); }
#define ATT_PK(k) (bf16x8){lo[k][0], lo[k][1], lo[k][2], lo[k][3], hh[k][0], hh[k][1], hh[k][2], hh[k][3]}
                o[d0] = __builtin_amdgcn_mfma_f32_32x32x16_bf16(__builtin_bit_cast(bf16x8, pw0), ATT_PK(0), o[d0], 0, 0, 0);
                o[d0] = __builtin_amdgcn_mfma_f32_32x32x16_bf16(__builtin_bit_cast(bf16x8, pw1), ATT_PK(1), o[d0], 0, 0, 0);
                o[d0] = __builtin_amdgcn_mfma_f32_32x32x16_bf16(__builtin_bit_cast(bf16x8, pw2), ATT_PK(2), o[d0], 0, 0, 0);
                o[d0] = __builtin_amdgcn_mfma_f32_32x32x16_bf16(__builtin_bit_cast(bf16x8, pw3), ATT_PK(3), o[d0], 0, 0, 0);
#undef ATT_PK
            }
        }
        { const int ts = jt - 4 - i;
          if (ts >= 0) { const int nb = (ts % NSLOT) * BUFB;
              if (MODE && tid < 16) { const float c = car[ts >> 4]; cfreg[ph ^ 1] = -(cfreg[ph ^ 1] + c); *(LAS f32x4*)(L + nb + 16384 + tid * 16) = cfreg[ph ^ 1]; }
              *(LAS v4u*)(L + nb + kdst) = kreg[ph ^ 1]; *(LAS v4u*)(L + nb + vdst) = vreg[ph ^ 1]; } }
        if (lane == 0) flg[ph * 8 + wid] = (wdone || j <= 0) ? 1u : 0u;
        __syncthreads();
        { unsigned alld = 1u;
#pragma unroll
          for (int w = 0; w < 8; ++w) alld &= flg[ph * 8 + w];
          if (alld) goto att_done; }
        ++i; sw = (sw == 0) ? (NSLOT - 1) * BUFB : sw - BUFB;
    }
    }
att_done:
    float rli[16];
    if (MODE) {
        lsum += __shfl_xor(lsum, 32);
        if (hi == 0) wsf[r32] = lsum;
        asm volatile("s_waitcnt lgkmcnt(0)" ::: "memory");
#pragma unroll
        for (int r = 0; r < 16; ++r) rli[r] = 1.f / wsf[crow(r, hi)];
    } else {
#pragma unroll
        for (int r = 0; r < 16; ++r) rli[r] = 1.f;
    }
    bf16* Ow = F.mixed + (rowbase + q0 + wid * 32) * D + (MODE ? HW : 0) + h * HD;
#pragma unroll
    for (int r = 0; r < 16; ++r) {
        bf16* rowp = Ow + (size_t)crow(r, hi) * D + r32;
        rowp[0] = (bf16)f2bf(o[0][r] * rli[r]); rowp[32] = (bf16)f2bf(o[1][r] * rli[r]);
    }
}
}

template <int MODE> __device__ __forceinline__ void p3_attn_fast(Frame& F) {
    for (int i = 3; i >= 0; --i) { const int id = (int)blockIdx.x + F.G * i; if (id < 1024) att::attn_unit<MODE>(F, id & 31, id >> 5); }
}

struct Args { const float* in[18]; float* out; unsigned char* ws; int ph_lo, ph_hi; };
__global__ void __launch_bounds__(NTHR, 2) mk_fwd(Args args) {
    extern __shared__ __attribute__((aligned(16))) unsigned char lds[];
    Frame F;
    F.lds = (LAS unsigned char*)lds; F.MISC = (volatile LAS unsigned*)(F.lds + MISC_OFF);
    F.tid = threadIdx.x; F.lane = F.tid & 63; F.wave = __builtin_amdgcn_readfirstlane(F.tid >> 6);
    F.G = gridDim.x; { const int bx = blockIdx.x; F.vcu = (F.G % 8 == 0) ? (bx % 8) * (F.G / 8) + bx / 8 : bx; }
    unsigned char* ws = args.ws;
    F.ctl = (gu32*)(ws + WS_CTL);
    F.x = args.in[0]; F.p = args.in[1]; F.w_in = args.in[2]; F.b_forget = args.in[3]; F.w_out = args.in[4]; F.ln1g = args.in[5]; F.ln1b = args.in[6]; F.w_group = args.in[7]; F.b_group = args.in[8];
    F.w_router = args.in[9]; F.b_router = args.in[10]; F.w_gate = args.in[11]; F.w_up = args.in[12]; F.w_down = args.in[13]; F.w_ple = args.in[14]; F.w_pg = args.in[15]; F.ln2g = args.in[16]; F.ln2b = args.in[17];
    F.out = args.out;
    F.Win_t = (bf16*)(ws + WS_WIN); F.Wout_t = (bf16*)(ws + WS_WOUT); F.Wple_t = (bf16*)(ws + WS_WPLE); F.Wpg_t = (bf16*)(ws + WS_WPG); F.Wgu_t = (bf16*)(ws + WS_WGU); F.Wd_t = (bf16*)(ws + WS_WD);
    F.pple = (bf16*)(ws + WS_PPLE); F.qkv = (bf16*)(ws + WS_R1); F.xs = (bf16*)(ws + WS_R1); F.y = (bf16*)(ws + WS_R1);
    F.xb = (bf16*)(ws + WS_R2); F.mixed = (bf16*)(ws + WS_R2); F.hb = (bf16*)(ws + WS_R2); F.pb = (bf16*)(ws + WS_R3); F.hdn = (bf16*)(ws + WS_R3); F.mixp = (bf16*)(ws + WS_R3);
    F.ls = (float*)(ws + WS_LS); F.cfl = (float*)(ws + WS_CFL); F.ctot = (float*)(ws + WS_CTOT); F.knt = (float*)(ws + WS_KNT); F.gatev = (float*)(ws + WS_GATE); F.gslot = (float*)(ws + WS_GSLOT);
    F.eid = (int*)(ws + WS_EID); F.rank = (int*)(ws + WS_RANK); F.slot = (int*)(ws + WS_SLOT);
    for (int u = F.tid; u < (LDS_BYTES - LDSCTL_OFF) / 4; u += NTHR) ((LAS unsigned*)(F.lds + LDSCTL_OFF))[u] = 0u;
    __syncthreads();
    XcdBarrier bar = xcd_barrier_post((unsigned*)(F.ctl + CW_BAR), F.MISC + 8);
    const int lo = args.ph_lo, hi = args.ph_hi;
#ifndef PH_MASK
#define PH_MASK 0x3ff
#endif
#define IN(k) (((PH_MASK >> (k)) & 1) && lo <= (k) && (k) < hi)
#ifndef PROBE_PH
#define PROBE_PH -1
#endif
    unsigned long long pt0_ = (PROBE_PH == 0) ? rt() : 0ull, pt1_ = 0ull;
#define SEAM(k) do { if (IN(k) && IN((k) + 1)) xcd_barrier(bar); if ((k) == PROBE_PH) pt1_ = rt(); if ((k) + 1 == PROBE_PH) pt0_ = rt(); } while (0)

#ifndef REPEAT_PH
#define REPEAT_PH -1
#endif
#define REP(k) _Pragma("unroll") for (int rep_ = 0; rep_ < ((k) == REPEAT_PH ? 2 : 1); ++rep_)
#define PSTAMP(id, body) do { if (PROBE_PH == (id)) { __syncthreads(); pt0_ = rt(); } body; if (PROBE_PH == (id)) { __syncthreads(); pt1_ = rt(); } } while (0)
    if (IN(0)) { PSTAMP(100, p0_prologue<0>(F)); PSTAMP(101, p0_prologue<1>(F)); PSTAMP(102, p0_prologue<2>(F)); }
    SEAM(0);

    if (IN(1)) {
        { pg8::Gemm g{F.xb, F.Win_t, M, NPROJ, D}; pg8::StaticOrder S; S.init(M, NPROJ, F.G, (int)blockIdx.x);
          pg8::EpiBf16<0> E{F.qkv, HW, nullptr, HW, (size_t)M * HW, 1.f};
          pg8::gemm_phase<pg8::EpiBf16<0>, pg8::StaticOrder, true, true>(F.lds + RING_OFF, g, S, E); }
        { pg8::Gemm g{F.pb, F.Wple_t, M, D, PLED}; pg8::StaticOrder S; S.init(M, D, F.G, (int)blockIdx.x);
          pg8::EpiBf16<0> E{F.pple, D, nullptr, 0, 0, 1.f};
          pg8::gemm_phase<pg8::EpiBf16<0>, pg8::StaticOrder, true, true>(F.lds + RING_OFF, g, S, E); }
    } SEAM(1);

    if (IN(2)) { p2_scan(F); } SEAM(2);

#if ATT_FAST
#ifndef ATT_ONLY
#define ATT_ONLY 3
#endif
    if (IN(3)) { if (ATT_ONLY & 1) PSTAMP(131, p3_attn_fast<1>(F)); if (ATT_ONLY & 2) PSTAMP(132, p3_attn_fast<0>(F)); }
    SEAM(3);
#else
    if (IN(3)) { p3_attn_simple(F); } SEAM(3);
#endif

    if (IN(4)) {
        pg8::Gemm g{F.mixed, F.Wout_t, M, D, D}; pg8::StaticOrder S; S.init(M, D, F.G, (int)blockIdx.x);
        pg8::EpiBf16<0> E{F.mixp, D, nullptr, 0, 0, 1.f};
        pg8::gemm_phase<pg8::EpiBf16<0>, pg8::StaticOrder, true, true>(F.lds + RING_OFF, g, S, E);
    } SEAM(4);

    if (IN(5)) { p5_ln_route(F); } SEAM(5);

    if (IN(6)) {
        build_pstart(F);
        { pg8::Gemm g{F.hb, F.Wpg_t, M, D, D}; pg8::StaticOrder S; S.init(M, D, F.G, (int)blockIdx.x);
          pg8::EpiPle E{F.pple, F.hb, F.xs, F.eid, F.rank, F.gatev, F.slot, F.gslot, (const LAS int*)(F.lds + PST_OFF)};
          pg8::gemm_phase<pg8::EpiPle, pg8::StaticOrder, true, true>(F.lds + RING_OFF, g, S, E); }
    } SEAM(6);

    if (IN(7)) {
        build_pstart(F);
        const LAS int* pst = (const LAS int*)(F.lds + PST_OFF);
        pg8::Gemm g{F.xs, F.Wgu_t, SPAD, NE * 1024, D}; MoeOrder S{pst, (pst[NE] >> 8) * 4, F.G, (int)blockIdx.x};
        pg8::EpiSwiglu E{F.hdn, F.gslot};
        pg8::gemm_phase<pg8::EpiSwiglu, MoeOrder, true, true>(F.lds + RING_OFF, g, S, E);
    } SEAM(7);

    if (IN(8)) {
        build_pstart(F);
        const LAS int* pst = (const LAS int*)(F.lds + PST_OFF);
        pg8::Gemm g{F.hdn, F.Wd_t, SPAD, NE * 1024, DF}; MoeOrder S{pst, (pst[NE] >> 8) * 4, F.G, (int)blockIdx.x};
        pg8::EpiBf16<0> E{F.y, D, nullptr, 1024, 0, 1.f};
        pg8::gemm_phase<pg8::EpiBf16<0>, MoeOrder, true, true>(F.lds + RING_OFF, g, S, E);
    } SEAM(8);

    if (IN(9)) {
        const bool poison = __hip_atomic_load((gu32*)((unsigned*)(F.ctl + CW_BAR) + XB_TMO), RLX_AGENT) != 0u || F.G != 256;
        p9_final(F, poison);
    }
    if (PROBE_PH >= 0 && blockIdx.x == 0) {
        const unsigned long long now = rt(); if (PROBE_PH == NPH - 1) pt1_ = now;
        const unsigned long long dur = pt1_ - pt0_;
        if (F.tid == 0) while (rt() - now < 4ull * dur) __builtin_amdgcn_s_sleep(8);
        __syncthreads();
    }
#undef IN
#undef SEAM
}

#ifndef MK_CUTS
#define MK_CUTS 0
#endif
extern "C" void kernel_launch(void* const* d_in, const int* in_sizes, int n_in, void* d_out, int out_size, void* d_ws, size_t ws_size, hipStream_t stream) {
    static int grid = 0;
    if (grid == 0) {
        if (n_in != 18 || in_sizes[0] != M * D || out_size != M * D || ws_size < WS_END) { fprintf(stderr, "kernel_launch: shape/workspace mismatch (n_in %d, in0 %d, out %d, ws %zu)\n", n_in, n_in > 0 ? in_sizes[0] : -1, out_size, ws_size); grid = -1; return; }
        int dev = 0, cus = 0, per_cu = 0;
        if (hipGetDevice(&dev) != hipSuccess || hipDeviceGetAttribute(&cus, hipDeviceAttributeMultiprocessorCount, dev) != hipSuccess) { grid = -1; return; }
        if (hipFuncSetAttribute((const void*)mk_fwd, hipFuncAttributeMaxDynamicSharedMemorySize, LDS_BYTES) != hipSuccess) { fprintf(stderr, "kernel_launch: hipFuncSetAttribute failed\n"); grid = -1; return; }
        if (hipOccupancyMaxActiveBlocksPerMultiprocessor(&per_cu, (const void*)mk_fwd, NTHR, LDS_BYTES) != hipSuccess || per_cu < 1) fprintf(stderr, "kernel_launch: occupancy query reports %d\n", per_cu);
        (void)hipGetLastError();
        grid = cus;
        if (grid != 256) fprintf(stderr, "kernel_launch: %d CUs; this kernel is built for 256\n", grid);
    }
    if (grid < 0) return;
    if (hipMemsetAsync((char*)d_ws + WS_CTL, 0, CTL_ZERO_BYTES, stream) != hipSuccess) return;
    Args a{};
    for (int i = 0; i < 18; ++i) a.in[i] = (const float*)d_in[i];
    a.out = (float*)d_out; a.ws = (unsigned char*)d_ws;
#if MK_CUTS
    for (int ph = 0; ph < NPH; ++ph) { a.ph_lo = ph; a.ph_hi = ph + 1; hipLaunchKernelGGL(mk_fwd, dim3(grid), dim3(NTHR), LDS_BYTES, stream, a); }
#else
    a.ph_lo = 0; a.ph_hi = NPH;
    hipLaunchKernelGGL(mk_fwd, dim3(grid), dim3(NTHR), LDS_BYTES, stream, a);
#endif
}
```

```cpp
#include <hip/hip_runtime.h>
#include <hip/hip_bf16.h>
#include <cstdio>
#include <cstdint>
#include <cmath>
namespace pg8 {
#define PG8_LAS __attribute__((address_space(3)))
typedef unsigned short bf16_t;
typedef short bf16x8 __attribute__((ext_vector_type(8)));
typedef float f32x4 __attribute__((ext_vector_type(4)));
typedef unsigned u32x4 __attribute__((ext_vector_type(4)));
constexpr int BM = 256, BK = 64, HALF = 128, HTB = HALF * BK * 2  , STAGE_BYTES = 8 * HTB, NXCD = 8, WGM = 8;

__host__ __device__ __forceinline__ int lds_byte(int r, int c) { const int st = (r >> 4) * 2 + (c >> 5), rr = r & 15, cc = c & 31, ob = rr * 64 + cc * 2; return st * 1024 + (ob ^ (((ob >> 9) & 1) << 5)); }
__host__ __device__ __forceinline__ void stage_rc(int b, int& R, int& C) { const int st = b / 1024, sb = b % 1024, swz = sb ^ (((sb >> 9) & 1) << 5); R = (st >> 1) * 16 + swz / 64; C = (st & 1) * 32 + (swz % 64) / 2; }
__host__ __device__ __forceinline__ int perm32(int rho) { const int n = rho >> 4, i = rho & 15; return 8 * (i >> 2) + 4 * n + (i & 3); }

struct Unit { int pm, pn; };
struct Gemm { const bf16_t* A; const bf16_t* Bt; int M, N, K; };

struct StaticOrder {
    int nM, nN, nwg, G, c;
    __host__ __device__ void init(int M, int N, int G_, int c_) { nM = M / BM; nN = N / BM; nwg = nM * nN; G = G_; c = c_; }
    __host__ __device__ bool next(int i, Unit& u) const {
        const long L = (long)i * G + c; if (L >= nwg) return false;
        int wgid = (int)L; { const int q = nwg / NXCD, r = nwg % NXCD, xcd = wgid % NXCD, off = wgid / NXCD; wgid = (xcd < r ? xcd * (q + 1) : r * (q + 1) + (xcd - r) * q) + off; }
        const int nig = WGM * nN, gid = wgid / nig, fm = gid * WGM, gsz = (nM - fm) < WGM ? (nM - fm) : WGM;
        u.pm = fm + ((wgid % nig) % gsz); u.pn = (wgid % nig) / gsz; return true;
    }
    __device__ __forceinline__ void a_ready(const Unit&) const {}
    __device__ __forceinline__ void done(const Unit&) const {}
};

__device__ __forceinline__ unsigned cvt_pk_bf16(float lo, float hi) { unsigned r; asm volatile("v_cvt_pk_bf16_f32 %0, %1, %2" : "=v"(r) : "v"(lo), "v"(hi)); return r; }
typedef float f32x2 __attribute__((ext_vector_type(2)));
__device__ __forceinline__ f32x2 gelu_pk(f32x2 v) {
    const f32x2 av = __builtin_elementwise_abs(v), d = av * 0.2316418882f + 1.0f;
    f32x2 t; t.x = __builtin_amdgcn_rcpf(d.x); t.y = __builtin_amdgcn_rcpf(d.y);
    f32x2 q = t * 0.5307027145f + (-0.7265760135f); q = q * t + 0.7107068705f; q = q * t + (-0.142248368f); q = q * t + 0.127414796f; q = q * t;
    const f32x2 s = (v * v) * (-0.72134752044f);
    f32x2 e; e.x = __builtin_amdgcn_exp2f(s.x); e.y = __builtin_amdgcn_exp2f(s.y);
    const f32x2 m = v * (q * e), r = v - m;
    f32x2 o; o.x = v.x < 0.f ? m.x : r.x; o.y = v.y < 0.f ? m.y : r.y; return o;
}

template <int ACT  > struct EpiBf16 {
    static constexpr bool PERM = true, AFTER_DRAIN = false; static_assert(ACT == 0 || ACT == 1, "EpiBf16: ACT is 0 (none) or 1 (gelu_pk)");
    bf16_t* O; int ldc; const float* bias; int split_cols; size_t split_stride; float scale0;
    __device__ __forceinline__ void operator()(const f32x4 (&acc)[2][2][4][2], const Unit& u, int wr, int wc, int fr, int fq) const {
        const int row0 = u.pm * BM + wr * 64 + fr; int colt = u.pn * BM; bf16_t* base = O;
        float sc = 1.f; if (split_cols) { const int t = colt / split_cols; base += (size_t)t * split_stride; colt -= t * split_cols; if (t == 0) sc = scale0; }
        const int col0 = colt + wc * 32 + 8 * fq, bcol0 = u.pn * BM + wc * 32 + 8 * fq;
        f32x4 bv[2][2];
#pragma unroll
        for (int bj = 0; bj < 2; ++bj)
#pragma unroll
            for (int n = 0; n < 2; ++n) bv[bj][n] = bias ? *(const f32x4*)(bias + bcol0 + bj * HALF + 4 * n) : (f32x4){0.f, 0.f, 0.f, 0.f};
#pragma unroll
        for (int ai = 0; ai < 2; ++ai)
#pragma unroll
            for (int m = 0; m < 4; ++m) { bf16_t* rowp = base + (size_t)(row0 + ai * HALF + m * 16) * ldc + col0;
#pragma unroll
                for (int bj = 0; bj < 2; ++bj) { f32x4 v0 = acc[ai][bj][m][0] + bv[bj][0], v1 = acc[ai][bj][m][1] + bv[bj][1];
                    if (ACT == 1) { f32x2 a = gelu_pk((f32x2){v0[0], v0[1]}), b = gelu_pk((f32x2){v0[2], v0[3]}), c = gelu_pk((f32x2){v1[0], v1[1]}), d = gelu_pk((f32x2){v1[2], v1[3]});
                        v0 = (f32x4){a.x, a.y, b.x, b.y}; v1 = (f32x4){c.x, c.y, d.x, d.y}; }
                    v0 = v0 * sc; v1 = v1 * sc; u32x4 w; w.x = cvt_pk_bf16(v0[0], v0[1]); w.y = cvt_pk_bf16(v0[2], v0[3]); w.z = cvt_pk_bf16(v1[0], v1[1]); w.w = cvt_pk_bf16(v1[2], v1[3]);
                    *(u32x4*)(rowp + bj * HALF) = w; } }
    }
};

struct PanelStats {
    unsigned* xbuf;
    unsigned* cnt;
    unsigned* tmo;
    int ntn; float eps;
    unsigned code;
    __device__ __forceinline__ bool run(const f32x4 (&v)[2][2][4][2], const Unit& u, int wr, int wc, int fr, int fq, PG8_LAS unsigned char* lds, int wid, int lane) const {
        typedef float f32x2v __attribute__((ext_vector_type(2)));
        PG8_LAS f32x2v* P = (PG8_LAS f32x2v*)lds;
        PG8_LAS f32x2v* S = (PG8_LAS f32x2v*)(lds + 8192);
        PG8_LAS unsigned* flag = (PG8_LAS unsigned*)(lds + 8192 + 2048);
#pragma unroll
        for (int ai = 0; ai < 2; ++ai)
#pragma unroll
            for (int m = 0; m < 4; ++m) {
                float s = 0.f;
#pragma unroll
                for (int bj = 0; bj < 2; ++bj)
#pragma unroll
                    for (int n = 0; n < 2; ++n) { const f32x4 x = v[ai][bj][m][n]; s += (x[0] + x[1]) + (x[2] + x[3]); }
                s += __shfl_xor(s, 16); s += __shfl_xor(s, 32);
                const float mw = s * (1.0f / 64.0f); float q = 0.f;
#pragma unroll
                for (int bj = 0; bj < 2; ++bj)
#pragma unroll
                    for (int n = 0; n < 2; ++n) { const f32x4 d = v[ai][bj][m][n] - mw; q += (d[0] * d[0] + d[1] * d[1]) + (d[2] * d[2] + d[3] * d[3]); }
                q += __shfl_xor(q, 16); q += __shfl_xor(q, 32);
                if (fq == 0) P[(ai * HALF + wr * 64 + m * 16 + fr) * 4 + wc] = (f32x2v){mw, q};
            }
        asm volatile("s_waitcnt lgkmcnt(0)" ::: "memory"); __builtin_amdgcn_s_barrier(); asm volatile("" ::: "memory");
#if defined(BROKEN_EXCHANGE_NO_WAIT)
#warning BROKEN CONTROL BUILD: the row-statistics exchange does not wait; results are wrong by design
        if (blockIdx.x >= 64) { const long long t0_ = clock64(); while (clock64() - t0_ < 60000) __builtin_amdgcn_s_sleep(8); }
#endif
        const int row = wid * 32 + (lane & 31);
        if (lane < 32) {
            const f32x2v a = P[row * 4 + 0], b = P[row * 4 + 1], c = P[row * 4 + 2], d = P[row * 4 + 3];
            const float mt = (a.x + b.x + c.x + d.x) * 0.25f;
            const float da = a.x - mt, db = b.x - mt, dc = c.x - mt, dd = d.x - mt;
            const float m2 = (a.y + b.y) + (c.y + d.y) + 64.0f * ((da * da + db * db) + (dc * dc + dd * dd));
            unsigned long long* slot = (unsigned long long*)xbuf + ((size_t)(u.pm * BM + row) * 4 + u.pn);
            __hip_atomic_store(slot, ((unsigned long long)__float_as_uint(m2) << 32) | __float_as_uint(mt), __ATOMIC_RELAXED, __HIP_MEMORY_SCOPE_AGENT);
        }
        asm volatile("s_waitcnt vmcnt(0)" ::: "memory");
        if (lane == 0) __hip_atomic_fetch_add(cnt + 64 * u.pm, 1u, __ATOMIC_RELAXED, __HIP_MEMORY_SCOPE_AGENT);
        if (wid == 0) {
            bool dead = false; const unsigned long long t0 = __builtin_amdgcn_s_memrealtime(); const unsigned want = 8u * (unsigned)ntn;
            for (;;) {
#if defined(BROKEN_EXCHANGE_NO_WAIT)
                break;
#endif
                if ((unsigned)__builtin_amdgcn_readfirstlane(__hip_atomic_load(cnt + 64 * u.pm, __ATOMIC_RELAXED, __HIP_MEMORY_SCOPE_AGENT)) >= want) break;
                if (__builtin_amdgcn_s_memrealtime() - t0 > 2000000ull) {
                    if (lane == 0) { unsigned expect = 0u; __hip_atomic_compare_exchange_strong(tmo + 1, &expect, code | (unsigned)(u.pm & 0xff), __ATOMIC_RELAXED, __ATOMIC_RELAXED, __HIP_MEMORY_SCOPE_AGENT);
                                     __hip_atomic_store(tmo, 1u, __ATOMIC_RELAXED, __HIP_MEMORY_SCOPE_AGENT); }
                    dead = true; break; }
                __builtin_amdgcn_s_sleep(2);
            }
            __builtin_amdgcn_fence(__ATOMIC_ACQUIRE, "agent");
            if (lane == 0) flag[0] = dead ? 1u : 0u;
        }
        asm volatile("s_waitcnt vmcnt(0) lgkmcnt(0)" ::: "memory"); __builtin_amdgcn_s_barrier(); asm volatile("" ::: "memory");
        const bool bad = flag[0] != 0u;
        if (lane < 32) {
            const unsigned long long* slot = (const unsigned long long*)xbuf + (size_t)(u.pm * BM + row) * 4; float mt[4], m2[4]; float ms = 0.f;
#pragma unroll
            for (int t = 0; t < 4; ++t) { if (t < ntn) { const unsigned long long w = __hip_atomic_load(slot + t, __ATOMIC_RELAXED, __HIP_MEMORY_SCOPE_AGENT); mt[t] = __uint_as_float((unsigned)w); m2[t] = __uint_as_float((unsigned)(w >> 32)); } else { mt[t] = 0.f; m2[t] = 0.f; } ms += mt[t]; }
            const float mean = ms / (float)ntn; float q = 0.f;
#pragma unroll
            for (int t = 0; t < 4; ++t) if (t < ntn) { const float dm = mt[t] - mean; q += m2[t] + 256.0f * dm * dm; }
            S[row] = (f32x2v){mean, 1.0f / sqrtf(q / (256.0f * (float)ntn) + eps)};
        }
        asm volatile("s_waitcnt lgkmcnt(0)" ::: "memory"); __builtin_amdgcn_s_barrier(); asm volatile("" ::: "memory");
        return bad;
    }
};
struct EpiLnRes {
    static constexpr bool PERM = false, AFTER_DRAIN = true;
    const float* base; float* out; int ldc; const float* bias; PanelStats st; unsigned poison;
    __device__ __forceinline__ void fused(f32x4 (&acc)[2][2][4][2], const Unit& u, int wr, int wc, int fr, int fq, PG8_LAS unsigned char* lds, int wid, int lane) const {
        typedef float f32x2v __attribute__((ext_vector_type(2)));
        const PG8_LAS f32x2v* S = (const PG8_LAS f32x2v*)(lds + 8192);
        const int col0 = u.pn * BM + wc * 32 + 4 * fq;
#pragma unroll
        for (int bj = 0; bj < 2; ++bj)
#pragma unroll
            for (int n = 0; n < 2; ++n) { const f32x4 bv = bias ? *(const f32x4*)(bias + col0 + bj * HALF + n * 16) : (f32x4){0.f, 0.f, 0.f, 0.f};
#pragma unroll
                for (int ai = 0; ai < 2; ++ai)
#pragma unroll
                    for (int m = 0; m < 4; ++m) acc[ai][bj][m][n] += bv; }
        f32x4 pre[4][2][2];
#pragma unroll
        for (int m = 0; m < 4; ++m) { const size_t off = (size_t)(u.pm * BM + wr * 64 + m * 16 + fr) * ldc + col0;
#pragma unroll
            for (int bj = 0; bj < 2; ++bj)
#pragma unroll
                for (int n = 0; n < 2; ++n) pre[m][bj][n] = *(const f32x4*)(base + off + bj * HALF + n * 16); }
        const bool bad = st.run(acc, u, wr, wc, fr, fq, lds, wid, lane) || poison != 0u;
        const float qnan = __builtin_nanf("");
#pragma unroll
        for (int ai = 0; ai < 2; ++ai)
#pragma unroll
            for (int m = 0; m < 4; ++m) { const int r = ai * HALF + wr * 64 + m * 16 + fr; const f32x2v sr = S[r]; const size_t off = (size_t)(u.pm * BM + r) * ldc + col0;
#pragma unroll
                for (int bj = 0; bj < 2; ++bj)
#pragma unroll
                    for (int n = 0; n < 2; ++n) { const f32x4 bs = ai == 0 ? pre[m][bj][n] : *(const f32x4*)(base + off + bj * HALF + n * 16); f32x4 o = bs + (acc[ai][bj][m][n] - sr.x) * sr.y;
                        if (bad) o = (f32x4){qnan, qnan, qnan, qnan}; *(f32x4*)(out + off + bj * HALF + n * 16) = o; }
                if (m & 1) asm volatile("" ::: "memory"); }
    }
};
struct EpiLnResLn {
    static constexpr bool PERM = false, AFTER_DRAIN = true;
    const float* base; float* out; bf16_t* xn; int ldc; const float* bias; PanelStats st1, st2; unsigned poison;
    __device__ __forceinline__ void fused(f32x4 (&acc)[2][2][4][2], const Unit& u, int wr, int wc, int fr, int fq, PG8_LAS unsigned char* lds, int wid, int lane) const {
        typedef float f32x2v __attribute__((ext_vector_type(2))); typedef unsigned u32x2v __attribute__((ext_vector_type(2)));
        const PG8_LAS f32x2v* S = (const PG8_LAS f32x2v*)(lds + 8192);
        const int col0 = u.pn * BM + wc * 32 + 4 * fq;
#pragma unroll
        for (int bj = 0; bj < 2; ++bj)
#pragma unroll
            for (int n = 0; n < 2; ++n) { const f32x4 bv = bias ? *(const f32x4*)(bias + col0 + bj * HALF + n * 16) : (f32x4){0.f, 0.f, 0.f, 0.f};
#pragma unroll
                for (int ai = 0; ai < 2; ++ai)
#pragma unroll
                    for (int m = 0; m < 4; ++m) acc[ai][bj][m][n] += bv; }
        bool bad = st1.run(acc, u, wr, wc, fr, fq, lds, wid, lane) || poison != 0u;
        const float qnan = __builtin_nanf("");
#pragma unroll
        for (int ai = 0; ai < 2; ++ai)
#pragma unroll
            for (int m = 0; m < 4; ++m) { const int r = ai * HALF + wr * 64 + m * 16 + fr; const f32x2v sr = S[r]; const size_t off = (size_t)(u.pm * BM + r) * ldc + col0;
#pragma unroll
                for (int bj = 0; bj < 2; ++bj)
#pragma unroll
                    for (int n = 0; n < 2; ++n) { const f32x4 bs = *(const f32x4*)(base + off + bj * HALF + n * 16); acc[ai][bj][m][n] = bs + (acc[ai][bj][m][n] - sr.x) * sr.y; }
                asm volatile("" : "+v"(acc[ai][0][m][0]), "+v"(acc[ai][0][m][1]), "+v"(acc[ai][1][m][0]), "+v"(acc[ai][1][m][1]));
                if (m & 1) asm volatile("" ::: "memory"); }
        const bool bad1 = bad;
        bad = st2.run(acc, u, wr, wc, fr, fq, lds, wid, lane) || bad;
#pragma unroll
        for (int ai = 0; ai < 2; ++ai)
#pragma unroll
            for (int m = 0; m < 4; ++m) { const int r = ai * HALF + wr * 64 + m * 16 + fr; const f32x2v sr = S[r]; const size_t off = (size_t)(u.pm * BM + r) * ldc + col0;
#pragma unroll
                for (int bj = 0; bj < 2; ++bj)
#pragma unroll
                    for (int n = 0; n < 2; ++n) { const f32x4 x1 = acc[ai][bj][m][n]; *(f32x4*)(out + off + bj * HALF + n * 16) = bad1 ? (f32x4){qnan, qnan, qnan, qnan} : x1;
                        const f32x4 o = (x1 - sr.x) * sr.y; u32x2v w; w.x = cvt_pk_bf16(o[0], o[1]); w.y = cvt_pk_bf16(o[2], o[3]);
                        if (bad) { w.x = 0x7fc07fc0u; w.y = 0x7fc07fc0u; } *(u32x2v*)(xn + off + bj * HALF + n * 16) = w; }
                asm volatile("" ::: "memory"); }
    }
};

template <class Epi, class Sched, bool ALIGN_EPI = false, bool SP2 = false>
__device__ __forceinline__ void gemm_phase(PG8_LAS unsigned char* lds, const Gemm g, const Sched& S, const Epi& E) {
    const int tid = threadIdx.x, wid = __builtin_amdgcn_readfirstlane(tid >> 6), lane = tid & 63, wr = wid >> 2, wc = wid & 3, fr = lane & 15, fq = lane >> 4;
    const int K = g.K, nt = K / BK;
    unsigned voffA[2], voffB[2];
#pragma unroll
    for (int i = 0; i < 2; ++i) { int R, C; stage_rc(tid * 16 + i * 8192, R, C); const int Rb = Epi::PERM ? ((R & ~31) + perm32(R & 31)) : R;
        voffA[i] = (unsigned)(R * K + C) * 2u; voffB[i] = (unsigned)(Rb * K + C) * 2u; }
    const size_t kstep = (size_t)(BK * 2);
    const size_t hstep = (size_t)HALF * K * 2;
    const size_t tstep = 2 * hstep;
    const unsigned ldsw = (unsigned)wid * 1024u;
    const int aoff = lds_byte(wr * 64 + fr, fq * 8), boff = lds_byte(wc * 32 + fr, fq * 8);
#define PG8_SA(b, h) (((b) * 2 + (h)) * HTB)
#define PG8_SB(b, h) ((4 + (b) * 2 + (h)) * HTB)
#define PG8_STAGE(bufoff, gbase, voff) do { _Pragma("unroll") for (int _i = 0; _i < 2; ++_i) \
        __builtin_amdgcn_global_load_lds((const unsigned*)((const char*)(gbase) + (voff)[_i]), (PG8_LAS unsigned*)(lds + (bufoff) + ldsw + _i * 8192), 16, 0, 0); } while (0)
#define PG8_LDA(dst, b, h) do { _Pragma("unroll") for (int m = 0; m < 4; ++m) _Pragma("unroll") for (int k = 0; k < 2; ++k) dst[m][k] = *(const PG8_LAS bf16x8*)(lds + PG8_SA(b, h) + aoff + m * 2048 + k * 1024); } while (0)
#define PG8_LDB(dst, b, h) do { _Pragma("unroll") for (int n = 0; n < 2; ++n) _Pragma("unroll") for (int k = 0; k < 2; ++k) dst[n][k] = *(const PG8_LAS bf16x8*)(lds + PG8_SB(b, h) + boff + n * 2048 + k * 1024); } while (0)
#define PG8_MMA(ai, bj, At, Bt) do { __builtin_amdgcn_s_setprio(1); _Pragma("unroll") for (int m = 0; m < 4; ++m) _Pragma("unroll") for (int n = 0; n < 2; ++n) _Pragma("unroll") for (int k = 0; k < 2; ++k) \
        acc[ai][bj][m][n] = __builtin_amdgcn_mfma_f32_16x16x32_bf16(Bt[n][k], At[m][k], acc[ai][bj][m][n], 0, 0, 0); __builtin_amdgcn_s_setprio(0); } while (0)
#define PG8_WAIT_V(n) asm volatile("s_waitcnt vmcnt(" #n ")" ::: "memory")
#define PG8_WAIT_L(n) asm volatile("s_waitcnt lgkmcnt(" #n ")" ::: "memory")
#define PG8_BAR __builtin_amdgcn_s_barrier()
#define PG8_SCHED __builtin_amdgcn_sched_barrier(0)
    Unit cur, nxt; int ui = 0;
    if (!S.next(0, cur)) return;
    f32x4 acc[2][2][4][2];
#pragma unroll
    for (int a = 0; a < 2; ++a)
#pragma unroll
        for (int b = 0; b < 2; ++b)
#pragma unroll
            for (int m = 0; m < 4; ++m)
#pragma unroll
                for (int n = 0; n < 2; ++n) acc[a][b][m][n] = (f32x4){0.f, 0.f, 0.f, 0.f};
    bf16x8 At[4][2], B0[2][2], B1[2][2];
    const char* cA = (const char*)g.A + (size_t)cur.pm * tstep; const char* cB = (const char*)g.Bt + (size_t)cur.pn * tstep;
    S.a_ready(cur);
    if constexpr (SP2) {
        PG8_STAGE(PG8_SB(0, 0), cB, voffB); PG8_STAGE(PG8_SB(0, 1), cB + hstep, voffB); PG8_STAGE(PG8_SA(0, 0), cA, voffA); PG8_STAGE(PG8_SA(0, 1), cA + hstep, voffA);
        if (wr == 1) PG8_BAR;
        PG8_WAIT_V(2); PG8_BAR;
        PG8_STAGE(PG8_SB(1, 0), cB + kstep, voffB); PG8_STAGE(PG8_SA(1, 0), cA + kstep, voffA); PG8_STAGE(PG8_SB(1, 1), cB + hstep + kstep, voffB);
        PG8_WAIT_V(6); PG8_BAR;
    } else {
        PG8_STAGE(PG8_SB(0, 0), cB, voffB); PG8_STAGE(PG8_SA(0, 0), cA, voffA); PG8_STAGE(PG8_SB(0, 1), cB + hstep, voffB); PG8_STAGE(PG8_SA(0, 1), cA + hstep, voffA);
        if (wr == 1) PG8_BAR;
        PG8_WAIT_V(4); PG8_BAR;
        PG8_STAGE(PG8_SB(1, 0), cB + kstep, voffB); PG8_STAGE(PG8_SA(1, 0), cA + kstep, voffA); PG8_STAGE(PG8_SB(1, 1), cB + hstep + kstep, voffB);
        PG8_WAIT_V(6); PG8_BAR;
    }
    for (;;) {
        const bool has_next = S.next(ui + 1, nxt);
        const char* nA = has_next ? (const char*)g.A + (size_t)nxt.pm * tstep : cA; const char* nB = has_next ? (const char*)g.Bt + (size_t)nxt.pn * tstep : cB;
        for (int t = 0; t < nt; t += 2) {
            const bool last = (t == nt - 2);
            const char* a1 = cA + (size_t)(t + 1) * kstep;
            const char* a2 = last ? nA : cA + (size_t)(t + 2) * kstep; const char* b2 = last ? nB : cB + (size_t)(t + 2) * kstep;
            const char* a3 = a2 + kstep; const char* b3 = b2 + kstep;
            if (last && has_next) S.a_ready(nxt);
            if constexpr (SP2) {
            PG8_LDB(B0, 0, 0); PG8_LDB(B1, 0, 1); PG8_SCHED; PG8_LDA(At, 0, 0); PG8_STAGE(PG8_SA(1, 1), a1 + hstep, voffA);
            PG8_WAIT_V(8); PG8_WAIT_L(0); PG8_BAR; PG8_MMA(0, 0, At, B0); PG8_MMA(0, 1, At, B1); PG8_BAR; PG8_SCHED;
            PG8_LDA(At, 0, 1); PG8_STAGE(PG8_SB(0, 0), b2, voffB); PG8_STAGE(PG8_SB(0, 1), b2 + hstep, voffB); PG8_STAGE(PG8_SA(0, 0), a2, voffA);
            PG8_WAIT_V(8); PG8_WAIT_L(0); PG8_BAR; PG8_MMA(1, 0, At, B0); PG8_MMA(1, 1, At, B1); PG8_BAR; PG8_SCHED;
            PG8_LDB(B0, 1, 0); PG8_LDB(B1, 1, 1); PG8_SCHED; PG8_LDA(At, 1, 0); PG8_STAGE(PG8_SA(0, 1), a2 + hstep, voffA);
            PG8_WAIT_V(8); PG8_WAIT_L(0); PG8_BAR; PG8_MMA(0, 0, At, B0); PG8_MMA(0, 1, At, B1); PG8_BAR; PG8_SCHED;
            PG8_LDA(At, 1, 1); PG8_STAGE(PG8_SB(1, 0), b3, voffB); PG8_STAGE(PG8_SB(1, 1), b3 + hstep, voffB); PG8_STAGE(PG8_SA(1, 0), a3, voffA);
            PG8_WAIT_V(8); PG8_WAIT_L(0); PG8_BAR; PG8_MMA(1, 0, At, B0); PG8_MMA(1, 1, At, B1); PG8_BAR; PG8_SCHED;
            } else {
            PG8_LDB(B0, 0, 0); PG8_SCHED; PG8_LDA(At, 0, 0); PG8_STAGE(PG8_SA(1, 1), a1 + hstep, voffA);
            PG8_WAIT_L(8); PG8_BAR; PG8_WAIT_L(0); PG8_MMA(0, 0, At, B0); PG8_BAR; PG8_SCHED;
            PG8_LDB(B1, 0, 1); PG8_STAGE(PG8_SB(0, 0), b2, voffB);
            PG8_BAR; PG8_WAIT_L(0); PG8_MMA(0, 1, At, B1); PG8_BAR;
            PG8_LDA(At, 0, 1); PG8_STAGE(PG8_SA(0, 0), a2, voffA);
            PG8_BAR; PG8_WAIT_L(0); PG8_MMA(1, 0, At, B0); PG8_BAR; PG8_SCHED;
            PG8_STAGE(PG8_SB(0, 1), b2 + hstep, voffB);
            PG8_WAIT_V(6); PG8_BAR; PG8_MMA(1, 1, At, B1); PG8_BAR;
            PG8_LDB(B0, 1, 0); PG8_SCHED; PG8_LDA(At, 1, 0); PG8_STAGE(PG8_SA(0, 1), a2 + hstep, voffA);
            PG8_WAIT_L(8); PG8_BAR; PG8_WAIT_L(0); PG8_MMA(0, 0, At, B0); PG8_BAR; PG8_SCHED;
            PG8_LDB(B1, 1, 1); PG8_STAGE(PG8_SB(1, 0), b3, voffB);
            PG8_BAR; PG8_WAIT_L(0); PG8_MMA(0, 1, At, B1); PG8_BAR;
            PG8_LDA(At, 1, 1); PG8_STAGE(PG8_SA(1, 0), a3, voffA);
            PG8_BAR; PG8_WAIT_L(0); PG8_MMA(1, 0, At, B0); PG8_BAR; PG8_SCHED;
            PG8_STAGE(PG8_SB(1, 1), b3 + hstep, voffB);
            PG8_WAIT_V(6); PG8_BAR; PG8_MMA(1, 1, At, B1); PG8_BAR;
            }
        }
        if constexpr (ALIGN_EPI) { if (wr == 0) PG8_BAR; }
        if constexpr (!Epi::AFTER_DRAIN) { E(acc, cur, wr, wc, fr, fq); S.done(cur); }
        if (!has_next) break;
#pragma unroll
        for (int a = 0; a < 2; ++a)
#pragma unroll
            for (int b = 0; b < 2; ++b)
#pragma unroll
                for (int m = 0; m < 4; ++m)
#pragma unroll
                    for (int n = 0; n < 2; ++n) acc[a][b][m][n] = (f32x4){0.f, 0.f, 0.f, 0.f};
        cur = nxt; cA = nA; cB = nB; ++ui;
        if constexpr (ALIGN_EPI) { if (wr == 1) PG8_BAR; }
    }
    PG8_WAIT_V(0);
    if constexpr (!ALIGN_EPI) { if (wr == 0) PG8_BAR; }
    PG8_BAR;
    if constexpr (Epi::AFTER_DRAIN) { E.fused(acc, cur, wr, wc, fr, fq, lds, wid, lane); S.done(cur); }
#undef PG8_SA
#undef PG8_SB
#undef PG8_STAGE
#undef PG8_LDA
#undef PG8_LDB
#undef PG8_MMA
#undef PG8_WAIT_V
#undef PG8_WAIT_L
#undef PG8_BAR
#undef PG8_SCHED
}
}
namespace pg8 {
template <class Epi, class Sched, bool ALIGN_EPI = false, bool SP2 = false>
__device__ __forceinline__ void gemm_phase_g(PG8_LAS unsigned char* lds, const Gemm g, const Sched& S, const Epi& E, const PG8_LAS int* rowmap) {
    static_assert(SP2, "gather variant: SP2 loop only");
    const int tid = threadIdx.x, wid = __builtin_amdgcn_readfirstlane(tid >> 6), lane = tid & 63, wr = wid >> 2, wc = wid & 3, fr = lane & 15, fq = lane >> 4;
    const int K = g.K, nt = K / BK;
    unsigned voffA[2] = {0u, 0u}, voffB[2]; unsigned goff0[2], goff1[2];
#pragma unroll
    for (int i = 0; i < 2; ++i) { int R, C; stage_rc(tid * 16 + i * 8192, R, C); const int Rb = Epi::PERM ? ((R & ~31) + perm32(R & 31)) : R;
        voffB[i] = (unsigned)(Rb * K + C) * 2u; }
    const size_t kstep = (size_t)(BK * 2);
    const size_t hstep = (size_t)HALF * K * 2;
    const size_t tstep = 2 * hstep;
    const unsigned ldsw = (unsigned)wid * 1024u;
    const int aoff = lds_byte(wr * 64 + fr, fq * 8), boff = lds_byte(wc * 32 + fr, fq * 8);
#define PG8_SA(b, h) (((b) * 2 + (h)) * HTB)
#define PG8_SB(b, h) ((4 + (b) * 2 + (h)) * HTB)
#define PG8_STAGE(bufoff, gbase, voff) do { _Pragma("unroll") for (int _i = 0; _i < 2; ++_i) \
        __builtin_amdgcn_global_load_lds((const unsigned*)((const char*)(gbase) + (voff)[_i]), (PG8_LAS unsigned*)(lds + (bufoff) + ldsw + _i * 8192), 16, 0, 0); } while (0)
#define PG8_LDA(dst, b, h) do { _Pragma("unroll") for (int m = 0; m < 4; ++m) _Pragma("unroll") for (int k = 0; k < 2; ++k) dst[m][k] = *(const PG8_LAS bf16x8*)(lds + PG8_SA(b, h) + aoff + m * 2048 + k * 1024); } while (0)
#define PG8_LDB(dst, b, h) do { _Pragma("unroll") for (int n = 0; n < 2; ++n) _Pragma("unroll") for (int k = 0; k < 2; ++k) dst[n][k] = *(const PG8_LAS bf16x8*)(lds + PG8_SB(b, h) + boff + n * 2048 + k * 1024); } while (0)
#define PG8_MMA(ai, bj, At, Bt) do { __builtin_amdgcn_s_setprio(1); _Pragma("unroll") for (int m = 0; m < 4; ++m) _Pragma("unroll") for (int n = 0; n < 2; ++n) _Pragma("unroll") for (int k = 0; k < 2; ++k) \
        acc[ai][bj][m][n] = __builtin_amdgcn_mfma_f32_16x16x32_bf16(Bt[n][k], At[m][k], acc[ai][bj][m][n], 0, 0, 0); __builtin_amdgcn_s_setprio(0); } while (0)
#define PG8_WAIT_V(n) asm volatile("s_waitcnt vmcnt(" #n ")" ::: "memory")
#define PG8_WAIT_L(n) asm volatile("s_waitcnt lgkmcnt(" #n ")" ::: "memory")
#define PG8_BAR __builtin_amdgcn_s_barrier()
#define PG8_SCHED __builtin_amdgcn_sched_barrier(0)
    Unit cur, nxt; int ui = 0;
    if (!S.next(0, cur)) return;
    f32x4 acc[2][2][4][2];
#pragma unroll
    for (int a = 0; a < 2; ++a)
#pragma unroll
        for (int b = 0; b < 2; ++b)
#pragma unroll
            for (int m = 0; m < 4; ++m)
#pragma unroll
                for (int n = 0; n < 2; ++n) acc[a][b][m][n] = (f32x4){0.f, 0.f, 0.f, 0.f};
    bf16x8 At[4][2], B0[2][2], B1[2][2];
#define PG8_GOFF(D0, D1, PM) do { _Pragma("unroll") for (int _i = 0; _i < 2; ++_i) { int R_, C_; stage_rc(tid * 16 + _i * 8192, R_, C_); D0[_i] = (unsigned)rowmap[(PM) * BM + R_] * (unsigned)(K * 2) + (unsigned)C_ * 2u; D1[_i] = (unsigned)rowmap[(PM) * BM + HALF + R_] * (unsigned)(K * 2) + (unsigned)C_ * 2u; } } while (0)
    PG8_GOFF(goff0, goff1, 0);
    const char* cA = (const char*)g.A; const char* cB = (const char*)g.Bt + (size_t)cur.pn * tstep;
    S.a_ready(cur);
    if constexpr (SP2) {
        PG8_STAGE(PG8_SB(0, 0), cB, voffB); PG8_STAGE(PG8_SB(0, 1), cB + hstep, voffB); PG8_STAGE(PG8_SA(0, 0), cA, goff0); PG8_STAGE(PG8_SA(0, 1), cA, goff1);
        if (wr == 1) PG8_BAR;
        PG8_WAIT_V(2); PG8_BAR;
        PG8_STAGE(PG8_SB(1, 0), cB + kstep, voffB); PG8_STAGE(PG8_SA(1, 0), cA + kstep, goff0); PG8_STAGE(PG8_SB(1, 1), cB + hstep + kstep, voffB);
        PG8_WAIT_V(6); PG8_BAR;
    } else {
        PG8_STAGE(PG8_SB(0, 0), cB, voffB); PG8_STAGE(PG8_SA(0, 0), cA, voffA); PG8_STAGE(PG8_SB(0, 1), cB + hstep, voffB); PG8_STAGE(PG8_SA(0, 1), cA + hstep, voffA);
        if (wr == 1) PG8_BAR;
        PG8_WAIT_V(4); PG8_BAR;
        PG8_STAGE(PG8_SB(1, 0), cB + kstep, voffB); PG8_STAGE(PG8_SA(1, 0), cA + kstep, goff0); PG8_STAGE(PG8_SB(1, 1), cB + hstep + kstep, voffB);
        PG8_WAIT_V(6); PG8_BAR;
    }
    for (;;) {
        const bool has_next = S.next(ui + 1, nxt);
        const char* nA = cA; const char* nB = has_next ? (const char*)g.Bt + (size_t)nxt.pn * tstep : cB;
        for (int t = 0; t < nt; t += 2) {
            const bool last = (t == nt - 2);
            const char* a1 = cA + (size_t)(t + 1) * kstep;
            const char* a2 = last ? nA : cA + (size_t)(t + 2) * kstep; const char* b2 = last ? nB : cB + (size_t)(t + 2) * kstep;
            const char* a3 = a2 + kstep; const char* b3 = b2 + kstep;
            unsigned* const s0 = goff0; unsigned* const s1 = goff1;
            if (last && has_next) S.a_ready(nxt);
            if constexpr (SP2) {
            PG8_LDB(B0, 0, 0); PG8_LDB(B1, 0, 1); PG8_SCHED; PG8_LDA(At, 0, 0); PG8_STAGE(PG8_SA(1, 1), a1, goff1);
            if (last && has_next) PG8_GOFF(goff0, goff1, ui + 1);
            PG8_WAIT_V(8); PG8_WAIT_L(0); PG8_BAR; PG8_MMA(0, 0, At, B0); PG8_MMA(0, 1, At, B1); PG8_BAR; PG8_SCHED;
            PG8_LDA(At, 0, 1); PG8_STAGE(PG8_SB(0, 0), b2, voffB); PG8_STAGE(PG8_SB(0, 1), b2 + hstep, voffB); PG8_STAGE(PG8_SA(0, 0), a2, s0);
            PG8_WAIT_V(8); PG8_WAIT_L(0); PG8_BAR; PG8_MMA(1, 0, At, B0); PG8_MMA(1, 1, At, B1); PG8_BAR; PG8_SCHED;
            PG8_LDB(B0, 1, 0); PG8_LDB(B1, 1, 1); PG8_SCHED; PG8_LDA(At, 1, 0); PG8_STAGE(PG8_SA(0, 1), a2, s1);
            PG8_WAIT_V(8); PG8_WAIT_L(0); PG8_BAR; PG8_MMA(0, 0, At, B0); PG8_MMA(0, 1, At, B1); PG8_BAR; PG8_SCHED;
            PG8_LDA(At, 1, 1); PG8_STAGE(PG8_SB(1, 0), b3, voffB); PG8_STAGE(PG8_SB(1, 1), b3 + hstep, voffB); PG8_STAGE(PG8_SA(1, 0), a3, s0);
            PG8_WAIT_V(8); PG8_WAIT_L(0); PG8_BAR; PG8_MMA(1, 0, At, B0); PG8_MMA(1, 1, At, B1); PG8_BAR; PG8_SCHED;
            } else {
            PG8_LDB(B0, 0, 0); PG8_SCHED; PG8_LDA(At, 0, 0); PG8_STAGE(PG8_SA(1, 1), a1, goff1);
            PG8_WAIT_L(8); PG8_BAR; PG8_WAIT_L(0); PG8_MMA(0, 0, At, B0); PG8_BAR; PG8_SCHED;
            PG8_LDB(B1, 0, 1); PG8_STAGE(PG8_SB(0, 0), b2, voffB);
            PG8_BAR; PG8_WAIT_L(0); PG8_MMA(0, 1, At, B1); PG8_BAR;
            PG8_LDA(At, 0, 1); PG8_STAGE(PG8_SA(0, 0), a2, s0);
            PG8_BAR; PG8_WAIT_L(0); PG8_MMA(1, 0, At, B0); PG8_BAR; PG8_SCHED;
            PG8_STAGE(PG8_SB(0, 1), b2 + hstep, voffB);
            PG8_WAIT_V(6); PG8_BAR; PG8_MMA(1, 1, At, B1); PG8_BAR;
            PG8_LDB(B0, 1, 0); PG8_SCHED; PG8_LDA(At, 1, 0); PG8_STAGE(PG8_SA(0, 1), a2, s1);
            PG8_WAIT_L(8); PG8_BAR; PG8_WAIT_L(0); PG8_MMA(0, 0, At, B0); PG8_BAR; PG8_SCHED;
            PG8_LDB(B1, 1, 1); PG8_STAGE(PG8_SB(1, 0), b3, voffB);
            PG8_BAR; PG8_WAIT_L(0); PG8_MMA(0, 1, At, B1); PG8_BAR;
            PG8_LDA(At, 1, 1); PG8_STAGE(PG8_SA(1, 0), a3, s0);
            PG8_BAR; PG8_WAIT_L(0); PG8_MMA(1, 0, At, B0); PG8_BAR; PG8_SCHED;
            PG8_STAGE(PG8_SB(1, 1), b3 + hstep, voffB);
            PG8_WAIT_V(6); PG8_BAR; PG8_MMA(1, 1, At, B1); PG8_BAR;
            }
        }
        if constexpr (ALIGN_EPI) { if (wr == 0) PG8_BAR; }
        if constexpr (!Epi::AFTER_DRAIN) { E(acc, cur, wr, wc, fr, fq); S.done(cur); }
        if (!has_next) break;
#pragma unroll
        for (int a = 0; a < 2; ++a)
#pragma unroll
            for (int b = 0; b < 2; ++b)
#pragma unroll
                for (int m = 0; m < 4; ++m)
#pragma unroll
                    for (int n = 0; n < 2; ++n) acc[a][b][m][n] = (f32x4){0.f, 0.f, 0.f, 0.f};
        cur = nxt; cA = nA; cB = nB; ++ui;
        if constexpr (ALIGN_EPI) { if (wr == 1) PG8_BAR; }
    }
    PG8_WAIT_V(0);
    if constexpr (!ALIGN_EPI) { if (wr == 0) PG8_BAR; }
    PG8_BAR;
    if constexpr (Epi::AFTER_DRAIN) { E.fused(acc, cur, wr, wc, fr, fq, lds, wid, lane); S.done(cur); }
#undef PG8_SA
#undef PG8_SB
#undef PG8_STAGE
#undef PG8_LDA
#undef PG8_LDB
#undef PG8_MMA
#undef PG8_WAIT_V
#undef PG8_WAIT_L
#undef PG8_BAR
#undef PG8_SCHED
#undef PG8_GOFF
}
}
namespace pg8 {
template <class F> struct EpiScalar {
    static constexpr bool PERM = true, AFTER_DRAIN = false; F f;
    __device__ __forceinline__ void operator()(const f32x4 (&acc)[2][2][4][2], const Unit& u, int wr, int wc, int fr, int fq) const {
        const int row0 = u.pm * BM + wr * 64 + fr, col0 = u.pn * BM + wc * 32 + 8 * fq;
#pragma unroll
        for (int ai = 0; ai < 2; ++ai)
#pragma unroll
            for (int m = 0; m < 4; ++m) {
#pragma unroll
                for (int bj = 0; bj < 2; ++bj)
#pragma unroll
                    for (int n = 0; n < 2; ++n)
#pragma unroll
                        for (int e = 0; e < 4; ++e) f(row0 + ai * HALF + m * 16, col0 + bj * HALF + 4 * n + e, acc[ai][bj][m][n][e]);
                asm volatile("" ::: "memory"); }
    }
};
template <class F> struct EpiScalarPair {
    static constexpr bool PERM = true, AFTER_DRAIN = false; F f;
    __device__ __forceinline__ void operator()(const f32x4 (&acc)[2][2][4][2], const Unit& u, int wr, int wc, int fr, int fq) const {
        const int row0 = u.pm * BM + wr * 64 + fr, cl0 = wc * 32 + 8 * fq;
#pragma unroll
        for (int ai = 0; ai < 2; ++ai)
#pragma unroll
            for (int m = 0; m < 4; ++m) {
#pragma unroll
                for (int n = 0; n < 2; ++n)
#pragma unroll
                    for (int e = 0; e < 4; ++e) f(row0 + ai * HALF + m * 16, u.pn, cl0 + 4 * n + e, acc[ai][0][m][n][e], acc[ai][1][m][n][e]);
                asm volatile("" ::: "memory"); }
    }
};
}
#define GAS __attribute__((address_space(1)))
#define LAS __attribute__((address_space(3)))
typedef unsigned short bf16;
typedef unsigned v4u __attribute__((ext_vector_type(4)));
typedef float f32x4 __attribute__((ext_vector_type(4)));
typedef short bf16x8 __attribute__((ext_vector_type(8)));
typedef GAS unsigned gu32;
typedef GAS unsigned long long gu64;
#define RLX_AGENT __ATOMIC_RELAXED, __HIP_MEMORY_SCOPE_AGENT
#define LDS_WAIT() asm volatile("s_waitcnt lgkmcnt(0)" ::: "memory")
#define VM_WAIT() asm volatile("s_waitcnt vmcnt(0)" ::: "memory")
__device__ __forceinline__ unsigned long long rt() { return __builtin_amdgcn_s_memrealtime(); }
__device__ __forceinline__ unsigned f2bf(float f) { unsigned u = __builtin_bit_cast(unsigned, f); return (u + 0x7fffu + ((u >> 16) & 1u)) >> 16; }
__device__ __forceinline__ unsigned pk2(float lo, float hi) { return f2bf(lo) | (f2bf(hi) << 16); }

#define XB_TMO      128
#define XB_XCNT(j)  (256  + 64 * (j))
#define XB_XSUB(j)  (1280 + 64 * (j))
#define XB_XGEN(j)  (2304 + 64 * (j))
#define XB_TOP      3328
#define XB_TOPGEN   3392
#define XCD_BAR_WORDS 3456
#define XB_SPIN_CAP (1u << 18)

__device__ __forceinline__ unsigned xb_ld(unsigned* p)              { return __hip_atomic_load(p, __ATOMIC_RELAXED, __HIP_MEMORY_SCOPE_AGENT); }
__device__ __forceinline__ unsigned xb_add(unsigned* p, unsigned v) { return __hip_atomic_fetch_add(p, v, __ATOMIC_RELAXED, __HIP_MEMORY_SCOPE_AGENT); }
__device__ __forceinline__ unsigned xb_xcc_id() { return (unsigned)__builtin_amdgcn_s_getreg((3 << 11) | 20) & 0xFu; }
#define XB_SPIN(cond, bar) do { unsigned _sp = 0; while (cond) { __builtin_amdgcn_s_sleep(1); \
    if ((++_sp & 255u) == 0u) { if (xb_ld(&(bar)[XB_TMO])) break; if (_sp > XB_SPIN_CAP) { atomicAdd(&(bar)[XB_TMO], 1u); break; } } } } while (0)

struct XcdBarrier {
    unsigned* bar; unsigned x;
    volatile LAS unsigned* st;
};

__device__ __forceinline__ XcdBarrier xcd_barrier_post(unsigned* bar, volatile LAS unsigned* st) {
    XcdBarrier b; b.bar = bar; b.x = xb_xcc_id(); b.st = st;
    if (threadIdx.x == 0) (void)xb_add(&bar[XB_XCNT(b.x)], 1u);
    return b;
}
__device__ __forceinline__ void xcd_barrier_complete(unsigned* bar, unsigned x, unsigned& nloc, unsigned& nx) {
    const unsigned G = gridDim.x * gridDim.y * gridDim.z;
    unsigned sum, cnt, mine, sp = 0u;
    for (;;) {
        sum = 0u; cnt = 0u; mine = 0u;
#pragma unroll
        for (unsigned j = 0; j < 16; ++j) { const unsigned c = xb_ld(&bar[XB_XCNT(j)]); sum += c; cnt += (c > 0u) ? 1u : 0u; mine = (j == x) ? c : mine; }
        if (sum == G) break;
        __builtin_amdgcn_s_sleep(1);
        if ((++sp & 255u) == 0u) { if (xb_ld(&bar[XB_TMO])) break; if (sp > XB_SPIN_CAP) { atomicAdd(&bar[XB_TMO], 1u); break; } }
    }
    nloc = mine > 0u ? mine : 1u; nx = cnt > 0u ? cnt : 1u;
}

__device__ __forceinline__ void xcd_barrier(const XcdBarrier& b) {
    asm volatile("s_waitcnt vmcnt(0)" ::: "memory");
    __syncthreads();
    if (threadIdx.x == 0) {
        unsigned* bar = b.bar;
        __builtin_amdgcn_s_waitcnt(0);
        unsigned nloc = b.st[0], nx = b.st[1];
        if (nloc == 0u) { xcd_barrier_complete(bar, b.x, nloc, nx); b.st[0] = nloc; b.st[1] = nx; }
        const unsigned old = xb_add(&bar[XB_XSUB(b.x)], 1u);
        const unsigned gen = old / nloc;
        if (old + 1u == (gen + 1u) * nloc) {
            __builtin_amdgcn_fence(__ATOMIC_RELEASE, "agent");
            asm volatile("s_waitcnt vmcnt(0)" ::: "memory");
            const unsigned og = xb_add(&bar[XB_TOP], 1u);
            const unsigned tg = og / nx;
            if (og + 1u == (tg + 1u) * nx) xb_add(&bar[XB_TOPGEN], 1u);
            else XB_SPIN(xb_ld(&bar[XB_TOPGEN]) == tg, bar);
            __builtin_amdgcn_fence(__ATOMIC_ACQUIRE, "agent");
            xb_add(&bar[XB_XGEN(b.x)], 1u);
            asm volatile("s_waitcnt vmcnt(0)" ::: "memory");
        } else {
            XB_SPIN(xb_ld(&bar[XB_XGEN(b.x)]) == gen, bar);
            __builtin_amdgcn_fence(__ATOMIC_ACQUIRE, "agent");
            asm volatile("s_waitcnt vmcnt(0)" ::: "memory");
        }
    }
    __syncthreads();
}
#ifndef ATT_FAST
#define ATT_FAST 1
#endif

constexpr int NWAVES = 8, NTHR = NWAVES * 64;
constexpr int BATCH = 4, SEQ = 8192, D = 1024, M = BATCH * SEQ;
constexpr int NHG = 8, HD = 64, HW = NHG * HD;
constexpr int INCOLS = 3080, NPROJ = 3072;
constexpr int NE = 32, NGRP = 4, EPG = 8, DF = 512, PLED = 256;
constexpr int SPAD = 2 * M + NE * 256;
constexpr float ALPHA = 1.189207115002721f, LN_EPS = 1e-5f, LOG2E = 1.4426950408889634f;
constexpr int NPH = 10;

constexpr size_t MiB = 1u << 20;
constexpr size_t WS_CTL = 0, CTL_ZERO_BYTES = 256 * 1024;
constexpr size_t WS_LS = 1 * MiB, WS_CFL = 2 * MiB, WS_CTOT = 3 * MiB, WS_KNT = 3 * MiB + 4096, WS_EID = 3 * MiB + 256 * 1024, WS_GATE = 3 * MiB + 512 * 1024, WS_RANK = 3 * MiB + 768 * 1024,
                 WS_SLOT = 4 * MiB, WS_GSLOT = 4 * MiB + 256 * 1024, WS_TOKSLOT = 4 * MiB + 640 * 1024;
constexpr size_t WS_WIN = 5 * MiB, WS_WOUT = 11 * MiB, WS_WPLE = 13 * MiB, WS_WPG = 14 * MiB, WS_WGU = 16 * MiB, WS_WD = 80 * MiB, WS_PPLE = 112 * MiB;
constexpr size_t WS_R1 = 176 * MiB;
constexpr size_t WS_R2 = 368 * MiB;
constexpr size_t WS_R3 = 432 * MiB;
constexpr size_t WS_END = 504 * MiB;
static_assert(WS_GSLOT + (size_t)SPAD * 4 <= WS_TOKSLOT && WS_TOKSLOT + (size_t)SPAD * 4 <= WS_WIN && WS_R1 + (size_t)SPAD * 2048 <= WS_R2 && WS_R3 + (size_t)SPAD * 1024 <= WS_END, "ws map");
constexpr int CW_TMO = 0, CW_BAR = 4096, CW_CNT = 8192;

constexpr int RING_OFF = 0, RING_BYTES = 131072;
constexpr int WGRP_OFF = RING_BYTES;
constexpr int LDSCTL_OFF = RING_BYTES + 16384, MISC_OFF = LDSCTL_OFF + 320, PST_OFF = LDSCTL_OFF + 1024, HIST_OFF = LDSCTL_OFF + 1280, BASE_OFF = LDSCTL_OFF + 1408, ROWL_OFF = LDSCTL_OFF + 2048;
constexpr int LDS_BYTES = 163840;

#define BFLO(w) __builtin_bit_cast(float, (w) << 16)
#define BFHI(w) __builtin_bit_cast(float, (w) & 0xffff0000u)
__device__ __forceinline__ float bf2f(unsigned short v) { return __builtin_bit_cast(float, (unsigned)v << 16); }
__device__ __forceinline__ float wave_sum(float v) {
#pragma unroll
    for (int o = 1; o < 64; o <<= 1) v += __shfl_xor(v, o);
    return v;
}
__device__ __forceinline__ float wave_max(float v) {
#pragma unroll
    for (int o = 1; o < 64; o <<= 1) v = fmaxf(v, __shfl_xor(v, o));
    return v;
}

struct Frame {
    LAS unsigned char* lds; volatile LAS unsigned* MISC; gu32* ctl;
    int tid, lane, wave, vcu, G;
    const float *x, *p, *w_in, *b_forget, *w_out, *ln1g, *ln1b, *w_group, *b_group, *w_router, *b_router, *w_gate, *w_up, *w_down, *w_ple, *w_pg, *ln2g, *ln2b;
    float* out;
    bf16 *Win_t, *Wout_t, *Wple_t, *Wpg_t, *Wgu_t, *Wd_t, *pple, *qkv, *xs, *y, *xb, *mixed, *hb, *pb, *hdn, *mixp;
    float *ls, *cfl, *ctot, *knt, *gatev, *gslot; int *eid, *rank, *slot, *tokslot;
};

struct TileRef { const float* src; bf16* dst; int ldw, ldt; float sc; };
__device__ __forceinline__ void tile_load(f32x4 (&r)[8], const TileRef& t, int lane) {
    const GAS float* p = (const GAS float*)t.src + (size_t)(lane >> 4) * t.ldw + 4 * (lane & 15);
#pragma unroll
    for (int i = 0; i < 8; ++i) r[i] = *(const GAS f32x4*)(p + (size_t)(4 * i) * t.ldw);
}
__device__ __forceinline__ void tile_store(const f32x4 (&r)[8], const TileRef& t, LAS float* scr, int lane) {
#pragma unroll
    for (int i = 0; i < 8; ++i) { LAS float* s = scr + (4 * i + (lane >> 4)) * 65 + 4 * (lane & 15); s[0] = r[i].x * t.sc; s[1] = r[i].y * t.sc; s[2] = r[i].z * t.sc; s[3] = r[i].w * t.sc; }
    LDS_WAIT(); asm volatile("" ::: "memory");
    const int c = lane & 3;
#pragma unroll
    for (int j = 0; j < 4; ++j) { const int n = 16 * j + (lane >> 2); const LAS float* s = scr + (8 * c) * 65 + n;
        v4u o; o.x = pk2(s[0 * 65], s[1 * 65]); o.y = pk2(s[2 * 65], s[3 * 65]); o.z = pk2(s[4 * 65], s[5 * 65]); o.w = pk2(s[6 * 65], s[7 * 65]);
        *(GAS v4u*)(t.dst + (size_t)n * t.ldt + 8 * c) = o; }
    LDS_WAIT(); asm volatile("" ::: "memory");
}
__device__ __forceinline__ float log_sigmoid_f(float v) { return fminf(v, 0.f) - log1pf(expf(-fabsf(v))); }
constexpr int I_IN = 16 * 48, I_OUT = 16 * 16, I_PLE = 4 * 16, I_PG = 16 * 16, I_GU = NE * 2 * 16 * 8, I_DN = NE * 8 * 16;
constexpr int P0_ITEMS = I_IN + I_OUT + I_PLE + I_PG + I_GU + I_DN;
__device__ __forceinline__ TileRef p0_item(Frame& F, int it, int sub) {
    int r = it; TileRef t; t.sc = 1.f;
    if (r < I_IN) { const int kb = 2 * (r / 48) + sub, nb = r % 48, s = nb >> 3;
        t.src = F.w_in + (size_t)kb * 32 * INCOLS + nb * 64; t.ldw = INCOLS; t.dst = F.Win_t + (size_t)nb * 64 * D + kb * 32; t.ldt = D; t.sc = (s == 0 || s == 3) ? 0.125f * LOG2E : 1.f; return t; } r -= I_IN;
    if (r < I_OUT) { const int kb = 2 * (r / 16) + sub, nb = r % 16; t.src = F.w_out + (size_t)kb * 32 * D + nb * 64; t.ldw = D; t.dst = F.Wout_t + (size_t)nb * 64 * D + kb * 32; t.ldt = D; return t; } r -= I_OUT;
    if (r < I_PLE) { const int kb = 2 * (r / 16) + sub, nb = r % 16; t.src = F.w_ple + (size_t)kb * 32 * D + nb * 64; t.ldw = D; t.dst = F.Wple_t + (size_t)nb * 64 * PLED + kb * 32; t.ldt = PLED; return t; } r -= I_PLE;
    if (r < I_PG) { const int kb = 2 * (r / 16) + sub, nb = r % 16; t.src = F.w_pg + (size_t)kb * 32 * D + nb * 64; t.ldw = D; t.dst = F.Wpg_t + (size_t)nb * 64 * D + kb * 32; t.ldt = D; return t; } r -= I_PG;
    if (r < I_GU) { const int e = r / 256, gu = (r >> 7) & 1, kb = 2 * ((r >> 3) & 15) + sub, nb = r & 7;
        t.src = (gu ? F.w_up : F.w_gate) + (size_t)e * D * DF + (size_t)kb * 32 * DF + nb * 64; t.ldw = DF;
        const int row = e * 1024 + (nb >> 1) * 256 + gu * 128 + (nb & 1) * 64;
        t.dst = F.Wgu_t + (size_t)row * D + kb * 32; t.ldt = D; return t; } r -= I_GU;
    { const int e = r / 128, kb = 2 * ((r >> 4) & 7) + sub, nb = r & 15;
        t.src = F.w_down + (size_t)e * DF * D + (size_t)kb * 32 * D + nb * 64; t.ldw = D; t.dst = F.Wd_t + (size_t)(e * 1024 + nb * 64) * DF + kb * 32; t.ldt = DF; return t; }
}
template <int PART> __device__ __forceinline__ void p0_prologue(Frame& F) {
    LAS float* scr = (LAS float*)(F.lds + RING_OFF + F.wave * 16384);
    const int gw = F.vcu * NWAVES + F.wave, NGW = F.G * NWAVES;
    if (PART == 0) {
        f32x4 ra[8], rb[8]; int it = gw;
        TileRef ta = p0_item(F, it < P0_ITEMS ? it : 0, 0), tb = p0_item(F, it < P0_ITEMS ? it : 0, 1);
        if (it < P0_ITEMS) { tile_load(ra, ta, F.lane); tile_load(rb, tb, F.lane); }
        while (it < P0_ITEMS) {
            const int i2 = it + NGW;
            tile_store(ra, ta, scr, F.lane);
            if (i2 < P0_ITEMS) { ta = p0_item(F, i2, 0); tile_load(ra, ta, F.lane); }
            tile_store(rb, tb, scr, F.lane);
            if (i2 < P0_ITEMS) { tb = p0_item(F, i2, 1); tile_load(rb, tb, F.lane); }
            it = i2;
        }
    }
    __syncthreads();
    if (PART == 1) {
    __syncthreads();
    LAS float* wf = (LAS float*)(F.lds + RING_OFF);
    for (int i = F.tid; i < 2048; i += NTHR) { const int c = i >> 1, j0 = (i & 1) * 4; const f32x4 w = *(const GAS f32x4*)(F.w_in + (size_t)c * INCOLS + NPROJ + j0);
        wf[(j0 + 0) * 1024 + c] = w.x; wf[(j0 + 1) * 1024 + c] = w.y; wf[(j0 + 2) * 1024 + c] = w.z; wf[(j0 + 3) * 1024 + c] = w.w; }
    __syncthreads();
    {
        f32x4 v[4], vn[4]; int m = gw;
        if (m < M) { const GAS f32x4* xr = (const GAS f32x4*)(F.x + (size_t)m * D) + F.lane;
#pragma unroll
            for (int j = 0; j < 4; ++j) v[j] = xr[64 * j]; }
        const float bfg = (F.lane < 8) ? F.b_forget[F.lane] : 0.f;
        for (; m < M; m += NGW) {
            const int mn = m + NGW;
            if (mn < M) { const GAS f32x4* xr = (const GAS f32x4*)(F.x + (size_t)mn * D) + F.lane;
#pragma unroll
                for (int j = 0; j < 4; ++j) vn[j] = xr[64 * j]; }
            GAS unsigned long long* o8 = (GAS unsigned long long*)(F.xb + (size_t)m * D) + F.lane;
#pragma unroll
            for (int j = 0; j < 4; ++j) o8[64 * j] = (unsigned long long)pk2(v[j].x, v[j].y) | ((unsigned long long)pk2(v[j].z, v[j].w) << 32);
            float mine = 0.f;
#pragma unroll
            for (int g = 0; g < 8; ++g) { float a = 0.f;
#pragma unroll
                for (int j = 0; j < 4; ++j) { const f32x4 w = *(const LAS f32x4*)(wf + g * 1024 + 4 * F.lane + 256 * j); a += (v[j].x * w.x + v[j].y * w.y) + (v[j].z * w.z + v[j].w * w.w); }
                a = wave_sum(a); if (F.lane == g) mine = a; }
            if (F.lane < 8) F.ls[(size_t)m * 8 + F.lane] = log_sigmoid_f(mine + bfg);
#pragma unroll
            for (int j = 0; j < 4; ++j) v[j] = vn[j];
        }
    }
    __syncthreads(); }
    if (PART == 2) { const int gtid = blockIdx.x * NTHR + F.tid, NT = F.G * NTHR;
      for (int i = gtid; i < SPAD; i += NT) F.tokslot[i] = 0;
      for (int i = gtid; i < M * PLED / 8; i += NT) { const GAS f32x4* s = (const GAS f32x4*)(F.p) + 2 * (size_t)i; const f32x4 a = s[0], b = s[1];
          v4u o; o.x = pk2(a.x, a.y); o.y = pk2(a.z, a.w); o.z = pk2(b.x, b.y); o.w = pk2(b.z, b.w); ((GAS v4u*)F.pb)[i] = o; } }
}

__device__ __forceinline__ void p2_scan(Frame& F) {
    LAS float* wt = (LAS float*)(F.lds + RING_OFF);
    for (int it = blockIdx.x; it < 256; it += F.G) {
        const int bh = it >> 3, chunk = it & 7, b = bh >> 3, h = bh & 7, t = chunk * 1024 + 2 * F.tid;
        const float a0 = F.ls[(size_t)(b * SEQ + t) * 8 + h] * LOG2E, a1 = F.ls[(size_t)(b * SEQ + t + 1) * 8 + h] * LOG2E;
        float s = a0 + a1;
#pragma unroll
        for (int o = 1; o < 64; o <<= 1) { const float u = __shfl_up(s, o); if (F.lane >= o) s += u; }
        __syncthreads();
        if (F.lane == 63) wt[F.wave] = s;
        __syncthreads();
        float off = 0.f, tot = 0.f;
#pragma unroll
        for (int w = 0; w < 8; ++w) { const float u = wt[w]; if (w < F.wave) off += u; tot += u; }
        const float i1 = off + s, i0 = i1 - a1;
        F.cfl[(size_t)bh * SEQ + t] = i0; F.cfl[(size_t)bh * SEQ + t + 1] = i1;
        if (F.tid == 0) F.ctot[bh * 8 + chunk] = tot;
        const bf16* kf = F.qkv + (size_t)4 * M * HW;
        float nmax = 0.f;
#pragma unroll
        for (int rr = 0; rr < 2; ++rr) { const GAS v4u* kp = (const GAS v4u*)(kf + (size_t)(b * SEQ + t + rr) * HW + h * HD); float n2 = 0.f;
#pragma unroll
            for (int c = 0; c < 8; ++c) { const v4u w = kp[c];
#pragma unroll
                for (int e = 0; e < 4; ++e) { const float lo = __builtin_bit_cast(float, w[e] << 16), hi = __builtin_bit_cast(float, w[e] & 0xffff0000u); n2 += lo * lo + hi * hi; } }
            nmax = fmaxf(nmax, n2); }
#pragma unroll
        for (int o = 1; o < 32; o <<= 1) nmax = fmaxf(nmax, __shfl_xor(nmax, o));
        if ((F.lane & 31) == 0) F.knt[bh * 128 + chunk * 16 + F.wave * 2 + (F.lane >> 5)] = sqrtf(nmax);
    }
}

#if !defined(ATT_FAST) || !ATT_FAST
__device__ __forceinline__ void ld64(float (&d)[64], const bf16* p) {
    const GAS v4u* s = (const GAS v4u*)p;
#pragma unroll
    for (int c = 0; c < 8; ++c) { const v4u w = s[c];
#pragma unroll
        for (int e = 0; e < 4; ++e) { d[c * 8 + 2 * e] = BFLO(w[e]); d[c * 8 + 2 * e + 1] = BFHI(w[e]); } }
}
__device__ __forceinline__ float dot64(const float (&q)[64], const bf16* p) {
    const GAS v4u* s = (const GAS v4u*)p; float z = 0.f;
#pragma unroll
    for (int c = 0; c < 8; ++c) { const v4u w = s[c];
#pragma unroll
        for (int e = 0; e < 4; ++e) { z += q[c * 8 + 2 * e] * BFLO(w[e]); z += q[c * 8 + 2 * e + 1] * BFHI(w[e]); } }
    return z;
}
__device__ __forceinline__ void axpy64(float (&o)[64], float a, const bf16* p) {
    const GAS v4u* s = (const GAS v4u*)p;
#pragma unroll
    for (int c = 0; c < 8; ++c) { const v4u w = s[c];
#pragma unroll
        for (int e = 0; e < 4; ++e) { o[c * 8 + 2 * e] += a * BFLO(w[e]); o[c * 8 + 2 * e + 1] += a * BFHI(w[e]); } }
}
__device__ __forceinline__ void st64(bf16* p, const float (&d)[64], float sc) {
    GAS v4u* s = (GAS v4u*)p;
#pragma unroll
    for (int c = 0; c < 8; ++c) { v4u w;
#pragma unroll
        for (int e = 0; e < 4; ++e) w[e] = pk2(d[c * 8 + 2 * e] * sc, d[c * 8 + 2 * e + 1] * sc);
        s[c] = w; }
}
__device__ __forceinline__ void p3_attn_simple(Frame& F) {
    const int gtid = blockIdx.x * NTHR + F.tid, NT = F.G * NTHR;
    const bf16 *Qs = F.qkv, *Ks = F.qkv + (size_t)1 * M * HW, *Vs = F.qkv + (size_t)2 * M * HW, *Qf = F.qkv + (size_t)3 * M * HW, *Kf = F.qkv + (size_t)4 * M * HW, *Vf = F.qkv + (size_t)5 * M * HW;
    for (int idx = gtid; idx < M * NHG; idx += NT) {
        const int h = idx >> 15, m = idx & (M - 1), b = m >> 13, t = m & (SEQ - 1);
        float q[64], o[64];
        ld64(q, Qs + (size_t)m * HW + h * HD);
#pragma unroll
        for (int d = 0; d < 64; ++d) o[d] = 0.f;
        float C2 = 0.f;
        for (int s = t - 1; s >= 0; --s) {
            const float z = dot64(q, Ks + (size_t)(b * SEQ + s) * HW + h * HD);
            const float L2 = -(fmaxf(z, 0.f) * LOG2E + log2f(1.f + exp2f(-fabsf(z) * LOG2E)));
            const float w = exp2f(z * LOG2E + L2 + C2);
            axpy64(o, w, Vs + (size_t)(b * SEQ + s) * HW + h * HD);
            C2 += L2;
            if (C2 < -160.f) break;
        }
        st64(F.mixed + (size_t)m * D + h * HD, o, 1.f);
    }
    for (int idx = gtid; idx < M * NHG; idx += NT) {
        const int h = idx >> 15, m = idx & (M - 1), b = m >> 13, t = m & (SEQ - 1), bh = b * 8 + h;
        float q[64], o[64];
        ld64(q, Qf + (size_t)m * HW + h * HD);
#pragma unroll
        for (int d = 0; d < 64; ++d) o[d] = 0.f;
        float cq = F.cfl[(size_t)bh * SEQ + t];
        for (int c = 0; c < (t >> 10); ++c) cq += F.ctot[bh * 8 + c];
        float carry = 0.f, mr = -1e30f, l = 0.f;
        for (int s = 0; s <= t; ++s) {
            if ((s & 1023) == 0 && s > 0) carry += F.ctot[bh * 8 + (s >> 10) - 1];
            const float z = dot64(q, Kf + (size_t)(b * SEQ + s) * HW + h * HD);
            const float s2 = z * LOG2E + (cq - (F.cfl[(size_t)bh * SEQ + s] + carry));
            if (s2 > mr) { const float f = exp2f(mr - s2); l *= f;
#pragma unroll
                for (int d = 0; d < 64; ++d) o[d] *= f;
                mr = s2; }
            const float pw = exp2f(s2 - mr); l += pw;
            axpy64(o, pw, Vf + (size_t)(b * SEQ + s) * HW + h * HD);
        }
        st64(F.mixed + (size_t)m * D + HW + h * HD, o, 1.f / l);
    }
}

#endif
struct FProj { bf16* qkv; __device__ __forceinline__ void operator()(int row, int col, float v) const { const int t = col >> 9, cc = col & 511; const float sc = (t == 0 || t == 3) ? 0.125f : 1.f;
    qkv[(size_t)t * M * HW + (size_t)row * HW + cc] = (bf16)f2bf(v * sc); } };
struct FBf16 { bf16* O; int ldc; int cmask; __device__ __forceinline__ void operator()(int row, int col, float v) const { O[(size_t)row * ldc + (col & cmask)] = (bf16)f2bf(v); } };
struct FPre { const float* x; float* out; __device__ __forceinline__ void operator()(int row, int col, float v) const { const size_t i = (size_t)row * D + col; out[i] = ALPHA * x[i] + v; } };
struct FSwiglu { bf16* hdn; const float* gslot; __device__ __forceinline__ void operator()(int row, int pn, int cl, float g, float u) const {
    const int f = (pn & 3) * 128 + cl; const float s = g / (1.f + __expf(-g)); hdn[(size_t)row * DF + f] = (bf16)f2bf(s * u * gslot[row]); } };
struct FComb { float* out; const bf16* pple; const bf16* y; const int* slot; __device__ __forceinline__ void operator()(int row, int col, float v) const {
    const size_t i = (size_t)row * D + col; const int s0 = slot[row * 2], s1 = slot[row * 2 + 1]; const float sig = 1.f / (1.f + __expf(-v));
    out[i] = ALPHA * out[i] + bf2f(pple[i]) * sig + bf2f(y[(size_t)s0 * D + col]) + bf2f(y[(size_t)s1 * D + col]); } };

#ifndef PROBE_TWICE
#define PROBE_TWICE -1
#endif
template <class S> struct Rep2T : S {
    __device__ __forceinline__ bool next(int i, pg8::Unit& u) const { return S::next(i >> 1, u); }
};
template <class S, bool ON> struct Rep2Sel { typedef S type; };
template <class S> struct Rep2Sel<S, true> { typedef Rep2T<S> type; };
#define Rep2(S, ON) typename Rep2Sel<S, ON>::type

namespace pg8 {
struct EpiPre {
    static constexpr bool PERM = true, AFTER_DRAIN = false; const float* x; float* out;
    __device__ __forceinline__ void operator()(const f32x4 (&acc)[2][2][4][2], const Unit& u, int wr, int wc, int fr, int fq) const {
        const int row0 = u.pm * BM + wr * 64 + fr, col0 = u.pn * BM + wc * 32 + 8 * fq;
#pragma unroll
        for (int ai = 0; ai < 2; ++ai)
#pragma unroll
            for (int m = 0; m < 4; ++m) { const size_t off = (size_t)(row0 + ai * HALF + m * 16) * D + col0;
#pragma unroll
                for (int bj = 0; bj < 2; ++bj) { const f32x4 x0 = *(const f32x4*)(x + off + bj * HALF), x1 = *(const f32x4*)(x + off + bj * HALF + 4);
                    *(f32x4*)(out + off + bj * HALF) = x0 * ALPHA + acc[ai][bj][m][0]; *(f32x4*)(out + off + bj * HALF + 4) = x1 * ALPHA + acc[ai][bj][m][1]; }
                asm volatile("" ::: "memory"); }
    }
};
struct EpiSwiglu {
    static constexpr bool PERM = true, AFTER_DRAIN = false; bf16_t* hdn; const float* gslot;
    __device__ __forceinline__ void operator()(const f32x4 (&acc)[2][2][4][2], const Unit& u, int wr, int wc, int fr, int fq) const {
        const int row0 = u.pm * BM + wr * 64 + fr, f0 = (u.pn & 3) * 128 + wc * 32 + 8 * fq;
#pragma unroll
        for (int ai = 0; ai < 2; ++ai)
#pragma unroll
            for (int m = 0; m < 4; ++m) { const int r = row0 + ai * HALF + m * 16; const float gs = gslot[r]; float v[8];
#pragma unroll
                for (int n = 0; n < 2; ++n)
#pragma unroll
                    for (int e = 0; e < 4; ++e) { const float g = acc[ai][0][m][n][e], up = acc[ai][1][m][n][e]; v[4 * n + e] = g * __builtin_amdgcn_rcpf(1.f + __expf(-g)) * up * gs; }
                u32x4 w; w.x = cvt_pk_bf16(v[0], v[1]); w.y = cvt_pk_bf16(v[2], v[3]); w.z = cvt_pk_bf16(v[4], v[5]); w.w = cvt_pk_bf16(v[6], v[7]);
                *(u32x4*)(hdn + (size_t)r * DF + f0) = w; }
    }
};
struct EpiPle {
    static constexpr bool PERM = true, AFTER_DRAIN = false; bf16_t* pple;
    const int* eid; const int* rank; const float* gatev; int* slot; float* gslot; int* tokslot; const PG8_LAS int* pst;
    __device__ __forceinline__ void operator()(const f32x4 (&acc)[2][2][4][2], const Unit& u, int wr, int wc, int fr, int fq) const {
        const int row0 = u.pm * BM + wr * 64 + fr, col0 = u.pn * BM + wc * 32 + 8 * fq;
#pragma unroll
        for (int ai = 0; ai < 2; ++ai)
#pragma unroll
            for (int m = 0; m < 4; ++m) { const size_t off = (size_t)(row0 + ai * HALF + m * 16) * D + col0;
#pragma unroll
                for (int bj = 0; bj < 2; ++bj) { const u32x4 pp = *(const u32x4*)(pple + off + bj * HALF); float v[8];
#pragma unroll
                    for (int e = 0; e < 8; ++e) { const float g = acc[ai][bj][m][e >> 2][e & 3]; const unsigned pw = pp[e >> 1];
                        const float pv = (e & 1) ? __builtin_bit_cast(float, pw & 0xffff0000u) : __builtin_bit_cast(float, pw << 16);
                        v[e] = pv * __builtin_amdgcn_rcpf(1.f + __expf(-g)); }
                    u32x4 w; w.x = cvt_pk_bf16(v[0], v[1]); w.y = cvt_pk_bf16(v[2], v[3]); w.z = cvt_pk_bf16(v[4], v[5]); w.w = cvt_pk_bf16(v[6], v[7]);
                    *(u32x4*)(pple + off + bj * HALF) = w; }
                asm volatile("" ::: "memory"); }
        const int lane = fq * 16 + fr, rb = u.pm * BM + (u.pn & 3) * 64 + (wr * 4 + wc) * 8;
        if (lane < 16) { const int mrow = rb + (lane >> 1), k = lane & 1; const int e = eid[mrow * 2 + k]; const int s = pst[e] + rank[mrow * 2 + k];
            slot[mrow * 2 + k] = s; gslot[s] = gatev[mrow * 2 + k]; tokslot[s] = mrow; }
    }
};
}

struct MoeOrder {
    const LAS int* pst; int nunits, G, c;
    __device__ __forceinline__ bool next(int i, pg8::Unit& u) const {
        const int L = i * G + c; if (L >= nunits) return false;
        const int pm = L >> 2, r0 = pm * 256; int e = 0;
        for (int k = 0; k < NE - 1; ++k) if (r0 >= pst[k + 1]) e = k + 1;
        u.pm = pm; u.pn = e * 4 + (L & 3); return true;
    }
    __device__ __forceinline__ void a_ready(const pg8::Unit&) const {}
    __device__ __forceinline__ void done(const pg8::Unit&) const {}
};
__device__ __forceinline__ void build_pstart(Frame& F) {
    LAS int* pst = (LAS int*)(F.lds + PST_OFF);
    if (F.tid == 0) { int acc = 0; for (int e = 0; e < NE; ++e) { const int c = (int)__hip_atomic_load(F.ctl + CW_CNT + 64 * e, RLX_AGENT); pst[e] = acc; acc += (c + 255) & ~255; } pst[NE] = acc; }
    __syncthreads();
}

constexpr int RB = 2;
__device__ __forceinline__ unsigned long long pk4(const f32x4 v) { return (unsigned long long)pk2(v.x, v.y) | ((unsigned long long)pk2(v.z, v.w) << 32); }
__device__ __forceinline__ float rdl(float v, int l) { return __builtin_bit_cast(float, __builtin_amdgcn_readlane(__builtin_bit_cast(int, v), l)); }
template <int H, int K> __device__ __forceinline__ void rs_step(float* a, int lane) {
    const bool up = (lane >> K) & 1;
#pragma unroll
    for (int i = 0; i < H; ++i) { const float keep = up ? a[H + i] : a[i], send = up ? a[i] : a[H + i]; a[i] = keep + __shfl_xor(send, 1 << K); }
}
__device__ __forceinline__ void p5_ln_route(Frame& F) {
    LAS unsigned* hist = (LAS unsigned*)(F.lds + HIST_OFF); LAS unsigned* base = (LAS unsigned*)(F.lds + BASE_OFF);
    LAS int* eidL = (LAS int*)(F.lds + ROWL_OFF); LAS int* rankL = eidL + 256;
    LAS f32x4* wr = (LAS f32x4*)(F.lds + RING_OFF); LAS f32x4* wg = (LAS f32x4*)(F.lds + WGRP_OFF);
    for (int it = F.wave; it < 128; it += NWAVES) { const int j = it >> 5, e = (it >> 3) & 3, ln = (it & 7) * 8 + (F.lane & 7), pc = F.lane >> 3, g = pc >> 1, half = pc & 1, c = 256 * j + 4 * ln + e;
        wr[((((g * 4 + j) * 4 + e) * 2 + half) << 6) + ln] = *(const GAS f32x4*)(F.w_router + (size_t)c * NE + pc * 4); }
    for (int c = F.tid; c < 1024; c += NTHR) { const int ln = (c & 255) >> 2, j = c >> 8, e = c & 3; wg[((j * 4 + e) << 6) + ln] = *(const GAS f32x4*)(F.w_group + (size_t)c * 4); }
    if (F.tid < NE) hist[F.tid] = 0u;
    __syncthreads();
    f32x4 gv[4], bv[4];
#pragma unroll
    for (int j = 0; j < 4; ++j) { gv[j] = *(const GAS f32x4*)(F.ln1g + 4 * F.lane + 256 * j); bv[j] = *(const GAS f32x4*)(F.ln1b + 4 * F.lane + 256 * j); }
    constexpr int R4 = 4;
    for (int r0 = F.wave * R4; r0 < 128; r0 += NWAVES * R4) {
        f32x4 v[R4][4]; float st[2 * R4];
#pragma unroll
        for (int rr = 0; rr < R4; ++rr) { const size_t ro = (size_t)(blockIdx.x * 128 + r0 + rr) * D;
            const GAS f32x4* pr = (const GAS f32x4*)(F.x + ro) + F.lane; const GAS unsigned long long* pm = (const GAS unsigned long long*)(F.mixp + ro) + F.lane;
#pragma unroll
            for (int j = 0; j < 4; ++j) { const f32x4 xv = pr[64 * j]; const unsigned long long mw = pm[64 * j]; const unsigned m0 = (unsigned)mw, m1 = (unsigned)(mw >> 32);
                v[rr][j] = (f32x4){xv.x * ALPHA + BFLO(m0), xv.y * ALPHA + BFHI(m0), xv.z * ALPHA + BFLO(m1), xv.w * ALPHA + BFHI(m1)}; } }
#pragma unroll
        for (int rr = 0; rr < R4; ++rr) { float s = 0.f, q = 0.f;
#pragma unroll
            for (int j = 0; j < 4; ++j) { s += (v[rr][j].x + v[rr][j].y) + (v[rr][j].z + v[rr][j].w); q += (v[rr][j].x * v[rr][j].x + v[rr][j].y * v[rr][j].y) + (v[rr][j].z * v[rr][j].z + v[rr][j].w * v[rr][j].w); }
            st[2 * rr] = s; st[2 * rr + 1] = q; }
        rs_step<4, 5>(st, F.lane); rs_step<2, 4>(st, F.lane); rs_step<1, 3>(st, F.lane);
#pragma unroll
        for (int o = 1; o < 8; o <<= 1) st[0] += __shfl_xor(st[0], o);
        float gl[4 * R4];
#pragma unroll
        for (int i = 0; i < 4 * R4; ++i) gl[i] = 0.f;
#pragma unroll
        for (int rr = 0; rr < R4; ++rr) { const int m = blockIdx.x * 128 + r0 + rr;
            const float sum = rdl(st[0], 16 * rr), sq = rdl(st[0], 16 * rr + 8);
            const float mean = sum * (1.f / D), rstd = 1.f / sqrtf(fmaxf(sq * (1.f / D) - mean * mean, 0.f) + LN_EPS);
            GAS unsigned long long* o8 = (GAS unsigned long long*)(F.hb + (size_t)m * D) + F.lane;
#pragma unroll
            for (int j = 0; j < 4; ++j) { v[rr][j] = (v[rr][j] - mean) * rstd * gv[j] + bv[j]; o8[64 * j] = pk4(v[rr][j]); } }
#pragma unroll
        for (int j = 0; j < 4; ++j)
#pragma unroll
            for (int e = 0; e < 4; ++e) { const f32x4 w = wg[((j * 4 + e) << 6) + F.lane];
#pragma unroll
                for (int rr = 0; rr < R4; ++rr) { const float hv = v[rr][j][e]; gl[4 * rr] += hv * w.x; gl[4 * rr + 1] += hv * w.y; gl[4 * rr + 2] += hv * w.z; gl[4 * rr + 3] += hv * w.w; } }
        rs_step<8, 5>(gl, F.lane); rs_step<4, 4>(gl, F.lane); rs_step<2, 3>(gl, F.lane); rs_step<1, 2>(gl, F.lane);
#pragma unroll
        for (int o = 1; o < 4; o <<= 1) gl[0] += __shfl_xor(gl[0], o);
        int gs[R4]; float gprob[R4]; float el[8 * R4];
#pragma unroll
        for (int rr = 0; rr < R4; ++rr) { float t[4];
#pragma unroll
            for (int i = 0; i < 4; ++i) t[i] = rdl(gl[0], 4 * (4 * rr + i)) + F.b_group[i];
            int g = 0; float gm = t[0];
#pragma unroll
            for (int i = 1; i < 4; ++i) if (t[i] > gm) { gm = t[i]; g = i; }
            gs[rr] = g; float gden = 0.f;
#pragma unroll
            for (int i = 0; i < 4; ++i) gden += expf(t[i] - gm);
            gprob[rr] = 1.f / gden; }
#pragma unroll
        for (int i = 0; i < 8 * R4; ++i) el[i] = 0.f;
#pragma unroll
        for (int j = 0; j < 4; ++j)
#pragma unroll
            for (int e = 0; e < 4; ++e)
#pragma unroll
                for (int rr = 0; rr < R4; ++rr) { const LAS f32x4* wp = wr + ((((gs[rr] * 4 + j) * 4 + e) * 2) << 6) + F.lane; const f32x4 w0 = wp[0], w1 = wp[64]; const float hv = v[rr][j][e];
                    el[8 * rr + 0] += hv * w0.x; el[8 * rr + 1] += hv * w0.y; el[8 * rr + 2] += hv * w0.z; el[8 * rr + 3] += hv * w0.w;
                    el[8 * rr + 4] += hv * w1.x; el[8 * rr + 5] += hv * w1.y; el[8 * rr + 6] += hv * w1.z; el[8 * rr + 7] += hv * w1.w; }
        rs_step<16, 5>(el, F.lane); rs_step<8, 4>(el, F.lane); rs_step<4, 3>(el, F.lane); rs_step<2, 2>(el, F.lane); rs_step<1, 1>(el, F.lane);
        el[0] += __shfl_xor(el[0], 1);
#pragma unroll
        for (int rr = 0; rr < R4; ++rr) { const int r = r0 + rr, m = blockIdx.x * 128 + r; float t[8];
#pragma unroll
            for (int i = 0; i < 8; ++i) t[i] = rdl(el[0], 2 * (8 * rr + i)) + F.b_router[gs[rr] * EPG + i];
            int i1 = 0; float v1 = t[0];
#pragma unroll
            for (int i = 1; i < 8; ++i) if (t[i] > v1) { v1 = t[i]; i1 = i; }
            int i2 = (i1 == 0) ? 1 : 0; float v2 = (i1 == 0) ? t[1] : t[0];
#pragma unroll
            for (int i = 1; i < 8; ++i) if (i != i1 && t[i] > v2) { v2 = t[i]; i2 = i; }
            const float e2 = expf(v2 - v1), g1 = 1.f / (1.f + e2), g2 = e2 * g1;
            if (F.lane == 0) {
                const int ea = gs[rr] * EPG + i1, eb = gs[rr] * EPG + i2;
                const unsigned ra = __hip_atomic_fetch_add(hist + ea, 1u, __ATOMIC_RELAXED, __HIP_MEMORY_SCOPE_WORKGROUP);
                const unsigned rb = __hip_atomic_fetch_add(hist + eb, 1u, __ATOMIC_RELAXED, __HIP_MEMORY_SCOPE_WORKGROUP);
                eidL[r * 2] = ea; eidL[r * 2 + 1] = eb; rankL[r * 2] = (int)ra; rankL[r * 2 + 1] = (int)rb;
                F.eid[m * 2] = ea; F.eid[m * 2 + 1] = eb; F.gatev[m * 2] = g1 * gprob[rr]; F.gatev[m * 2 + 1] = g2 * gprob[rr];
            } }
    }
    __syncthreads();
    if (F.tid < NE) base[F.tid] = __hip_atomic_fetch_add(F.ctl + CW_CNT + 64 * F.tid, hist[F.tid], RLX_AGENT);
    __syncthreads();
    if (F.tid < 256) F.rank[blockIdx.x * 256 + F.tid] = rankL[F.tid] + (int)base[eidL[F.tid]];
}
__device__ __forceinline__ void p6_slots_gather(Frame& F) {
    build_pstart(F);
    const LAS int* pst = (const LAS int*)(F.lds + PST_OFF);
    for (int r0 = F.wave * 4; r0 < 128; r0 += NWAVES * 4) {
        v4u a[4], b[4]; int s0[4], s1[4];
#pragma unroll
        for (int rr = 0; rr < 4; ++rr) { const int m = blockIdx.x * 128 + r0 + rr; int s = 0;
            if (F.lane < 2) { const int e = F.eid[m * 2 + F.lane]; s = pst[e] + F.rank[m * 2 + F.lane]; F.slot[m * 2 + F.lane] = s; F.gslot[s] = F.gatev[m * 2 + F.lane]; }
            s0[rr] = __shfl(s, 0); s1[rr] = __shfl(s, 1);
            const GAS v4u* src = (const GAS v4u*)(F.hb + (size_t)m * D); a[rr] = src[F.lane]; b[rr] = src[F.lane + 64]; }
#pragma unroll
        for (int rr = 0; rr < 4; ++rr) { GAS v4u* d0 = (GAS v4u*)(F.xs + (size_t)s0[rr] * D); GAS v4u* d1 = (GAS v4u*)(F.xs + (size_t)s1[rr] * D);
            d0[F.lane] = a[rr]; d0[F.lane + 64] = b[rr]; d1[F.lane] = a[rr]; d1[F.lane + 64] = b[rr]; }
    }
}
__device__ __forceinline__ void p9_final(Frame& F, bool poison) {
    f32x4 gv[4], bv[4];
#pragma unroll
    for (int j = 0; j < 4; ++j) { gv[j] = *(const GAS f32x4*)(F.ln2g + 4 * F.lane + 256 * j); bv[j] = *(const GAS f32x4*)(F.ln2b + 4 * F.lane + 256 * j); }
    const int gw = blockIdx.x * NWAVES + F.wave, NGW = F.G * NWAVES; const float qn = __builtin_nanf("");
    for (int m0 = gw * RB; m0 < M; m0 += NGW * RB) {
        f32x4 v[RB][4]; float mean[RB], rstd[RB];
#pragma unroll
        for (int rr = 0; rr < RB; ++rr) { const int m = m0 + rr; const int s0 = F.slot[2 * m], s1 = F.slot[2 * m + 1];
            const GAS unsigned long long* ph = (const GAS unsigned long long*)(F.hb + (size_t)m * D) + F.lane;
            const GAS unsigned long long* pp = (const GAS unsigned long long*)(F.pple + (size_t)m * D) + F.lane;
            const GAS unsigned long long* y0 = (const GAS unsigned long long*)(F.y + (size_t)s0 * D) + F.lane; const GAS unsigned long long* y1 = (const GAS unsigned long long*)(F.y + (size_t)s1 * D) + F.lane;
#pragma unroll
            for (int j = 0; j < 4; ++j) { const unsigned long long hw = ph[64 * j], pw = pp[64 * j], aw = y0[64 * j], bw = y1[64 * j];
                const unsigned h0 = (unsigned)hw, h1 = (unsigned)(hw >> 32), p0 = (unsigned)pw, p1 = (unsigned)(pw >> 32), a0 = (unsigned)aw, a1 = (unsigned)(aw >> 32), b0 = (unsigned)bw, b1 = (unsigned)(bw >> 32);
                f32x4 t;
                t.x = BFLO(h0) * ALPHA + BFLO(p0) + (BFLO(a0) + BFLO(b0)); t.y = BFHI(h0) * ALPHA + BFHI(p0) + (BFHI(a0) + BFHI(b0));
                t.z = BFLO(h1) * ALPHA + BFLO(p1) + (BFLO(a1) + BFLO(b1)); t.w = BFHI(h1) * ALPHA + BFHI(p1) + (BFHI(a1) + BFHI(b1));
                v[rr][j] = t; } }
#pragma unroll
        for (int rr = 0; rr < RB; ++rr) { float s = 0.f;
#pragma unroll
            for (int j = 0; j < 4; ++j) s += (v[rr][j].x + v[rr][j].y) + (v[rr][j].z + v[rr][j].w);
            mean[rr] = s; }
#pragma unroll
        for (int o = 1; o < 64; o <<= 1)
#pragma unroll
            for (int rr = 0; rr < RB; ++rr) mean[rr] += __shfl_xor(mean[rr], o);
#pragma unroll
        for (int rr = 0; rr < RB; ++rr) { mean[rr] *= (1.f / D); float s2 = 0.f;
#pragma unroll
            for (int j = 0; j < 4; ++j) { v[rr][j] = v[rr][j] - mean[rr]; s2 += (v[rr][j].x * v[rr][j].x + v[rr][j].y * v[rr][j].y) + (v[rr][j].z * v[rr][j].z + v[rr][j].w * v[rr][j].w); }
            rstd[rr] = s2; }
#pragma unroll
        for (int o = 1; o < 64; o <<= 1)
#pragma unroll
            for (int rr = 0; rr < RB; ++rr) rstd[rr] += __shfl_xor(rstd[rr], o);
#pragma unroll
        for (int rr = 0; rr < RB; ++rr) { const float rs = 1.f / sqrtf(rstd[rr] * (1.f / D) + LN_EPS); GAS f32x4* pr = (GAS f32x4*)(F.out + (size_t)(m0 + rr) * D) + F.lane;
#pragma unroll
            for (int j = 0; j < 4; ++j) { f32x4 o = v[rr][j] * rs * gv[j] + bv[j]; if (poison) o = (f32x4){qn, qn, qn, qn}; pr[64 * j] = o; } }
    }
}


namespace att {
typedef float f32x16 __attribute__((ext_vector_type(16)));
typedef short s16x4 __attribute__((ext_vector_type(4)));
typedef short v4i16_t __attribute__((ext_vector_type(4)));
constexpr int NSLOT = 5, BUFB = 16384 + 512, A_WS = NSLOT * BUFB, A_FLAG = A_WS + 2048, A_CAR = A_FLAG + 64, A_END = A_CAR + 64;
constexpr float STOP2 = -40.f;
__device__ __forceinline__ int crow(int r, int hi) { return (r & 3) + 8 * (r >> 2) + 4 * hi; }
__device__ __forceinline__ unsigned cvtpk(float lo, float hi) { typedef float f2 __attribute__((ext_vector_type(2))); typedef __bf16 b2 __attribute__((ext_vector_type(2))); f2 v = {lo, hi}; b2 b = __builtin_convertvector(v, b2); return __builtin_bit_cast(unsigned, b); }

template <int MODE> __device__ __forceinline__ void attn_unit(Frame& F, int bh, int qb) {
    const int tid = F.tid, lane = F.lane, r32 = lane & 31, hi = lane >> 5, wid = F.wave;
    const int b = bh >> 3, h = bh & 7;
    const bf16* Qg = F.qkv + (size_t)(MODE ? 3 : 0) * M * HW; const bf16* Kg = F.qkv + (size_t)(MODE ? 4 : 1) * M * HW; const bf16* Vg = F.qkv + (size_t)(MODE ? 5 : 2) * M * HW;
    const size_t rowbase = (size_t)b * SEQ; const int q0 = qb * 256;
    const bf16* Qw = Qg + (rowbase + q0 + wid * 32) * HW + h * HD;
    const bf16* Kh = Kg + rowbase * HW + h * HD; const bf16* Vh = Vg + rowbase * HW + h * HD;
    LAS unsigned char* L = F.lds + RING_OFF;
    LAS float* wsf = (LAS float*)(L + A_WS) + wid * 64;
    LAS unsigned* flg = (LAS unsigned*)(L + A_FLAG);
    LAS float* car = (LAS float*)(L + A_CAR);
    const int jt = (q0 >> 6) + 3, jw = (q0 >> 6) + (wid >> 1);
    const bf16* ksrc = Kh + (size_t)lane * HW + wid * 8;
    const bf16* vsrc = Vh + (size_t)(16 * (wid & 3) + (lane >> 2)) * HW + (wid >> 2) * 32 + (lane & 3) * 8;
    const int kdst = wid * 1024 + lane * 16, vdst = 8192 + wid * 1024 + lane * 16;
    const float* cfsrc = F.cfl + (size_t)bh * SEQ + tid * 4;
    float KNu = 0.f;
    if (MODE) {
        if (tid < 8) { float c = 0.f; for (int k = 0; k < tid; ++k) c += F.ctot[bh * 8 + k]; car[tid] = c; }
        float kn = (lane <= jt) ? F.knt[bh * 128 + lane] : 0.f; if (lane + 64 <= jt) kn = fmaxf(kn, F.knt[bh * 128 + lane + 64]);
        KNu = wave_max(kn);
    }
    bf16x8 qr[4];
#pragma unroll
    for (int d0 = 0; d0 < 4; ++d0) qr[d0] = *(const GAS bf16x8*)(Qw + (size_t)r32 * HW + d0 * 16 + hi * 8);
    __syncthreads();
    v4u kreg[2], vreg[2]; f32x4 cfreg[2]; cfreg[0] = (f32x4){0.f, 0.f, 0.f, 0.f}; cfreg[1] = cfreg[0];
#pragma unroll
    for (int k = 0; k < 4; ++k) { const int t = jt - k, so = (t % NSLOT) * BUFB;
        const v4u kk = *(const GAS v4u*)(ksrc + (size_t)t * 64 * HW), vv = *(const GAS v4u*)(vsrc + (size_t)t * 64 * HW);
        *(LAS v4u*)(L + so + kdst) = kk; *(LAS v4u*)(L + so + vdst) = vv;
        if (MODE && tid < 16) { f32x4 cc = *(const GAS f32x4*)(cfsrc + t * 64); const float c = car[t >> 4]; cc = -(cc + c); *(LAS f32x4*)(L + so + 16384 + tid * 16) = cc; } }
    if (jt >= 4) { kreg[1] = *(const GAS v4u*)(ksrc + (size_t)(jt - 4) * 64 * HW); vreg[1] = *(const GAS v4u*)(vsrc + (size_t)(jt - 4) * 64 * HW);
        if (MODE && tid < 16) cfreg[1] = *(const GAS f32x4*)(cfsrc + (jt - 4) * 64); }
    float qnb = 0.f;
    if (MODE) {
        float n2 = 0.f;
#pragma unroll
        for (int d0 = 0; d0 < 4; ++d0)
#pragma unroll
            for (int e = 0; e < 8; ++e) { const float qv = __builtin_bit_cast(float, (unsigned)(unsigned short)qr[d0][e] << 16); n2 += qv * qv; }
        n2 += __shfl_xor(n2, 32);
        qnb = sqrtf(n2) * KNu * 1.01f;
    }
    __syncthreads();
    f32x16 o[2]; o[0] = f32x16{}; o[1] = f32x16{};
    float C2 = 0.f, mhat = -1e30f, lsum = 0.f;
    bool wdone = false;
    const LAS unsigned char* vb0 = L + 8192 + ((lane >> 4) & 1) * 32 + (lane & 3) * 8 + (4 * hi + ((lane & 15) >> 2)) * 64;
    int i = 0, sw = (jw % NSLOT) * BUFB;
    for (;;) {
#pragma unroll
    for (int ph = 0; ph < 2; ++ph) {
        const int j = jw - i;
        { const int tl = jt - 5 - i;
          if (tl >= 0) { kreg[ph] = *(const GAS v4u*)(ksrc + (size_t)tl * 64 * HW); vreg[ph] = *(const GAS v4u*)(vsrc + (size_t)tl * 64 * HW);
              if (MODE && tid < 16) cfreg[ph] = *(const GAS f32x4*)(cfsrc + tl * 64); } }
        if (!wdone && j >= 0) {
            const LAS unsigned char* Kb = L + sw;
            f32x16 p0 = f32x16{}, p1 = f32x16{};
            if (MODE) {
                const LAS float* cfp = (const LAS float*)(Kb + 16384);
#pragma unroll
                for (int g = 0; g < 4; ++g) { const f32x4 c0 = *(const LAS f32x4*)(cfp + 8 * g + 4 * hi), c1 = *(const LAS f32x4*)(cfp + 32 + 8 * g + 4 * hi);
#pragma unroll
                    for (int e = 0; e < 4; ++e) { p0[4 * g + e] = c0[e]; p1[4 * g + e] = c1[e]; } }
            }
            { const LAS unsigned char* kb = Kb + hi * 1024 + r32 * 16;
#pragma unroll
              for (int d0 = 0; d0 < 4; ++d0) { const bf16x8 b0 = *(const LAS bf16x8*)(kb + d0 * 2048), b1 = *(const LAS bf16x8*)(kb + d0 * 2048 + 512);
                  p0 = __builtin_amdgcn_mfma_f32_32x32x16_bf16(b0, qr[d0], p0, 0, 0, 0); p1 = __builtin_amdgcn_mfma_f32_32x32x16_bf16(b1, qr[d0], p1, 0, 0, 0); } }
            const bool diag = (i == 0); const int qrel = 32 * (wid & 1) + r32;
            if (MODE == 0) {
                float Lg[32];
#pragma unroll
                for (int r = 0; r < 16; ++r) {
                    const float z0 = p0[r], z1 = p1[r];
                    Lg[r] = -(fmaxf(z0, 0.f) + __builtin_amdgcn_logf(1.f + __builtin_amdgcn_exp2f(-fabsf(z0))));
                    Lg[16 + r] = -(fmaxf(z1, 0.f) + __builtin_amdgcn_logf(1.f + __builtin_amdgcn_exp2f(-fabsf(z1))));
                }
                if (diag) {
                    asm volatile("" ::: "memory");
#pragma unroll
                    for (int r = 0; r < 16; ++r) { Lg[r] = (crow(r, hi) >= qrel) ? 0.f : Lg[r]; Lg[16 + r] = (crow(r, hi) + 32 >= qrel) ? 0.f : Lg[16 + r]; } }
                float Os[8], Ps[8];
#pragma unroll
                for (int i = 0; i < 8; ++i) { Os[i] = (Lg[4 * i] + Lg[4 * i + 1]) + (Lg[4 * i + 2] + Lg[4 * i + 3]); Ps[i] = __shfl_xor(Os[i], 32); }
                float T = 0.f;
#pragma unroll
                for (int i = 7; i >= 0; --i) {
                    float s = T + (hi ? 0.f : Ps[i]) + C2;
#pragma unroll
                    for (int e = 3; e >= 0; --e) { s += Lg[4 * i + e]; const int r = (4 * i + e) & 15; const float zz = (i < 4) ? p0[r] : p1[r];
                        const float w = __builtin_amdgcn_exp2f(zz + s);
                        if (i < 4) p0[r] = w; else p1[r] = w; }
                    T += Os[i] + Ps[i];
                }
                if (diag) {
                    asm volatile("" ::: "memory");
#pragma unroll
                    for (int r = 0; r < 16; ++r) { p0[r] = (crow(r, hi) >= qrel) ? 0.f : p0[r]; p1[r] = (crow(r, hi) + 32 >= qrel) ? 0.f : p1[r]; } }
                C2 += T;
                wdone = __all(C2 < STOP2);
            } else {
                const LAS float* cfp = (const LAS float*)(Kb + 16384);
                if (diag) {
                    asm volatile("" ::: "memory");
#pragma unroll
                    for (int r = 0; r < 16; ++r) { p0[r] = (crow(r, hi) > qrel) ? -INFINITY : p0[r]; p1[r] = (crow(r, hi) + 32 > qrel) ? -INFINITY : p1[r]; } }
#define ATT_MX3(a, b, c) __builtin_fmaxf(__builtin_fmaxf((a), (b)), (c))
                float ra = ATT_MX3(p0[0], p0[1], p1[0]), rb = ATT_MX3(p0[2], p0[3], p1[1]); ra = ATT_MX3(ra, p1[2], p1[3]);
#pragma unroll
                for (int r = 4; r < 16; r += 4) { ra = ATT_MX3(ra, p0[r], p0[r + 1]); rb = ATT_MX3(rb, p0[r + 2], p0[r + 3]); ra = ATT_MX3(ra, p1[r], p1[r + 1]); rb = ATT_MX3(rb, p1[r + 2], p1[r + 3]); }
#undef ATT_MX3
                float rm = fmaxf(ra, rb); rm = fmaxf(rm, __shfl_xor(rm, 32));
                const float mnew = fmaxf(mhat, rm);
                if (__any(mnew > mhat)) {
                    const float f = __builtin_amdgcn_exp2f(mhat - mnew); lsum *= f;
                    if (hi == 0) wsf[r32] = f;
                    asm volatile("s_waitcnt lgkmcnt(0)" ::: "memory");
#pragma unroll
                    for (int r = 0; r < 16; ++r) { const float fr = wsf[crow(r, hi)]; o[0][r] *= fr; o[1][r] *= fr; }
                    mhat = mnew;
                }
                typedef float f32x2 __attribute__((ext_vector_type(2)));
                const f32x2 nm2 = {-mhat, -mhat}; f32x2 sa = {0.f, 0.f}, sb = {0.f, 0.f};
#pragma unroll
                for (int r = 0; r < 16; r += 2) { f32x2 t0 = (f32x2){p0[r], p0[r + 1]} + nm2, t1 = (f32x2){p1[r], p1[r + 1]} + nm2;
                    t0.x = __builtin_amdgcn_exp2f(t0.x); t0.y = __builtin_amdgcn_exp2f(t0.y); t1.x = __builtin_amdgcn_exp2f(t1.x); t1.y = __builtin_amdgcn_exp2f(t1.y);
                    sa += t0; sb += t1; p0[r] = t0.x; p0[r + 1] = t0.y; p1[r] = t1.x; p1[r + 1] = t1.y; }
                sa += sb; lsum += sa.x + sa.y;
                const float n00 = cfp[0];
                wdone = __all(qnb + n00 - mhat < STOP2);
            }
            v4u pw0, pw1, pw2, pw3;
#pragma unroll
            for (int e = 0; e < 4; ++e) { pw0[e] = cvtpk(p0[2 * e], p0[2 * e + 1]); pw1[e] = cvtpk(p0[8 + 2 * e], p0[8 + 2 * e + 1]); pw2[e] = cvtpk(p1[2 * e], p1[2 * e + 1]); pw3[e] = cvtpk(p1[8 + 2 * e], p1[8 + 2 * e + 1]); }
            const LAS unsigned char* vb = vb0 + sw;
#pragma unroll
            for (int d0 = 0; d0 < 2; ++d0) { s16x4 lo[4], hh[4];
#pragma unroll
                for (int ks = 0; ks < 4; ++ks) {
                    lo[ks] = __builtin_bit_cast(s16x4, __builtin_amdgcn_ds_read_tr16_b64_v4i16((LAS v4i16_t*)(vb + d0 * 4096 + ks * 1024)));
                    hh[ks] = __builtin_bit_cast(s16x4, __builtin_amdgcn_ds_read_tr16_b64_v4i16((LAS v4i16_t*)(vb + d0 * 4096 + ks * 1024 + 512))); }
#define ATT_PK(k) (bf16x8){lo[k][0], lo[k][1], lo[k][2], lo[k][3], hh[k][0], hh[k][1], hh[k][2], hh[k][3]}
                o[d0] = __builtin_amdgcn_mfma_f32_32x32x16_bf16(__builtin_bit_cast(bf16x8, pw0), ATT_PK(0), o[d0], 0, 0, 0);
                o[d0] = __builtin_amdgcn_mfma_f32_32x32x16_bf16(__builtin_bit_cast(bf16x8, pw1), ATT_PK(1), o[d0], 0, 0, 0);
                o[d0] = __builtin_amdgcn_mfma_f32_32x32x16_bf16(__builtin_bit_cast(bf16x8, pw2), ATT_PK(2), o[d0], 0, 0, 0);
                o[d0] = __builtin_amdgcn_mfma_f32_32x32x16_bf16(__builtin_bit_cast(bf16x8, pw3), ATT_PK(3), o[d0], 0, 0, 0);
#undef ATT_PK
            }
        }
        { const int ts = jt - 4 - i;
          if (ts >= 0) { const int nb = (ts % NSLOT) * BUFB;
              if (MODE && tid < 16) { const float c = car[ts >> 4]; cfreg[ph ^ 1] = -(cfreg[ph ^ 1] + c); *(LAS f32x4*)(L + nb + 16384 + tid * 16) = cfreg[ph ^ 1]; }
              *(LAS v4u*)(L + nb + kdst) = kreg[ph ^ 1]; *(LAS v4u*)(L + nb + vdst) = vreg[ph ^ 1]; } }
        if (lane == 0) flg[ph * 8 + wid] = (wdone || j <= 0) ? 1u : 0u;
        __syncthreads();
        { unsigned alld = 1u;
#pragma unroll
          for (int w = 0; w < 8; ++w) alld &= flg[ph * 8 + w];
          if (alld) goto att_done; }
        ++i; sw = (sw == 0) ? (NSLOT - 1) * BUFB : sw - BUFB;
    }
    }
att_done:
    float rli[16];
    if (MODE) {
        lsum += __shfl_xor(lsum, 32);
        if (hi == 0) wsf[r32] = lsum;
        asm volatile("s_waitcnt lgkmcnt(0)" ::: "memory");
#pragma unroll
        for (int r = 0; r < 16; ++r) rli[r] = 1.f / wsf[crow(r, hi)];
    } else {
#pragma unroll
        for (int r = 0; r < 16; ++r) rli[r] = 1.f;
    }
    bf16* Ow = F.mixed + (rowbase + q0 + wid * 32) * D + (MODE ? HW : 0) + h * HD;
#pragma unroll
    for (int r = 0; r < 16; ++r) {
        bf16* rowp = Ow + (size_t)crow(r, hi) * D + r32;
        rowp[0] = (bf16)f2bf(o[0][r] * rli[r]); rowp[32] = (bf16)f2bf(o[1][r] * rli[r]);
    }
}
}

template <int MODE> __device__ __forceinline__ void p3_attn_fast(Frame& F) {
    for (int i = 3; i >= 0; --i) { const int id = (int)blockIdx.x + F.G * i; if (id < 1024) att::attn_unit<MODE>(F, id & 31, id >> 5); }
}

struct Args { const float* in[18]; float* out; unsigned char* ws; int ph_lo, ph_hi; };
__global__ void __launch_bounds__(NTHR, 2) mk_fwd(Args args) {
    extern __shared__ __attribute__((aligned(16))) unsigned char lds[];
    Frame F;
    F.lds = (LAS unsigned char*)lds; F.MISC = (volatile LAS unsigned*)(F.lds + MISC_OFF);
    F.tid = threadIdx.x; F.lane = F.tid & 63; F.wave = __builtin_amdgcn_readfirstlane(F.tid >> 6);
    F.G = gridDim.x; { const int bx = blockIdx.x; F.vcu = (F.G % 8 == 0) ? (bx % 8) * (F.G / 8) + bx / 8 : bx; }
    unsigned char* ws = args.ws;
    F.ctl = (gu32*)(ws + WS_CTL);
    F.x = args.in[0]; F.p = args.in[1]; F.w_in = args.in[2]; F.b_forget = args.in[3]; F.w_out = args.in[4]; F.ln1g = args.in[5]; F.ln1b = args.in[6]; F.w_group = args.in[7]; F.b_group = args.in[8];
    F.w_router = args.in[9]; F.b_router = args.in[10]; F.w_gate = args.in[11]; F.w_up = args.in[12]; F.w_down = args.in[13]; F.w_ple = args.in[14]; F.w_pg = args.in[15]; F.ln2g = args.in[16]; F.ln2b = args.in[17];
    F.out = args.out;
    F.Win_t = (bf16*)(ws + WS_WIN); F.Wout_t = (bf16*)(ws + WS_WOUT); F.Wple_t = (bf16*)(ws + WS_WPLE); F.Wpg_t = (bf16*)(ws + WS_WPG); F.Wgu_t = (bf16*)(ws + WS_WGU); F.Wd_t = (bf16*)(ws + WS_WD);
    F.pple = (bf16*)(ws + WS_PPLE); F.qkv = (bf16*)(ws + WS_R1); F.xs = (bf16*)(ws + WS_R1); F.y = (bf16*)(ws + WS_R1);
    F.xb = (bf16*)(ws + WS_R2); F.mixed = (bf16*)(ws + WS_R2); F.hb = (bf16*)(ws + WS_R2); F.pb = (bf16*)(ws + WS_R3); F.hdn = (bf16*)(ws + WS_R3); F.mixp = (bf16*)(ws + WS_R3);
    F.ls = (float*)(ws + WS_LS); F.cfl = (float*)(ws + WS_CFL); F.ctot = (float*)(ws + WS_CTOT); F.knt = (float*)(ws + WS_KNT); F.gatev = (float*)(ws + WS_GATE); F.gslot = (float*)(ws + WS_GSLOT);
    F.eid = (int*)(ws + WS_EID); F.rank = (int*)(ws + WS_RANK); F.slot = (int*)(ws + WS_SLOT); F.tokslot = (int*)(ws + WS_TOKSLOT);
    for (int u = F.tid; u < (LDS_BYTES - LDSCTL_OFF) / 4; u += NTHR) ((LAS unsigned*)(F.lds + LDSCTL_OFF))[u] = 0u;
    __syncthreads();
    XcdBarrier bar = xcd_barrier_post((unsigned*)(F.ctl + CW_BAR), F.MISC + 8);
    const int lo = args.ph_lo, hi = args.ph_hi;
#ifndef PH_MASK
#define PH_MASK 0x3ff
#endif
#define IN(k) (((PH_MASK >> (k)) & 1) && lo <= (k) && (k) < hi)
#ifndef PROBE_PH
#define PROBE_PH -1
#endif
    unsigned long long pt0_ = (PROBE_PH == 0) ? rt() : 0ull, pt1_ = 0ull;
#define SEAM(k) do { if (IN(k) && IN((k) + 1)) xcd_barrier(bar); if ((k) == PROBE_PH) pt1_ = rt(); if ((k) + 1 == PROBE_PH) pt0_ = rt(); } while (0)

#ifndef REPEAT_PH
#define REPEAT_PH -1
#endif
#define REP(k) _Pragma("unroll") for (int rep_ = 0; rep_ < ((k) == REPEAT_PH ? 2 : 1); ++rep_)
#define PSTAMP(id, body) do { if (PROBE_PH == (id)) { __syncthreads(); pt0_ = rt(); } body; if (PROBE_PH == (id)) { __syncthreads(); pt1_ = rt(); } } while (0)
    if (IN(0)) { PSTAMP(100, p0_prologue<0>(F)); PSTAMP(101, p0_prologue<1>(F)); PSTAMP(102, p0_prologue<2>(F)); }
    SEAM(0);

    if (IN(1)) {
        { pg8::Gemm g{F.xb, F.Win_t, M, NPROJ, D}; pg8::StaticOrder S; S.init(M, NPROJ, F.G, (int)blockIdx.x);
          pg8::EpiBf16<0> E{F.qkv, HW, nullptr, HW, (size_t)M * HW, 1.f};
          pg8::gemm_phase<pg8::EpiBf16<0>, pg8::StaticOrder, true, true>(F.lds + RING_OFF, g, S, E); }
        { pg8::Gemm g{F.pb, F.Wple_t, M, D, PLED}; pg8::StaticOrder S; S.init(M, D, F.G, (int)blockIdx.x);
          pg8::EpiBf16<0> E{F.pple, D, nullptr, 0, 0, 1.f};
          pg8::gemm_phase<pg8::EpiBf16<0>, pg8::StaticOrder, true, true>(F.lds + RING_OFF, g, S, E); }
    } SEAM(1);

    if (IN(2)) { p2_scan(F); } SEAM(2);

#if ATT_FAST
#ifndef ATT_ONLY
#define ATT_ONLY 3
#endif
    if (IN(3)) { if (ATT_ONLY & 1) PSTAMP(131, p3_attn_fast<1>(F)); if (ATT_ONLY & 2) PSTAMP(132, p3_attn_fast<0>(F)); }
    SEAM(3);
#else
    if (IN(3)) { p3_attn_simple(F); } SEAM(3);
#endif

    if (IN(4)) {
        pg8::Gemm g{F.mixed, F.Wout_t, M, D, D}; pg8::StaticOrder S; S.init(M, D, F.G, (int)blockIdx.x);
        pg8::EpiBf16<0> E{F.mixp, D, nullptr, 0, 0, 1.f};
        pg8::gemm_phase<pg8::EpiBf16<0>, pg8::StaticOrder, true, true>(F.lds + RING_OFF, g, S, E);
    } SEAM(4);

    if (IN(5)) { p5_ln_route(F); } SEAM(5);

    if (IN(6)) {
        build_pstart(F);
        { pg8::Gemm g{F.hb, F.Wpg_t, M, D, D}; pg8::StaticOrder S; S.init(M, D, F.G, (int)blockIdx.x);
          pg8::EpiPle E{F.pple, F.eid, F.rank, F.gatev, F.slot, F.gslot, F.tokslot, (const LAS int*)(F.lds + PST_OFF)};
          pg8::gemm_phase<pg8::EpiPle, pg8::StaticOrder, true, true>(F.lds + RING_OFF, g, S, E); }
    } SEAM(6);

    if (IN(7)) {
        build_pstart(F);
        const LAS int* pst = (const LAS int*)(F.lds + PST_OFF);
        pg8::Gemm g{F.hb, F.Wgu_t, SPAD, NE * 1024, D}; MoeOrder S{pst, (pst[NE] >> 8) * 4, F.G, (int)blockIdx.x};
        pg8::EpiSwiglu E{F.hdn, F.gslot};
        LAS int* rml = (LAS int*)(F.lds + ROWL_OFF);
        { pg8::Unit u; for (int ui = 0; ui < 8 && S.next(ui, u); ++ui) if (F.tid < 256) rml[ui * 256 + F.tid] = F.tokslot[u.pm * 256 + F.tid]; }
        __syncthreads();
        pg8::gemm_phase_g<pg8::EpiSwiglu, MoeOrder, true, true>(F.lds + RING_OFF, g, S, E, rml);
    } SEAM(7);

    if (IN(8)) {
        build_pstart(F);
        const LAS int* pst = (const LAS int*)(F.lds + PST_OFF);
        pg8::Gemm g{F.hdn, F.Wd_t, SPAD, NE * 1024, DF}; MoeOrder S{pst, (pst[NE] >> 8) * 4, F.G, (int)blockIdx.x};
        pg8::EpiBf16<0> E{F.y, D, nullptr, 1024, 0, 1.f};
        pg8::gemm_phase<pg8::EpiBf16<0>, MoeOrder, true, true>(F.lds + RING_OFF, g, S, E);
    } SEAM(8);

    if (IN(9)) {
        const bool poison = __hip_atomic_load((gu32*)((unsigned*)(F.ctl + CW_BAR) + XB_TMO), RLX_AGENT) != 0u || F.G != 256;
        p9_final(F, poison);
    }
    if (PROBE_PH >= 0 && blockIdx.x == 0) {
        const unsigned long long now = rt(); if (PROBE_PH == NPH - 1) pt1_ = now;
        const unsigned long long dur = pt1_ - pt0_;
        if (F.tid == 0) while (rt() - now < 4ull * dur) __builtin_amdgcn_s_sleep(8);
        __syncthreads();
    }
#undef IN
#undef SEAM
}

#ifndef MK_CUTS
#define MK_CUTS 0
#endif
extern "C" void kernel_launch(void* const* d_in, const int* in_sizes, int n_in, void* d_out, int out_size, void* d_ws, size_t ws_size, hipStream_t stream) {
    static int grid = 0;
    if (grid == 0) {
        if (n_in != 18 || in_sizes[0] != M * D || out_size != M * D || ws_size < WS_END) { fprintf(stderr, "kernel_launch: shape/workspace mismatch (n_in %d, in0 %d, out %d, ws %zu)\n", n_in, n_in > 0 ? in_sizes[0] : -1, out_size, ws_size); grid = -1; return; }
        int dev = 0, cus = 0, per_cu = 0;
        if (hipGetDevice(&dev) != hipSuccess || hipDeviceGetAttribute(&cus, hipDeviceAttributeMultiprocessorCount, dev) != hipSuccess) { grid = -1; return; }
        if (hipFuncSetAttribute((const void*)mk_fwd, hipFuncAttributeMaxDynamicSharedMemorySize, LDS_BYTES) != hipSuccess) { fprintf(stderr, "kernel_launch: hipFuncSetAttribute failed\n"); grid = -1; return; }
        if (hipOccupancyMaxActiveBlocksPerMultiprocessor(&per_cu, (const void*)mk_fwd, NTHR, LDS_BYTES) != hipSuccess || per_cu < 1) fprintf(stderr, "kernel_launch: occupancy query reports %d\n", per_cu);
        (void)hipGetLastError();
        grid = cus;
        if (grid != 256) fprintf(stderr, "kernel_launch: %d CUs; this kernel is built for 256\n", grid);
    }
    if (grid < 0) return;
    if (hipMemsetAsync((char*)d_ws + WS_CTL, 0, CTL_ZERO_BYTES, stream) != hipSuccess) return;
    Args a{};
    for (int i = 0; i < 18; ++i) a.in[i] = (const float*)d_in[i];
    a.out = (float*)d_out; a.ws = (unsigned char*)d_ws;
#if MK_CUTS
    for (int ph = 0; ph < NPH; ++ph) { a.ph_lo = ph; a.ph_hi = ph + 1; hipLaunchKernelGGL(mk_fwd, dim3(grid), dim3(NTHR), LDS_BYTES, stream, a); }
#else
    a.ph_lo = 0; a.ph_hi = NPH;
    hipLaunchKernelGGL(mk_fwd, dim3(grid), dim3(NTHR), LDS_BYTES, stream, a);
#endif
}
```
